# Optimizing an MI355X kernel written in HIP

```python
import jax, jax.numpy as jnp
from jax import lax
import numpy as np

D_MODEL = 1024
BATCH = 16
SEQ = 4096
DEPTH = 1

GLA_HEADS = 4
GLA_DK = 64
GLA_DV = 128
GLA_KEY_W = GLA_HEADS * GLA_DK
GLA_VAL_W = GLA_HEADS * GLA_DV
GLA_GATE_RANK = 16
GLA_GATE_NORMALIZER = 16.0
GLA_CHUNK = 64
POOL_GROUPS = 4
POOL_WINDOWS = (2, 4, 8, 16)
POOL_W = D_MODEL // 2
POOL_GW = POOL_W // POOL_GROUPS
IN_WIDTHS = (GLA_KEY_W, GLA_KEY_W, GLA_VAL_W, GLA_VAL_W, GLA_GATE_RANK, POOL_W, D_MODEL, D_MODEL)
D_IN = sum(IN_WIDTHS)
N_GROUPS = 4
EXPERTS_PER_GROUP = 8
N_EXPERTS = N_GROUPS * EXPERTS_PER_GROUP
TOP_K_IN_GROUP = 2
D_EXPERT = 256
MOE_BLOCK = 128
NORM_EPS = 1e-6

kernel_name = "hybrid_gla_pool_hmoe_block"


def rmsnorm(x, g):
    xf = x.astype(jnp.float32)
    y = xf * lax.rsqrt(jnp.mean(xf * xf, axis=-1, keepdims=True) + NORM_EPS)
    return (y * g.astype(jnp.float32)).astype(x.dtype)


def gla_mix(q, k, v, log_a):
    B, S, _ = q.shape
    C = GLA_CHUNK
    N = S // C

    def split(t, d):
        return t.astype(jnp.float32).reshape(B, N, C, GLA_HEADS, d).transpose(0, 3, 1, 2, 4)

    qc, kc, gc = split(q, GLA_DK), split(k, GLA_DK), split(log_a, GLA_DK)
    vc = split(v, GLA_DV)
    b = jnp.cumsum(gc, axis=3)
    b_last = b[:, :, :, -1:, :]
    q_dec = qc * jnp.exp(b) * (GLA_DK ** -0.5)
    k_dec = kc * jnp.exp(-b)
    causal = jnp.tril(jnp.ones((C, C), dtype=bool))
    scores = jnp.where(causal, jnp.einsum('bhntd,bhnsd->bhnts', q_dec, k_dec), 0.0)
    o_intra = jnp.einsum('bhnts,bhnsv->bhntv', scores, vc)
    k_end = kc * jnp.exp(b_last - b)
    inc = jnp.einsum('bhnsd,bhnsv->bhndv', k_end, vc)
    decay = jnp.exp(b_last[:, :, :, 0, :])

    def step(state, inp):
        dec, u = inp
        return dec[..., None] * state + u, state

    state0 = jnp.zeros((B, GLA_HEADS, GLA_DK, GLA_DV), jnp.float32)
    _, s_prev = lax.scan(step, state0, (jnp.moveaxis(decay, 2, 0), jnp.moveaxis(inc, 2, 0)))
    s_prev = jnp.moveaxis(s_prev, 0, 2)
    o = o_intra + jnp.einsum('bhntd,bhndv->bhntv', q_dec, s_prev)
    return o.transpose(0, 2, 3, 1, 4).reshape(B, S, GLA_VAL_W)


def head_rmsnorm(o, g):
    B, S, _ = o.shape
    oh = o.reshape(B, S, GLA_HEADS, GLA_DV)
    oh = oh * lax.rsqrt(jnp.mean(oh * oh, axis=-1, keepdims=True) + NORM_EPS)
    return oh.reshape(B, S, GLA_VAL_W) * g.astype(jnp.float32)


def pool_mix(u, pool_w, pool_scale):
    B, S, _ = u.shape
    uf = u.astype(jnp.float32)
    ug = uf.reshape(B, S, POOL_GROUPS, POOL_GW)
    cs = jnp.cumsum(uf, axis=1).reshape(B, S, POOL_GROUPS, POOL_GW)
    pos = jnp.arange(S, dtype=jnp.float32)
    pooled = []
    for gi, w in enumerate(POOL_WINDOWS):
        c = cs[:, :, gi]
        shifted = jnp.pad(c[:, :S - w], ((0, 0), (w, 0), (0, 0)))
        cnt = jnp.minimum(pos + 1.0, float(w))[None, :, None]
        pooled.append((c - shifted) / cnt)
    pooled = jnp.stack(pooled, axis=2)
    mixed = jnp.einsum('bsgc,gcd->bsgd', pooled - ug, pool_w.astype(jnp.float32))
    return (mixed.reshape(B, S, POOL_W) * pool_scale.astype(jnp.float32)).astype(u.dtype)


def hier_moe(h, w_rg, b_rg, w_re, b_re, w_gate, w_up, w_down):
    B, S, D = h.shape
    T = B * S
    ht = h.reshape(T, D)
    g_logits = (ht @ w_rg).astype(jnp.float32) + b_rg.astype(jnp.float32)
    g_p, g_idx = lax.top_k(jax.nn.softmax(g_logits, axis=-1), 1)
    e_all = jnp.einsum('td,gde->tge', ht, w_re).astype(jnp.float32) + b_re.astype(jnp.float32)
    e_logits = e_all[jnp.arange(T), g_idx[:, 0]]
    e_top, e_idx = lax.top_k(e_logits, TOP_K_IN_GROUP)
    gate = g_p * jax.nn.softmax(e_top, axis=-1)
    A = T * TOP_K_IN_GROUP
    weights = gate.reshape(A)
    expert_ids = (g_idx * EXPERTS_PER_GROUP + e_idx).reshape(A).astype(jnp.int32)
    token_ids = jnp.repeat(jnp.arange(T, dtype=jnp.int32), TOP_K_IN_GROUP)

    n_blocks = -(-(A + N_EXPERTS * (MOE_BLOCK - 1)) // MOE_BLOCK)
    R = n_blocks * MOE_BLOCK
    order = jnp.argsort(expert_ids)
    sorted_e = expert_ids[order]
    counts = jnp.zeros((N_EXPERTS,), jnp.int32).at[expert_ids].add(1)
    padded = ((counts + MOE_BLOCK - 1) // MOE_BLOCK) * MOE_BLOCK
    starts = jnp.cumsum(counts) - counts
    pends = jnp.cumsum(padded)
    pstarts = pends - padded
    dest = pstarts[sorted_e] + (jnp.arange(A, dtype=jnp.int32) - starts[sorted_e])
    row_token = jnp.full((R,), T, jnp.int32).at[dest].set(token_ids[order])
    row_w = jnp.zeros((R,), jnp.float32).at[dest].set(weights[order])
    block_e = jnp.minimum(jnp.searchsorted(pends, jnp.arange(n_blocks, dtype=jnp.int32) * MOE_BLOCK,
                                           side='right'), N_EXPERTS - 1).astype(jnp.int32)
    h_pad = jnp.concatenate([ht, jnp.zeros((1, D), ht.dtype)], axis=0)
    x_blocks = h_pad[row_token].reshape(n_blocks, MOE_BLOCK, D)

    def expert_block(args):
        xb, e = args
        return (jax.nn.silu(xb @ w_gate[e]) * (xb @ w_up[e])) @ w_down[e]

    y_rows = lax.map(expert_block, (x_blocks, block_e)).reshape(R, D)
    y_rows = y_rows * row_w[:, None].astype(y_rows.dtype)
    out = jnp.zeros((T + 1, D), y_rows.dtype).at[row_token].add(y_rows)[:T]
    return out.reshape(B, S, D).astype(h.dtype)


def setup_inputs(seed: int = 0) -> dict:
    key = jax.random.key(seed)
    ks = jax.random.split(key, 24)
    L, D = DEPTH, D_MODEL
    nrm = lambda k, shape, s: jax.random.normal(k, shape, jnp.float32) * s
    return {
        "x": nrm(ks[0], (BATCH, SEQ, D), 1.0),
        "norm1_g": 1.0 + nrm(ks[1], (L, D), 0.05),
        "w_in": nrm(ks[2], (L, D, D_IN), D ** -0.5),
        "w_alpha_up": nrm(ks[3], (L, GLA_GATE_RANK, GLA_KEY_W), GLA_GATE_RANK ** -0.5),
        "b_alpha": nrm(ks[4], (L, GLA_KEY_W), 0.1),
        "gla_norm_g": 1.0 + nrm(ks[5], (L, GLA_VAL_W), 0.05),
        "w_gla_branch": nrm(ks[6], (L, GLA_VAL_W, D), GLA_VAL_W ** -0.5),
        "pool_w": nrm(ks[7], (L, POOL_GROUPS, POOL_GW, POOL_GW), POOL_GW ** -0.5),
        "pool_scale": 1.0 + nrm(ks[8], (L, POOL_W), 0.05),
        "w_pool_branch": nrm(ks[9], (L, POOL_W, D), POOL_W ** -0.5),
        "w_out": nrm(ks[10], (L, D, D), D ** -0.5),
        "norm2_g": 1.0 + nrm(ks[11], (L, D), 0.05),
        "w_router_group": nrm(ks[12], (L, D, N_GROUPS), D ** -0.5),
        "b_router_group": nrm(ks[13], (L, N_GROUPS), 0.01),
        "w_router_expert": nrm(ks[14], (L, N_GROUPS, D, EXPERTS_PER_GROUP), D ** -0.5),
        "b_router_expert": nrm(ks[15], (L, N_GROUPS, EXPERTS_PER_GROUP), 0.01),
        "w_exp_gate": nrm(ks[16], (L, N_EXPERTS, D, D_EXPERT), D ** -0.5),
        "w_exp_up": nrm(ks[17], (L, N_EXPERTS, D, D_EXPERT), D ** -0.5),
        "w_exp_down": nrm(ks[18], (L, N_EXPERTS, D_EXPERT, D), D_EXPERT ** -0.5),
        "norm_f_g": 1.0 + nrm(ks[19], (D,), 0.05),
    }


def reference(x, norm1_g, w_in, w_alpha_up, b_alpha, gla_norm_g, w_gla_branch, pool_w, pool_scale,
              w_pool_branch, w_out, norm2_g, w_router_group, b_router_group, w_router_expert,
              b_router_expert, w_exp_gate, w_exp_up, w_exp_down, norm_f_g):
    split_idx = [int(i) for i in np.cumsum(IN_WIDTHS)[:-1]]
    for l in range(DEPTH):
        h = rmsnorm(x, norm1_g[l])
        proj = h @ w_in[l]
        q, k, v, r, a_low, u_pool, gate_gla, gate_pool = jnp.split(proj, split_idx, axis=-1)
        log_a = jax.nn.log_sigmoid((a_low @ w_alpha_up[l] + b_alpha[l]).astype(jnp.float32)) / GLA_GATE_NORMALIZER
        o = gla_mix(q, k, v, log_a)
        o = (head_rmsnorm(o, gla_norm_g[l]) * jax.nn.silu(r.astype(jnp.float32))).astype(x.dtype)
        y_gla = o @ w_gla_branch[l]
        y_pool = pool_mix(u_pool, pool_w[l], pool_scale[l]) @ w_pool_branch[l]
        merged = jax.nn.sigmoid(gate_gla) * y_gla + jax.nn.sigmoid(gate_pool) * y_pool
        x = x + merged @ w_out[l]
        h2 = rmsnorm(x, norm2_g[l])
        x = x + hier_moe(h2, w_router_group[l], b_router_group[l], w_router_expert[l], b_router_expert[l],
                         w_exp_gate[l], w_exp_up[l], w_exp_down[l])
    return rmsnorm(x, norm_f_g)
```

```cpp
#include <hip/hip_runtime.h>
#include <cstdio>
#include <cstdint>

#ifndef DBG
#define DBG 0
#endif
#ifndef NPH
#define NPH 10
#endif

constexpr int BATCH = 16, SEQ = 4096, T = BATCH * SEQ, D = 1024;
constexpr int GH = 4, GDK = 64, GDV = 128, GKW = 256, GVW = 512, GRANK = 16, GCH = 64;
constexpr int PW = 512, PGW = 128;
constexpr int D_IN = 4112;
constexpr int IN_Q = 0, IN_K = 256, IN_V = 512, IN_R = 1024, IN_A = 1536, IN_U = 1552, IN_GG = 2064, IN_GP = 3088;
constexpr int NPJ = 4352;
constexpr int PJ_Q = 0, PJ_K = 256, PJ_V = 512, PJ_R = 1024, PJ_Z = 1536, PJ_U = 1792, PJ_GG = 2304, PJ_GP = 3328;
constexpr int NE = 32, EPG = 8, NG = 4, DE = 256;
constexpr int NA = 2 * T;
constexpr int LCAP = T;
constexpr float EPS = 1e-6f;

constexpr size_t MiB = 1u << 20;
constexpr size_t WS_CTL = 0, CTL_ZERO_BYTES = 1 * MiB;
constexpr size_t WS_WIN = 1 * MiB;
constexpr size_t WS_WG = 10 * MiB;
constexpr size_t WS_WP = 11 * MiB;
constexpr size_t WS_WOUT = 12 * MiB;
constexpr size_t WS_WR = 14 * MiB;
constexpr size_t WS_WGU = 15 * MiB;
constexpr size_t WS_WD = 47 * MiB;
constexpr size_t WS_HB = 64 * MiB;
constexpr size_t WS_TG = WS_HB;
constexpr size_t WS_MG = 192 * MiB;
constexpr size_t WS_Y = 64 * MiB;
constexpr size_t WS_ON = 320 * MiB;
constexpr size_t WS_PD = 384 * MiB;
constexpr size_t WS_ACT = 320 * MiB;
constexpr size_t WS_PJ = 448 * MiB;
constexpr size_t WS_X1 = 448 * MiB;
constexpr size_t WS_X1B = 704 * MiB;
constexpr size_t WS_LG = 832 * MiB;
constexpr size_t WS_SSQ = 848 * MiB;
constexpr size_t WS_LIST = 852 * MiB;
constexpr size_t WS_LISTW = 864 * MiB;
constexpr size_t WS_LISTR = 872 * MiB;
constexpr size_t WS_END = 992 * MiB;
static_assert(WS_PJ + (size_t)T * NPJ * 2 <= WS_END && WS_LISTR + (size_t)NE * LCAP * 4 <= WS_END && WS_ACT + (size_t)(NA + NE * 256) * DE * 2 <= WS_PJ, "d_ws map");
constexpr int CW_TMO = 0, CW_DBG = 2;
constexpr int CW_BAR = 4096;
constexpr int CW_ECNT = 16384;

constexpr int RING_BYTES = 131072;
constexpr int MISC_OFF = RING_BYTES + 320;
constexpr int SCHED_OFF = RING_BYTES + 1024;
constexpr int LDS_BYTES = 147456;

#define GAS __attribute__((address_space(1)))
#define LAS __attribute__((address_space(3)))
typedef unsigned short bf16;
typedef unsigned v4u __attribute__((ext_vector_type(4)));
typedef unsigned v2u __attribute__((ext_vector_type(2)));
typedef float f32x4 __attribute__((ext_vector_type(4)));
typedef short bf16x8 __attribute__((ext_vector_type(8)));
typedef short bf16x4 __attribute__((ext_vector_type(4)));
typedef GAS unsigned gu32;
#define RLX_AGENT __ATOMIC_RELAXED, __HIP_MEMORY_SCOPE_AGENT
#define LDS_WAIT() asm volatile("s_waitcnt lgkmcnt(0)" ::: "memory")
#define VM_WAIT() asm volatile("s_waitcnt vmcnt(0)" ::: "memory")
__device__ __forceinline__ unsigned f2bf(float f) { unsigned u = __builtin_bit_cast(unsigned, f); return (u + 0x7fffu + ((u >> 16) & 1u)) >> 16; }
__device__ __forceinline__ unsigned pk2(float lo, float hi) { unsigned r; asm volatile("v_cvt_pk_bf16_f32 %0, %1, %2" : "=v"(r) : "v"(lo), "v"(hi)); return r; }
__device__ __forceinline__ float bflo(unsigned w) { return __builtin_bit_cast(float, w << 16); }
__device__ __forceinline__ float bfhi(unsigned w) { return __builtin_bit_cast(float, w & 0xffff0000u); }
__device__ __forceinline__ float bf1(bf16 h) { return __builtin_bit_cast(float, (unsigned)h << 16); }
__device__ __forceinline__ float fsigmoid(float x) { return __builtin_amdgcn_rcpf(1.0f + __expf(-x)); }
__device__ __forceinline__ float wave_sum(float v) {
#pragma unroll
    for (int o = 1; o < 64; o <<= 1) v += __shfl_xor(v, o);
    return v;
}

#define XB_TMO      128
#define XB_XCNT(j)  (256  + 64 * (j))
#define XB_XSUB(j)  (1280 + 64 * (j))
#define XB_XGEN(j)  (2304 + 64 * (j))
#define XB_TOP      3328
#define XB_TOPGEN   3392
#define XCD_BAR_WORDS 3456
#define XB_SPIN_CAP (1u << 18)
__device__ __forceinline__ unsigned xb_ld(unsigned* p)              { return __hip_atomic_load(p, __ATOMIC_RELAXED, __HIP_MEMORY_SCOPE_AGENT); }
__device__ __forceinline__ unsigned xb_add(unsigned* p, unsigned v) { return __hip_atomic_fetch_add(p, v, __ATOMIC_RELAXED, __HIP_MEMORY_SCOPE_AGENT); }
__device__ __forceinline__ unsigned xb_xcc_id() { return (unsigned)__builtin_amdgcn_s_getreg((3 << 11) | 20) & 0xFu; }
#define XB_SPIN(cond, bar) do { unsigned _sp = 0; while (cond) { __builtin_amdgcn_s_sleep(1); \
    if ((++_sp & 255u) == 0u) { if (xb_ld(&(bar)[XB_TMO])) break; if (_sp > XB_SPIN_CAP) { atomicAdd(&(bar)[XB_TMO], 1u); break; } } } } while (0)
struct XcdBarrier { unsigned* bar; unsigned x; volatile LAS unsigned* st; };
__device__ __forceinline__ XcdBarrier xcd_barrier_post(unsigned* bar, volatile LAS unsigned* st) {
    XcdBarrier b; b.bar = bar; b.x = xb_xcc_id(); b.st = st;
    if (threadIdx.x == 0) (void)xb_add(&bar[XB_XCNT(b.x)], 1u);
    return b;
}
__device__ __forceinline__ void xcd_barrier_complete(unsigned* bar, unsigned x, unsigned& nloc, unsigned& nx) {
    const unsigned G = gridDim.x * gridDim.y * gridDim.z;
    unsigned sum, cnt, mine, sp = 0u;
    for (;;) {
        sum = 0u; cnt = 0u; mine = 0u;
#pragma unroll
        for (unsigned j = 0; j < 16; ++j) { const unsigned c = xb_ld(&bar[XB_XCNT(j)]); sum += c; cnt += (c > 0u) ? 1u : 0u; mine = (j == x) ? c : mine; }
        if (sum == G) break;
        __builtin_amdgcn_s_sleep(1);
        if ((++sp & 255u) == 0u) { if (xb_ld(&bar[XB_TMO])) break; if (sp > XB_SPIN_CAP) { atomicAdd(&bar[XB_TMO], 1u); break; } }
    }
    nloc = mine > 0u ? mine : 1u; nx = cnt > 0u ? cnt : 1u;
}
__device__ __forceinline__ void xcd_barrier(const XcdBarrier& b) {
    asm volatile("s_waitcnt vmcnt(0)" ::: "memory");
    __syncthreads();
    if (threadIdx.x == 0) {
        unsigned* bar = b.bar;
        __builtin_amdgcn_s_waitcnt(0);
        unsigned nloc = b.st[0], nx = b.st[1];
        if (nloc == 0u) { xcd_barrier_complete(bar, b.x, nloc, nx); b.st[0] = nloc; b.st[1] = nx; }
        const unsigned old = xb_add(&bar[XB_XSUB(b.x)], 1u);
        const unsigned gen = old / nloc;
        if (old + 1u == (gen + 1u) * nloc) {
            __builtin_amdgcn_fence(__ATOMIC_RELEASE, "agent");
            asm volatile("s_waitcnt vmcnt(0)" ::: "memory");
            const unsigned og = xb_add(&bar[XB_TOP], 1u);
            const unsigned tg = og / nx;
            if (og + 1u == (tg + 1u) * nx) xb_add(&bar[XB_TOPGEN], 1u);
            else XB_SPIN(xb_ld(&bar[XB_TOPGEN]) == tg, bar);
            __builtin_amdgcn_fence(__ATOMIC_ACQUIRE, "agent");
            xb_add(&bar[XB_XGEN(b.x)], 1u);
            asm volatile("s_waitcnt vmcnt(0)" ::: "memory");
        } else {
            XB_SPIN(xb_ld(&bar[XB_XGEN(b.x)]) == gen, bar);
            __builtin_amdgcn_fence(__ATOMIC_ACQUIRE, "agent");
            asm volatile("s_waitcnt vmcnt(0)" ::: "memory");
        }
    }
    __syncthreads();
}

namespace pg8 {
#define PG8_LAS __attribute__((address_space(3)))
constexpr int BM = 256, BK = 64, HALF = 128, HTB = HALF * BK * 2, STAGE_BYTES = 8 * HTB, NXCD = 8, WGM = 8;
__host__ __device__ __forceinline__ int lds_byte(int r, int c) { const int st = (r >> 4) * 2 + (c >> 5), rr = r & 15, cc = c & 31, ob = rr * 64 + cc * 2; return st * 1024 + (ob ^ (((ob >> 9) & 1) << 5)); }
__host__ __device__ __forceinline__ void stage_rc(int b, int& R, int& C) { const int st = b / 1024, sb = b % 1024, swz = sb ^ (((sb >> 9) & 1) << 5); R = (st >> 1) * 16 + swz / 64; C = (st & 1) * 32 + (swz % 64) / 2; }
__host__ __device__ __forceinline__ int perm32(int rho) { const int n = rho >> 4, i = rho & 15; return 8 * (i >> 2) + 4 * n + (i & 3); }

struct Unit { const char* A; const char* B; int r0, c0, e, nvalid, lb, pad; };

__device__ __forceinline__ int remap_xcd(int L, int nwg) { const int q = nwg / NXCD, r = nwg % NXCD, xcd = L % NXCD, off = L / NXCD; return (xcd < r ? xcd * (q + 1) : r * (q + 1) + (xcd - r) * q) + off; }
struct StaticSched {
    const char* A; const char* B; int lda, ldb, nM, nN, nwg, G, c;
    __device__ __forceinline__ void init(const void* A_, int lda_, const void* B_, int ldb_, int M, int N, int G_, int c_) { A = (const char*)A_; B = (const char*)B_; lda = lda_; ldb = ldb_; nM = M / BM; nN = N / BM; nwg = nM * nN; G = G_; c = c_; }
    __device__ __forceinline__ bool next(int i, Unit& u) const {
        const long L = (long)i * G + c; if (L >= nwg) return false;
        const int wgid = remap_xcd((int)L, nwg);
        const int nig = WGM * nN, gid = wgid / nig, fm = gid * WGM, gsz = (nM - fm) < WGM ? (nM - fm) : WGM;
        const int pm = fm + ((wgid % nig) % gsz), pn = (wgid % nig) / gsz;
        u.A = A + (size_t)pm * BM * lda * 2; u.B = B + (size_t)pn * BM * ldb * 2; u.r0 = pm * BM; u.c0 = pn * BM; u.e = 0; u.nvalid = BM; u.lb = 0; u.pad = 0; return true;
    }
    __device__ __forceinline__ void fill_tab(const Unit&, PG8_LAS unsigned*) const {}
};

template <class Epi, class Sched, bool GATHER, bool ALIGN_EPI>
__device__ __forceinline__ void gemm_phase(PG8_LAS unsigned char* lds, const int K, const int lda, const int ldb, const Sched& S, const Epi& E) {
    int tid_ = threadIdx.x; asm volatile("" : "+v"(tid_));
    const int tid = tid_, wid = __builtin_amdgcn_readfirstlane(tid >> 6), lane = tid & 63, wr = wid >> 2, wc = wid & 3, fr = lane & 15, fq = lane >> 4;
    const int nt = K / BK;
    int Rr[2], Cc[2];
    unsigned voffA[2][2], voffB[2], nvA[2][2];
#pragma unroll
    for (int i = 0; i < 2; ++i) { int R, C; stage_rc(tid * 16 + i * 8192, R, C); Rr[i] = R; Cc[i] = C; const int Rb = Epi::PERM ? ((R & ~31) + perm32(R & 31)) : R;
        voffB[i] = (unsigned)(Rb * ldb + C) * 2u;
#pragma unroll
        for (int h = 0; h < 2; ++h) { voffA[h][i] = (unsigned)((R + HALF * h) * lda + C) * 2u; nvA[h][i] = voffA[h][i]; } }
    const size_t kstep = (size_t)(BK * 2);
    const size_t hstepB = (size_t)HALF * ldb * 2;
    const unsigned ldsw = (unsigned)wid * 1024u;
    const int aoff = lds_byte(wr * 64 + fr, fq * 8), boff = lds_byte(wc * 32 + fr, fq * 8);
#define PG8_SA(b, h) (((b) * 2 + (h)) * HTB)
#define PG8_SB(b, h) ((4 + (b) * 2 + (h)) * HTB)
#define PG8_STAGE(bufoff, gbase, voff) do { _Pragma("unroll") for (int _i = 0; _i < 2; ++_i) \
        __builtin_amdgcn_global_load_lds((const unsigned*)((const char*)(gbase) + (voff)[_i]), (PG8_LAS unsigned*)(lds + (bufoff) + ldsw + _i * 8192), 16, 0, 0); } while (0)
#define PG8_LDA(dst, b, h) do { _Pragma("unroll") for (int m = 0; m < 4; ++m) _Pragma("unroll") for (int k = 0; k < 2; ++k) dst[m][k] = *(const PG8_LAS bf16x8*)(lds + PG8_SA(b, h) + aoff + m * 2048 + k * 1024); } while (0)
#define PG8_LDB(dst, b, h) do { _Pragma("unroll") for (int n = 0; n < 2; ++n) _Pragma("unroll") for (int k = 0; k < 2; ++k) dst[n][k] = *(const PG8_LAS bf16x8*)(lds + PG8_SB(b, h) + boff + n * 2048 + k * 1024); } while (0)
#define PG8_MMA(ai, bj, At, Bt) do { __builtin_amdgcn_s_setprio(1); _Pragma("unroll") for (int m = 0; m < 4; ++m) _Pragma("unroll") for (int n = 0; n < 2; ++n) _Pragma("unroll") for (int k = 0; k < 2; ++k) \
        acc[ai][bj][m][n] = __builtin_amdgcn_mfma_f32_16x16x32_bf16(Bt[n][k], At[m][k], acc[ai][bj][m][n], 0, 0, 0); __builtin_amdgcn_s_setprio(0); } while (0)
#define PG8_WAIT_V(n) asm volatile("s_waitcnt vmcnt(" #n ")" ::: "memory")
#define PG8_WAIT_L(n) asm volatile("s_waitcnt lgkmcnt(" #n ")" ::: "memory")
#define PG8_BAR __builtin_amdgcn_s_barrier()
#define PG8_SCHED __builtin_amdgcn_sched_barrier(0)
    Unit cur, nxt; int ui = 0;
    if (!S.next(0, cur)) return;
    f32x4 acc[2][2][4][2];
#pragma unroll
    for (int a = 0; a < 2; ++a)
#pragma unroll
        for (int b = 0; b < 2; ++b)
#pragma unroll
            for (int m = 0; m < 4; ++m)
#pragma unroll
                for (int n = 0; n < 2; ++n) acc[a][b][m][n] = (f32x4){0.f, 0.f, 0.f, 0.f};
    bf16x8 At[4][2], B0[2][2], B1[2][2];
    const char* cA = cur.A; const char* cB = cur.B;
    PG8_LAS unsigned* gtab = (PG8_LAS unsigned*)(lds + STAGE_BYTES + 2048);
    if constexpr (GATHER) {
        S.fill_tab(cur, gtab);
        asm volatile("s_waitcnt lgkmcnt(0)" ::: "memory"); __builtin_amdgcn_s_barrier(); asm volatile("" ::: "memory");
#pragma unroll
        for (int h = 0; h < 2; ++h)
#pragma unroll
            for (int i = 0; i < 2; ++i) { voffA[h][i] = gtab[Rr[i] + HALF * h] + (unsigned)Cc[i] * 2u; nvA[h][i] = voffA[h][i]; }
    }
    PG8_STAGE(PG8_SB(0, 0), cB, voffB); PG8_STAGE(PG8_SB(0, 1), cB + hstepB, voffB); PG8_STAGE(PG8_SA(0, 0), cA, voffA[0]); PG8_STAGE(PG8_SA(0, 1), cA, voffA[1]);
    if (wr == 1) PG8_BAR;
    PG8_WAIT_V(2); PG8_BAR;
    PG8_STAGE(PG8_SB(1, 0), cB + kstep, voffB); PG8_STAGE(PG8_SA(1, 0), cA + kstep, voffA[0]); PG8_STAGE(PG8_SB(1, 1), cB + hstepB + kstep, voffB);
    PG8_WAIT_V(6); PG8_BAR;
    for (;;) {
        const bool has_next = S.next(ui + 1, nxt);
        const char* nA = has_next ? nxt.A : cA; const char* nB = has_next ? nxt.B : cB;
        if constexpr (GATHER) { if (has_next) S.fill_tab(nxt, gtab + ((ui + 1) & 1) * 256); }
#pragma unroll 1
        for (int t = 0; t < nt; t += 2) {
            const bool last = (t == nt - 2);
            const char* a1 = cA + (size_t)(t + 1) * kstep;
            const char* a2 = last ? nA : cA + (size_t)(t + 2) * kstep; const char* b2 = last ? nB : cB + (size_t)(t + 2) * kstep;
            const char* a3 = a2 + kstep; const char* b3 = b2 + kstep;
            unsigned sv[2][2];
            if constexpr (GATHER) {
                if (last && has_next) {
#pragma unroll
                    for (int h = 0; h < 2; ++h)
#pragma unroll
                        for (int i = 0; i < 2; ++i) nvA[h][i] = gtab[((ui + 1) & 1) * 256 + Rr[i] + HALF * h] + (unsigned)Cc[i] * 2u;
                }
#pragma unroll
                for (int h = 0; h < 2; ++h)
#pragma unroll
                    for (int i = 0; i < 2; ++i) sv[h][i] = last ? nvA[h][i] : voffA[h][i];
            } else {
#pragma unroll
                for (int h = 0; h < 2; ++h)
#pragma unroll
                    for (int i = 0; i < 2; ++i) sv[h][i] = voffA[h][i];
            }
            PG8_LDB(B0, 0, 0); PG8_LDB(B1, 0, 1); PG8_SCHED; PG8_LDA(At, 0, 0); PG8_STAGE(PG8_SA(1, 1), a1, voffA[1]);
            PG8_WAIT_V(8); PG8_WAIT_L(0); PG8_BAR; PG8_MMA(0, 0, At, B0); PG8_MMA(0, 1, At, B1); PG8_BAR; PG8_SCHED;
            PG8_LDA(At, 0, 1); PG8_STAGE(PG8_SB(0, 0), b2, voffB); PG8_STAGE(PG8_SB(0, 1), b2 + hstepB, voffB); PG8_STAGE(PG8_SA(0, 0), a2, sv[0]);
            PG8_WAIT_V(8); PG8_WAIT_L(0); PG8_BAR; PG8_MMA(1, 0, At, B0); PG8_MMA(1, 1, At, B1); PG8_BAR; PG8_SCHED;
            PG8_LDB(B0, 1, 0); PG8_LDB(B1, 1, 1); PG8_SCHED; PG8_LDA(At, 1, 0); PG8_STAGE(PG8_SA(0, 1), a2, sv[1]);
            PG8_WAIT_V(8); PG8_WAIT_L(0); PG8_BAR; PG8_MMA(0, 0, At, B0); PG8_MMA(0, 1, At, B1); PG8_BAR; PG8_SCHED;
            PG8_LDA(At, 1, 1); PG8_STAGE(PG8_SB(1, 0), b3, voffB); PG8_STAGE(PG8_SB(1, 1), b3 + hstepB, voffB); PG8_STAGE(PG8_SA(1, 0), a3, sv[0]);
            PG8_WAIT_V(8); PG8_WAIT_L(0); PG8_BAR; PG8_MMA(1, 0, At, B0); PG8_MMA(1, 1, At, B1); PG8_BAR; PG8_SCHED;
        }
        if constexpr (ALIGN_EPI) { if (wr == 0) PG8_BAR; }
        E(acc, cur, wr, wc, fr, fq);
        if (!has_next) break;
#pragma unroll
        for (int a = 0; a < 2; ++a)
#pragma unroll
            for (int b = 0; b < 2; ++b)
#pragma unroll
                for (int m = 0; m < 4; ++m)
#pragma unroll
                    for (int n = 0; n < 2; ++n) acc[a][b][m][n] = (f32x4){0.f, 0.f, 0.f, 0.f};
        cur = nxt; cA = nA; cB = nB; ++ui;
        if constexpr (GATHER) {
#pragma unroll
            for (int h = 0; h < 2; ++h)
#pragma unroll
                for (int i = 0; i < 2; ++i) voffA[h][i] = nvA[h][i];
        }
        if constexpr (ALIGN_EPI) { if (wr == 1) PG8_BAR; }
    }
    PG8_WAIT_V(0);
    if constexpr (!ALIGN_EPI) { if (wr == 0) PG8_BAR; }
    PG8_BAR;
#undef PG8_SA
#undef PG8_SB
#undef PG8_STAGE
#undef PG8_LDA
#undef PG8_LDB
#undef PG8_MMA
#undef PG8_WAIT_V
#undef PG8_WAIT_L
#undef PG8_BAR
#undef PG8_SCHED
}
}

struct Frame {
    LAS unsigned char* lds;
    volatile LAS unsigned* MISC;
    gu32* ctl;
    int tid, lane, wave, G, bid;
    const float* in[20]; float* out; unsigned char* ws;
};
#define WSP(T_, off) ((T_*)(F.ws + (off)))

__device__ __forceinline__ v4u pack8(const f32x4 a, const f32x4 b) { v4u w; w.x = pk2(a[0], a[1]); w.y = pk2(a[2], a[3]); w.z = pk2(b[0], b[1]); w.w = pk2(b[2], b[3]); return w; }
__device__ __forceinline__ void unpack8(const v4u w, f32x4& a, f32x4& b) { a = (f32x4){bflo(w.x), bfhi(w.x), bflo(w.y), bfhi(w.y)}; b = (f32x4){bflo(w.z), bfhi(w.z), bflo(w.w), bfhi(w.w)}; }

struct EpiP1 {
    static constexpr bool PERM = true;
    bf16* PJ; const float* b_alpha;
    __device__ __forceinline__ void operator()(const f32x4 (&acc)[2][2][4][2], const pg8::Unit& u, int wr, int wc, int fr, int fq) const {
        const int pn = u.c0 >> 8;
        const int mode = (pn == 4 || pn == 5) ? 1 : (pn == 6) ? 2 : (pn >= 9) ? 3 : 0;
        const int row0 = u.r0 + wr * 64 + fr, col0 = u.c0 + wc * 32 + 8 * fq;
        f32x4 bv[2][2];
        const int bidx = (mode == 2) ? (col0 - PJ_Z) : 0;
#pragma unroll
        for (int bj = 0; bj < 2; ++bj)
#pragma unroll
            for (int n = 0; n < 2; ++n) { bv[bj][n] = *(const f32x4*)(b_alpha + bidx + bj * 128 + 4 * n); asm volatile("" :: "v"(bv[bj][n])); }
#pragma unroll
        for (int ai = 0; ai < 2; ++ai)
#pragma unroll
            for (int m = 0; m < 4; ++m) { bf16* rowp = PJ + (size_t)(row0 + ai * 128 + m * 16) * NPJ + col0;
#pragma unroll
                for (int bj = 0; bj < 2; ++bj) { f32x4 v[2] = {acc[ai][bj][m][0], acc[ai][bj][m][1]};
                    if (mode == 1) {
#pragma unroll
                        for (int n = 0; n < 2; ++n)
#pragma unroll
                            for (int j = 0; j < 4; ++j) v[n][j] = v[n][j] * fsigmoid(v[n][j]);
                    } else if (mode == 2) {
#pragma unroll
                        for (int n = 0; n < 2; ++n)
#pragma unroll
                            for (int j = 0; j < 4; ++j) { const float z = v[n][j] + bv[bj][n][j]; v[n][j] = (fminf(z, 0.f) - __logf(1.0f + __expf(-fabsf(z)))) * (1.0f / 16.0f); }
                    } else if (mode == 3) {
#pragma unroll
                        for (int n = 0; n < 2; ++n)
#pragma unroll
                            for (int j = 0; j < 4; ++j) v[n][j] = fsigmoid(v[n][j]);
                    }
                    *(v4u*)(rowp + bj * 128) = pack8(v[0], v[1]); } }
    }
};


struct EpiD {
    static constexpr bool PERM = true;
    bf16* TG; const bf16* PJ;
    __device__ __forceinline__ void operator()(const f32x4 (&acc)[2][2][4][2], const pg8::Unit& u, int wr, int wc, int fr, int fq) const {
        const int row0 = u.r0 + wr * 64 + fr, col0 = u.c0 + wc * 32 + 8 * fq;
#pragma unroll
        for (int ai = 0; ai < 2; ++ai)
#pragma unroll
            for (int m = 0; m < 4; ++m) { const size_t row = (size_t)(row0 + ai * 128 + m * 16);
#pragma unroll
                for (int bj = 0; bj < 2; ++bj) { const int c = col0 + bj * 128; const v4u gw = *(const v4u*)(PJ + row * NPJ + PJ_GG + c); f32x4 g0, g1; unpack8(gw, g0, g1);
                    *(v4u*)(TG + row * D + c) = pack8(acc[ai][bj][m][0] * g0, acc[ai][bj][m][1] * g1); } }
    }
};
struct EpiE {
    static constexpr bool PERM = true;
    bf16* MG; const bf16* TG; const bf16* PJ;
    __device__ __forceinline__ void operator()(const f32x4 (&acc)[2][2][4][2], const pg8::Unit& u, int wr, int wc, int fr, int fq) const {
        const int row0 = u.r0 + wr * 64 + fr, col0 = u.c0 + wc * 32 + 8 * fq;
#pragma unroll
        for (int ai = 0; ai < 2; ++ai)
#pragma unroll
            for (int m = 0; m < 4; ++m) { const size_t row = (size_t)(row0 + ai * 128 + m * 16);
#pragma unroll
                for (int bj = 0; bj < 2; ++bj) { const int c = col0 + bj * 128; const v4u gw = *(const v4u*)(PJ + row * NPJ + PJ_GP + c); const v4u tw = *(const v4u*)(TG + row * D + c);
                    f32x4 g0, g1, t0, t1; unpack8(gw, g0, g1); unpack8(tw, t0, t1);
                    *(v4u*)(MG + row * D + c) = pack8(t0 + acc[ai][bj][m][0] * g0, t1 + acc[ai][bj][m][1] * g1); } }
    }
};
struct EpiF {
    static constexpr bool PERM = true;
    const float* x; float* X1; bf16* X1B; float* SSQ;
    __device__ __forceinline__ void operator()(const f32x4 (&acc)[2][2][4][2], const pg8::Unit& u, int wr, int wc, int fr, int fq) const {
        const int row0 = u.r0 + wr * 64 + fr, col0 = u.c0 + wc * 32 + 8 * fq;
#pragma unroll
        for (int ai = 0; ai < 2; ++ai)
#pragma unroll
            for (int m = 0; m < 4; ++m) { const size_t row = (size_t)(row0 + ai * 128 + m * 16); float ss = 0.f;
#pragma unroll
                for (int bj = 0; bj < 2; ++bj) { const int c = col0 + bj * 128; const f32x4 x0 = *(const f32x4*)(x + row * D + c), x1 = *(const f32x4*)(x + row * D + c + 4);
                    const f32x4 y0 = x0 + acc[ai][bj][m][0], y1 = x1 + acc[ai][bj][m][1];
                    *(f32x4*)(X1 + row * D + c) = y0; *(f32x4*)(X1 + row * D + c + 4) = y1; *(v4u*)(X1B + row * D + c) = pack8(y0, y1);
                    ss += (y0[0] * y0[0] + y0[1] * y0[1]) + (y0[2] * y0[2] + y0[3] * y0[3]) + (y1[0] * y1[0] + y1[1] * y1[1]) + (y1[2] * y1[2] + y1[3] * y1[3]); }
                ss += __shfl_xor(ss, 16); ss += __shfl_xor(ss, 32);
                if (fq == 0) SSQ[row * 16 + (u.c0 >> 8) * 4 + wc] = ss; }
    }
};


struct MoeSched {
    const LAS int* cum; const LAS int* cnt; const unsigned* LIST;
    const char* Abase; const char* Bbase; int NT, G, c, mode;
    __device__ __forceinline__ bool next(int i, pg8::Unit& u) const {
        const int nunits = __builtin_amdgcn_readfirstlane(cum[NE]) * NT; const long L = (long)i * G + c; if (L >= nunits) return false;
        const int wgid = pg8::remap_xcd((int)L, nunits), gb = wgid / NT, pn = wgid % NT;
        int e_ = 0;
#pragma unroll 8
        for (int j = 1; j < NE; ++j) e_ += (cum[j] <= gb) ? 1 : 0;
        const int e = __builtin_amdgcn_readfirstlane(e_);
        const int blk = gb - __builtin_amdgcn_readfirstlane(cum[e]), rem = __builtin_amdgcn_readfirstlane(cnt[e]) - blk * 256;
        u.e = e; u.nvalid = rem < 256 ? rem : 256; u.lb = e * LCAP + blk * 256; u.r0 = gb * 256; u.pad = 0;
        if (mode == 0) { u.A = Abase; u.B = Bbase + ((size_t)e * 512 + (size_t)pn * 256) * D * 2; u.c0 = pn * 128; }
        else { u.A = Abase + (size_t)gb * 256 * DE * 2; u.B = Bbase + ((size_t)e * D + (size_t)pn * 256) * DE * 2; u.c0 = pn * 256; }
        return true;
    }
    __device__ __forceinline__ void fill_tab(const pg8::Unit& u, LAS unsigned* tab) const {
        const int t = threadIdx.x;
        if (t < 256) { const int lp = t < u.nvalid ? t : u.nvalid - 1; const unsigned slot = LIST[u.lb + lp]; tab[t] = (slot >> 1) * (unsigned)(D * 2); }
    }
};
struct EpiG {
    static constexpr bool PERM = false;
    float* LG;
    __device__ __forceinline__ void operator()(const f32x4 (&acc)[2][2][4][2], const pg8::Unit& u, int wr, int wc, int fr, int fq) const {
        if (wc >= 2) return;
        const int row0 = u.r0 + wr * 64 + fr;
#pragma unroll
        for (int ai = 0; ai < 2; ++ai)
#pragma unroll
            for (int m = 0; m < 4; ++m)
#pragma unroll
                for (int n = 0; n < 2; ++n) *(f32x4*)(LG + (size_t)(row0 + ai * 128 + m * 16) * 64 + 32 * wc + 16 * n + 4 * fq) = acc[ai][0][m][n];
    }
};
struct EpiH {
    static constexpr bool PERM = true;
    bf16* ACT; const float* LISTR;
    __device__ __forceinline__ void operator()(const f32x4 (&acc)[2][2][4][2], const pg8::Unit& u, int wr, int wc, int fr, int fq) const {
        float rs[2][4];
#pragma unroll
        for (int ai = 0; ai < 2; ++ai)
#pragma unroll
            for (int m = 0; m < 4; ++m) { const int rl = ai * 128 + wr * 64 + m * 16 + fr, lp = rl < u.nvalid ? rl : u.nvalid - 1; rs[ai][m] = LISTR[u.lb + lp]; }
#pragma unroll
        for (int ai = 0; ai < 2; ++ai)
#pragma unroll
            for (int m = 0; m < 4; ++m) { asm volatile("" :: "v"(rs[ai][m])); }
#pragma unroll
        for (int ai = 0; ai < 2; ++ai)
#pragma unroll
            for (int m = 0; m < 4; ++m) { const int rl = ai * 128 + wr * 64 + m * 16 + fr; const float r = rs[ai][m]; f32x4 a[2];
#pragma unroll
                for (int n = 0; n < 2; ++n)
#pragma unroll
                    for (int j = 0; j < 4; ++j) { const float g = acc[ai][0][m][n][j] * r, up = acc[ai][1][m][n][j] * r; a[n][j] = g * fsigmoid(g) * up; }
                *(v4u*)(ACT + (size_t)(u.r0 + rl) * DE + u.c0 + wc * 32 + 8 * fq) = pack8(a[0], a[1]); }
    }
};
struct EpiI {
    static constexpr bool PERM = true;
    bf16* Y; const unsigned* LIST; const float* LISTW;
    __device__ __forceinline__ void operator()(const f32x4 (&acc)[2][2][4][2], const pg8::Unit& u, int wr, int wc, int fr, int fq) const {
#pragma unroll
        for (int ai = 0; ai < 2; ++ai) {
            unsigned sl[4]; float gw[4];
#pragma unroll
            for (int m = 0; m < 4; ++m) { const int rl = ai * 128 + wr * 64 + m * 16 + fr, lp = rl < u.nvalid ? rl : u.nvalid - 1; sl[m] = LIST[u.lb + lp]; gw[m] = LISTW[u.lb + lp]; }
#pragma unroll
            for (int m = 0; m < 4; ++m) { asm volatile("" :: "v"(gw[m]), "v"(sl[m])); }
#pragma unroll
            for (int m = 0; m < 4; ++m) { const int rl = ai * 128 + wr * 64 + m * 16 + fr; const float g = gw[m];
                if (rl < u.nvalid) {
#pragma unroll
                    for (int bj = 0; bj < 2; ++bj) *(v4u*)(Y + (size_t)sl[m] * D + u.c0 + bj * 128 + wc * 32 + 8 * fq) = pack8(acc[ai][bj][m][0] * g, acc[ai][bj][m][1] * g); } }
        }
    }
};
__device__ __forceinline__ void route_rows(Frame& F, const int r0) {
    const float* LG = WSP(float, WS_LG); const float* SSQ = WSP(float, WS_SSQ); const float* brg = F.in[13]; const float* bre = F.in[15];
    unsigned* LIST = WSP(unsigned, WS_LIST); float* LISTW = WSP(float, WS_LISTW); float* LISTR = WSP(float, WS_LISTR);
    LAS unsigned* hcnt = (LAS unsigned*)(F.lds + SCHED_OFF); LAS unsigned* hbase = hcnt + 32;
    if (F.tid < 32) hcnt[F.tid] = 0u;
    __syncthreads();
    int e0 = 0, e1 = 0; unsigned p0 = 0, p1 = 0; float w0 = 0.f, w1 = 0.f, rstd = 0.f; const int row = r0 + F.tid;
    if (F.tid < 256) {
        float ss = 0.f;
#pragma unroll
        for (int j = 0; j < 16; ++j) ss += SSQ[(size_t)row * 16 + j];
        rstd = 1.0f / sqrtf(ss * (1.0f / D) + EPS);
        const float* lr = LG + (size_t)row * 64;
        float gl[4];
#pragma unroll
        for (int g = 0; g < 4; ++g) gl[g] = __hip_atomic_load(lr + g, RLX_AGENT) * rstd + brg[g];
        int gi = 0; float gm = gl[0];
#pragma unroll
        for (int g = 1; g < 4; ++g) if (gl[g] > gm) { gm = gl[g]; gi = g; }
        float den = 0.f;
#pragma unroll
        for (int g = 0; g < 4; ++g) den += expf(gl[g] - gm);
        const float gp = 1.0f / den;
        float el[8];
#pragma unroll
        for (int e = 0; e < 8; ++e) el[e] = __hip_atomic_load(lr + 4 + gi * 8 + e, RLX_AGENT) * rstd + bre[gi * 8 + e];
        int i0 = 0; float m0 = el[0];
#pragma unroll
        for (int e = 1; e < 8; ++e) if (el[e] > m0) { m0 = el[e]; i0 = e; }
        int i1 = -1; float m1 = 0.f;
#pragma unroll
        for (int e = 0; e < 8; ++e) if (e != i0 && (i1 < 0 || el[e] > m1)) { m1 = el[e]; i1 = e; }
        const float q = expf(m1 - m0); w0 = gp / (1.0f + q); w1 = gp * q / (1.0f + q);
        e0 = gi * 8 + i0; e1 = gi * 8 + i1;
        p0 = __hip_atomic_fetch_add(&hcnt[e0], 1u, __ATOMIC_RELAXED, __HIP_MEMORY_SCOPE_WORKGROUP); p1 = __hip_atomic_fetch_add(&hcnt[e1], 1u, __ATOMIC_RELAXED, __HIP_MEMORY_SCOPE_WORKGROUP);
    }
    __syncthreads();
    if (F.tid < 32) hbase[F.tid] = hcnt[F.tid] ? __hip_atomic_fetch_add((unsigned*)(F.ctl + CW_ECNT + 64 * F.tid), hcnt[F.tid], RLX_AGENT) : 0u;
    __syncthreads();
    if (F.tid < 256) { const size_t q0 = (size_t)e0 * LCAP + hbase[e0] + p0, q1 = (size_t)e1 * LCAP + hbase[e1] + p1;
        LIST[q0] = (unsigned)row * 2u; LIST[q1] = (unsigned)row * 2u + 1u; LISTW[q0] = w0; LISTW[q1] = w1; LISTR[q0] = rstd; LISTR[q1] = rstd; }
    __syncthreads();
}
__device__ __forceinline__ void moe_tables(Frame& F) {
    LAS int* cum = (LAS int*)(F.lds + SCHED_OFF + 256); LAS int* cnt = cum + 40;
    if (F.tid == 0) { int a = 0; for (int e = 0; e < NE; ++e) { const int c = (int)__hip_atomic_load((unsigned*)(F.ctl + CW_ECNT + 64 * e), RLX_AGENT); cnt[e] = c; cum[e] = a; a += (c + 255) >> 8; } cum[NE] = a; }
    __syncthreads();
}

template <class Src>
__device__ __forceinline__ void transpose_item(const Src& src, int k0, int n0, bf16* dst, int drow0, int dld, LAS float* scr, int lane) {
#pragma unroll 8
    for (int i = 0; i < 32; ++i) { const int kk = 2 * i + (lane >> 5); scr[kk * 33 + (lane & 31)] = src(k0 + kk, n0 + (lane & 31)); }
    LDS_WAIT(); asm volatile("" ::: "memory");
    const int c = lane & 7;
#pragma unroll
    for (int j = 0; j < 4; ++j) { const int n = (lane >> 3) + 8 * j; const LAS float* s = scr + (8 * c) * 33 + n;
        v4u o; o.x = pk2(s[0 * 33], s[1 * 33]); o.y = pk2(s[2 * 33], s[3 * 33]); o.z = pk2(s[4 * 33], s[5 * 33]); o.w = pk2(s[6 * 33], s[7 * 33]);
        *(GAS v4u*)(dst + (size_t)(drow0 + n) * dld + k0 + 8 * c) = o; }
    LDS_WAIT(); asm volatile("" ::: "memory");
}
struct SrcScaled { const float* W; int ld; const float* g;
    __device__ __forceinline__ float operator()(int k, int n) const { const float w = W[(size_t)k * ld + n]; return g ? w * g[k] : w; } };

__device__ __forceinline__ void p0_prologue(Frame& F) {
    const float* x = F.in[0]; const float* g1 = F.in[1]; const float* w_in = F.in[2]; const float* wau = F.in[3];
    const float* gng = F.in[5]; const float* wgb = F.in[6]; const float* pw = F.in[7]; const float* ps = F.in[8]; const float* wpb = F.in[9];
    const float* wout = F.in[10]; const float* g2 = F.in[11]; const float* wrg = F.in[12]; const float* wre = F.in[14];
    const float* weg = F.in[16]; const float* weu = F.in[17]; const float* wed = F.in[18];
    bf16* WIN = WSP(bf16, WS_WIN); bf16* WG = WSP(bf16, WS_WG); bf16* WP = WSP(bf16, WS_WP); bf16* WOUT = WSP(bf16, WS_WOUT); bf16* WR = WSP(bf16, WS_WR);
    bf16* WGU = WSP(bf16, WS_WGU); bf16* WD = WSP(bf16, WS_WD); bf16* HB = WSP(bf16, WS_HB);
    {
        LAS float* PWL = (LAS float*)F.lds;
        LAS float* WL = (LAS float*)(F.lds + 65536);
        for (int it = F.bid; it < 64; it += F.G) {
            const int g = it >> 4, nb = it & 15;
            for (int i = F.tid; i < 128 * 128; i += 512) { const int d = i & 127; PWL[i] = pw[(size_t)g * 16384 + i] * ps[g * 128 + d]; }
            for (int i = F.tid; i < 128 * 64; i += 512) { const int d = i >> 6, n = i & 63; WL[i] = wpb[(size_t)(g * 128 + d) * D + nb * 64 + n]; }
            __syncthreads();
            const int n = F.tid & 63, cg = F.tid >> 6;
            float a[16];
#pragma unroll
            for (int ci = 0; ci < 16; ++ci) a[ci] = 0.f;
            for (int d = 0; d < 128; d += 4) {
                const float w0 = WL[(d + 0) * 64 + n], w1 = WL[(d + 1) * 64 + n], w2 = WL[(d + 2) * 64 + n], w3 = WL[(d + 3) * 64 + n];
#pragma unroll
                for (int ci = 0; ci < 16; ++ci) { const f32x4 p = *(const LAS f32x4*)(PWL + (cg * 16 + ci) * 128 + d); a[ci] += p[0] * w0 + p[1] * w1 + p[2] * w2 + p[3] * w3; }
            }
            v4u o0, o1; o0.x = pk2(a[0], a[1]); o0.y = pk2(a[2], a[3]); o0.z = pk2(a[4], a[5]); o0.w = pk2(a[6], a[7]); o1.x = pk2(a[8], a[9]); o1.y = pk2(a[10], a[11]); o1.z = pk2(a[12], a[13]); o1.w = pk2(a[14], a[15]);
            bf16* dp = WP + (size_t)(nb * 64 + n) * PW + g * 128 + cg * 16;
            *(GAS v4u*)dp = o0; *(GAS v4u*)(dp + 8) = o1;
            __syncthreads();
        }
    }
    LAS float* scr = (LAS float*)(F.lds + F.wave * 16384);
    const int gw = F.bid * 8 + F.wave, NGW = F.G * 8;
    constexpr int I_IN1 = 16 * (1536 / 32), I_IN2 = 16 * (2560 / 32), I_Z = 4 * 64, I_WG = 8 * 32, I_WO = 16 * 32, I_WR = 256, I_GU = NE * 2 * 16 * 8, I_WD = NE * 4 * 32;
    constexpr int NITEMS = I_IN1 + I_IN2 + I_Z + I_WG + I_WO + I_WR + I_GU + I_WD;
    for (int it = gw; it < NITEMS; it += NGW) {
        int r = it;
        if (r < I_IN1) { const int kb = r / 48, nb = r % 48; SrcScaled s{w_in, D_IN, g1}; transpose_item(s, 64 * kb, 32 * nb, WIN, 32 * nb, D, scr, F.lane); continue; } r -= I_IN1;
        if (r < I_IN2) { const int kb = r / 80, nb = r % 80; SrcScaled s{w_in, D_IN, g1}; transpose_item(s, 64 * kb, IN_U + 32 * nb, WIN, PJ_U + 32 * nb, D, scr, F.lane); continue; } r -= I_IN2;
        if (r < I_Z) {
            const int nb = r & 3, kb = r >> 2, n = nb * 64 + F.lane;
            float wa[16];
#pragma unroll
            for (int j = 0; j < 16; ++j) wa[j] = wau[j * GKW + n];
            float o[16];
#pragma unroll
            for (int kk = 0; kk < 16; ++kk) { const int k = kb * 16 + kk; const float* wr_ = w_in + (size_t)k * D_IN + IN_A; float a = 0.f;
#pragma unroll
                for (int j = 0; j < 16; ++j) a += wr_[j] * wa[j];
                o[kk] = a * g1[k]; }
            v4u o0, o1; o0.x = pk2(o[0], o[1]); o0.y = pk2(o[2], o[3]); o0.z = pk2(o[4], o[5]); o0.w = pk2(o[6], o[7]); o1.x = pk2(o[8], o[9]); o1.y = pk2(o[10], o[11]); o1.z = pk2(o[12], o[13]); o1.w = pk2(o[14], o[15]);
            bf16* dp = WIN + (size_t)(PJ_Z + n) * D + kb * 16; *(GAS v4u*)dp = o0; *(GAS v4u*)(dp + 8) = o1; continue; } r -= I_Z;
        if (r < I_WG) { const int kb = r / 32, nb = r % 32; SrcScaled s{wgb, D, gng}; transpose_item(s, 64 * kb, 32 * nb, WG, 32 * nb, GVW, scr, F.lane); continue; } r -= I_WG;
        if (r < I_WO) { const int kb = r / 32, nb = r % 32; SrcScaled s{wout, D, nullptr}; transpose_item(s, 64 * kb, 32 * nb, WOUT, 32 * nb, D, scr, F.lane); continue; } r -= I_WO;
        if (r < I_WR) {
            const int j = r; bf16* dp = WR + (size_t)j * D;
#pragma unroll
            for (int q = 0; q < 16; ++q) { const int k = q * 64 + F.lane; float v = 0.f;
                if (j < NG) v = wrg[(size_t)k * NG + j] * g2[k]; else if (j < NG + NE) { const int g = (j - NG) >> 3, e = (j - NG) & 7; v = wre[((size_t)g * D + k) * EPG + e] * g2[k]; }
                dp[k] = (bf16)f2bf(v); }
            continue; } r -= I_WR;
        if (r < I_GU) {
            const int e = r / 256, q = r % 256, bj = q / 128, kb = (q % 128) / 8, nb = q % 8;
            SrcScaled s{(bj ? weu : weg) + (size_t)e * D * DE, DE, g2};
            const int hid0 = 32 * nb, pn = hid0 >> 7, i0 = hid0 & 127;
            transpose_item(s, 64 * kb, hid0, WGU + (size_t)e * 512 * D, pn * 256 + bj * 128 + i0, D, scr, F.lane); continue; } r -= I_GU;
        { const int e = r / 128, q = r % 128, kb = q / 32, nb = q % 32;
            SrcScaled s{wed + (size_t)e * DE * D, D, nullptr}; transpose_item(s, 64 * kb, 32 * nb, WD + (size_t)e * D * DE, 32 * nb, DE, scr, F.lane); }
    }
    for (int m = gw; m < T; m += NGW) {
        const GAS f32x4* xr = (const GAS f32x4*)(x + (size_t)m * D) + F.lane;
        f32x4 v[4]; float s = 0.f;
#pragma unroll
        for (int j = 0; j < 4; ++j) { v[j] = xr[64 * j]; s += (v[j].x * v[j].x + v[j].y * v[j].y) + (v[j].z * v[j].z + v[j].w * v[j].w); }
        const float rstd = 1.0f / sqrtf(wave_sum(s) * (1.f / D) + EPS);
        GAS v2u* o8 = (GAS v2u*)(HB + (size_t)m * D) + F.lane;
#pragma unroll
        for (int j = 0; j < 4; ++j) { v2u w; w.x = pk2(v[j].x * rstd, v[j].y * rstd); w.y = pk2(v[j].z * rstd, v[j].w * rstd); o8[64 * j] = w; }
    }
}


#define WG_SYNC() do { asm volatile("s_waitcnt lgkmcnt(0)" ::: "memory"); __builtin_amdgcn_s_barrier(); asm volatile("" ::: "memory"); } while (0)
constexpr int GL_QD = 0, GL_KD = 9216, GL_KET = 18432, GL_P = 27648, GL_VT = 36864, GL_TOT = 55296, GL_DEC = 57344, GL_SS = 57600;
constexpr int GLS = 72;
__device__ __forceinline__ void gla_unit(Frame& F, const int b, const int h) {
    const bf16* PJ = WSP(bf16, WS_PJ); bf16* ON = WSP(bf16, WS_ON);
    int tid_ = threadIdx.x; asm volatile("" : "+v"(tid_));
    const int tid = tid_, lane = tid & 63, w = __builtin_amdgcn_readfirstlane(tid >> 6), fr = lane & 15, fq = lane >> 4;
    const int tr = tid >> 3, db = tid & 7;
    LAS bf16* QD = (LAS bf16*)(F.lds + GL_QD); LAS bf16* KD = (LAS bf16*)(F.lds + GL_KD); LAS bf16* KET = (LAS bf16*)(F.lds + GL_KET);
    LAS bf16* P = (LAS bf16*)(F.lds + GL_P); LAS bf16* VT = (LAS bf16*)(F.lds + GL_VT);
    LAS float* TOT = (LAS float*)(F.lds + GL_TOT); LAS float* DEC = (LAS float*)(F.lds + GL_DEC); LAS float* SS = (LAS float*)(F.lds + GL_SS);
    f32x4 Sacc[4];
#pragma unroll
    for (int i = 0; i < 4; ++i) Sacc[i] = (f32x4){0.f, 0.f, 0.f, 0.f};
    const size_t rowbase = (size_t)b * SEQ;
    const int vs0 = tid >> 4, vb = tid & 15;
    v4u gq, qq, kq, vq0, vq1;
    { const bf16* rp = PJ + (rowbase + tr) * NPJ + h * 64 + db * 8; gq = *(const v4u*)(rp + PJ_Z); qq = *(const v4u*)(rp + PJ_Q); kq = *(const v4u*)(rp + PJ_K);
      const bf16* vp = PJ + (rowbase + vs0) * NPJ + PJ_V + h * 128 + vb * 8; vq0 = *(const v4u*)vp; vq1 = *(const v4u*)(vp + (size_t)32 * NPJ); }
    for (int n = 0; n < SEQ / GCH; ++n) {
        const size_t tb = rowbase + (size_t)n * GCH;
        const v4u g8 = gq, q8 = qq, k8 = kq, v80 = vq0, v81 = vq1;
        if (n + 1 < SEQ / GCH) { const bf16* rp = PJ + (tb + GCH + tr) * NPJ + h * 64 + db * 8; gq = *(const v4u*)(rp + PJ_Z); qq = *(const v4u*)(rp + PJ_Q); kq = *(const v4u*)(rp + PJ_K);
            const bf16* vp = PJ + (tb + GCH + vs0) * NPJ + PJ_V + h * 128 + vb * 8; vq0 = *(const v4u*)vp; vq1 = *(const v4u*)(vp + (size_t)32 * NPJ); }
        float bx[8];
        { f32x4 a, c; unpack8(g8, a, c); bx[0] = a[0]; bx[1] = a[1]; bx[2] = a[2]; bx[3] = a[3]; bx[4] = c[0]; bx[5] = c[1]; bx[6] = c[2]; bx[7] = c[3]; }
#pragma unroll
        for (int off = 8; off < 64; off <<= 1) {
#pragma unroll
            for (int j = 0; j < 8; ++j) { const float y = __shfl_up(bx[j], off); bx[j] += (lane >= off) ? y : 0.f; } }
        if (lane >= 56) { LAS f32x4* tp = (LAS f32x4*)(TOT + w * 64 + db * 8); tp[0] = (f32x4){bx[0], bx[1], bx[2], bx[3]}; tp[1] = (f32x4){bx[4], bx[5], bx[6], bx[7]}; }
        WG_SYNC();
        float pre[8], tot[8];
#pragma unroll
        for (int j = 0; j < 8; ++j) { pre[j] = 0.f; tot[j] = 0.f; }
#pragma unroll
        for (int ww = 0; ww < 8; ++ww) { const f32x4 a = *(const LAS f32x4*)(TOT + ww * 64 + db * 8), c = *(const LAS f32x4*)(TOT + ww * 64 + db * 8 + 4); const float sel = (ww < w) ? 1.f : 0.f;
#pragma unroll
            for (int j = 0; j < 4; ++j) { tot[j] += a[j]; tot[4 + j] += c[j]; pre[j] += sel * a[j]; pre[4 + j] += sel * c[j]; } }
        float qf[8], kf[8];
        { f32x4 a, c; unpack8(q8, a, c); qf[0] = a[0]; qf[1] = a[1]; qf[2] = a[2]; qf[3] = a[3]; qf[4] = c[0]; qf[5] = c[1]; qf[6] = c[2]; qf[7] = c[3];
          unpack8(k8, a, c); kf[0] = a[0]; kf[1] = a[1]; kf[2] = a[2]; kf[3] = a[3]; kf[4] = c[0]; kf[5] = c[1]; kf[6] = c[2]; kf[7] = c[3]; }
        float qd[8], kd[8], ke[8], dc[8];
#pragma unroll
        for (int j = 0; j < 8; ++j) { const float bb = bx[j] + pre[j]; const float eb = __expf(bb), enb = __builtin_amdgcn_rcpf(eb); dc[j] = __expf(tot[j]);
            qd[j] = qf[j] * eb * 0.125f; kd[j] = kf[j] * enb; ke[j] = kd[j] * dc[j]; }
        { v4u o; o.x = pk2(qd[0], qd[1]); o.y = pk2(qd[2], qd[3]); o.z = pk2(qd[4], qd[5]); o.w = pk2(qd[6], qd[7]); *(LAS v4u*)(QD + tr * GLS + db * 8) = o;
          o.x = pk2(kd[0], kd[1]); o.y = pk2(kd[2], kd[3]); o.z = pk2(kd[4], kd[5]); o.w = pk2(kd[6], kd[7]); *(LAS v4u*)(KD + tr * GLS + db * 8) = o; }
#pragma unroll
        for (int j = 0; j < 8; ++j) KET[(db * 8 + j) * GLS + tr] = (bf16)(pk2(ke[j], ke[j]) & 0xffffu);
        if (tr == 0) { *(LAS f32x4*)(DEC + db * 8) = (f32x4){dc[0], dc[1], dc[2], dc[3]}; *(LAS f32x4*)(DEC + db * 8 + 4) = (f32x4){dc[4], dc[5], dc[6], dc[7]}; }
        { const unsigned vw0[4] = {v80.x, v80.y, v80.z, v80.w}, vw1[4] = {v81.x, v81.y, v81.z, v81.w};
#pragma unroll
          for (int j = 0; j < 4; ++j) { VT[(vb * 8 + 2 * j) * GLS + vs0] = (bf16)(vw0[j] & 0xffffu); VT[(vb * 8 + 2 * j + 1) * GLS + vs0] = (bf16)(vw0[j] >> 16);
              VT[(vb * 8 + 2 * j) * GLS + vs0 + 32] = (bf16)(vw1[j] & 0xffffu); VT[(vb * 8 + 2 * j + 1) * GLS + vs0 + 32] = (bf16)(vw1[j] >> 16); } }
        WG_SYNC();
        bf16 rv[4][4];
#pragma unroll
        for (int mt = 0; mt < 4; ++mt)
#pragma unroll
            for (int i = 0; i < 4; ++i) rv[mt][i] = PJ[(tb + 16 * mt + 4 * fq + i) * NPJ + PJ_R + h * 128 + 16 * w + fr];
        { const int tt = w >> 1, st0 = (w & 1) * 2;
          bf16x8 af[2];
#pragma unroll
          for (int ks = 0; ks < 2; ++ks) af[ks] = *(const LAS bf16x8*)(QD + (16 * tt + fr) * GLS + 32 * ks + 8 * fq);
#pragma unroll
          for (int q2 = 0; q2 < 2; ++q2) { const int st = st0 + q2; f32x4 c = (f32x4){0.f, 0.f, 0.f, 0.f};
              if (st <= tt) {
#pragma unroll
                  for (int ks = 0; ks < 2; ++ks) { const bf16x8 bfm = *(const LAS bf16x8*)(KD + (16 * st + fr) * GLS + 32 * ks + 8 * fq); c = __builtin_amdgcn_mfma_f32_16x16x32_bf16(af[ks], bfm, c, 0, 0, 0); } }
#pragma unroll
              for (int i = 0; i < 4; ++i) { const int t = 16 * tt + 4 * fq + i, sidx = 16 * st + fr; const float val = (sidx <= t) ? c[i] : 0.f; P[t * GLS + sidx] = (bf16)(pk2(val, val) & 0xffffu); } } }
        WG_SYNC();
        bf16x8 vtf[2], sb[2];
#pragma unroll
        for (int ks = 0; ks < 2; ++ks) { vtf[ks] = *(const LAS bf16x8*)(VT + (16 * w + fr) * GLS + 32 * ks + 8 * fq);
            v4u pw_; pw_.x = pk2(Sacc[2 * ks][0], Sacc[2 * ks][1]); pw_.y = pk2(Sacc[2 * ks][2], Sacc[2 * ks][3]); pw_.z = pk2(Sacc[2 * ks + 1][0], Sacc[2 * ks + 1][1]); pw_.w = pk2(Sacc[2 * ks + 1][2], Sacc[2 * ks + 1][3]);
            sb[ks] = __builtin_bit_cast(bf16x8, pw_); }
        f32x4 o[4];
#pragma unroll
        for (int mt = 0; mt < 4; ++mt) { o[mt] = (f32x4){0.f, 0.f, 0.f, 0.f};
#pragma unroll
            for (int ks = 0; ks < 2; ++ks) { const bf16x8 a = *(const LAS bf16x8*)(P + (16 * mt + fr) * GLS + 32 * ks + 8 * fq); o[mt] = __builtin_amdgcn_mfma_f32_16x16x32_bf16(a, vtf[ks], o[mt], 0, 0, 0); }
#pragma unroll
            for (int ks = 0; ks < 2; ++ks) { const v2u lo = *(const LAS v2u*)(QD + (16 * mt + fr) * GLS + 32 * ks + 4 * fq), hi = *(const LAS v2u*)(QD + (16 * mt + fr) * GLS + 32 * ks + 16 + 4 * fq);
                v4u aw; aw.x = lo.x; aw.y = lo.y; aw.z = hi.x; aw.w = hi.y; o[mt] = __builtin_amdgcn_mfma_f32_16x16x32_bf16(__builtin_bit_cast(bf16x8, aw), sb[ks], o[mt], 0, 0, 0); } }
#pragma unroll
        for (int mt = 0; mt < 4; ++mt) { const f32x4 d4 = *(const LAS f32x4*)(DEC + 16 * mt + 4 * fq); Sacc[mt] = Sacc[mt] * d4;
#pragma unroll
            for (int ks = 0; ks < 2; ++ks) { const bf16x8 a = *(const LAS bf16x8*)(KET + (16 * mt + fr) * GLS + 32 * ks + 8 * fq); Sacc[mt] = __builtin_amdgcn_mfma_f32_16x16x32_bf16(a, vtf[ks], Sacc[mt], 0, 0, 0); } }
#pragma unroll
        for (int mt = 0; mt < 4; ++mt)
#pragma unroll
            for (int i = 0; i < 4; ++i) { float sq = o[mt][i] * o[mt][i]; sq += __shfl_xor(sq, 1); sq += __shfl_xor(sq, 2); sq += __shfl_xor(sq, 4); sq += __shfl_xor(sq, 8);
                if (fr == 0) SS[(16 * mt + 4 * fq + i) * 8 + w] = sq; }
        WG_SYNC();
#pragma unroll
        for (int mt = 0; mt < 4; ++mt)
#pragma unroll
            for (int i = 0; i < 4; ++i) { const int t = 16 * mt + 4 * fq + i; const f32x4 s0 = *(const LAS f32x4*)(SS + t * 8), s1 = *(const LAS f32x4*)(SS + t * 8 + 4);
                const float tot2 = ((s0[0] + s0[1]) + (s0[2] + s0[3])) + ((s1[0] + s1[1]) + (s1[2] + s1[3]));
                const float rstd = 1.0f / sqrtf(tot2 * (1.0f / GDV) + EPS);
                const float val = o[mt][i] * rstd * bf1(rv[mt][i]);
                ON[(tb + t) * GVW + h * 128 + 16 * w + fr] = (bf16)(pk2(val, val) & 0xffffu); }
    }
    WG_SYNC();
}
__device__ __forceinline__ void pool_items(Frame& F, const int widx, const int nworkers) {
    const bf16* PJ = WSP(bf16, WS_PJ); bf16* PD = WSP(bf16, WS_PD);
    for (long p = (long)widx * 512 + F.tid; p < (long)T * 64; p += (long)nworkers * 512) {
        const int t = (int)(p >> 6), cb = (int)(p & 63), pos = t & (SEQ - 1), wlen = 2 << (cb >> 4), cnt = (pos + 1 < wlen) ? pos + 1 : wlen;
        f32x4 a0 = (f32x4){0.f, 0.f, 0.f, 0.f}, a1 = a0, o0 = a0, o1 = a0;
        for (int i = 0; i < cnt; ++i) { const v4u vw = *(const v4u*)(PJ + (size_t)(t - i) * NPJ + PJ_U + cb * 8); f32x4 u0, u1; unpack8(vw, u0, u1); a0 += u0; a1 += u1; if (i == 0) { o0 = u0; o1 = u1; } }
        const float inv = 1.0f / (float)cnt;
        *(v4u*)(PD + (size_t)t * PW + cb * 8) = pack8(a0 * inv - o0, a1 * inv - o1);
    }
}
__device__ __forceinline__ void p2_phase(Frame& F) {
    constexpr int NU = BATCH * GH;
    if (F.G > NU) {
        if (F.bid < NU) gla_unit(F, F.bid >> 2, F.bid & 3);
        else pool_items(F, F.bid - NU, F.G - NU);
    } else {
        for (int u = F.bid; u < NU; u += F.G) gla_unit(F, u >> 2, u & 3);
        pool_items(F, F.bid, F.G);
    }
}

#if DBG
__device__ __forceinline__ void dbg_fail(Frame& F, unsigned code) { unsigned expect = 0u; __hip_atomic_compare_exchange_strong((unsigned*)(F.ctl + CW_DBG), &expect, code, __ATOMIC_RELAXED, __ATOMIC_RELAXED, __HIP_MEMORY_SCOPE_AGENT); }
__device__ __forceinline__ bool dbg_close(float got, float want) { return fabsf(got - want) <= 0.03f + 0.03f * fabsf(want); }
__device__ __forceinline__ void dbg_check_p1(Frame& F) {
    if (F.bid != 0 || F.tid >= 256) return;
    const float* x = F.in[0]; const float* g1 = F.in[1]; const float* w_in = F.in[2]; const float* wau = F.in[3]; const float* ba = F.in[4];
    const bf16* PJ = WSP(bf16, WS_PJ);
    const int tok = (int)(((unsigned)F.tid * 2654435761u) % (unsigned)T);
    const int col = (int)(((unsigned)F.tid * 40503u + 17u * (unsigned)F.tid * (unsigned)F.tid) % (unsigned)NPJ);
    const float* xr = x + (size_t)tok * D; float ss = 0.f;
    for (int k = 0; k < D; ++k) ss += xr[k] * xr[k];
    const float rstd = 1.0f / sqrtf(ss / D + EPS);
    float want;
    if (col >= PJ_Z && col < PJ_U) {
        float al[16];
#pragma unroll
        for (int j = 0; j < 16; ++j) al[j] = 0.f;
        for (int k = 0; k < D; ++k) { const float hk = xr[k] * rstd * g1[k];
#pragma unroll
            for (int j = 0; j < 16; ++j) al[j] += hk * w_in[(size_t)k * D_IN + IN_A + j]; }
        float z = 0.f;
#pragma unroll
        for (int j = 0; j < 16; ++j) z += al[j] * wau[j * GKW + (col - PJ_Z)];
        z += ba[col - PJ_Z];
        want = (fminf(z, 0.f) - logf(1.0f + expf(-fabsf(z)))) / 16.0f;
    } else {
        const int wc_ = col < PJ_Z ? col : col - PJ_U + IN_U; float a = 0.f;
        for (int k = 0; k < D; ++k) a += xr[k] * rstd * g1[k] * w_in[(size_t)k * D_IN + wc_];
        if (col >= PJ_R && col < PJ_Z) want = a / (1.0f + expf(-a)); else if (col >= PJ_GG) want = 1.0f / (1.0f + expf(-a)); else want = a;
    }
    const float got = bf1(PJ[(size_t)tok * NPJ + col]);
    if (!dbg_close(got, want)) dbg_fail(F, 1u);
}

__device__ __forceinline__ void dbg_check_gla(Frame& F) {
    if (F.bid != 1) return;
    const bf16* PJ = WSP(bf16, WS_PJ); const bf16* ON = WSP(bf16, WS_ON);
    const int b = 2, h = 1, v = F.tid & 127; const bool act = F.tid < 128;
    LAS float* S = (LAS float*)F.lds;
    LAS float* red = (LAS float*)(F.lds + 32768);
    if (act) for (int d = 0; d < 64; ++d) S[d * 128 + v] = 0.f;
    __syncthreads();
    bool bad = false;
    for (int t = 0; t < 150; ++t) {
        const bf16* rp = PJ + ((size_t)b * SEQ + t) * NPJ; float o = 0.f;
        if (act) { const float vv = bf1(rp[PJ_V + h * 128 + v]);
            for (int d = 0; d < 64; ++d) { const float la = bf1(rp[PJ_Z + h * 64 + d]), kk = bf1(rp[PJ_K + h * 64 + d]), qq = bf1(rp[PJ_Q + h * 64 + d]);
                const float sn = expf(la) * S[d * 128 + v] + kk * vv; S[d * 128 + v] = sn; o += qq * 0.125f * sn; }
            red[v] = o * o; }
        __syncthreads();
        if (act) { float ss = 0.f; for (int i = 0; i < 128; ++i) ss += red[i];
            const float want = o * (1.0f / sqrtf(ss / 128.f + EPS)) * bf1(rp[PJ_R + h * 128 + v]);
            const float got = bf1(ON[((size_t)b * SEQ + t) * GVW + h * 128 + v]);
            if (!dbg_close(got, want)) bad = true; }
        __syncthreads();
    }
    if (bad) dbg_fail(F, 2u);
}
__device__ __forceinline__ void dbg_check_pool(Frame& F) {
    if (F.bid != 2) return;
    const bf16* PJ = WSP(bf16, WS_PJ); const bf16* PD = WSP(bf16, WS_PD);
    int tok = (int)(((unsigned)F.tid * 2654435761u) % (unsigned)T); if (F.tid < 40) tok = (F.tid & 1) * SEQ * 3 + (F.tid >> 1);
    const int c = (int)(((unsigned)F.tid * 40503u) % (unsigned)PW), pos = tok & (SEQ - 1), wlen = 2 << (c >> 7), cnt = pos + 1 < wlen ? pos + 1 : wlen;
    float a = 0.f; for (int i = 0; i < cnt; ++i) a += bf1(PJ[(size_t)(tok - i) * NPJ + PJ_U + c]);
    const float want = a / cnt - bf1(PJ[(size_t)tok * NPJ + PJ_U + c]);
    if (!dbg_close(bf1(PD[(size_t)tok * PW + c]), want)) dbg_fail(F, 3u);
}
__device__ __forceinline__ void dbg_check_mg(Frame& F) {
    if (F.bid != 3 || F.tid >= 64) return;
    const bf16* PJ = WSP(bf16, WS_PJ); const bf16* ON = WSP(bf16, WS_ON); const bf16* PD = WSP(bf16, WS_PD); const bf16* MG = WSP(bf16, WS_MG);
    const float* gng = F.in[5]; const float* wgb = F.in[6]; const float* pw = F.in[7]; const float* ps = F.in[8]; const float* wpb = F.in[9];
    const int tok = (int)(((unsigned)F.tid * 2654435761u + 12345u) % (unsigned)T), col = (int)(((unsigned)F.tid * 40503u + 77u) % (unsigned)D);
    float yg = 0.f; for (int k = 0; k < GVW; ++k) yg += bf1(ON[(size_t)tok * GVW + k]) * gng[k] * wgb[(size_t)k * D + col];
    float yp = 0.f;
    for (int g = 0; g < 4; ++g) for (int d = 0; d < 128; ++d) { float m = 0.f; for (int c = 0; c < 128; ++c) m += bf1(PD[(size_t)tok * PW + g * 128 + c]) * pw[((size_t)g * 128 + c) * 128 + d];
        yp += m * ps[g * 128 + d] * wpb[(size_t)(g * 128 + d) * D + col]; }
    const float want = bf1(PJ[(size_t)tok * NPJ + PJ_GG + col]) * yg + bf1(PJ[(size_t)tok * NPJ + PJ_GP + col]) * yp;
    if (!dbg_close(bf1(MG[(size_t)tok * D + col]), want)) dbg_fail(F, 4u);
}
__device__ __forceinline__ void dbg_check_x1(Frame& F) {
    if (F.bid != 4 || F.tid >= 128) return;
    const bf16* MG = WSP(bf16, WS_MG); const float* X1 = WSP(float, WS_X1); const bf16* X1B = WSP(bf16, WS_X1B); const float* SSQ = WSP(float, WS_SSQ); const float* x = F.in[0]; const float* wout = F.in[10];
    const int tok = (int)(((unsigned)F.tid * 2654435761u + 999u) % (unsigned)T), col = (int)(((unsigned)F.tid * 40503u + 5u) % (unsigned)D);
    float a = x[(size_t)tok * D + col]; for (int k = 0; k < D; ++k) a += bf1(MG[(size_t)tok * D + k]) * wout[(size_t)k * D + col];
    if (!dbg_close(X1[(size_t)tok * D + col], a) || !dbg_close(bf1(X1B[(size_t)tok * D + col]), a)) dbg_fail(F, 5u);
    float ss = 0.f; for (int k = 0; k < D; ++k) { const float v = X1[(size_t)tok * D + k]; ss += v * v; }
    float sp = 0.f; for (int j = 0; j < 16; ++j) sp += SSQ[(size_t)tok * 16 + j];
    if (fabsf(ss - sp) > 1e-3f * ss) dbg_fail(F, 6u);
}
#endif

struct Args { const float* in[20]; float* out; unsigned char* ws; };
__global__ void __launch_bounds__(512, 2) fwd_kernel(Args args) {
    extern __shared__ __attribute__((aligned(16))) unsigned char lds[];
    Frame F;
    F.lds = (LAS unsigned char*)lds;
    F.MISC = (volatile LAS unsigned*)(F.lds + MISC_OFF);
    F.tid = threadIdx.x; F.lane = F.tid & 63; F.wave = __builtin_amdgcn_readfirstlane(F.tid >> 6);
    F.G = gridDim.x; F.bid = blockIdx.x;
    F.ws = args.ws; F.out = args.out; F.ctl = (gu32*)(args.ws + WS_CTL);
#pragma unroll
    for (int i = 0; i < 20; ++i) F.in[i] = args.in[i];
    for (int u = F.tid; u < (LDS_BYTES - RING_BYTES) / 4; u += 512) ((LAS unsigned*)(F.lds + RING_BYTES))[u] = 0u;
    __syncthreads();
    XcdBarrier bar = xcd_barrier_post((unsigned*)(F.ctl + CW_BAR), F.MISC + 8);
#define GRID_BAR() xcd_barrier(bar)

    p0_prologue(F);
    GRID_BAR();
    if (NPH > 1) {
        pg8::StaticSched S; S.init(WSP(bf16, WS_HB), D, WSP(bf16, WS_WIN), D, T, NPJ, F.G, F.bid);
        EpiP1 E{WSP(bf16, WS_PJ), F.in[4]};
        pg8::gemm_phase<EpiP1, pg8::StaticSched, false, true>(F.lds, D, D, D, S, E);
        GRID_BAR();
#if DBG
        dbg_check_p1(F);
        GRID_BAR();
#endif
    }
    if (NPH > 2) {
        p2_phase(F);
        GRID_BAR();
#if DBG
        dbg_check_gla(F); dbg_check_pool(F);
        GRID_BAR();
#endif
    }
    if (NPH > 3) {
        pg8::StaticSched S; S.init(WSP(bf16, WS_ON), GVW, WSP(bf16, WS_WG), GVW, T, D, F.G, F.bid);
        EpiD E{WSP(bf16, WS_TG), WSP(bf16, WS_PJ)};
        pg8::gemm_phase<EpiD, pg8::StaticSched, false, true>(F.lds, GVW, GVW, GVW, S, E);
        GRID_BAR();
    }
    if (NPH > 4) {
        pg8::StaticSched S; S.init(WSP(bf16, WS_PD), PW, WSP(bf16, WS_WP), PW, T, D, F.G, F.bid);
        EpiE E{WSP(bf16, WS_MG), WSP(bf16, WS_TG), WSP(bf16, WS_PJ)};
        pg8::gemm_phase<EpiE, pg8::StaticSched, false, true>(F.lds, PW, PW, PW, S, E);
        GRID_BAR();
#if DBG
        dbg_check_mg(F);
        GRID_BAR();
#endif
    }
    if (NPH > 5) {
        pg8::StaticSched S; S.init(WSP(bf16, WS_MG), D, WSP(bf16, WS_WOUT), D, T, D, F.G, F.bid);
        EpiF E{F.in[0], WSP(float, WS_X1), WSP(bf16, WS_X1B), WSP(float, WS_SSQ)};
        pg8::gemm_phase<EpiF, pg8::StaticSched, false, true>(F.lds, D, D, D, S, E);
        GRID_BAR();
#if DBG
        dbg_check_x1(F);
        GRID_BAR();
#endif
    }
    if (NPH > 6) {
        pg8::StaticSched S; S.init(WSP(bf16, WS_X1B), D, WSP(bf16, WS_WR), D, T, 256, F.G, F.bid);
        EpiG E{WSP(float, WS_LG)};
        pg8::gemm_phase<EpiG, pg8::StaticSched, false, true>(F.lds, D, D, D, S, E);
        VM_WAIT(); __syncthreads();
        pg8::Unit u; for (int i = 0; S.next(i, u); ++i) route_rows(F, u.r0);
        GRID_BAR();
    }
    if (NPH > 7) {
        moe_tables(F);
        MoeSched S{(const LAS int*)(F.lds + SCHED_OFF + 256), (const LAS int*)(F.lds + SCHED_OFF + 256) + 40, WSP(unsigned, WS_LIST), (const char*)WSP(bf16, WS_X1B), (const char*)WSP(bf16, WS_WGU), 2, F.G, F.bid, 0};
        EpiH E{WSP(bf16, WS_ACT), WSP(float, WS_LISTR)};
        pg8::gemm_phase<EpiH, MoeSched, true, true>(F.lds, D, D, D, S, E);
        GRID_BAR();
    }
    if (NPH > 8) {
        MoeSched S{(const LAS int*)(F.lds + SCHED_OFF + 256), (const LAS int*)(F.lds + SCHED_OFF + 256) + 40, WSP(unsigned, WS_LIST), (const char*)WSP(bf16, WS_ACT), (const char*)WSP(bf16, WS_WD), 4, F.G, F.bid, 1};
        EpiI E{WSP(bf16, WS_Y), WSP(unsigned, WS_LIST), WSP(float, WS_LISTW)};
        pg8::gemm_phase<EpiI, MoeSched, false, true>(F.lds, DE, DE, DE, S, E);
        GRID_BAR();
    }
    if (NPH > 9) {
        const float* gf = F.in[19]; const float* X1 = WSP(float, WS_X1); const bf16* Y = WSP(bf16, WS_Y);
        const int gw = F.bid * 8 + F.wave, NGW = F.G * 8;
        unsigned code = 0;
#if DBG
        code = __hip_atomic_load((unsigned*)(F.ctl + CW_DBG), RLX_AGENT);
        if (__hip_atomic_load((unsigned*)(F.ctl + CW_BAR) + XB_TMO, RLX_AGENT) != 0u) code = 9;
#endif
        for (int m = gw; m < T; m += NGW) {
            const GAS f32x4* xr = (const GAS f32x4*)(X1 + (size_t)m * D) + F.lane;
            const GAS v2u* y0 = (const GAS v2u*)(Y + (size_t)(2 * m) * D) + F.lane; const GAS v2u* y1 = (const GAS v2u*)(Y + (size_t)(2 * m + 1) * D) + F.lane;
            f32x4 v[4]; float s_ = 0.f;
#pragma unroll
            for (int j = 0; j < 4; ++j) { const v2u a = y0[64 * j], b = y1[64 * j]; v[j] = xr[64 * j] + (f32x4){bflo(a.x), bfhi(a.x), bflo(a.y), bfhi(a.y)} + (f32x4){bflo(b.x), bfhi(b.x), bflo(b.y), bfhi(b.y)};
                s_ += (v[j].x * v[j].x + v[j].y * v[j].y) + (v[j].z * v[j].z + v[j].w * v[j].w); }
            const float rstd = 1.0f / sqrtf(wave_sum(s_) * (1.f / D) + EPS);
            GAS f32x4* o = (GAS f32x4*)(F.out + (size_t)m * D) + F.lane;
#pragma unroll
            for (int j = 0; j < 4; ++j) { const f32x4 g = *((const GAS f32x4*)gf + F.lane + 64 * j); f32x4 r = v[j] * rstd * g; if (code) r = (f32x4){10.f * code, 10.f * code, 10.f * code, 10.f * code}; o[64 * j] = r; }
        }
    } else
    {
        const float* gf = F.in[19]; const float* x = (NPH > 5) ? (const float*)WSP(float, WS_X1) : F.in[0];
        const int gw = F.bid * 8 + F.wave, NGW = F.G * 8;
        unsigned code = 0;
#if DBG
        code = __hip_atomic_load((unsigned*)(F.ctl + CW_DBG), RLX_AGENT);
        if (__hip_atomic_load((unsigned*)(F.ctl + CW_BAR) + XB_TMO, RLX_AGENT) != 0u) code = 9;
#endif
        for (int m = gw; m < T; m += NGW) {
            const GAS f32x4* xr = (const GAS f32x4*)(x + (size_t)m * D) + F.lane;
            f32x4 v[4]; float s = 0.f;
#pragma unroll
            for (int j = 0; j < 4; ++j) { v[j] = xr[64 * j]; s += (v[j].x * v[j].x + v[j].y * v[j].y) + (v[j].z * v[j].z + v[j].w * v[j].w); }
            const float rstd = 1.0f / sqrtf(wave_sum(s) * (1.f / D) + EPS);
            GAS f32x4* o = (GAS f32x4*)(F.out + (size_t)m * D) + F.lane;
#pragma unroll
            for (int j = 0; j < 4; ++j) { const f32x4 g = *((const GAS f32x4*)gf + F.lane + 64 * j); f32x4 r = v[j] * rstd * g; if (code) r = (f32x4){10.f * code, 10.f * code, 10.f * code, 10.f * code}; o[64 * j] = r; }
        }
    }
}

extern "C" void kernel_launch(void* const* d_in, const int* in_sizes, int n_in, void* d_out, int out_size, void* d_ws, size_t ws_size, hipStream_t stream) {
    static int grid = 0;
    if (grid == 0) {
        if (n_in != 20 || in_sizes[0] != T * D || out_size != T * D || ws_size < WS_END) { fprintf(stderr, "kernel_launch: unexpected shapes (n_in %d, in0 %d, out %d, ws %zu)\n", n_in, n_in > 0 ? in_sizes[0] : -1, out_size, ws_size); grid = -1; return; }
        int dev = 0, cus = 0, per_cu = 0;
        if (hipGetDevice(&dev) != hipSuccess || hipDeviceGetAttribute(&cus, hipDeviceAttributeMultiprocessorCount, dev) != hipSuccess) { grid = -1; return; }
        if (hipFuncSetAttribute((const void*)fwd_kernel, hipFuncAttributeMaxDynamicSharedMemorySize, LDS_BYTES) != hipSuccess) { fprintf(stderr, "kernel_launch: hipFuncSetAttribute failed\n"); grid = -1; return; }
        if (hipOccupancyMaxActiveBlocksPerMultiprocessor(&per_cu, (const void*)fwd_kernel, 512, LDS_BYTES) != hipSuccess || per_cu < 1) fprintf(stderr, "kernel_launch: occupancy query says %d\n", per_cu);
        (void)hipGetLastError();
        grid = cus;
    }
    if (grid < 0) return;
    if (hipMemsetAsync((char*)d_ws + WS_CTL, 0, CTL_ZERO_BYTES, stream) != hipSuccess) return;
    Args a{};
    for (int i = 0; i < 20; ++i) a.in[i] = (const float*)d_in[i];
    a.out = (float*)d_out; a.ws = (unsigned char*)d_ws;
    hipLaunchKernelGGL(fwd_kernel, dim3(grid), dim3(512), LDS_BYTES, stream, a);
}
```

```cpp
#include <hip/hip_runtime.h>
#include <cstdio>
#include <cstdint>

#ifndef DBG
#define DBG 0
#endif
#ifndef REPMASK
#define REPMASK 0
#endif
#define REPS(k) ((((REPMASK) >> (k)) & 1) ? 2 : 1)
#ifndef NPH
#define NPH 10
#endif

constexpr int BATCH = 16, SEQ = 4096, T = BATCH * SEQ, D = 1024;
constexpr int GH = 4, GDK = 64, GDV = 128, GKW = 256, GVW = 512, GRANK = 16, GCH = 64;
constexpr int PW = 512, PGW = 128;
constexpr int D_IN = 4112;
constexpr int IN_Q = 0, IN_K = 256, IN_V = 512, IN_R = 1024, IN_A = 1536, IN_U = 1552, IN_GG = 2064, IN_GP = 3088;
constexpr int NPJ = 4352;
constexpr int PJ_Q = 0, PJ_K = 256, PJ_V = 512, PJ_R = 1024, PJ_Z = 1536, PJ_U = 1792, PJ_GG = 2304, PJ_GP = 3328;
constexpr int NE = 32, EPG = 8, NG = 4, DE = 256;
constexpr int NA = 2 * T;
constexpr int LCAP = T;
constexpr float EPS = 1e-6f;

constexpr size_t MiB = 1u << 20;
constexpr size_t WS_CTL = 0, CTL_ZERO_BYTES = 1 * MiB;
constexpr size_t WS_WIN = 1 * MiB;
constexpr size_t WS_WG = 10 * MiB;
constexpr size_t WS_WP = 11 * MiB;
constexpr size_t WS_WOUT = 12 * MiB;
constexpr size_t WS_WR = 14 * MiB;
constexpr size_t WS_WGU = 15 * MiB;
constexpr size_t WS_WD = 47 * MiB;
constexpr size_t WS_HB = 64 * MiB;
constexpr size_t WS_TG = WS_HB;
constexpr size_t WS_MG = 192 * MiB;
constexpr size_t WS_BC = 192 * MiB;
constexpr size_t WS_Y = 64 * MiB;
constexpr size_t WS_ON = 320 * MiB;
constexpr size_t WS_PD = 384 * MiB;
constexpr size_t WS_ACT = 320 * MiB;
constexpr size_t WS_PJ = 448 * MiB;
constexpr size_t WS_X1B = 704 * MiB;
constexpr size_t WS_LG = 832 * MiB;
constexpr size_t WS_SSQ = 848 * MiB;
constexpr size_t WS_LIST = 852 * MiB;
constexpr size_t WS_LISTW = 864 * MiB;
constexpr size_t WS_LISTR = 872 * MiB;
constexpr size_t WS_END = 992 * MiB;
static_assert(WS_PJ + (size_t)T * NPJ * 2 <= WS_END && WS_LISTR + (size_t)NE * LCAP * 4 <= WS_END && WS_ACT + (size_t)(NA + NE * 256) * DE * 2 <= WS_PJ, "d_ws map");
constexpr int CW_TMO = 0, CW_DBG = 2;
constexpr int CW_BAR = 4096;
constexpr int CW_ECNT = 16384;

constexpr int RING_BYTES = 131072;
constexpr int MISC_OFF = RING_BYTES + 320;
constexpr int SCHED_OFF = RING_BYTES + 1024;
constexpr int LDS_BYTES = 147456;

#define GAS __attribute__((address_space(1)))
#define LAS __attribute__((address_space(3)))
typedef unsigned short bf16;
typedef unsigned v4u __attribute__((ext_vector_type(4)));
typedef unsigned v2u __attribute__((ext_vector_type(2)));
typedef float f32x4 __attribute__((ext_vector_type(4)));
typedef short bf16x8 __attribute__((ext_vector_type(8)));
typedef short bf16x4 __attribute__((ext_vector_type(4)));
typedef GAS unsigned gu32;
#define RLX_AGENT __ATOMIC_RELAXED, __HIP_MEMORY_SCOPE_AGENT
#define LDS_WAIT() asm volatile("s_waitcnt lgkmcnt(0)" ::: "memory")
#define VM_WAIT() asm volatile("s_waitcnt vmcnt(0)" ::: "memory")
__device__ __forceinline__ unsigned f2bf(float f) { unsigned u = __builtin_bit_cast(unsigned, f); return (u + 0x7fffu + ((u >> 16) & 1u)) >> 16; }
__device__ __forceinline__ unsigned pk2(float lo, float hi) { unsigned r; asm volatile("v_cvt_pk_bf16_f32 %0, %1, %2" : "=v"(r) : "v"(lo), "v"(hi)); return r; }
__device__ __forceinline__ float bflo(unsigned w) { return __builtin_bit_cast(float, w << 16); }
__device__ __forceinline__ float bfhi(unsigned w) { return __builtin_bit_cast(float, w & 0xffff0000u); }
__device__ __forceinline__ float bf1(bf16 h) { return __builtin_bit_cast(float, (unsigned)h << 16); }
__device__ __forceinline__ float fsigmoid(float x) { return __builtin_amdgcn_rcpf(1.0f + __expf(-x)); }
__device__ __forceinline__ float wave_sum(float v) {
#pragma unroll
    for (int o = 1; o < 64; o <<= 1) v += __shfl_xor(v, o);
    return v;
}


template <int CTRL> __device__ __forceinline__ float dpp_f(float x) { return __builtin_bit_cast(float, __builtin_amdgcn_update_dpp(0, __builtin_bit_cast(int, x), CTRL, 0xf, 0xf, true)); }
__device__ __forceinline__ float row16_sum(float x) { x += dpp_f<0x128>(x); x += dpp_f<0x124>(x); x += dpp_f<0x122>(x); x += dpp_f<0x121>(x); return x; }
__device__ __forceinline__ float row16_scan(float x) { x += dpp_f<0x111>(x); x += dpp_f<0x112>(x); x += dpp_f<0x114>(x); x += dpp_f<0x118>(x); return x; }

#define XB_TMO      128
#define XB_XCNT(j)  (256  + 64 * (j))
#define XB_XSUB(j)  (1280 + 64 * (j))
#define XB_XGEN(j)  (2304 + 64 * (j))
#define XB_TOP      3328
#define XB_TOPGEN   3392
#define XCD_BAR_WORDS 3456
#define XB_SPIN_CAP (1u << 18)
__device__ __forceinline__ unsigned xb_ld(unsigned* p)              { return __hip_atomic_load(p, __ATOMIC_RELAXED, __HIP_MEMORY_SCOPE_AGENT); }
__device__ __forceinline__ unsigned xb_add(unsigned* p, unsigned v) { return __hip_atomic_fetch_add(p, v, __ATOMIC_RELAXED, __HIP_MEMORY_SCOPE_AGENT); }
__device__ __forceinline__ unsigned xb_xcc_id() { return (unsigned)__builtin_amdgcn_s_getreg((3 << 11) | 20) & 0xFu; }
#define XB_SPIN(cond, bar) do { unsigned _sp = 0; while (cond) { __builtin_amdgcn_s_sleep(1); \
    if ((++_sp & 255u) == 0u) { if (xb_ld(&(bar)[XB_TMO])) break; if (_sp > XB_SPIN_CAP) { atomicAdd(&(bar)[XB_TMO], 1u); break; } } } } while (0)
struct XcdBarrier { unsigned* bar; unsigned x; volatile LAS unsigned* st; };
__device__ __forceinline__ XcdBarrier xcd_barrier_post(unsigned* bar, volatile LAS unsigned* st) {
    XcdBarrier b; b.bar = bar; b.x = xb_xcc_id(); b.st = st;
    if (threadIdx.x == 0) (void)xb_add(&bar[XB_XCNT(b.x)], 1u);
    return b;
}
__device__ __forceinline__ void xcd_barrier_complete(unsigned* bar, unsigned x, unsigned& nloc, unsigned& nx) {
    const unsigned G = gridDim.x * gridDim.y * gridDim.z;
    unsigned sum, cnt, mine, sp = 0u;
    for (;;) {
        sum = 0u; cnt = 0u; mine = 0u;
#pragma unroll
        for (unsigned j = 0; j < 16; ++j) { const unsigned c = xb_ld(&bar[XB_XCNT(j)]); sum += c; cnt += (c > 0u) ? 1u : 0u; mine = (j == x) ? c : mine; }
        if (sum == G) break;
        __builtin_amdgcn_s_sleep(1);
        if ((++sp & 255u) == 0u) { if (xb_ld(&bar[XB_TMO])) break; if (sp > XB_SPIN_CAP) { atomicAdd(&bar[XB_TMO], 1u); break; } }
    }
    nloc = mine > 0u ? mine : 1u; nx = cnt > 0u ? cnt : 1u;
}
__device__ __forceinline__ void xcd_barrier(const XcdBarrier& b) {
    asm volatile("s_waitcnt vmcnt(0)" ::: "memory");
    __syncthreads();
    if (threadIdx.x == 0) {
        unsigned* bar = b.bar;
        __builtin_amdgcn_s_waitcnt(0);
        unsigned nloc = b.st[0], nx = b.st[1];
        if (nloc == 0u) { xcd_barrier_complete(bar, b.x, nloc, nx); b.st[0] = nloc; b.st[1] = nx; }
        const unsigned old = xb_add(&bar[XB_XSUB(b.x)], 1u);
        const unsigned gen = old / nloc;
        if (old + 1u == (gen + 1u) * nloc) {
            __builtin_amdgcn_fence(__ATOMIC_RELEASE, "agent");
            asm volatile("s_waitcnt vmcnt(0)" ::: "memory");
            const unsigned og = xb_add(&bar[XB_TOP], 1u);
            const unsigned tg = og / nx;
            if (og + 1u == (tg + 1u) * nx) xb_add(&bar[XB_TOPGEN], 1u);
            else XB_SPIN(xb_ld(&bar[XB_TOPGEN]) == tg, bar);
            __builtin_amdgcn_fence(__ATOMIC_ACQUIRE, "agent");
            xb_add(&bar[XB_XGEN(b.x)], 1u);
            asm volatile("s_waitcnt vmcnt(0)" ::: "memory");
        } else {
            XB_SPIN(xb_ld(&bar[XB_XGEN(b.x)]) == gen, bar);
            __builtin_amdgcn_fence(__ATOMIC_ACQUIRE, "agent");
            asm volatile("s_waitcnt vmcnt(0)" ::: "memory");
        }
    }
    __syncthreads();
}

namespace pg8 {
#define PG8_LAS __attribute__((address_space(3)))
constexpr int BM = 256, BK = 64, HALF = 128, HTB = HALF * BK * 2, STAGE_BYTES = 8 * HTB, NXCD = 8, WGM = 8;
__host__ __device__ __forceinline__ int lds_byte(int r, int c) { const int st = (r >> 4) * 2 + (c >> 5), rr = r & 15, cc = c & 31, ob = rr * 64 + cc * 2; return st * 1024 + (ob ^ (((ob >> 9) & 1) << 5)); }
__host__ __device__ __forceinline__ void stage_rc(int b, int& R, int& C) { const int st = b / 1024, sb = b % 1024, swz = sb ^ (((sb >> 9) & 1) << 5); R = (st >> 1) * 16 + swz / 64; C = (st & 1) * 32 + (swz % 64) / 2; }
__host__ __device__ __forceinline__ int perm32(int rho) { const int n = rho >> 4, i = rho & 15; return 8 * (i >> 2) + 4 * n + (i & 3); }

struct Unit { const char* A; const char* B; int r0, c0, e, nvalid, lb, pad; };

__device__ __forceinline__ int remap_xcd(int L, int nwg) { const int q = nwg / NXCD, r = nwg % NXCD, xcd = L % NXCD, off = L / NXCD; return (xcd < r ? xcd * (q + 1) : r * (q + 1) + (xcd - r) * q) + off; }
struct StaticSched {
    const char* A; const char* B; int lda, ldb, nM, nN, nwg, G, c;
    __device__ __forceinline__ void init(const void* A_, int lda_, const void* B_, int ldb_, int M, int N, int G_, int c_) { A = (const char*)A_; B = (const char*)B_; lda = lda_; ldb = ldb_; nM = M / BM; nN = N / BM; nwg = nM * nN; G = G_; c = c_; }
    __device__ __forceinline__ bool next(int i, Unit& u) const {
        const long L = (long)i * G + c; if (L >= nwg) return false;
        const int wgid = remap_xcd((int)L, nwg);
        const int nig = WGM * nN, gid = wgid / nig, fm = gid * WGM, gsz = (nM - fm) < WGM ? (nM - fm) : WGM;
        const int pm = fm + ((wgid % nig) % gsz), pn = (wgid % nig) / gsz;
        u.A = A + (size_t)pm * BM * lda * 2; u.B = B + (size_t)pn * BM * ldb * 2; u.r0 = pm * BM; u.c0 = pn * BM; u.e = 0; u.nvalid = BM; u.lb = 0; u.pad = 0; return true;
    }
    __device__ __forceinline__ void fill_tab(const Unit&, PG8_LAS unsigned*) const {}
};

template <class Epi, class Sched, bool GATHER, bool ALIGN_EPI>
__device__ __forceinline__ void gemm_phase(PG8_LAS unsigned char* lds, const int K, const int lda, const int ldb, const Sched& S, const Epi& E) {
    int tid_ = threadIdx.x; asm volatile("" : "+v"(tid_));
    const int tid = tid_, wid = __builtin_amdgcn_readfirstlane(tid >> 6), lane = tid & 63, wr = wid >> 2, wc = wid & 3, fr = lane & 15, fq = lane >> 4;
    const int nt = K / BK;
    int Rr[2], Cc[2];
    unsigned voffA[2][2], voffB[2], nvA[2][2];
#pragma unroll
    for (int i = 0; i < 2; ++i) { int R, C; stage_rc(tid * 16 + i * 8192, R, C); Rr[i] = R; Cc[i] = C; const int Rb = Epi::PERM ? ((R & ~31) + perm32(R & 31)) : R;
        voffB[i] = (unsigned)(Rb * ldb + C) * 2u;
#pragma unroll
        for (int h = 0; h < 2; ++h) { voffA[h][i] = (unsigned)((R + HALF * h) * lda + C) * 2u; nvA[h][i] = voffA[h][i]; } }
    const size_t kstep = (size_t)(BK * 2);
    const size_t hstepB = (size_t)HALF * ldb * 2;
    const unsigned ldsw = (unsigned)wid * 1024u;
    const int aoff = lds_byte(wr * 64 + fr, fq * 8), boff = lds_byte(wc * 32 + fr, fq * 8);
#define PG8_SA(b, h) (((b) * 2 + (h)) * HTB)
#define PG8_SB(b, h) ((4 + (b) * 2 + (h)) * HTB)
#define PG8_STAGE(bufoff, gbase, voff) do { _Pragma("unroll") for (int _i = 0; _i < 2; ++_i) \
        __builtin_amdgcn_global_load_lds((const unsigned*)((const char*)(gbase) + (voff)[_i]), (PG8_LAS unsigned*)(lds + (bufoff) + ldsw + _i * 8192), 16, 0, 0); } while (0)
#define PG8_LDA(dst, b, h) do { _Pragma("unroll") for (int m = 0; m < 4; ++m) _Pragma("unroll") for (int k = 0; k < 2; ++k) dst[m][k] = *(const PG8_LAS bf16x8*)(lds + PG8_SA(b, h) + aoff + m * 2048 + k * 1024); } while (0)
#define PG8_LDB(dst, b, h) do { _Pragma("unroll") for (int n = 0; n < 2; ++n) _Pragma("unroll") for (int k = 0; k < 2; ++k) dst[n][k] = *(const PG8_LAS bf16x8*)(lds + PG8_SB(b, h) + boff + n * 2048 + k * 1024); } while (0)
#define PG8_MMA(ai, bj, At, Bt) do { __builtin_amdgcn_s_setprio(1); _Pragma("unroll") for (int m = 0; m < 4; ++m) _Pragma("unroll") for (int n = 0; n < 2; ++n) _Pragma("unroll") for (int k = 0; k < 2; ++k) \
        acc[ai][bj][m][n] = __builtin_amdgcn_mfma_f32_16x16x32_bf16(Bt[n][k], At[m][k], acc[ai][bj][m][n], 0, 0, 0); __builtin_amdgcn_s_setprio(0); } while (0)
#define PG8_WAIT_V(n) asm volatile("s_waitcnt vmcnt(" #n ")" ::: "memory")
#define PG8_WAIT_L(n) asm volatile("s_waitcnt lgkmcnt(" #n ")" ::: "memory")
#define PG8_BAR __builtin_amdgcn_s_barrier()
#define PG8_SCHED __builtin_amdgcn_sched_barrier(0)
    Unit cur, nxt; int ui = 0;
    if (!S.next(0, cur)) return;
    f32x4 acc[2][2][4][2];
#pragma unroll
    for (int a = 0; a < 2; ++a)
#pragma unroll
        for (int b = 0; b < 2; ++b)
#pragma unroll
            for (int m = 0; m < 4; ++m)
#pragma unroll
                for (int n = 0; n < 2; ++n) acc[a][b][m][n] = (f32x4){0.f, 0.f, 0.f, 0.f};
    bf16x8 At[4][2], B0[2][2], B1[2][2];
    const char* cA = cur.A; const char* cB = cur.B;
    PG8_LAS unsigned* gtab = (PG8_LAS unsigned*)(lds + STAGE_BYTES + 2048);
    if constexpr (GATHER) {
        S.fill_tab(cur, gtab);
        asm volatile("s_waitcnt lgkmcnt(0)" ::: "memory"); __builtin_amdgcn_s_barrier(); asm volatile("" ::: "memory");
#pragma unroll
        for (int h = 0; h < 2; ++h)
#pragma unroll
            for (int i = 0; i < 2; ++i) { voffA[h][i] = gtab[Rr[i] + HALF * h] + (unsigned)Cc[i] * 2u; nvA[h][i] = voffA[h][i]; }
    }
    PG8_STAGE(PG8_SB(0, 0), cB, voffB); PG8_STAGE(PG8_SB(0, 1), cB + hstepB, voffB); PG8_STAGE(PG8_SA(0, 0), cA, voffA[0]); PG8_STAGE(PG8_SA(0, 1), cA, voffA[1]);
    if (wr == 1) PG8_BAR;
    PG8_WAIT_V(2); PG8_BAR;
    PG8_STAGE(PG8_SB(1, 0), cB + kstep, voffB); PG8_STAGE(PG8_SA(1, 0), cA + kstep, voffA[0]); PG8_STAGE(PG8_SB(1, 1), cB + hstepB + kstep, voffB);
    PG8_WAIT_V(6); PG8_BAR;
    for (;;) {
        const bool has_next = S.next(ui + 1, nxt);
        const char* nA = has_next ? nxt.A : cA; const char* nB = has_next ? nxt.B : cB;
        if constexpr (GATHER) { if (has_next) S.fill_tab(nxt, gtab + ((ui + 1) & 1) * 256); }
#pragma unroll 1
        for (int t = 0; t < nt; t += 2) {
            const bool last = (t == nt - 2);
            const char* a1 = cA + (size_t)(t + 1) * kstep;
            const char* a2 = last ? nA : cA + (size_t)(t + 2) * kstep; const char* b2 = last ? nB : cB + (size_t)(t + 2) * kstep;
            const char* a3 = a2 + kstep; const char* b3 = b2 + kstep;
            unsigned sv[2][2];
            if constexpr (GATHER) {
                if (last && has_next) {
#pragma unroll
                    for (int h = 0; h < 2; ++h)
#pragma unroll
                        for (int i = 0; i < 2; ++i) nvA[h][i] = gtab[((ui + 1) & 1) * 256 + Rr[i] + HALF * h] + (unsigned)Cc[i] * 2u;
                }
#pragma unroll
                for (int h = 0; h < 2; ++h)
#pragma unroll
                    for (int i = 0; i < 2; ++i) sv[h][i] = last ? nvA[h][i] : voffA[h][i];
            } else {
#pragma unroll
                for (int h = 0; h < 2; ++h)
#pragma unroll
                    for (int i = 0; i < 2; ++i) sv[h][i] = voffA[h][i];
            }
            PG8_LDB(B0, 0, 0); PG8_LDB(B1, 0, 1); PG8_SCHED; PG8_LDA(At, 0, 0); PG8_STAGE(PG8_SA(1, 1), a1, voffA[1]);
            PG8_WAIT_V(8); PG8_WAIT_L(0); PG8_BAR; PG8_MMA(0, 0, At, B0); PG8_MMA(0, 1, At, B1); PG8_BAR; PG8_SCHED;
            PG8_LDA(At, 0, 1); PG8_STAGE(PG8_SB(0, 0), b2, voffB); PG8_STAGE(PG8_SB(0, 1), b2 + hstepB, voffB); PG8_STAGE(PG8_SA(0, 0), a2, sv[0]);
            PG8_WAIT_V(8); PG8_WAIT_L(0); PG8_BAR; PG8_MMA(1, 0, At, B0); PG8_MMA(1, 1, At, B1); PG8_BAR; PG8_SCHED;
            PG8_LDB(B0, 1, 0); PG8_LDB(B1, 1, 1); PG8_SCHED; PG8_LDA(At, 1, 0); PG8_STAGE(PG8_SA(0, 1), a2, sv[1]);
            PG8_WAIT_V(8); PG8_WAIT_L(0); PG8_BAR; PG8_MMA(0, 0, At, B0); PG8_MMA(0, 1, At, B1); PG8_BAR; PG8_SCHED;
            PG8_LDA(At, 1, 1); PG8_STAGE(PG8_SB(1, 0), b3, voffB); PG8_STAGE(PG8_SB(1, 1), b3 + hstepB, voffB); PG8_STAGE(PG8_SA(1, 0), a3, sv[0]);
            PG8_WAIT_V(8); PG8_WAIT_L(0); PG8_BAR; PG8_MMA(1, 0, At, B0); PG8_MMA(1, 1, At, B1); PG8_BAR; PG8_SCHED;
        }
        if constexpr (ALIGN_EPI) { if (wr == 0) PG8_BAR; }
        E(acc, cur, wr, wc, fr, fq);
        if (!has_next) break;
#pragma unroll
        for (int a = 0; a < 2; ++a)
#pragma unroll
            for (int b = 0; b < 2; ++b)
#pragma unroll
                for (int m = 0; m < 4; ++m)
#pragma unroll
                    for (int n = 0; n < 2; ++n) acc[a][b][m][n] = (f32x4){0.f, 0.f, 0.f, 0.f};
        cur = nxt; cA = nA; cB = nB; ++ui;
        if constexpr (GATHER) {
#pragma unroll
            for (int h = 0; h < 2; ++h)
#pragma unroll
                for (int i = 0; i < 2; ++i) voffA[h][i] = nvA[h][i];
        }
        if constexpr (ALIGN_EPI) { if (wr == 1) PG8_BAR; }
    }
    PG8_WAIT_V(0);
    if constexpr (!ALIGN_EPI) { if (wr == 0) PG8_BAR; }
    PG8_BAR;
#undef PG8_SA
#undef PG8_SB
#undef PG8_STAGE
#undef PG8_LDA
#undef PG8_LDB
#undef PG8_MMA
#undef PG8_WAIT_V
#undef PG8_WAIT_L
#undef PG8_BAR
#undef PG8_SCHED
}
}

struct Frame {
    LAS unsigned char* lds;
    volatile LAS unsigned* MISC;
    gu32* ctl;
    int tid, lane, wave, G, bid;
    const float* in[20]; float* out; unsigned char* ws;
};
#define WSP(T_, off) ((T_*)(F.ws + (off)))

__device__ __forceinline__ v4u pack8(const f32x4 a, const f32x4 b) { v4u w; w.x = pk2(a[0], a[1]); w.y = pk2(a[2], a[3]); w.z = pk2(b[0], b[1]); w.w = pk2(b[2], b[3]); return w; }
__device__ __forceinline__ void unpack8(const v4u w, f32x4& a, f32x4& b) { a = (f32x4){bflo(w.x), bfhi(w.x), bflo(w.y), bfhi(w.y)}; b = (f32x4){bflo(w.z), bfhi(w.z), bflo(w.w), bfhi(w.w)}; }

struct EpiP1 {
    static constexpr bool PERM = true;
    bf16* PJ; const float* b_alpha; float* BC;
    __device__ __forceinline__ void operator()(const f32x4 (&acc)[2][2][4][2], const pg8::Unit& u, int wr, int wc, int fr, int fq) const {
        const int pn = u.c0 >> 8;
        const int mode = (pn == 4 || pn == 5) ? 1 : (pn == 6) ? 2 : (pn >= 9) ? 3 : 0;
        const int row0 = u.r0 + wr * 64 + fr, col0 = u.c0 + wc * 32 + 8 * fq;
        f32x4 bv[2][2];
        const int bidx = (mode == 2) ? (col0 - PJ_Z) : 0;
#pragma unroll
        for (int bj = 0; bj < 2; ++bj)
#pragma unroll
            for (int n = 0; n < 2; ++n) { bv[bj][n] = *(const f32x4*)(b_alpha + bidx + bj * 128 + 4 * n); asm volatile("" :: "v"(bv[bj][n])); }
        if (mode == 2) {
#pragma unroll
            for (int ai = 0; ai < 2; ++ai)
#pragma unroll
                for (int bj = 0; bj < 2; ++bj) { f32x4 pr[4][2];
#pragma unroll
                    for (int n = 0; n < 2; ++n)
#pragma unroll
                        for (int j = 0; j < 4; ++j) { float carry = 0.f;
#pragma unroll
                            for (int m = 0; m < 4; ++m) { const float z = acc[ai][bj][m][n][j] + bv[bj][n][j]; const float la = (fminf(z, 0.f) - __logf(1.0f + __expf(-fabsf(z)))) * (1.0f / 16.0f);
                                pr[m][n][j] = row16_scan(la) + carry; carry += row16_sum(la); } }
#pragma unroll
                    for (int m = 0; m < 4; ++m) { float* bp = BC + (size_t)(row0 + ai * 128 + m * 16) * GKW + (col0 - PJ_Z) + bj * 128; *(f32x4*)bp = pr[m][0]; *(f32x4*)(bp + 4) = pr[m][1]; } }
            return;
        }
#pragma unroll
        for (int ai = 0; ai < 2; ++ai)
#pragma unroll
            for (int m = 0; m < 4; ++m) { bf16* rowp = PJ + (size_t)(row0 + ai * 128 + m * 16) * NPJ + col0;
#pragma unroll
                for (int bj = 0; bj < 2; ++bj) { f32x4 v[2] = {acc[ai][bj][m][0], acc[ai][bj][m][1]};
                    if (mode == 1) {
#pragma unroll
                        for (int n = 0; n < 2; ++n)
#pragma unroll
                            for (int j = 0; j < 4; ++j) v[n][j] = v[n][j] * fsigmoid(v[n][j]);
                    } else if (mode == 3) {
#pragma unroll
                        for (int n = 0; n < 2; ++n)
#pragma unroll
                            for (int j = 0; j < 4; ++j) v[n][j] = fsigmoid(v[n][j]);
                    }
                    *(v4u*)(rowp + bj * 128) = pack8(v[0], v[1]); } }
    }
};

struct EpiD {
    static constexpr bool PERM = true;
    bf16* TG; const bf16* PJ;
    __device__ __forceinline__ void operator()(const f32x4 (&acc)[2][2][4][2], const pg8::Unit& u, int wr, int wc, int fr, int fq) const {
        const int row0 = u.r0 + wr * 64 + fr, col0 = u.c0 + wc * 32 + 8 * fq;
#pragma unroll
        for (int ai = 0; ai < 2; ++ai)
#pragma unroll
            for (int m = 0; m < 4; ++m) { const size_t row = (size_t)(row0 + ai * 128 + m * 16);
#pragma unroll
                for (int bj = 0; bj < 2; ++bj) { const int c = col0 + bj * 128; const v4u gw = *(const v4u*)(PJ + row * NPJ + PJ_GG + c); f32x4 g0, g1; unpack8(gw, g0, g1);
                    *(v4u*)(TG + row * D + c) = pack8(acc[ai][bj][m][0] * g0, acc[ai][bj][m][1] * g1); } }
    }
};
struct EpiE {
    static constexpr bool PERM = true;
    bf16* MG; const bf16* TG; const bf16* PJ;
    __device__ __forceinline__ void operator()(const f32x4 (&acc)[2][2][4][2], const pg8::Unit& u, int wr, int wc, int fr, int fq) const {
        const int row0 = u.r0 + wr * 64 + fr, col0 = u.c0 + wc * 32 + 8 * fq;
#pragma unroll
        for (int ai = 0; ai < 2; ++ai)
#pragma unroll
            for (int m = 0; m < 4; ++m) { const size_t row = (size_t)(row0 + ai * 128 + m * 16);
#pragma unroll
                for (int bj = 0; bj < 2; ++bj) { const int c = col0 + bj * 128; const v4u gw = *(const v4u*)(PJ + row * NPJ + PJ_GP + c); const v4u tw = *(const v4u*)(TG + row * D + c);
                    f32x4 g0, g1, t0, t1; unpack8(gw, g0, g1); unpack8(tw, t0, t1);
                    *(v4u*)(MG + row * D + c) = pack8(t0 + acc[ai][bj][m][0] * g0, t1 + acc[ai][bj][m][1] * g1); } }
    }
};
struct EpiF {
    static constexpr bool PERM = true;
    const float* x; bf16* X1B; float* SSQ;
    __device__ __forceinline__ void operator()(const f32x4 (&acc)[2][2][4][2], const pg8::Unit& u, int wr, int wc, int fr, int fq) const {
        const int row0 = u.r0 + wr * 64 + fr, col0 = u.c0 + wc * 32 + 8 * fq;
#pragma unroll
        for (int ai = 0; ai < 2; ++ai)
#pragma unroll
            for (int m = 0; m < 4; ++m) { const size_t row = (size_t)(row0 + ai * 128 + m * 16); float ss = 0.f;
#pragma unroll
                for (int bj = 0; bj < 2; ++bj) { const int c = col0 + bj * 128; const f32x4 x0 = *(const f32x4*)(x + row * D + c), x1 = *(const f32x4*)(x + row * D + c + 4);
                    const f32x4 y0 = x0 + acc[ai][bj][m][0], y1 = x1 + acc[ai][bj][m][1];
                    *(v4u*)(X1B + row * D + c) = pack8(y0, y1);
                    ss += (y0[0] * y0[0] + y0[1] * y0[1]) + (y0[2] * y0[2] + y0[3] * y0[3]) + (y1[0] * y1[0] + y1[1] * y1[1]) + (y1[2] * y1[2] + y1[3] * y1[3]); }
                ss += __shfl_xor(ss, 16); ss += __shfl_xor(ss, 32);
                if (fq == 0) SSQ[row * 16 + (u.c0 >> 8) * 4 + wc] = ss; }
    }
};


struct MoeSched {
    const LAS int* cum; const LAS int* cnt; const unsigned* LIST;
    const char* Abase; const char* Bbase; int NT, G, c, mode;
    __device__ __forceinline__ bool next(int i, pg8::Unit& u) const {
        const int nunits = __builtin_amdgcn_readfirstlane(cum[NE]) * NT; const long L = (long)i * G + c; if (L >= nunits) return false;
        const int wgid = pg8::remap_xcd((int)L, nunits), gb = wgid / NT, pn = wgid % NT;
        int e_ = 0;
#pragma unroll 8
        for (int j = 1; j < NE; ++j) e_ += (cum[j] <= gb) ? 1 : 0;
        const int e = __builtin_amdgcn_readfirstlane(e_);
        const int blk = gb - __builtin_amdgcn_readfirstlane(cum[e]), rem = __builtin_amdgcn_readfirstlane(cnt[e]) - blk * 256;
        u.e = e; u.nvalid = rem < 256 ? rem : 256; u.lb = e * LCAP + blk * 256; u.r0 = gb * 256; u.pad = 0;
        if (mode == 0) { u.A = Abase; u.B = Bbase + ((size_t)e * 512 + (size_t)pn * 256) * D * 2; u.c0 = pn * 128; }
        else { u.A = Abase + (size_t)gb * 256 * DE * 2; u.B = Bbase + ((size_t)e * D + (size_t)pn * 256) * DE * 2; u.c0 = pn * 256; }
        return true;
    }
    __device__ __forceinline__ void fill_tab(const pg8::Unit& u, LAS unsigned* tab) const {
        const int t = threadIdx.x;
        if (t < 256) { const int lp = t < u.nvalid ? t : u.nvalid - 1; const unsigned slot = LIST[u.lb + lp]; tab[t] = (slot >> 1) * (unsigned)(D * 2); }
    }
};
struct EpiG {
    static constexpr bool PERM = false;
    float* LG;
    __device__ __forceinline__ void operator()(const f32x4 (&acc)[2][2][4][2], const pg8::Unit& u, int wr, int wc, int fr, int fq) const {
        if (wc >= 2) return;
        const int row0 = u.r0 + wr * 64 + fr;
#pragma unroll
        for (int ai = 0; ai < 2; ++ai)
#pragma unroll
            for (int m = 0; m < 4; ++m)
#pragma unroll
                for (int n = 0; n < 2; ++n) *(f32x4*)(LG + (size_t)(row0 + ai * 128 + m * 16) * 64 + 32 * wc + 16 * n + 4 * fq) = acc[ai][0][m][n];
    }
};
struct EpiH {
    static constexpr bool PERM = true;
    bf16* ACT; const float* LISTR;
    __device__ __forceinline__ void operator()(const f32x4 (&acc)[2][2][4][2], const pg8::Unit& u, int wr, int wc, int fr, int fq) const {
        float rs[2][4];
#pragma unroll
        for (int ai = 0; ai < 2; ++ai)
#pragma unroll
            for (int m = 0; m < 4; ++m) { const int rl = ai * 128 + wr * 64 + m * 16 + fr, lp = rl < u.nvalid ? rl : u.nvalid - 1; rs[ai][m] = LISTR[u.lb + lp]; }
#pragma unroll
        for (int ai = 0; ai < 2; ++ai)
#pragma unroll
            for (int m = 0; m < 4; ++m) { asm volatile("" :: "v"(rs[ai][m])); }
#pragma unroll
        for (int ai = 0; ai < 2; ++ai)
#pragma unroll
            for (int m = 0; m < 4; ++m) { const int rl = ai * 128 + wr * 64 + m * 16 + fr; const float r = rs[ai][m]; f32x4 a[2];
#pragma unroll
                for (int n = 0; n < 2; ++n)
#pragma unroll
                    for (int j = 0; j < 4; ++j) { const float g = acc[ai][0][m][n][j] * r, up = acc[ai][1][m][n][j] * r; a[n][j] = g * fsigmoid(g) * up; }
                *(v4u*)(ACT + (size_t)(u.r0 + rl) * DE + u.c0 + wc * 32 + 8 * fq) = pack8(a[0], a[1]); }
    }
};
struct EpiI {
    static constexpr bool PERM = true;
    bf16* Y; const unsigned* LIST; const float* LISTW;
    __device__ __forceinline__ void operator()(const f32x4 (&acc)[2][2][4][2], const pg8::Unit& u, int wr, int wc, int fr, int fq) const {
#pragma unroll
        for (int ai = 0; ai < 2; ++ai) {
            unsigned sl[4]; float gw[4];
#pragma unroll
            for (int m = 0; m < 4; ++m) { const int rl = ai * 128 + wr * 64 + m * 16 + fr, lp = rl < u.nvalid ? rl : u.nvalid - 1; sl[m] = LIST[u.lb + lp]; gw[m] = LISTW[u.lb + lp]; }
#pragma unroll
            for (int m = 0; m < 4; ++m) { asm volatile("" :: "v"(gw[m]), "v"(sl[m])); }
#pragma unroll
            for (int m = 0; m < 4; ++m) { const int rl = ai * 128 + wr * 64 + m * 16 + fr; const float g = gw[m];
                if (rl < u.nvalid) {
#pragma unroll
                    for (int bj = 0; bj < 2; ++bj) *(v4u*)(Y + (size_t)sl[m] * D + u.c0 + bj * 128 + wc * 32 + 8 * fq) = pack8(acc[ai][bj][m][0] * g, acc[ai][bj][m][1] * g); } }
        }
    }
};
__device__ __forceinline__ void route_rows(Frame& F, const int r0) {
    const float* LG = WSP(float, WS_LG); const float* SSQ = WSP(float, WS_SSQ); const float* brg = F.in[13]; const float* bre = F.in[15];
    unsigned* LIST = WSP(unsigned, WS_LIST); float* LISTW = WSP(float, WS_LISTW); float* LISTR = WSP(float, WS_LISTR);
    LAS unsigned* hcnt = (LAS unsigned*)(F.lds + SCHED_OFF); LAS unsigned* hbase = hcnt + 32;
    if (F.tid < 32) hcnt[F.tid] = 0u;
    __syncthreads();
    int e0 = 0, e1 = 0; unsigned p0 = 0, p1 = 0; float w0 = 0.f, w1 = 0.f, rstd = 0.f; const int row = r0 + F.tid;
    if (F.tid < 256) {
        float ss = 0.f;
#pragma unroll
        for (int j = 0; j < 16; ++j) ss += SSQ[(size_t)row * 16 + j];
        rstd = 1.0f / sqrtf(ss * (1.0f / D) + EPS);
        const float* lr = LG + (size_t)row * 64;
        float gl[4];
#pragma unroll
        for (int g = 0; g < 4; ++g) gl[g] = __hip_atomic_load(lr + g, RLX_AGENT) * rstd + brg[g];
        int gi = 0; float gm = gl[0];
#pragma unroll
        for (int g = 1; g < 4; ++g) if (gl[g] > gm) { gm = gl[g]; gi = g; }
        float den = 0.f;
#pragma unroll
        for (int g = 0; g < 4; ++g) den += expf(gl[g] - gm);
        const float gp = 1.0f / den;
        float el[8];
#pragma unroll
        for (int e = 0; e < 8; ++e) el[e] = __hip_atomic_load(lr + 4 + gi * 8 + e, RLX_AGENT) * rstd + bre[gi * 8 + e];
        int i0 = 0; float m0 = el[0];
#pragma unroll
        for (int e = 1; e < 8; ++e) if (el[e] > m0) { m0 = el[e]; i0 = e; }
        int i1 = -1; float m1 = 0.f;
#pragma unroll
        for (int e = 0; e < 8; ++e) if (e != i0 && (i1 < 0 || el[e] > m1)) { m1 = el[e]; i1 = e; }
        const float q = expf(m1 - m0); w0 = gp / (1.0f + q); w1 = gp * q / (1.0f + q);
        e0 = gi * 8 + i0; e1 = gi * 8 + i1;
        p0 = __hip_atomic_fetch_add(&hcnt[e0], 1u, __ATOMIC_RELAXED, __HIP_MEMORY_SCOPE_WORKGROUP); p1 = __hip_atomic_fetch_add(&hcnt[e1], 1u, __ATOMIC_RELAXED, __HIP_MEMORY_SCOPE_WORKGROUP);
    }
    __syncthreads();
    if (F.tid < 32) hbase[F.tid] = hcnt[F.tid] ? __hip_atomic_fetch_add((unsigned*)(F.ctl + CW_ECNT + 64 * F.tid), hcnt[F.tid], RLX_AGENT) : 0u;
    __syncthreads();
    if (F.tid < 256) { const size_t q0 = (size_t)e0 * LCAP + hbase[e0] + p0, q1 = (size_t)e1 * LCAP + hbase[e1] + p1;
        LIST[q0] = (unsigned)row * 2u; LIST[q1] = (unsigned)row * 2u + 1u; LISTW[q0] = w0; LISTW[q1] = w1; LISTR[q0] = rstd; LISTR[q1] = rstd; }
    __syncthreads();
}
__device__ __forceinline__ void moe_tables(Frame& F) {
    LAS int* cum = (LAS int*)(F.lds + SCHED_OFF + 256); LAS int* cnt = cum + 40;
    if (F.tid == 0) { int a = 0; for (int e = 0; e < NE; ++e) { const int c = (int)__hip_atomic_load((unsigned*)(F.ctl + CW_ECNT + 64 * e), RLX_AGENT); cnt[e] = c; cum[e] = a; a += (c + 255) >> 8; } cum[NE] = a; }
    __syncthreads();
}

template <class Src>
__device__ __forceinline__ void transpose_item(const Src& src, int k0, int n0, bf16* dst, int drow0, int dld, LAS float* scr, int lane) {
#pragma unroll 8
    for (int i = 0; i < 32; ++i) { const int kk = 2 * i + (lane >> 5); scr[kk * 33 + (lane & 31)] = src(k0 + kk, n0 + (lane & 31)); }
    LDS_WAIT(); asm volatile("" ::: "memory");
    const int c = lane & 7;
#pragma unroll
    for (int j = 0; j < 4; ++j) { const int n = (lane >> 3) + 8 * j; const LAS float* s = scr + (8 * c) * 33 + n;
        v4u o; o.x = pk2(s[0 * 33], s[1 * 33]); o.y = pk2(s[2 * 33], s[3 * 33]); o.z = pk2(s[4 * 33], s[5 * 33]); o.w = pk2(s[6 * 33], s[7 * 33]);
        *(GAS v4u*)(dst + (size_t)(drow0 + n) * dld + k0 + 8 * c) = o; }
    LDS_WAIT(); asm volatile("" ::: "memory");
}
struct SrcScaled { const float* W; int ld; const float* g;
    __device__ __forceinline__ float operator()(int k, int n) const { const float w = W[(size_t)k * ld + n]; return g ? w * g[k] : w; } };

__device__ __forceinline__ void p0_prologue(Frame& F) {
    const float* x = F.in[0]; const float* g1 = F.in[1]; const float* w_in = F.in[2]; const float* wau = F.in[3];
    const float* gng = F.in[5]; const float* wgb = F.in[6]; const float* pw = F.in[7]; const float* ps = F.in[8]; const float* wpb = F.in[9];
    const float* wout = F.in[10]; const float* g2 = F.in[11]; const float* wrg = F.in[12]; const float* wre = F.in[14];
    const float* weg = F.in[16]; const float* weu = F.in[17]; const float* wed = F.in[18];
    bf16* WIN = WSP(bf16, WS_WIN); bf16* WG = WSP(bf16, WS_WG); bf16* WP = WSP(bf16, WS_WP); bf16* WOUT = WSP(bf16, WS_WOUT); bf16* WR = WSP(bf16, WS_WR);
    bf16* WGU = WSP(bf16, WS_WGU); bf16* WD = WSP(bf16, WS_WD); bf16* HB = WSP(bf16, WS_HB);
    {
        LAS float* PWL = (LAS float*)F.lds;
        LAS float* WL = (LAS float*)(F.lds + 65536);
        for (int it = F.bid; it < 64; it += F.G) {
            const int g = it >> 4, nb = it & 15;
            for (int i = F.tid; i < 128 * 128; i += 512) { const int d = i & 127; PWL[i] = pw[(size_t)g * 16384 + i] * ps[g * 128 + d]; }
            for (int i = F.tid; i < 128 * 64; i += 512) { const int d = i >> 6, n = i & 63; WL[i] = wpb[(size_t)(g * 128 + d) * D + nb * 64 + n]; }
            __syncthreads();
            const int n = F.tid & 63, cg = F.tid >> 6;
            float a[16];
#pragma unroll
            for (int ci = 0; ci < 16; ++ci) a[ci] = 0.f;
            for (int d = 0; d < 128; d += 4) {
                const float w0 = WL[(d + 0) * 64 + n], w1 = WL[(d + 1) * 64 + n], w2 = WL[(d + 2) * 64 + n], w3 = WL[(d + 3) * 64 + n];
#pragma unroll
                for (int ci = 0; ci < 16; ++ci) { const f32x4 p = *(const LAS f32x4*)(PWL + (cg * 16 + ci) * 128 + d); a[ci] += p[0] * w0 + p[1] * w1 + p[2] * w2 + p[3] * w3; }
            }
            v4u o0, o1; o0.x = pk2(a[0], a[1]); o0.y = pk2(a[2], a[3]); o0.z = pk2(a[4], a[5]); o0.w = pk2(a[6], a[7]); o1.x = pk2(a[8], a[9]); o1.y = pk2(a[10], a[11]); o1.z = pk2(a[12], a[13]); o1.w = pk2(a[14], a[15]);
            bf16* dp = WP + (size_t)(nb * 64 + n) * PW + g * 128 + cg * 16;
            *(GAS v4u*)dp = o0; *(GAS v4u*)(dp + 8) = o1;
            __syncthreads();
        }
    }
    LAS float* scr = (LAS float*)(F.lds + F.wave * 16384);
    const int gw = F.bid * 8 + F.wave, NGW = F.G * 8;
    constexpr int I_IN1 = 16 * (1536 / 32), I_IN2 = 16 * (2560 / 32), I_Z = 4 * 64, I_WG = 8 * 32, I_WO = 16 * 32, I_WR = 256;
    constexpr int NITEMS = I_IN1 + I_IN2 + I_Z + I_WG + I_WO + I_WR;
    for (int it = gw; it < NITEMS; it += NGW) {
        int r = it;
        if (r < I_IN1) { const int kb = r / 48, nb = r % 48; SrcScaled s{w_in, D_IN, g1}; transpose_item(s, 64 * kb, 32 * nb, WIN, 32 * nb, D, scr, F.lane); continue; } r -= I_IN1;
        if (r < I_IN2) { const int kb = r / 80, nb = r % 80; SrcScaled s{w_in, D_IN, g1}; transpose_item(s, 64 * kb, IN_U + 32 * nb, WIN, PJ_U + 32 * nb, D, scr, F.lane); continue; } r -= I_IN2;
        if (r < I_Z) {
            const int nb = r & 3, kb = r >> 2, n = nb * 64 + F.lane;
            float wa[16];
#pragma unroll
            for (int j = 0; j < 16; ++j) wa[j] = wau[j * GKW + n];
            float o[16];
#pragma unroll
            for (int kk = 0; kk < 16; ++kk) { const int k = kb * 16 + kk; const float* wr_ = w_in + (size_t)k * D_IN + IN_A; float a = 0.f;
#pragma unroll
                for (int j = 0; j < 16; ++j) a += wr_[j] * wa[j];
                o[kk] = a * g1[k]; }
            v4u o0, o1; o0.x = pk2(o[0], o[1]); o0.y = pk2(o[2], o[3]); o0.z = pk2(o[4], o[5]); o0.w = pk2(o[6], o[7]); o1.x = pk2(o[8], o[9]); o1.y = pk2(o[10], o[11]); o1.z = pk2(o[12], o[13]); o1.w = pk2(o[14], o[15]);
            bf16* dp = WIN + (size_t)(PJ_Z + n) * D + kb * 16; *(GAS v4u*)dp = o0; *(GAS v4u*)(dp + 8) = o1; continue; } r -= I_Z;
        if (r < I_WG) { const int kb = r / 32, nb = r % 32; SrcScaled s{wgb, D, gng}; transpose_item(s, 64 * kb, 32 * nb, WG, 32 * nb, GVW, scr, F.lane); continue; } r -= I_WG;
        if (r < I_WO) { const int kb = r / 32, nb = r % 32; SrcScaled s{wout, D, nullptr}; transpose_item(s, 64 * kb, 32 * nb, WOUT, 32 * nb, D, scr, F.lane); continue; } r -= I_WO;
        if (r < I_WR) {
            const int j = r; bf16* dp = WR + (size_t)j * D;
#pragma unroll
            for (int q = 0; q < 16; ++q) { const int k = q * 64 + F.lane; float v = 0.f;
                if (j < NG) v = wrg[(size_t)k * NG + j] * g2[k]; else if (j < NG + NE) { const int g = (j - NG) >> 3, e = (j - NG) & 7; v = wre[((size_t)g * D + k) * EPG + e] * g2[k]; }
                dp[k] = (bf16)f2bf(v); }
            continue; }
    }
    for (int m = gw; m < T / 2; m += NGW) {
        const GAS f32x4* xa = (const GAS f32x4*)(x + (size_t)m * D) + F.lane; const GAS f32x4* xb = (const GAS f32x4*)(x + (size_t)(m + T / 2) * D) + F.lane;
        f32x4 va[4], vb[4]; float sa = 0.f, sb = 0.f;
#pragma unroll
        for (int j = 0; j < 4; ++j) { va[j] = __builtin_nontemporal_load(xa + 64 * j); vb[j] = __builtin_nontemporal_load(xb + 64 * j); }
#pragma unroll
        for (int j = 0; j < 4; ++j) { sa += (va[j].x * va[j].x + va[j].y * va[j].y) + (va[j].z * va[j].z + va[j].w * va[j].w); sb += (vb[j].x * vb[j].x + vb[j].y * vb[j].y) + (vb[j].z * vb[j].z + vb[j].w * vb[j].w); }
        const float ra = 1.0f / sqrtf(wave_sum(sa) * (1.f / D) + EPS), rb = 1.0f / sqrtf(wave_sum(sb) * (1.f / D) + EPS);
        GAS v2u* oa = (GAS v2u*)(HB + (size_t)m * D) + F.lane; GAS v2u* ob = (GAS v2u*)(HB + (size_t)(m + T / 2) * D) + F.lane;
#pragma unroll
        for (int j = 0; j < 4; ++j) { v2u w; w.x = pk2(va[j].x * ra, va[j].y * ra); w.y = pk2(va[j].z * ra, va[j].w * ra); oa[64 * j] = w; w.x = pk2(vb[j].x * rb, vb[j].y * rb); w.y = pk2(vb[j].z * rb, vb[j].w * rb); ob[64 * j] = w; }
    }
}

__device__ __forceinline__ void moe_weight_items(Frame& F, const int widx, const int nworkers) {
    const float* g2 = F.in[11]; const float* weg = F.in[16]; const float* weu = F.in[17]; const float* wed = F.in[18];
    bf16* WGU = WSP(bf16, WS_WGU); bf16* WD = WSP(bf16, WS_WD);
    LAS float* scr = (LAS float*)(F.lds + F.wave * 16384);
    const int gw = widx * 8 + F.wave, NGW = nworkers * 8;
    constexpr int I_GU = NE * 2 * 16 * 8, I_WD = NE * 4 * 32;
    for (int it = gw; it < I_GU + I_WD; it += NGW) {
        int r = it;
        if (r < I_GU) {
            const int e = r / 256, q = r % 256, bj = q / 128, kb = (q % 128) / 8, nb = q % 8;
            SrcScaled sc{(bj ? weu : weg) + (size_t)e * D * DE, DE, g2};
            const int hid0 = 32 * nb, pn = hid0 >> 7, i0 = hid0 & 127;
            transpose_item(sc, 64 * kb, hid0, WGU + (size_t)e * 512 * D, pn * 256 + bj * 128 + i0, D, scr, F.lane); continue; } r -= I_GU;
        { const int e = r / 128, q = r % 128, kb = q / 32, nb = q % 32;
            SrcScaled sc{wed + (size_t)e * DE * D, D, nullptr}; transpose_item(sc, 64 * kb, 32 * nb, WD + (size_t)e * D * DE, 32 * nb, DE, scr, F.lane); }
    }
}

#define WG_SYNC() do { asm volatile("s_waitcnt lgkmcnt(0)" ::: "memory"); __builtin_amdgcn_s_barrier(); asm volatile("" ::: "memory"); } while (0)
constexpr int GL_QD = 0, GL_KD = 9216, GL_KET = 18432, GL_P = 27648, GL_VT = 36864, GL_DEC = 55296, GL_SS = 55552, GL_OT = 57600;
constexpr int GLS = 72, OTS = 132;
__device__ __forceinline__ void gla_unit(Frame& F, const int b, const int h) {
    const bf16* PJ = WSP(bf16, WS_PJ); const float* BC = WSP(float, WS_BC); bf16* ON = WSP(bf16, WS_ON);
    int tid_ = threadIdx.x; asm volatile("" : "+v"(tid_));
    const int tid = tid_, lane = tid & 63, w = __builtin_amdgcn_readfirstlane(tid >> 6), fr = lane & 15, fq = lane >> 4;
    LAS bf16* QD = (LAS bf16*)(F.lds + GL_QD); LAS bf16* KD = (LAS bf16*)(F.lds + GL_KD); LAS bf16* KET = (LAS bf16*)(F.lds + GL_KET);
    LAS bf16* P = (LAS bf16*)(F.lds + GL_P); LAS bf16* VT = (LAS bf16*)(F.lds + GL_VT);
    LAS float* DEC = (LAS float*)(F.lds + GL_DEC); LAS float* SS = (LAS float*)(F.lds + GL_SS); LAS float* OT = (LAS float*)(F.lds + GL_OT);
    f32x4 Sacc[4];
#pragma unroll
    for (int i = 0; i < 4; ++i) Sacc[i] = (f32x4){0.f, 0.f, 0.f, 0.f};
    const size_t rowbase = (size_t)b * SEQ;
    const int vsl = lane & 31, vbk = 2 * w + (lane >> 5);
    const int ot = tid >> 3, ov = (tid & 7) * 16;
    v4u qq, kq, vq0, vq1, rq0, rq1; f32x4 bq0, bq1;
#define GLA_LOADS(tb_) do { const size_t tb__ = (tb_); \
        const bf16* rp = PJ + (tb__ + lane) * NPJ + h * 64 + w * 8; qq = *(const v4u*)(rp + PJ_Q); kq = *(const v4u*)(rp + PJ_K); \
        const float* bp = BC + (tb__ + lane) * GKW + h * 64 + w * 8; bq0 = *(const f32x4*)bp; bq1 = *(const f32x4*)(bp + 4); \
        const bf16* vp = PJ + (tb__ + vsl) * NPJ + PJ_V + h * 128 + vbk * 8; vq0 = *(const v4u*)vp; vq1 = *(const v4u*)(vp + (size_t)32 * NPJ); \
        const bf16* rr = PJ + (tb__ + ot) * NPJ + PJ_R + h * 128 + ov; rq0 = *(const v4u*)rr; rq1 = *(const v4u*)(rr + 8); } while (0)
    GLA_LOADS(rowbase);
    for (int n = 0; n < SEQ / GCH; ++n) {
        const size_t tb = rowbase + (size_t)n * GCH;
        const v4u q8 = qq, k8 = kq, v80 = vq0, v81 = vq1, r80 = rq0, r81 = rq1; const f32x4 b80 = bq0, b81 = bq1;
        if (n + 1 < SEQ / GCH) GLA_LOADS(tb + GCH);
        { float bx[8] = {b80[0], b80[1], b80[2], b80[3], b81[0], b81[1], b81[2], b81[3]}, qf[8], kf[8];
          { f32x4 a, c; unpack8(q8, a, c); qf[0] = a[0]; qf[1] = a[1]; qf[2] = a[2]; qf[3] = a[3]; qf[4] = c[0]; qf[5] = c[1]; qf[6] = c[2]; qf[7] = c[3];
            unpack8(k8, a, c); kf[0] = a[0]; kf[1] = a[1]; kf[2] = a[2]; kf[3] = a[3]; kf[4] = c[0]; kf[5] = c[1]; kf[6] = c[2]; kf[7] = c[3]; }
          float qd[8], kd[8], ke[8], dc[8];
#pragma unroll
          for (int j = 0; j < 8; ++j) { const float blast = __builtin_bit_cast(float, __builtin_amdgcn_readlane(__builtin_bit_cast(int, bx[j]), 63));
              const float eb = __expf(bx[j]), enb = __builtin_amdgcn_rcpf(eb); dc[j] = __expf(blast);
              qd[j] = qf[j] * eb * 0.125f; kd[j] = kf[j] * enb; ke[j] = kd[j] * dc[j]; }
          v4u o; o.x = pk2(qd[0], qd[1]); o.y = pk2(qd[2], qd[3]); o.z = pk2(qd[4], qd[5]); o.w = pk2(qd[6], qd[7]); *(LAS v4u*)(QD + lane * GLS + w * 8) = o;
          o.x = pk2(kd[0], kd[1]); o.y = pk2(kd[2], kd[3]); o.z = pk2(kd[4], kd[5]); o.w = pk2(kd[6], kd[7]); *(LAS v4u*)(KD + lane * GLS + w * 8) = o;
#pragma unroll
          for (int j = 0; j < 8; ++j) KET[(w * 8 + j) * GLS + lane] = (bf16)(pk2(ke[j], ke[j]) & 0xffffu);
          if (lane == 0) { *(LAS f32x4*)(DEC + w * 8) = (f32x4){dc[0], dc[1], dc[2], dc[3]}; *(LAS f32x4*)(DEC + w * 8 + 4) = (f32x4){dc[4], dc[5], dc[6], dc[7]}; }
          const unsigned vw0[4] = {v80.x, v80.y, v80.z, v80.w}, vw1[4] = {v81.x, v81.y, v81.z, v81.w};
#pragma unroll
          for (int j = 0; j < 4; ++j) { VT[(vbk * 8 + 2 * j) * GLS + vsl] = (bf16)(vw0[j] & 0xffffu); VT[(vbk * 8 + 2 * j + 1) * GLS + vsl] = (bf16)(vw0[j] >> 16);
              VT[(vbk * 8 + 2 * j) * GLS + vsl + 32] = (bf16)(vw1[j] & 0xffffu); VT[(vbk * 8 + 2 * j + 1) * GLS + vsl + 32] = (bf16)(vw1[j] >> 16); } }
        WG_SYNC();
        { const int tt = w >> 1, st0 = (w & 1) * 2;
          bf16x8 af[2];
#pragma unroll
          for (int ks = 0; ks < 2; ++ks) af[ks] = *(const LAS bf16x8*)(QD + (16 * tt + fr) * GLS + 32 * ks + 8 * fq);
#pragma unroll
          for (int q2 = 0; q2 < 2; ++q2) { const int st = st0 + q2; f32x4 c = (f32x4){0.f, 0.f, 0.f, 0.f};
              if (st <= tt) {
#pragma unroll
                  for (int ks = 0; ks < 2; ++ks) { const bf16x8 bfm = *(const LAS bf16x8*)(KD + (16 * st + fr) * GLS + 32 * ks + 8 * fq); c = __builtin_amdgcn_mfma_f32_16x16x32_bf16(af[ks], bfm, c, 0, 0, 0); } }
#pragma unroll
              for (int i = 0; i < 4; ++i) { const int t = 16 * tt + 4 * fq + i, sidx = 16 * st + fr; const float val = (sidx <= t) ? c[i] : 0.f; P[t * GLS + sidx] = (bf16)(pk2(val, val) & 0xffffu); } } }
        WG_SYNC();
        { bf16x8 vtf[2], sb[2];
#pragma unroll
          for (int ks = 0; ks < 2; ++ks) { vtf[ks] = *(const LAS bf16x8*)(VT + (16 * w + fr) * GLS + 32 * ks + 8 * fq);
              v4u pw_; pw_.x = pk2(Sacc[2 * ks][0], Sacc[2 * ks][1]); pw_.y = pk2(Sacc[2 * ks][2], Sacc[2 * ks][3]); pw_.z = pk2(Sacc[2 * ks + 1][0], Sacc[2 * ks + 1][1]); pw_.w = pk2(Sacc[2 * ks + 1][2], Sacc[2 * ks + 1][3]);
              sb[ks] = __builtin_bit_cast(bf16x8, pw_); }
          f32x4 o[4];
#pragma unroll
          for (int mt = 0; mt < 4; ++mt) { o[mt] = (f32x4){0.f, 0.f, 0.f, 0.f};
#pragma unroll
              for (int ks = 0; ks < 2; ++ks) { const bf16x8 a = *(const LAS bf16x8*)(P + (16 * mt + fr) * GLS + 32 * ks + 8 * fq); o[mt] = __builtin_amdgcn_mfma_f32_16x16x32_bf16(a, vtf[ks], o[mt], 0, 0, 0); }
#pragma unroll
              for (int ks = 0; ks < 2; ++ks) { const v2u lo = *(const LAS v2u*)(QD + (16 * mt + fr) * GLS + 32 * ks + 4 * fq), hi = *(const LAS v2u*)(QD + (16 * mt + fr) * GLS + 32 * ks + 16 + 4 * fq);
                  v4u aw; aw.x = lo.x; aw.y = lo.y; aw.z = hi.x; aw.w = hi.y; o[mt] = __builtin_amdgcn_mfma_f32_16x16x32_bf16(__builtin_bit_cast(bf16x8, aw), sb[ks], o[mt], 0, 0, 0); } }
#pragma unroll
          for (int mt = 0; mt < 4; ++mt) { const f32x4 d4 = *(const LAS f32x4*)(DEC + 16 * mt + 4 * fq); Sacc[mt] = Sacc[mt] * d4;
#pragma unroll
              for (int ks = 0; ks < 2; ++ks) { const bf16x8 a = *(const LAS bf16x8*)(KET + (16 * mt + fr) * GLS + 32 * ks + 8 * fq); Sacc[mt] = __builtin_amdgcn_mfma_f32_16x16x32_bf16(a, vtf[ks], Sacc[mt], 0, 0, 0); } }
#pragma unroll
          for (int mt = 0; mt < 4; ++mt)
#pragma unroll
              for (int i = 0; i < 4; ++i) { const int t = 16 * mt + 4 * fq + i; OT[t * OTS + 16 * w + fr] = o[mt][i]; const float sq = row16_sum(o[mt][i] * o[mt][i]); if (fr == 0) SS[t * 8 + w] = sq; } }
        WG_SYNC();
        { const f32x4 s0 = *(const LAS f32x4*)(SS + ot * 8), s1 = *(const LAS f32x4*)(SS + ot * 8 + 4);
          const float tot2 = ((s0[0] + s0[1]) + (s0[2] + s0[3])) + ((s1[0] + s1[1]) + (s1[2] + s1[3]));
          const float rstd = __builtin_amdgcn_rsqf(tot2 * (1.0f / GDV) + EPS);
          f32x4 ov4[4];
#pragma unroll
          for (int q = 0; q < 4; ++q) ov4[q] = *(const LAS f32x4*)(OT + ot * OTS + ov + 4 * q);
          f32x4 r0, r1, r2, r3; unpack8(r80, r0, r1); unpack8(r81, r2, r3);
          bf16* op = ON + (tb + ot) * GVW + h * 128 + ov;
          *(v4u*)op = pack8(ov4[0] * rstd * r0, ov4[1] * rstd * r1); *(v4u*)(op + 8) = pack8(ov4[2] * rstd * r2, ov4[3] * rstd * r3); }
    }
#undef GLA_LOADS
    WG_SYNC();
}
template <int WLEN>
__device__ __forceinline__ void pool_unit(const bf16* PJ, bf16* PD, const int g, const int t0, const int lane) {
    const int t = t0 + (lane >> 4), cb = g * 16 + (lane & 15), pos = t & (SEQ - 1), cnt = (pos + 1 < WLEN) ? pos + 1 : WLEN;
    v4u vw[WLEN];
#pragma unroll
    for (int i = 0; i < WLEN; ++i) { const int back = i < cnt ? i : 0; vw[i] = *(const v4u*)(PJ + (size_t)(t - back) * NPJ + PJ_U + cb * 8); }
    f32x4 a0 = (f32x4){0.f, 0.f, 0.f, 0.f}, a1 = a0, o0, o1;
    unpack8(vw[0], o0, o1);
#pragma unroll
    for (int i = 0; i < WLEN; ++i) { f32x4 u0, u1; unpack8(vw[i], u0, u1); const float m = i < cnt ? 1.f : 0.f; a0 += u0 * m; a1 += u1 * m; }
    const float inv = 1.0f / (float)cnt;
    *(v4u*)(PD + (size_t)t * PW + cb * 8) = pack8(a0 * inv - o0, a1 * inv - o1);
}
__device__ __forceinline__ void pool_items(Frame& F, const int widx, const int nworkers) {
    const bf16* PJ = WSP(bf16, WS_PJ); bf16* PD = WSP(bf16, WS_PD);
    const int gw = widx * 8 + F.wave, NGW = nworkers * 8;
    for (int u = gw; u < T; u += NGW) {
        const int g = u & 3, t0 = (u >> 2) * 4;
        if (g == 0) pool_unit<2>(PJ, PD, 0, t0, F.lane); else if (g == 1) pool_unit<4>(PJ, PD, 1, t0, F.lane); else if (g == 2) pool_unit<8>(PJ, PD, 2, t0, F.lane); else pool_unit<16>(PJ, PD, 3, t0, F.lane);
    }
}
__device__ __forceinline__ void p2_phase(Frame& F) {
    constexpr int NU = BATCH * GH;
    if (F.G > NU) {
        if (F.bid < NU) {
#pragma unroll 1
            for (int r_ = 0; r_ < REPS(10); ++r_) gla_unit(F, F.bid >> 2, F.bid & 3);
        } else {
#pragma unroll 1
            for (int r_ = 0; r_ < REPS(11); ++r_) pool_items(F, F.bid - NU, F.G - NU);
#pragma unroll 1
            for (int r_ = 0; r_ < REPS(12); ++r_) moe_weight_items(F, F.bid - NU, F.G - NU); }
    } else {
        for (int u = F.bid; u < NU; u += F.G) gla_unit(F, u >> 2, u & 3);
        pool_items(F, F.bid, F.G); moe_weight_items(F, F.bid, F.G);
    }
}

#if DBG
__device__ __forceinline__ void dbg_fail(Frame& F, unsigned code) { unsigned expect = 0u; __hip_atomic_compare_exchange_strong((unsigned*)(F.ctl + CW_DBG), &expect, code, __ATOMIC_RELAXED, __ATOMIC_RELAXED, __HIP_MEMORY_SCOPE_AGENT); }
__device__ __forceinline__ bool dbg_close(float got, float want) { return fabsf(got - want) <= 0.03f + 0.03f * fabsf(want); }
__device__ __forceinline__ void dbg_check_p1(Frame& F) {
    if (F.bid != 0 || F.tid >= 256) return;
    const float* x = F.in[0]; const float* g1 = F.in[1]; const float* w_in = F.in[2]; const float* wau = F.in[3]; const float* ba = F.in[4];
    const bf16* PJ = WSP(bf16, WS_PJ);
    const int tok = (int)(((unsigned)F.tid * 2654435761u) % (unsigned)T);
    const int col = (int)(((unsigned)F.tid * 40503u + 17u * (unsigned)F.tid * (unsigned)F.tid) % (unsigned)NPJ);
    const float* xr = x + (size_t)tok * D; float ss = 0.f;
    for (int k = 0; k < D; ++k) ss += xr[k] * xr[k];
    const float rstd = 1.0f / sqrtf(ss / D + EPS);
    float want;
    if (col >= PJ_Z && col < PJ_U) {
        return;
        float al[16];
#pragma unroll
        for (int j = 0; j < 16; ++j) al[j] = 0.f;
        for (int k = 0; k < D; ++k) { const float hk = xr[k] * rstd * g1[k];
#pragma unroll
            for (int j = 0; j < 16; ++j) al[j] += hk * w_in[(size_t)k * D_IN + IN_A + j]; }
        float z = 0.f;
#pragma unroll
        for (int j = 0; j < 16; ++j) z += al[j] * wau[j * GKW + (col - PJ_Z)];
        z += ba[col - PJ_Z];
        want = (fminf(z, 0.f) - logf(1.0f + expf(-fabsf(z)))) / 16.0f;
    } else {
        const int wc_ = col < PJ_Z ? col : col - PJ_U + IN_U; float a = 0.f;
        for (int k = 0; k < D; ++k) a += xr[k] * rstd * g1[k] * w_in[(size_t)k * D_IN + wc_];
        if (col >= PJ_R && col < PJ_Z) want = a / (1.0f + expf(-a)); else if (col >= PJ_GG) want = 1.0f / (1.0f + expf(-a)); else want = a;
    }
    const float got = bf1(PJ[(size_t)tok * NPJ + col]);
    if (!dbg_close(got, want)) dbg_fail(F, 1u);
}


__device__ __forceinline__ void dbg_check_bc(Frame& F) {
    if (F.bid != 5 || F.tid >= 64) return;
    const float* x = F.in[0]; const float* g1 = F.in[1]; const float* w_in = F.in[2]; const float* wau = F.in[3]; const float* ba = F.in[4]; const float* BC = WSP(float, WS_BC);
    const int offs[5] = {0, 1, 5, 18, 63}; const int off = (F.tid % 5 == 0) ? 0 : (F.tid % 5 == 1) ? 1 : (F.tid % 5 == 2) ? 5 : (F.tid % 5 == 3) ? 18 : 63; (void)offs;
    const int chunk = (int)(((unsigned)F.tid * 2654435761u) % (unsigned)(T / 64)), col = (int)(((unsigned)F.tid * 40503u + 3u) % (unsigned)GKW);
    float cum = 0.f;
    for (int r = 0; r <= off; ++r) { const float* xr = x + ((size_t)chunk * 64 + r) * D; float ss = 0.f; for (int k = 0; k < D; ++k) ss += xr[k] * xr[k];
        const float rstd = 1.0f / sqrtf(ss / D + EPS); float al[16];
#pragma unroll
        for (int j = 0; j < 16; ++j) al[j] = 0.f;
        for (int k = 0; k < D; ++k) { const float hk = xr[k] * rstd * g1[k];
#pragma unroll
            for (int j = 0; j < 16; ++j) al[j] += hk * w_in[(size_t)k * D_IN + IN_A + j]; }
        float z = ba[col];
#pragma unroll
        for (int j = 0; j < 16; ++j) z += al[j] * wau[j * GKW + col];
        cum += (fminf(z, 0.f) - logf(1.0f + expf(-fabsf(z)))) / 16.0f; }
    const float got = BC[((size_t)chunk * 64 + off) * GKW + col];
    if (fabsf(got - cum) > 0.004f + 0.01f * fabsf(cum)) dbg_fail(F, 7u);
}
__device__ __forceinline__ void dbg_check_gla(Frame& F) {
    if (F.bid != 1) return;
    const bf16* PJ = WSP(bf16, WS_PJ); const bf16* ON = WSP(bf16, WS_ON);
    const int b = 2, h = 1, v = F.tid & 127; const bool act = F.tid < 128;
    LAS float* S = (LAS float*)F.lds;
    LAS float* red = (LAS float*)(F.lds + 32768);
    if (act) for (int d = 0; d < 64; ++d) S[d * 128 + v] = 0.f;
    __syncthreads();
    bool bad = false;
    for (int t = 0; t < 150; ++t) {
        const bf16* rp = PJ + ((size_t)b * SEQ + t) * NPJ; float o = 0.f;
        if (act) { const float vv = bf1(rp[PJ_V + h * 128 + v]);
            for (int d = 0; d < 64; ++d) { const float* bcp = WSP(float, WS_BC) + ((size_t)b * SEQ + t) * GKW + h * 64 + d; const float la = (t & 63) ? bcp[0] - bcp[-GKW] : bcp[0]; const float kk = bf1(rp[PJ_K + h * 64 + d]), qq = bf1(rp[PJ_Q + h * 64 + d]);
                const float sn = expf(la) * S[d * 128 + v] + kk * vv; S[d * 128 + v] = sn; o += qq * 0.125f * sn; }
            red[v] = o * o; }
        __syncthreads();
        if (act) { float ss = 0.f; for (int i = 0; i < 128; ++i) ss += red[i];
            const float want = o * (1.0f / sqrtf(ss / 128.f + EPS)) * bf1(rp[PJ_R + h * 128 + v]);
            const float got = bf1(ON[((size_t)b * SEQ + t) * GVW + h * 128 + v]);
            if (!dbg_close(got, want)) bad = true; }
        __syncthreads();
    }
    if (bad) dbg_fail(F, 2u);
}
__device__ __forceinline__ void dbg_check_pool(Frame& F) {
    if (F.bid != 2) return;
    const bf16* PJ = WSP(bf16, WS_PJ); const bf16* PD = WSP(bf16, WS_PD);
    int tok = (int)(((unsigned)F.tid * 2654435761u) % (unsigned)T); if (F.tid < 40) tok = (F.tid & 1) * SEQ * 3 + (F.tid >> 1);
    const int c = (int)(((unsigned)F.tid * 40503u) % (unsigned)PW), pos = tok & (SEQ - 1), wlen = 2 << (c >> 7), cnt = pos + 1 < wlen ? pos + 1 : wlen;
    float a = 0.f; for (int i = 0; i < cnt; ++i) a += bf1(PJ[(size_t)(tok - i) * NPJ + PJ_U + c]);
    const float want = a / cnt - bf1(PJ[(size_t)tok * NPJ + PJ_U + c]);
    if (!dbg_close(bf1(PD[(size_t)tok * PW + c]), want)) dbg_fail(F, 3u);
}
__device__ __forceinline__ void dbg_check_mg(Frame& F) {
    if (F.bid != 3 || F.tid >= 64) return;
    const bf16* PJ = WSP(bf16, WS_PJ); const bf16* ON = WSP(bf16, WS_ON); const bf16* PD = WSP(bf16, WS_PD); const bf16* MG = WSP(bf16, WS_MG);
    const float* gng = F.in[5]; const float* wgb = F.in[6]; const float* pw = F.in[7]; const float* ps = F.in[8]; const float* wpb = F.in[9];
    const int tok = (int)(((unsigned)F.tid * 2654435761u + 12345u) % (unsigned)T), col = (int)(((unsigned)F.tid * 40503u + 77u) % (unsigned)D);
    float yg = 0.f; for (int k = 0; k < GVW; ++k) yg += bf1(ON[(size_t)tok * GVW + k]) * gng[k] * wgb[(size_t)k * D + col];
    float yp = 0.f;
    for (int g = 0; g < 4; ++g) for (int d = 0; d < 128; ++d) { float m = 0.f; for (int c = 0; c < 128; ++c) m += bf1(PD[(size_t)tok * PW + g * 128 + c]) * pw[((size_t)g * 128 + c) * 128 + d];
        yp += m * ps[g * 128 + d] * wpb[(size_t)(g * 128 + d) * D + col]; }
    const float want = bf1(PJ[(size_t)tok * NPJ + PJ_GG + col]) * yg + bf1(PJ[(size_t)tok * NPJ + PJ_GP + col]) * yp;
    if (!dbg_close(bf1(MG[(size_t)tok * D + col]), want)) dbg_fail(F, 4u);
}
__device__ __forceinline__ void dbg_check_x1(Frame& F) {
    if (F.bid != 4 || F.tid >= 128) return;
    const bf16* MG = WSP(bf16, WS_MG); const bf16* X1B = WSP(bf16, WS_X1B); const float* SSQ = WSP(float, WS_SSQ); const float* x = F.in[0]; const float* wout = F.in[10];
    const int tok = (int)(((unsigned)F.tid * 2654435761u + 999u) % (unsigned)T), col = (int)(((unsigned)F.tid * 40503u + 5u) % (unsigned)D);
    float a = x[(size_t)tok * D + col]; for (int k = 0; k < D; ++k) a += bf1(MG[(size_t)tok * D + k]) * wout[(size_t)k * D + col];
    if (!dbg_close(bf1(X1B[(size_t)tok * D + col]), a)) dbg_fail(F, 5u);
    float ss = 0.f; for (int k = 0; k < D; ++k) { const float v = bf1(X1B[(size_t)tok * D + k]); ss += v * v; }
    float sp = 0.f; for (int j = 0; j < 16; ++j) sp += SSQ[(size_t)tok * 16 + j];
    if (fabsf(ss - sp) > 1e-2f * ss) dbg_fail(F, 6u);
}
#endif

struct Args { const float* in[20]; float* out; unsigned char* ws; };
__global__ void __launch_bounds__(512, 2) fwd_kernel(Args args) {
    extern __shared__ __attribute__((aligned(16))) unsigned char lds[];
    Frame F;
    F.lds = (LAS unsigned char*)lds;
    F.MISC = (volatile LAS unsigned*)(F.lds + MISC_OFF);
    F.tid = threadIdx.x; F.lane = F.tid & 63; F.wave = __builtin_amdgcn_readfirstlane(F.tid >> 6);
    F.G = gridDim.x; F.bid = blockIdx.x;
    F.ws = args.ws; F.out = args.out; F.ctl = (gu32*)(args.ws + WS_CTL);
#pragma unroll
    for (int i = 0; i < 20; ++i) F.in[i] = args.in[i];
    for (int u = F.tid; u < (LDS_BYTES - RING_BYTES) / 4; u += 512) ((LAS unsigned*)(F.lds + RING_BYTES))[u] = 0u;
    __syncthreads();
    XcdBarrier bar = xcd_barrier_post((unsigned*)(F.ctl + CW_BAR), F.MISC + 8);
#define GRID_BAR() xcd_barrier(bar)

#pragma unroll 1
    for (int rep_ = 0; rep_ < REPS(0); ++rep_) p0_prologue(F);
    GRID_BAR();
    if (NPH > 1) {
        pg8::StaticSched S; S.init(WSP(bf16, WS_HB), D, WSP(bf16, WS_WIN), D, T, NPJ, F.G, F.bid);
        EpiP1 E{WSP(bf16, WS_PJ), F.in[4], WSP(float, WS_BC)};
#pragma unroll 1
        for (int rep_ = 0; rep_ < REPS(1); ++rep_) pg8::gemm_phase<EpiP1, pg8::StaticSched, false, true>(F.lds, D, D, D, S, E);
        GRID_BAR();
#if DBG
        dbg_check_p1(F); dbg_check_bc(F);
        GRID_BAR();
#endif
    }
    if (NPH > 2) {
#pragma unroll 1
        for (int rep_ = 0; rep_ < REPS(2); ++rep_) p2_phase(F);
        GRID_BAR();
#if DBG
        dbg_check_gla(F); dbg_check_pool(F);
        GRID_BAR();
#endif
    }
    if (NPH > 3) {
        pg8::StaticSched S; S.init(WSP(bf16, WS_ON), GVW, WSP(bf16, WS_WG), GVW, T, D, F.G, F.bid);
        EpiD E{WSP(bf16, WS_TG), WSP(bf16, WS_PJ)};
#pragma unroll 1
        for (int rep_ = 0; rep_ < REPS(3); ++rep_) pg8::gemm_phase<EpiD, pg8::StaticSched, false, true>(F.lds, GVW, GVW, GVW, S, E);
        GRID_BAR();
    }
    if (NPH > 4) {
        pg8::StaticSched S; S.init(WSP(bf16, WS_PD), PW, WSP(bf16, WS_WP), PW, T, D, F.G, F.bid);
        EpiE E{WSP(bf16, WS_MG), WSP(bf16, WS_TG), WSP(bf16, WS_PJ)};
#pragma unroll 1
        for (int rep_ = 0; rep_ < REPS(4); ++rep_) pg8::gemm_phase<EpiE, pg8::StaticSched, false, true>(F.lds, PW, PW, PW, S, E);
        GRID_BAR();
#if DBG
        dbg_check_mg(F);
        GRID_BAR();
#endif
    }
    if (NPH > 5) {
        pg8::StaticSched S; S.init(WSP(bf16, WS_MG), D, WSP(bf16, WS_WOUT), D, T, D, F.G, F.bid);
        EpiF E{F.in[0], WSP(bf16, WS_X1B), WSP(float, WS_SSQ)};
#pragma unroll 1
        for (int rep_ = 0; rep_ < REPS(5); ++rep_) pg8::gemm_phase<EpiF, pg8::StaticSched, false, true>(F.lds, D, D, D, S, E);
        GRID_BAR();
#if DBG
        dbg_check_x1(F);
        GRID_BAR();
#endif
    }
    if (NPH > 6) {
        pg8::StaticSched S; S.init(WSP(bf16, WS_X1B), D, WSP(bf16, WS_WR), D, T, 256, F.G, F.bid);
        EpiG E{WSP(float, WS_LG)};
#pragma unroll 1
        for (int rep_ = 0; rep_ < REPS(6); ++rep_) pg8::gemm_phase<EpiG, pg8::StaticSched, false, true>(F.lds, D, D, D, S, E);
        VM_WAIT(); __syncthreads();
        pg8::Unit u; for (int i = 0; S.next(i, u); ++i) route_rows(F, u.r0);
        GRID_BAR();
    }
    if (NPH > 7) {
        moe_tables(F);
        MoeSched S{(const LAS int*)(F.lds + SCHED_OFF + 256), (const LAS int*)(F.lds + SCHED_OFF + 256) + 40, WSP(unsigned, WS_LIST), (const char*)WSP(bf16, WS_X1B), (const char*)WSP(bf16, WS_WGU), 2, F.G, F.bid, 0};
        EpiH E{WSP(bf16, WS_ACT), WSP(float, WS_LISTR)};
#pragma unroll 1
        for (int rep_ = 0; rep_ < REPS(7); ++rep_) pg8::gemm_phase<EpiH, MoeSched, true, true>(F.lds, D, D, D, S, E);
        GRID_BAR();
    }
    if (NPH > 8) {
        MoeSched S{(const LAS int*)(F.lds + SCHED_OFF + 256), (const LAS int*)(F.lds + SCHED_OFF + 256) + 40, WSP(unsigned, WS_LIST), (const char*)WSP(bf16, WS_ACT), (const char*)WSP(bf16, WS_WD), 4, F.G, F.bid, 1};
        EpiI E{WSP(bf16, WS_Y), WSP(unsigned, WS_LIST), WSP(float, WS_LISTW)};
#pragma unroll 1
        for (int rep_ = 0; rep_ < REPS(8); ++rep_) pg8::gemm_phase<EpiI, MoeSched, false, true>(F.lds, DE, DE, DE, S, E);
        GRID_BAR();
    }
    if (NPH > 9) {
        const float* gf = F.in[19]; const bf16* X1B = WSP(bf16, WS_X1B); const bf16* Y = WSP(bf16, WS_Y);
        const int gw = F.bid * 8 + F.wave, NGW = F.G * 8;
        unsigned code = 0;
#if DBG
        code = __hip_atomic_load((unsigned*)(F.ctl + CW_DBG), RLX_AGENT);
        if (__hip_atomic_load((unsigned*)(F.ctl + CW_BAR) + XB_TMO, RLX_AGENT) != 0u) code = 9;
#endif
#pragma unroll 1
        for (int rep_ = 0; rep_ < REPS(9); ++rep_)
        for (int m = gw; m < T; m += NGW) {
            const GAS v2u* xr = (const GAS v2u*)(X1B + (size_t)m * D) + F.lane;
            const GAS v2u* y0 = (const GAS v2u*)(Y + (size_t)(2 * m) * D) + F.lane; const GAS v2u* y1 = (const GAS v2u*)(Y + (size_t)(2 * m + 1) * D) + F.lane;
            f32x4 v[4]; float s_ = 0.f;
#pragma unroll
            for (int j = 0; j < 4; ++j) { const v2u a = y0[64 * j], b = y1[64 * j], c = xr[64 * j]; v[j] = (f32x4){bflo(c.x), bfhi(c.x), bflo(c.y), bfhi(c.y)} + (f32x4){bflo(a.x), bfhi(a.x), bflo(a.y), bfhi(a.y)} + (f32x4){bflo(b.x), bfhi(b.x), bflo(b.y), bfhi(b.y)};
                s_ += (v[j].x * v[j].x + v[j].y * v[j].y) + (v[j].z * v[j].z + v[j].w * v[j].w); }
            const float rstd = 1.0f / sqrtf(wave_sum(s_) * (1.f / D) + EPS);
            GAS f32x4* o = (GAS f32x4*)(F.out + (size_t)m * D) + F.lane;
#pragma unroll
            for (int j = 0; j < 4; ++j) { const f32x4 g = *((const GAS f32x4*)gf + F.lane + 64 * j); f32x4 r = v[j] * rstd * g; if (code) r = (f32x4){10.f * code, 10.f * code, 10.f * code, 10.f * code}; o[64 * j] = r; }
        }
    } else
    {
        const float* gf = F.in[19]; const float* x = F.in[0];
        const int gw = F.bid * 8 + F.wave, NGW = F.G * 8;
        unsigned code = 0;
#if DBG
        code = __hip_atomic_load((unsigned*)(F.ctl + CW_DBG), RLX_AGENT);
        if (__hip_atomic_load((unsigned*)(F.ctl + CW_BAR) + XB_TMO, RLX_AGENT) != 0u) code = 9;
#endif
        for (int m = gw; m < T; m += NGW) {
            const GAS f32x4* xr = (const GAS f32x4*)(x + (size_t)m * D) + F.lane;
            f32x4 v[4]; float s = 0.f;
#pragma unroll
            for (int j = 0; j < 4; ++j) { v[j] = xr[64 * j]; s += (v[j].x * v[j].x + v[j].y * v[j].y) + (v[j].z * v[j].z + v[j].w * v[j].w); }
            const float rstd = 1.0f / sqrtf(wave_sum(s) * (1.f / D) + EPS);
            GAS f32x4* o = (GAS f32x4*)(F.out + (size_t)m * D) + F.lane;
#pragma unroll
            for (int j = 0; j < 4; ++j) { const f32x4 g = *((const GAS f32x4*)gf + F.lane + 64 * j); f32x4 r = v[j] * rstd * g; if (code) r = (f32x4){10.f * code, 10.f * code, 10.f * code, 10.f * code}; o[64 * j] = r; }
        }
    }
}

extern "C" void kernel_launch(void* const* d_in, const int* in_sizes, int n_in, void* d_out, int out_size, void* d_ws, size_t ws_size, hipStream_t stream) {
    static int grid = 0;
    if (grid == 0) {
        if (n_in != 20 || in_sizes[0] != T * D || out_size != T * D || ws_size < WS_END) { fprintf(stderr, "kernel_launch: unexpected shapes (n_in %d, in0 %d, out %d, ws %zu)\n", n_in, n_in > 0 ? in_sizes[0] : -1, out_size, ws_size); grid = -1; return; }
        int dev = 0, cus = 0, per_cu = 0;
        if (hipGetDevice(&dev) != hipSuccess || hipDeviceGetAttribute(&cus, hipDeviceAttributeMultiprocessorCount, dev) != hipSuccess) { grid = -1; return; }
        if (hipFuncSetAttribute((const void*)fwd_kernel, hipFuncAttributeMaxDynamicSharedMemorySize, LDS_BYTES) != hipSuccess) { fprintf(stderr, "kernel_launch: hipFuncSetAttribute failed\n"); grid = -1; return; }
        if (hipOccupancyMaxActiveBlocksPerMultiprocessor(&per_cu, (const void*)fwd_kernel, 512, LDS_BYTES) != hipSuccess || per_cu < 1) fprintf(stderr, "kernel_launch: occupancy query says %d\n", per_cu);
        (void)hipGetLastError();
        grid = cus;
    }
    if (grid < 0) return;
    if (hipMemsetAsync((char*)d_ws + WS_CTL, 0, CTL_ZERO_BYTES, stream) != hipSuccess) return;
    Args a{};
    for (int i = 0; i < 20; ++i) a.in[i] = (const float*)d_in[i];
    a.out = (float*)d_out; a.ws = (unsigned char*)d_ws;
    hipLaunchKernelGGL(fwd_kernel, dim3(grid), dim3(512), LDS_BYTES, stream, a);
}
```

```cpp
#include <hip/hip_runtime.h>
#include <cstdio>
#include <cstdint>

#ifndef DBG
#define DBG 0
#endif
#ifndef REPMASK
#define REPMASK 0
#endif
#define REPS(k) ((((REPMASK) >> (k)) & 1) ? 2 : 1)
#ifndef NPH
#define NPH 10
#endif

constexpr int BATCH = 16, SEQ = 4096, T = BATCH * SEQ, D = 1024;
constexpr int GH = 4, GDK = 64, GDV = 128, GKW = 256, GVW = 512, GRANK = 16, GCH = 64;
constexpr int PW = 512, PGW = 128;
constexpr int D_IN = 4112;
constexpr int IN_Q = 0, IN_K = 256, IN_V = 512, IN_R = 1024, IN_A = 1536, IN_U = 1552, IN_GG = 2064, IN_GP = 3088;
constexpr int NPJ = 4352;
constexpr int PJ_Q = 0, PJ_K = 256, PJ_V = 512, PJ_R = 1024, PJ_Z = 1536, PJ_U = 1792, PJ_GG = 2304, PJ_GP = 3328;
constexpr int NE = 32, EPG = 8, NG = 4, DE = 256;
constexpr int NSEG = 4, SEGCH = SEQ / GCH / NSEG;
constexpr int NA = 2 * T;
constexpr int LCAP = T;
constexpr float EPS = 1e-6f;

constexpr size_t MiB = 1u << 20;
constexpr size_t WS_CTL = 0, CTL_ZERO_BYTES = 1 * MiB;
constexpr size_t WS_WIN = 1 * MiB;
constexpr size_t WS_WG = 10 * MiB;
constexpr size_t WS_WP = 11 * MiB;
constexpr size_t WS_WOUT = 12 * MiB;
constexpr size_t WS_WR = 14 * MiB;
constexpr size_t WS_WGU = 15 * MiB;
constexpr size_t WS_WD = 47 * MiB;
constexpr size_t WS_HB = 64 * MiB;
constexpr size_t WS_TG = WS_HB;
constexpr size_t WS_MG = 192 * MiB;
constexpr size_t WS_SLOC = 256 * MiB;
constexpr size_t WS_DTOT = 264 * MiB;
constexpr size_t WS_CUMB = 265 * MiB;
constexpr size_t WS_BC = 192 * MiB;
constexpr size_t WS_Y = 64 * MiB;
constexpr size_t WS_ON = 320 * MiB;
constexpr size_t WS_PD = 384 * MiB;
constexpr size_t WS_ACT = 320 * MiB;
constexpr size_t WS_PJ = 448 * MiB;
constexpr size_t WS_X1B = 704 * MiB;
constexpr size_t WS_LG = 832 * MiB;
constexpr size_t WS_SSQ = 848 * MiB;
constexpr size_t WS_LIST = 852 * MiB;
constexpr size_t WS_LISTW = 864 * MiB;
constexpr size_t WS_LISTR = 872 * MiB;
constexpr size_t WS_END = 992 * MiB;
static_assert(WS_PJ + (size_t)T * NPJ * 2 <= WS_END && WS_LISTR + (size_t)NE * LCAP * 4 <= WS_END && WS_ACT + (size_t)(NA + NE * 256) * DE * 2 <= WS_PJ, "d_ws map");
constexpr int CW_TMO = 0, CW_DBG = 2;
constexpr int CW_BAR = 4096;
constexpr int CW_ECNT = 16384;

constexpr int RING_BYTES = 131072;
constexpr int MISC_OFF = RING_BYTES + 320;
constexpr int SCHED_OFF = RING_BYTES + 1024;
constexpr int LDS_BYTES = 147456;

#define GAS __attribute__((address_space(1)))
#define LAS __attribute__((address_space(3)))
typedef unsigned short bf16;
typedef unsigned v4u __attribute__((ext_vector_type(4)));
typedef unsigned v2u __attribute__((ext_vector_type(2)));
typedef float f32x4 __attribute__((ext_vector_type(4)));
typedef short bf16x8 __attribute__((ext_vector_type(8)));
typedef short bf16x4 __attribute__((ext_vector_type(4)));
typedef GAS unsigned gu32;
#define RLX_AGENT __ATOMIC_RELAXED, __HIP_MEMORY_SCOPE_AGENT
#define LDS_WAIT() asm volatile("s_waitcnt lgkmcnt(0)" ::: "memory")
#define VM_WAIT() asm volatile("s_waitcnt vmcnt(0)" ::: "memory")
__device__ __forceinline__ unsigned f2bf(float f) { unsigned u = __builtin_bit_cast(unsigned, f); return (u + 0x7fffu + ((u >> 16) & 1u)) >> 16; }
__device__ __forceinline__ unsigned pk2(float lo, float hi) { unsigned r; asm volatile("v_cvt_pk_bf16_f32 %0, %1, %2" : "=v"(r) : "v"(lo), "v"(hi)); return r; }
__device__ __forceinline__ float bflo(unsigned w) { return __builtin_bit_cast(float, w << 16); }
__device__ __forceinline__ float bfhi(unsigned w) { return __builtin_bit_cast(float, w & 0xffff0000u); }
__device__ __forceinline__ float bf1(bf16 h) { return __builtin_bit_cast(float, (unsigned)h << 16); }
__device__ __forceinline__ float fsigmoid(float x) { return __builtin_amdgcn_rcpf(1.0f + __expf(-x)); }
__device__ __forceinline__ float wave_sum(float v) {
#pragma unroll
    for (int o = 1; o < 64; o <<= 1) v += __shfl_xor(v, o);
    return v;
}


template <int CTRL> __device__ __forceinline__ float dpp_f(float x) { return __builtin_bit_cast(float, __builtin_amdgcn_update_dpp(0, __builtin_bit_cast(int, x), CTRL, 0xf, 0xf, true)); }
__device__ __forceinline__ float row16_sum(float x) { x += dpp_f<0x128>(x); x += dpp_f<0x124>(x); x += dpp_f<0x122>(x); x += dpp_f<0x121>(x); return x; }
__device__ __forceinline__ float row16_scan(float x) { x += dpp_f<0x111>(x); x += dpp_f<0x112>(x); x += dpp_f<0x114>(x); x += dpp_f<0x118>(x); return x; }

#define XB_TMO      128
#define XB_XCNT(j)  (256  + 64 * (j))
#define XB_XSUB(j)  (1280 + 64 * (j))
#define XB_XGEN(j)  (2304 + 64 * (j))
#define XB_TOP      3328
#define XB_TOPGEN   3392
#define XCD_BAR_WORDS 3456
#define XB_SPIN_CAP (1u << 18)
__device__ __forceinline__ unsigned xb_ld(unsigned* p)              { return __hip_atomic_load(p, __ATOMIC_RELAXED, __HIP_MEMORY_SCOPE_AGENT); }
__device__ __forceinline__ unsigned xb_add(unsigned* p, unsigned v) { return __hip_atomic_fetch_add(p, v, __ATOMIC_RELAXED, __HIP_MEMORY_SCOPE_AGENT); }
__device__ __forceinline__ unsigned xb_xcc_id() { return (unsigned)__builtin_amdgcn_s_getreg((3 << 11) | 20) & 0xFu; }
#define XB_SPIN(cond, bar) do { unsigned _sp = 0; while (cond) { __builtin_amdgcn_s_sleep(1); \
    if ((++_sp & 255u) == 0u) { if (xb_ld(&(bar)[XB_TMO])) break; if (_sp > XB_SPIN_CAP) { atomicAdd(&(bar)[XB_TMO], 1u); break; } } } } while (0)
struct XcdBarrier { unsigned* bar; unsigned x; volatile LAS unsigned* st; };
__device__ __forceinline__ XcdBarrier xcd_barrier_post(unsigned* bar, volatile LAS unsigned* st) {
    XcdBarrier b; b.bar = bar; b.x = xb_xcc_id(); b.st = st;
    if (threadIdx.x == 0) (void)xb_add(&bar[XB_XCNT(b.x)], 1u);
    return b;
}
__device__ __forceinline__ void xcd_barrier_complete(unsigned* bar, unsigned x, unsigned& nloc, unsigned& nx) {
    const unsigned G = gridDim.x * gridDim.y * gridDim.z;
    unsigned sum, cnt, mine, sp = 0u;
    for (;;) {
        sum = 0u; cnt = 0u; mine = 0u;
#pragma unroll
        for (unsigned j = 0; j < 16; ++j) { const unsigned c = xb_ld(&bar[XB_XCNT(j)]); sum += c; cnt += (c > 0u) ? 1u : 0u; mine = (j == x) ? c : mine; }
        if (sum == G) break;
        __builtin_amdgcn_s_sleep(1);
        if ((++sp & 255u) == 0u) { if (xb_ld(&bar[XB_TMO])) break; if (sp > XB_SPIN_CAP) { atomicAdd(&bar[XB_TMO], 1u); break; } }
    }
    nloc = mine > 0u ? mine : 1u; nx = cnt > 0u ? cnt : 1u;
}
__device__ __forceinline__ void xcd_barrier(const XcdBarrier& b) {
    asm volatile("s_waitcnt vmcnt(0)" ::: "memory");
    __syncthreads();
    if (threadIdx.x == 0) {
        unsigned* bar = b.bar;
        __builtin_amdgcn_s_waitcnt(0);
        unsigned nloc = b.st[0], nx = b.st[1];
        if (nloc == 0u) { xcd_barrier_complete(bar, b.x, nloc, nx); b.st[0] = nloc; b.st[1] = nx; }
        const unsigned old = xb_add(&bar[XB_XSUB(b.x)], 1u);
        const unsigned gen = old / nloc;
        if (old + 1u == (gen + 1u) * nloc) {
            __builtin_amdgcn_fence(__ATOMIC_RELEASE, "agent");
            asm volatile("s_waitcnt vmcnt(0)" ::: "memory");
            const unsigned og = xb_add(&bar[XB_TOP], 1u);
            const unsigned tg = og / nx;
            if (og + 1u == (tg + 1u) * nx) xb_add(&bar[XB_TOPGEN], 1u);
            else XB_SPIN(xb_ld(&bar[XB_TOPGEN]) == tg, bar);
            __builtin_amdgcn_fence(__ATOMIC_ACQUIRE, "agent");
            xb_add(&bar[XB_XGEN(b.x)], 1u);
            asm volatile("s_waitcnt vmcnt(0)" ::: "memory");
        } else {
            XB_SPIN(xb_ld(&bar[XB_XGEN(b.x)]) == gen, bar);
            __builtin_amdgcn_fence(__ATOMIC_ACQUIRE, "agent");
            asm volatile("s_waitcnt vmcnt(0)" ::: "memory");
        }
    }
    __syncthreads();
}

namespace pg8 {
#define PG8_LAS __attribute__((address_space(3)))
constexpr int BM = 256, BK = 64, HALF = 128, HTB = HALF * BK * 2, STAGE_BYTES = 8 * HTB, NXCD = 8, WGM = 8;
__host__ __device__ __forceinline__ int lds_byte(int r, int c) { const int st = (r >> 4) * 2 + (c >> 5), rr = r & 15, cc = c & 31, ob = rr * 64 + cc * 2; return st * 1024 + (ob ^ (((ob >> 9) & 1) << 5)); }
__host__ __device__ __forceinline__ void stage_rc(int b, int& R, int& C) { const int st = b / 1024, sb = b % 1024, swz = sb ^ (((sb >> 9) & 1) << 5); R = (st >> 1) * 16 + swz / 64; C = (st & 1) * 32 + (swz % 64) / 2; }
__host__ __device__ __forceinline__ int perm32(int rho) { const int n = rho >> 4, i = rho & 15; return 8 * (i >> 2) + 4 * n + (i & 3); }

struct Unit { const char* A; const char* B; int r0, c0, e, nvalid, lb, pad; };

__device__ __forceinline__ int remap_xcd(int L, int nwg) { const int q = nwg / NXCD, r = nwg % NXCD, xcd = L % NXCD, off = L / NXCD; return (xcd < r ? xcd * (q + 1) : r * (q + 1) + (xcd - r) * q) + off; }
struct StaticSched {
    const char* A; const char* B; int lda, ldb, nM, nN, nwg, G, c;
    __device__ __forceinline__ void init(const void* A_, int lda_, const void* B_, int ldb_, int M, int N, int G_, int c_) { A = (const char*)A_; B = (const char*)B_; lda = lda_; ldb = ldb_; nM = M / BM; nN = N / BM; nwg = nM * nN; G = G_; c = c_; }
    __device__ __forceinline__ bool next(int i, Unit& u) const {
        const long L = (long)i * G + c; if (L >= nwg) return false;
        const int wgid = remap_xcd((int)L, nwg);
        const int nig = WGM * nN, gid = wgid / nig, fm = gid * WGM, gsz = (nM - fm) < WGM ? (nM - fm) : WGM;
        const int pm = fm + ((wgid % nig) % gsz), pn = (wgid % nig) / gsz;
        u.A = A + (size_t)pm * BM * lda * 2; u.B = B + (size_t)pn * BM * ldb * 2; u.r0 = pm * BM; u.c0 = pn * BM; u.e = 0; u.nvalid = BM; u.lb = 0; u.pad = 0; return true;
    }
    __device__ __forceinline__ void fill_tab(const Unit&, PG8_LAS unsigned*) const {}
};

template <class Epi, class Sched, bool GATHER, bool ALIGN_EPI>
__device__ __forceinline__ void gemm_phase(PG8_LAS unsigned char* lds, const int K, const int lda, const int ldb, const Sched& S, const Epi& E) {
    int tid_ = threadIdx.x; asm volatile("" : "+v"(tid_));
    const int tid = tid_, wid = __builtin_amdgcn_readfirstlane(tid >> 6), lane = tid & 63, wr = wid >> 2, wc = wid & 3, fr = lane & 15, fq = lane >> 4;
    const int nt = K / BK;
    int Rr[2], Cc[2];
    unsigned voffA[2][2], voffB[2], nvA[2][2];
#pragma unroll
    for (int i = 0; i < 2; ++i) { int R, C; stage_rc(tid * 16 + i * 8192, R, C); Rr[i] = R; Cc[i] = C; const int Rb = Epi::PERM ? ((R & ~31) + perm32(R & 31)) : R;
        voffB[i] = (unsigned)(Rb * ldb + C) * 2u;
#pragma unroll
        for (int h = 0; h < 2; ++h) { voffA[h][i] = (unsigned)((R + HALF * h) * lda + C) * 2u; nvA[h][i] = voffA[h][i]; } }
    const size_t kstep = (size_t)(BK * 2);
    const size_t hstepB = (size_t)HALF * ldb * 2;
    const unsigned ldsw = (unsigned)wid * 1024u;
    const int aoff = lds_byte(wr * 64 + fr, fq * 8), boff = lds_byte(wc * 32 + fr, fq * 8);
#define PG8_SA(b, h) (((b) * 2 + (h)) * HTB)
#define PG8_SB(b, h) ((4 + (b) * 2 + (h)) * HTB)
#define PG8_STAGE(bufoff, gbase, voff) do { _Pragma("unroll") for (int _i = 0; _i < 2; ++_i) \
        __builtin_amdgcn_global_load_lds((const unsigned*)((const char*)(gbase) + (voff)[_i]), (PG8_LAS unsigned*)(lds + (bufoff) + ldsw + _i * 8192), 16, 0, 0); } while (0)
#define PG8_LDA(dst, b, h) do { _Pragma("unroll") for (int m = 0; m < 4; ++m) _Pragma("unroll") for (int k = 0; k < 2; ++k) dst[m][k] = *(const PG8_LAS bf16x8*)(lds + PG8_SA(b, h) + aoff + m * 2048 + k * 1024); } while (0)
#define PG8_LDB(dst, b, h) do { _Pragma("unroll") for (int n = 0; n < 2; ++n) _Pragma("unroll") for (int k = 0; k < 2; ++k) dst[n][k] = *(const PG8_LAS bf16x8*)(lds + PG8_SB(b, h) + boff + n * 2048 + k * 1024); } while (0)
#define PG8_MMA(ai, bj, At, Bt) do { __builtin_amdgcn_s_setprio(1); _Pragma("unroll") for (int m = 0; m < 4; ++m) _Pragma("unroll") for (int n = 0; n < 2; ++n) _Pragma("unroll") for (int k = 0; k < 2; ++k) \
        acc[ai][bj][m][n] = __builtin_amdgcn_mfma_f32_16x16x32_bf16(Bt[n][k], At[m][k], acc[ai][bj][m][n], 0, 0, 0); __builtin_amdgcn_s_setprio(0); } while (0)
#define PG8_WAIT_V(n) asm volatile("s_waitcnt vmcnt(" #n ")" ::: "memory")
#define PG8_WAIT_L(n) asm volatile("s_waitcnt lgkmcnt(" #n ")" ::: "memory")
#define PG8_BAR __builtin_amdgcn_s_barrier()
#define PG8_SCHED __builtin_amdgcn_sched_barrier(0)
    Unit cur, nxt; int ui = 0;
    if (!S.next(0, cur)) return;
    f32x4 acc[2][2][4][2];
#pragma unroll
    for (int a = 0; a < 2; ++a)
#pragma unroll
        for (int b = 0; b < 2; ++b)
#pragma unroll
            for (int m = 0; m < 4; ++m)
#pragma unroll
                for (int n = 0; n < 2; ++n) acc[a][b][m][n] = (f32x4){0.f, 0.f, 0.f, 0.f};
    bf16x8 At[4][2], B0[2][2], B1[2][2];
    const char* cA = cur.A; const char* cB = cur.B;
    PG8_LAS unsigned* gtab = (PG8_LAS unsigned*)(lds + STAGE_BYTES + 2048);
    if constexpr (GATHER) {
        S.fill_tab(cur, gtab);
        asm volatile("s_waitcnt lgkmcnt(0)" ::: "memory"); __builtin_amdgcn_s_barrier(); asm volatile("" ::: "memory");
#pragma unroll
        for (int h = 0; h < 2; ++h)
#pragma unroll
            for (int i = 0; i < 2; ++i) { voffA[h][i] = gtab[Rr[i] + HALF * h] + (unsigned)Cc[i] * 2u; nvA[h][i] = voffA[h][i]; }
    }
    PG8_STAGE(PG8_SB(0, 0), cB, voffB); PG8_STAGE(PG8_SB(0, 1), cB + hstepB, voffB); PG8_STAGE(PG8_SA(0, 0), cA, voffA[0]); PG8_STAGE(PG8_SA(0, 1), cA, voffA[1]);
    if (wr == 1) PG8_BAR;
    PG8_WAIT_V(2); PG8_BAR;
    PG8_STAGE(PG8_SB(1, 0), cB + kstep, voffB); PG8_STAGE(PG8_SA(1, 0), cA + kstep, voffA[0]); PG8_STAGE(PG8_SB(1, 1), cB + hstepB + kstep, voffB);
    PG8_WAIT_V(6); PG8_BAR;
    for (;;) {
        const bool has_next = S.next(ui + 1, nxt);
        const char* nA = has_next ? nxt.A : cA; const char* nB = has_next ? nxt.B : cB;
        if constexpr (GATHER) { if (has_next) S.fill_tab(nxt, gtab + ((ui + 1) & 1) * 256); }
#pragma unroll 1
        for (int t = 0; t < nt; t += 2) {
            const bool last = (t == nt - 2);
            const char* a1 = cA + (size_t)(t + 1) * kstep;
            const char* a2 = last ? nA : cA + (size_t)(t + 2) * kstep; const char* b2 = last ? nB : cB + (size_t)(t + 2) * kstep;
            const char* a3 = a2 + kstep; const char* b3 = b2 + kstep;
            unsigned sv[2][2];
            if constexpr (GATHER) {
                if (last && has_next) {
#pragma unroll
                    for (int h = 0; h < 2; ++h)
#pragma unroll
                        for (int i = 0; i < 2; ++i) nvA[h][i] = gtab[((ui + 1) & 1) * 256 + Rr[i] + HALF * h] + (unsigned)Cc[i] * 2u;
                }
#pragma unroll
                for (int h = 0; h < 2; ++h)
#pragma unroll
                    for (int i = 0; i < 2; ++i) sv[h][i] = last ? nvA[h][i] : voffA[h][i];
            } else {
#pragma unroll
                for (int h = 0; h < 2; ++h)
#pragma unroll
                    for (int i = 0; i < 2; ++i) sv[h][i] = voffA[h][i];
            }
            PG8_LDB(B0, 0, 0); PG8_LDB(B1, 0, 1); PG8_SCHED; PG8_LDA(At, 0, 0); PG8_STAGE(PG8_SA(1, 1), a1, voffA[1]);
            PG8_WAIT_V(8); PG8_WAIT_L(0); PG8_BAR; PG8_MMA(0, 0, At, B0); PG8_MMA(0, 1, At, B1); PG8_BAR; PG8_SCHED;
            PG8_LDA(At, 0, 1); PG8_STAGE(PG8_SB(0, 0), b2, voffB); PG8_STAGE(PG8_SB(0, 1), b2 + hstepB, voffB); PG8_STAGE(PG8_SA(0, 0), a2, sv[0]);
            PG8_WAIT_V(8); PG8_WAIT_L(0); PG8_BAR; PG8_MMA(1, 0, At, B0); PG8_MMA(1, 1, At, B1); PG8_BAR; PG8_SCHED;
            PG8_LDB(B0, 1, 0); PG8_LDB(B1, 1, 1); PG8_SCHED; PG8_LDA(At, 1, 0); PG8_STAGE(PG8_SA(0, 1), a2, sv[1]);
            PG8_WAIT_V(8); PG8_WAIT_L(0); PG8_BAR; PG8_MMA(0, 0, At, B0); PG8_MMA(0, 1, At, B1); PG8_BAR; PG8_SCHED;
            PG8_LDA(At, 1, 1); PG8_STAGE(PG8_SB(1, 0), b3, voffB); PG8_STAGE(PG8_SB(1, 1), b3 + hstepB, voffB); PG8_STAGE(PG8_SA(1, 0), a3, sv[0]);
            PG8_WAIT_V(8); PG8_WAIT_L(0); PG8_BAR; PG8_MMA(1, 0, At, B0); PG8_MMA(1, 1, At, B1); PG8_BAR; PG8_SCHED;
        }
        if constexpr (ALIGN_EPI) { if (wr == 0) PG8_BAR; }
        E(acc, cur, wr, wc, fr, fq);
        if (!has_next) break;
#pragma unroll
        for (int a = 0; a < 2; ++a)
#pragma unroll
            for (int b = 0; b < 2; ++b)
#pragma unroll
                for (int m = 0; m < 4; ++m)
#pragma unroll
                    for (int n = 0; n < 2; ++n) acc[a][b][m][n] = (f32x4){0.f, 0.f, 0.f, 0.f};
        cur = nxt; cA = nA; cB = nB; ++ui;
        if constexpr (GATHER) {
#pragma unroll
            for (int h = 0; h < 2; ++h)
#pragma unroll
                for (int i = 0; i < 2; ++i) voffA[h][i] = nvA[h][i];
        }
        if constexpr (ALIGN_EPI) { if (wr == 1) PG8_BAR; }
    }
    PG8_WAIT_V(0);
    if constexpr (!ALIGN_EPI) { if (wr == 0) PG8_BAR; }
    PG8_BAR;
#undef PG8_SA
#undef PG8_SB
#undef PG8_STAGE
#undef PG8_LDA
#undef PG8_LDB
#undef PG8_MMA
#undef PG8_WAIT_V
#undef PG8_WAIT_L
#undef PG8_BAR
#undef PG8_SCHED
}
}

struct Frame {
    LAS unsigned char* lds;
    volatile LAS unsigned* MISC;
    gu32* ctl;
    int tid, lane, wave, G, bid;
    const float* in[20]; float* out; unsigned char* ws;
};
#define WSP(T_, off) ((T_*)(F.ws + (off)))

__device__ __forceinline__ v4u pack8(const f32x4 a, const f32x4 b) { v4u w; w.x = pk2(a[0], a[1]); w.y = pk2(a[2], a[3]); w.z = pk2(b[0], b[1]); w.w = pk2(b[2], b[3]); return w; }
__device__ __forceinline__ void unpack8(const v4u w, f32x4& a, f32x4& b) { a = (f32x4){bflo(w.x), bfhi(w.x), bflo(w.y), bfhi(w.y)}; b = (f32x4){bflo(w.z), bfhi(w.z), bflo(w.w), bfhi(w.w)}; }

struct EpiP1 {
    static constexpr bool PERM = true;
    bf16* PJ; const float* b_alpha; float* BC;
    __device__ __forceinline__ void operator()(const f32x4 (&acc)[2][2][4][2], const pg8::Unit& u, int wr, int wc, int fr, int fq) const {
        const int pn = u.c0 >> 8;
        const int mode = (pn == 4 || pn == 5) ? 1 : (pn == 6) ? 2 : (pn >= 9) ? 3 : 0;
        const int row0 = u.r0 + wr * 64 + fr, col0 = u.c0 + wc * 32 + 8 * fq;
        f32x4 bv[2][2];
        const int bidx = (mode == 2) ? (col0 - PJ_Z) : 0;
#pragma unroll
        for (int bj = 0; bj < 2; ++bj)
#pragma unroll
            for (int n = 0; n < 2; ++n) { bv[bj][n] = *(const f32x4*)(b_alpha + bidx + bj * 128 + 4 * n); asm volatile("" :: "v"(bv[bj][n])); }
        if (mode == 2) {
#pragma unroll
            for (int ai = 0; ai < 2; ++ai)
#pragma unroll
                for (int bj = 0; bj < 2; ++bj) { f32x4 pr[4][2];
#pragma unroll
                    for (int n = 0; n < 2; ++n)
#pragma unroll
                        for (int j = 0; j < 4; ++j) { float carry = 0.f;
#pragma unroll
                            for (int m = 0; m < 4; ++m) { const float z = acc[ai][bj][m][n][j] + bv[bj][n][j]; const float la = (fminf(z, 0.f) - __logf(1.0f + __expf(-fabsf(z)))) * (1.0f / 16.0f);
                                pr[m][n][j] = row16_scan(la) + carry; carry += row16_sum(la); } }
#pragma unroll
                    for (int m = 0; m < 4; ++m) { float* bp = BC + (size_t)(row0 + ai * 128 + m * 16) * GKW + (col0 - PJ_Z) + bj * 128; *(f32x4*)bp = pr[m][0]; *(f32x4*)(bp + 4) = pr[m][1]; } }
            return;
        }
#pragma unroll
        for (int ai = 0; ai < 2; ++ai)
#pragma unroll
            for (int m = 0; m < 4; ++m) { bf16* rowp = PJ + (size_t)(row0 + ai * 128 + m * 16) * NPJ + col0;
#pragma unroll
                for (int bj = 0; bj < 2; ++bj) { f32x4 v[2] = {acc[ai][bj][m][0], acc[ai][bj][m][1]};
                    if (mode == 1) {
#pragma unroll
                        for (int n = 0; n < 2; ++n)
#pragma unroll
                            for (int j = 0; j < 4; ++j) v[n][j] = v[n][j] * fsigmoid(v[n][j]);
                    } else if (mode == 3) {
#pragma unroll
                        for (int n = 0; n < 2; ++n)
#pragma unroll
                            for (int j = 0; j < 4; ++j) v[n][j] = fsigmoid(v[n][j]);
                    }
                    *(v4u*)(rowp + bj * 128) = pack8(v[0], v[1]); } }
    }
};

struct EpiD {
    static constexpr bool PERM = true;
    bf16* TG; const bf16* PJ;
    __device__ __forceinline__ void operator()(const f32x4 (&acc)[2][2][4][2], const pg8::Unit& u, int wr, int wc, int fr, int fq) const {
        const int row0 = u.r0 + wr * 64 + fr, col0 = u.c0 + wc * 32 + 8 * fq;
#pragma unroll
        for (int ai = 0; ai < 2; ++ai)
#pragma unroll
            for (int m = 0; m < 4; ++m) { const size_t row = (size_t)(row0 + ai * 128 + m * 16);
#pragma unroll
                for (int bj = 0; bj < 2; ++bj) { const int c = col0 + bj * 128; const v4u gw = *(const v4u*)(PJ + row * NPJ + PJ_GG + c); f32x4 g0, g1; unpack8(gw, g0, g1);
                    *(v4u*)(TG + row * D + c) = pack8(acc[ai][bj][m][0] * g0, acc[ai][bj][m][1] * g1); } }
    }
};
struct EpiE {
    static constexpr bool PERM = true;
    bf16* MG; const bf16* TG; const bf16* PJ;
    __device__ __forceinline__ void operator()(const f32x4 (&acc)[2][2][4][2], const pg8::Unit& u, int wr, int wc, int fr, int fq) const {
        const int row0 = u.r0 + wr * 64 + fr, col0 = u.c0 + wc * 32 + 8 * fq;
#pragma unroll
        for (int ai = 0; ai < 2; ++ai)
#pragma unroll
            for (int m = 0; m < 4; ++m) { const size_t row = (size_t)(row0 + ai * 128 + m * 16);
#pragma unroll
                for (int bj = 0; bj < 2; ++bj) { const int c = col0 + bj * 128; const v4u gw = *(const v4u*)(PJ + row * NPJ + PJ_GP + c); const v4u tw = *(const v4u*)(TG + row * D + c);
                    f32x4 g0, g1, t0, t1; unpack8(gw, g0, g1); unpack8(tw, t0, t1);
                    *(v4u*)(MG + row * D + c) = pack8(t0 + acc[ai][bj][m][0] * g0, t1 + acc[ai][bj][m][1] * g1); } }
    }
};
struct EpiF {
    static constexpr bool PERM = true;
    const float* x; bf16* X1B; float* SSQ;
    __device__ __forceinline__ void operator()(const f32x4 (&acc)[2][2][4][2], const pg8::Unit& u, int wr, int wc, int fr, int fq) const {
        const int row0 = u.r0 + wr * 64 + fr, col0 = u.c0 + wc * 32 + 8 * fq;
#pragma unroll
        for (int ai = 0; ai < 2; ++ai)
#pragma unroll
            for (int m = 0; m < 4; ++m) { const size_t row = (size_t)(row0 + ai * 128 + m * 16); float ss = 0.f;
#pragma unroll
                for (int bj = 0; bj < 2; ++bj) { const int c = col0 + bj * 128; const f32x4 x0 = *(const f32x4*)(x + row * D + c), x1 = *(const f32x4*)(x + row * D + c + 4);
                    const f32x4 y0 = x0 + acc[ai][bj][m][0], y1 = x1 + acc[ai][bj][m][1];
                    *(v4u*)(X1B + row * D + c) = pack8(y0, y1);
                    ss += (y0[0] * y0[0] + y0[1] * y0[1]) + (y0[2] * y0[2] + y0[3] * y0[3]) + (y1[0] * y1[0] + y1[1] * y1[1]) + (y1[2] * y1[2] + y1[3] * y1[3]); }
                ss += __shfl_xor(ss, 16); ss += __shfl_xor(ss, 32);
                if (fq == 0) SSQ[row * 16 + (u.c0 >> 8) * 4 + wc] = ss; }
    }
};


struct MoeSched {
    const LAS int* cum; const LAS int* cnt; const unsigned* LIST;
    const char* Abase; const char* Bbase; int NT, G, c, mode;
    __device__ __forceinline__ bool next(int i, pg8::Unit& u) const {
        const int nunits = __builtin_amdgcn_readfirstlane(cum[NE]) * NT; const long L = (long)i * G + c; if (L >= nunits) return false;
        const int wgid = pg8::remap_xcd((int)L, nunits), gb = wgid / NT, pn = wgid % NT;
        int e_ = 0;
#pragma unroll 8
        for (int j = 1; j < NE; ++j) e_ += (cum[j] <= gb) ? 1 : 0;
        const int e = __builtin_amdgcn_readfirstlane(e_);
        const int blk = gb - __builtin_amdgcn_readfirstlane(cum[e]), rem = __builtin_amdgcn_readfirstlane(cnt[e]) - blk * 256;
        u.e = e; u.nvalid = rem < 256 ? rem : 256; u.lb = e * LCAP + blk * 256; u.r0 = gb * 256; u.pad = 0;
        if (mode == 0) { u.A = Abase; u.B = Bbase + ((size_t)e * 512 + (size_t)pn * 256) * D * 2; u.c0 = pn * 128; }
        else { u.A = Abase + (size_t)gb * 256 * DE * 2; u.B = Bbase + ((size_t)e * D + (size_t)pn * 256) * DE * 2; u.c0 = pn * 256; }
        return true;
    }
    __device__ __forceinline__ void fill_tab(const pg8::Unit& u, LAS unsigned* tab) const {
        const int t = threadIdx.x;
        if (t < 256) { const int lp = t < u.nvalid ? t : u.nvalid - 1; const unsigned slot = LIST[u.lb + lp]; tab[t] = (slot >> 1) * (unsigned)(D * 2); }
    }
};
struct EpiG {
    static constexpr bool PERM = false;
    float* LG;
    __device__ __forceinline__ void operator()(const f32x4 (&acc)[2][2][4][2], const pg8::Unit& u, int wr, int wc, int fr, int fq) const {
        if (wc >= 2) return;
        const int row0 = u.r0 + wr * 64 + fr;
#pragma unroll
        for (int ai = 0; ai < 2; ++ai)
#pragma unroll
            for (int m = 0; m < 4; ++m)
#pragma unroll
                for (int n = 0; n < 2; ++n) *(f32x4*)(LG + (size_t)(row0 + ai * 128 + m * 16) * 64 + 32 * wc + 16 * n + 4 * fq) = acc[ai][0][m][n];
    }
};
struct EpiH {
    static constexpr bool PERM = true;
    bf16* ACT; const float* LISTR;
    __device__ __forceinline__ void operator()(const f32x4 (&acc)[2][2][4][2], const pg8::Unit& u, int wr, int wc, int fr, int fq) const {
        float rs[2][4];
#pragma unroll
        for (int ai = 0; ai < 2; ++ai)
#pragma unroll
            for (int m = 0; m < 4; ++m) { const int rl = ai * 128 + wr * 64 + m * 16 + fr, lp = rl < u.nvalid ? rl : u.nvalid - 1; rs[ai][m] = LISTR[u.lb + lp]; }
#pragma unroll
        for (int ai = 0; ai < 2; ++ai)
#pragma unroll
            for (int m = 0; m < 4; ++m) { asm volatile("" :: "v"(rs[ai][m])); }
#pragma unroll
        for (int ai = 0; ai < 2; ++ai)
#pragma unroll
            for (int m = 0; m < 4; ++m) { const int rl = ai * 128 + wr * 64 + m * 16 + fr; const float r = rs[ai][m]; f32x4 a[2];
#pragma unroll
                for (int n = 0; n < 2; ++n)
#pragma unroll
                    for (int j = 0; j < 4; ++j) { const float g = acc[ai][0][m][n][j] * r, up = acc[ai][1][m][n][j] * r; a[n][j] = g * fsigmoid(g) * up; }
                *(v4u*)(ACT + (size_t)(u.r0 + rl) * DE + u.c0 + wc * 32 + 8 * fq) = pack8(a[0], a[1]); }
    }
};
struct EpiI {
    static constexpr bool PERM = true;
    bf16* Y; const unsigned* LIST; const float* LISTW;
    __device__ __forceinline__ void operator()(const f32x4 (&acc)[2][2][4][2], const pg8::Unit& u, int wr, int wc, int fr, int fq) const {
#pragma unroll
        for (int ai = 0; ai < 2; ++ai) {
            unsigned sl[4]; float gw[4];
#pragma unroll
            for (int m = 0; m < 4; ++m) { const int rl = ai * 128 + wr * 64 + m * 16 + fr, lp = rl < u.nvalid ? rl : u.nvalid - 1; sl[m] = LIST[u.lb + lp]; gw[m] = LISTW[u.lb + lp]; }
#pragma unroll
            for (int m = 0; m < 4; ++m) { asm volatile("" :: "v"(gw[m]), "v"(sl[m])); }
#pragma unroll
            for (int m = 0; m < 4; ++m) { const int rl = ai * 128 + wr * 64 + m * 16 + fr; const float g = gw[m];
                if (rl < u.nvalid) {
#pragma unroll
                    for (int bj = 0; bj < 2; ++bj) *(v4u*)(Y + (size_t)sl[m] * D + u.c0 + bj * 128 + wc * 32 + 8 * fq) = pack8(acc[ai][bj][m][0] * g, acc[ai][bj][m][1] * g); } }
        }
    }
};
__device__ __forceinline__ void route_rows(Frame& F, const int r0) {
    const float* LG = WSP(float, WS_LG); const float* SSQ = WSP(float, WS_SSQ); const float* brg = F.in[13]; const float* bre = F.in[15];
    unsigned* LIST = WSP(unsigned, WS_LIST); float* LISTW = WSP(float, WS_LISTW); float* LISTR = WSP(float, WS_LISTR);
    LAS unsigned* hcnt = (LAS unsigned*)(F.lds + SCHED_OFF); LAS unsigned* hbase = hcnt + 32;
    if (F.tid < 32) hcnt[F.tid] = 0u;
    __syncthreads();
    int e0 = 0, e1 = 0; unsigned p0 = 0, p1 = 0; float w0 = 0.f, w1 = 0.f, rstd = 0.f; const int row = r0 + F.tid;
    if (F.tid < 256) {
        float ss = 0.f;
#pragma unroll
        for (int j = 0; j < 16; ++j) ss += SSQ[(size_t)row * 16 + j];
        rstd = 1.0f / sqrtf(ss * (1.0f / D) + EPS);
        const float* lr = LG + (size_t)row * 64;
        float gl[4];
#pragma unroll
        for (int g = 0; g < 4; ++g) gl[g] = __hip_atomic_load(lr + g, RLX_AGENT) * rstd + brg[g];
        int gi = 0; float gm = gl[0];
#pragma unroll
        for (int g = 1; g < 4; ++g) if (gl[g] > gm) { gm = gl[g]; gi = g; }
        float den = 0.f;
#pragma unroll
        for (int g = 0; g < 4; ++g) den += expf(gl[g] - gm);
        const float gp = 1.0f / den;
        float el[8];
#pragma unroll
        for (int e = 0; e < 8; ++e) el[e] = __hip_atomic_load(lr + 4 + gi * 8 + e, RLX_AGENT) * rstd + bre[gi * 8 + e];
        int i0 = 0; float m0 = el[0];
#pragma unroll
        for (int e = 1; e < 8; ++e) if (el[e] > m0) { m0 = el[e]; i0 = e; }
        int i1 = -1; float m1 = 0.f;
#pragma unroll
        for (int e = 0; e < 8; ++e) if (e != i0 && (i1 < 0 || el[e] > m1)) { m1 = el[e]; i1 = e; }
        const float q = expf(m1 - m0); w0 = gp / (1.0f + q); w1 = gp * q / (1.0f + q);
        e0 = gi * 8 + i0; e1 = gi * 8 + i1;
        p0 = __hip_atomic_fetch_add(&hcnt[e0], 1u, __ATOMIC_RELAXED, __HIP_MEMORY_SCOPE_WORKGROUP); p1 = __hip_atomic_fetch_add(&hcnt[e1], 1u, __ATOMIC_RELAXED, __HIP_MEMORY_SCOPE_WORKGROUP);
    }
    __syncthreads();
    if (F.tid < 32) hbase[F.tid] = hcnt[F.tid] ? __hip_atomic_fetch_add((unsigned*)(F.ctl + CW_ECNT + 64 * F.tid), hcnt[F.tid], RLX_AGENT) : 0u;
    __syncthreads();
    if (F.tid < 256) { const size_t q0 = (size_t)e0 * LCAP + hbase[e0] + p0, q1 = (size_t)e1 * LCAP + hbase[e1] + p1;
        LIST[q0] = (unsigned)row * 2u; LIST[q1] = (unsigned)row * 2u + 1u; LISTW[q0] = w0; LISTW[q1] = w1; LISTR[q0] = rstd; LISTR[q1] = rstd; }
    __syncthreads();
}
__device__ __forceinline__ void moe_tables(Frame& F) {
    LAS int* cum = (LAS int*)(F.lds + SCHED_OFF + 256); LAS int* cnt = cum + 40;
    if (F.tid == 0) { int a = 0; for (int e = 0; e < NE; ++e) { const int c = (int)__hip_atomic_load((unsigned*)(F.ctl + CW_ECNT + 64 * e), RLX_AGENT); cnt[e] = c; cum[e] = a; a += (c + 255) >> 8; } cum[NE] = a; }
    __syncthreads();
}

template <class Src>
__device__ __forceinline__ void transpose_item(const Src& src, int k0, int n0, bf16* dst, int drow0, int dld, LAS float* scr, int lane) {
#pragma unroll 8
    for (int i = 0; i < 32; ++i) { const int kk = 2 * i + (lane >> 5); scr[kk * 33 + (lane & 31)] = src(k0 + kk, n0 + (lane & 31)); }
    LDS_WAIT(); asm volatile("" ::: "memory");
    const int c = lane & 7;
#pragma unroll
    for (int j = 0; j < 4; ++j) { const int n = (lane >> 3) + 8 * j; const LAS float* s = scr + (8 * c) * 33 + n;
        v4u o; o.x = pk2(s[0 * 33], s[1 * 33]); o.y = pk2(s[2 * 33], s[3 * 33]); o.z = pk2(s[4 * 33], s[5 * 33]); o.w = pk2(s[6 * 33], s[7 * 33]);
        *(GAS v4u*)(dst + (size_t)(drow0 + n) * dld + k0 + 8 * c) = o; }
    LDS_WAIT(); asm volatile("" ::: "memory");
}
struct SrcScaled { const float* W; int ld; const float* g;
    __device__ __forceinline__ float operator()(int k, int n) const { const float w = W[(size_t)k * ld + n]; return g ? w * g[k] : w; } };

__device__ __forceinline__ void p0_prologue(Frame& F) {
    const float* x = F.in[0]; const float* g1 = F.in[1]; const float* w_in = F.in[2]; const float* wau = F.in[3];
    const float* gng = F.in[5]; const float* wgb = F.in[6]; const float* pw = F.in[7]; const float* ps = F.in[8]; const float* wpb = F.in[9];
    const float* wout = F.in[10]; const float* g2 = F.in[11]; const float* wrg = F.in[12]; const float* wre = F.in[14];
    const float* weg = F.in[16]; const float* weu = F.in[17]; const float* wed = F.in[18];
    bf16* WIN = WSP(bf16, WS_WIN); bf16* WG = WSP(bf16, WS_WG); bf16* WP = WSP(bf16, WS_WP); bf16* WOUT = WSP(bf16, WS_WOUT); bf16* WR = WSP(bf16, WS_WR);
    bf16* WGU = WSP(bf16, WS_WGU); bf16* WD = WSP(bf16, WS_WD); bf16* HB = WSP(bf16, WS_HB);
    {
        LAS float* PWL = (LAS float*)F.lds;
        LAS float* WL = (LAS float*)(F.lds + 65536);
        for (int it = F.bid; it < 64; it += F.G) {
            const int g = it >> 4, nb = it & 15;
            for (int i = F.tid; i < 128 * 128; i += 512) { const int d = i & 127; PWL[i] = pw[(size_t)g * 16384 + i] * ps[g * 128 + d]; }
            for (int i = F.tid; i < 128 * 64; i += 512) { const int d = i >> 6, n = i & 63; WL[i] = wpb[(size_t)(g * 128 + d) * D + nb * 64 + n]; }
            __syncthreads();
            const int n = F.tid & 63, cg = F.tid >> 6;
            float a[16];
#pragma unroll
            for (int ci = 0; ci < 16; ++ci) a[ci] = 0.f;
            for (int d = 0; d < 128; d += 4) {
                const float w0 = WL[(d + 0) * 64 + n], w1 = WL[(d + 1) * 64 + n], w2 = WL[(d + 2) * 64 + n], w3 = WL[(d + 3) * 64 + n];
#pragma unroll
                for (int ci = 0; ci < 16; ++ci) { const f32x4 p = *(const LAS f32x4*)(PWL + (cg * 16 + ci) * 128 + d); a[ci] += p[0] * w0 + p[1] * w1 + p[2] * w2 + p[3] * w3; }
            }
            v4u o0, o1; o0.x = pk2(a[0], a[1]); o0.y = pk2(a[2], a[3]); o0.z = pk2(a[4], a[5]); o0.w = pk2(a[6], a[7]); o1.x = pk2(a[8], a[9]); o1.y = pk2(a[10], a[11]); o1.z = pk2(a[12], a[13]); o1.w = pk2(a[14], a[15]);
            bf16* dp = WP + (size_t)(nb * 64 + n) * PW + g * 128 + cg * 16;
            *(GAS v4u*)dp = o0; *(GAS v4u*)(dp + 8) = o1;
            __syncthreads();
        }
    }
    LAS float* scr = (LAS float*)(F.lds + F.wave * 16384);
    const int gw = F.bid * 8 + F.wave, NGW = F.G * 8;
    constexpr int I_IN1 = 16 * (1536 / 32), I_IN2 = 16 * (2560 / 32), I_Z = 4 * 64, I_WG = 8 * 32, I_WO = 16 * 32, I_WR = 256;
    constexpr int NITEMS = I_IN1 + I_IN2 + I_Z + I_WG + I_WO + I_WR;
    for (int it = gw; it < NITEMS; it += NGW) {
        int r = it;
        if (r < I_IN1) { const int kb = r / 48, nb = r % 48; SrcScaled s{w_in, D_IN, g1}; transpose_item(s, 64 * kb, 32 * nb, WIN, 32 * nb, D, scr, F.lane); continue; } r -= I_IN1;
        if (r < I_IN2) { const int kb = r / 80, nb = r % 80; SrcScaled s{w_in, D_IN, g1}; transpose_item(s, 64 * kb, IN_U + 32 * nb, WIN, PJ_U + 32 * nb, D, scr, F.lane); continue; } r -= I_IN2;
        if (r < I_Z) {
            const int nb = r & 3, kb = r >> 2, n = nb * 64 + F.lane;
            float wa[16];
#pragma unroll
            for (int j = 0; j < 16; ++j) wa[j] = wau[j * GKW + n];
            float o[16];
#pragma unroll
            for (int kk = 0; kk < 16; ++kk) { const int k = kb * 16 + kk; const float* wr_ = w_in + (size_t)k * D_IN + IN_A; float a = 0.f;
#pragma unroll
                for (int j = 0; j < 16; ++j) a += wr_[j] * wa[j];
                o[kk] = a * g1[k]; }
            v4u o0, o1; o0.x = pk2(o[0], o[1]); o0.y = pk2(o[2], o[3]); o0.z = pk2(o[4], o[5]); o0.w = pk2(o[6], o[7]); o1.x = pk2(o[8], o[9]); o1.y = pk2(o[10], o[11]); o1.z = pk2(o[12], o[13]); o1.w = pk2(o[14], o[15]);
            bf16* dp = WIN + (size_t)(PJ_Z + n) * D + kb * 16; *(GAS v4u*)dp = o0; *(GAS v4u*)(dp + 8) = o1; continue; } r -= I_Z;
        if (r < I_WG) { const int kb = r / 32, nb = r % 32; SrcScaled s{wgb, D, gng}; transpose_item(s, 64 * kb, 32 * nb, WG, 32 * nb, GVW, scr, F.lane); continue; } r -= I_WG;
        if (r < I_WO) { const int kb = r / 32, nb = r % 32; SrcScaled s{wout, D, nullptr}; transpose_item(s, 64 * kb, 32 * nb, WOUT, 32 * nb, D, scr, F.lane); continue; } r -= I_WO;
        if (r < I_WR) {
            const int j = r; bf16* dp = WR + (size_t)j * D;
#pragma unroll
            for (int q = 0; q < 16; ++q) { const int k = q * 64 + F.lane; float v = 0.f;
                if (j < NG) v = wrg[(size_t)k * NG + j] * g2[k]; else if (j < NG + NE) { const int g = (j - NG) >> 3, e = (j - NG) & 7; v = wre[((size_t)g * D + k) * EPG + e] * g2[k]; }
                dp[k] = (bf16)f2bf(v); }
            continue; }
    }
    for (int m = gw; m < T / 2; m += NGW) {
        const GAS f32x4* xa = (const GAS f32x4*)(x + (size_t)m * D) + F.lane; const GAS f32x4* xb = (const GAS f32x4*)(x + (size_t)(m + T / 2) * D) + F.lane;
        f32x4 va[4], vb[4]; float sa = 0.f, sb = 0.f;
#pragma unroll
        for (int j = 0; j < 4; ++j) { va[j] = __builtin_nontemporal_load(xa + 64 * j); vb[j] = __builtin_nontemporal_load(xb + 64 * j); }
#pragma unroll
        for (int j = 0; j < 4; ++j) { sa += (va[j].x * va[j].x + va[j].y * va[j].y) + (va[j].z * va[j].z + va[j].w * va[j].w); sb += (vb[j].x * vb[j].x + vb[j].y * vb[j].y) + (vb[j].z * vb[j].z + vb[j].w * vb[j].w); }
        const float ra = 1.0f / sqrtf(wave_sum(sa) * (1.f / D) + EPS), rb = 1.0f / sqrtf(wave_sum(sb) * (1.f / D) + EPS);
        GAS v2u* oa = (GAS v2u*)(HB + (size_t)m * D) + F.lane; GAS v2u* ob = (GAS v2u*)(HB + (size_t)(m + T / 2) * D) + F.lane;
#pragma unroll
        for (int j = 0; j < 4; ++j) { v2u w; w.x = pk2(va[j].x * ra, va[j].y * ra); w.y = pk2(va[j].z * ra, va[j].w * ra); oa[64 * j] = w; w.x = pk2(vb[j].x * rb, vb[j].y * rb); w.y = pk2(vb[j].z * rb, vb[j].w * rb); ob[64 * j] = w; }
    }
}

__device__ __forceinline__ void moe_weight_items(Frame& F, const int widx, const int nworkers) {
    const float* g2 = F.in[11]; const float* weg = F.in[16]; const float* weu = F.in[17]; const float* wed = F.in[18];
    bf16* WGU = WSP(bf16, WS_WGU); bf16* WD = WSP(bf16, WS_WD);
    LAS float* scr = (LAS float*)(F.lds + F.wave * 16384);
    const int gw = widx * 8 + F.wave, NGW = nworkers * 8;
    constexpr int I_GU = NE * 2 * 16 * 8, I_WD = NE * 4 * 32;
    for (int it = gw; it < I_GU + I_WD; it += NGW) {
        int r = it;
        if (r < I_GU) {
            const int e = r / 256, q = r % 256, bj = q / 128, kb = (q % 128) / 8, nb = q % 8;
            SrcScaled sc{(bj ? weu : weg) + (size_t)e * D * DE, DE, g2};
            const int hid0 = 32 * nb, pn = hid0 >> 7, i0 = hid0 & 127;
            transpose_item(sc, 64 * kb, hid0, WGU + (size_t)e * 512 * D, pn * 256 + bj * 128 + i0, D, scr, F.lane); continue; } r -= I_GU;
        { const int e = r / 128, q = r % 128, kb = q / 32, nb = q % 32;
            SrcScaled sc{wed + (size_t)e * DE * D, D, nullptr}; transpose_item(sc, 64 * kb, 32 * nb, WD + (size_t)e * D * DE, 32 * nb, DE, scr, F.lane); }
    }
}

#define WG_SYNC() do { asm volatile("s_waitcnt lgkmcnt(0)" ::: "memory"); __builtin_amdgcn_s_barrier(); asm volatile("" ::: "memory"); } while (0)
constexpr int GL_QD = 0, GL_KD = 9216, GL_KET = 18432, GL_P = 27648, GL_VT = 36864, GL_DEC = 55296, GL_SS = 55552, GL_OT = 57600;
constexpr int GLS = 72, OTS = 132;
__device__ __forceinline__ void gla_unit(Frame& F, const int b, const int h, const int seg) {
    const bf16* PJ = WSP(bf16, WS_PJ); const float* BC = WSP(float, WS_BC); bf16* ON = WSP(bf16, WS_ON);
    int tid_ = threadIdx.x; asm volatile("" : "+v"(tid_));
    const int tid = tid_, lane = tid & 63, w = __builtin_amdgcn_readfirstlane(tid >> 6), fr = lane & 15, fq = lane >> 4;
    LAS bf16* QD = (LAS bf16*)(F.lds + GL_QD); LAS bf16* KD = (LAS bf16*)(F.lds + GL_KD); LAS bf16* KET = (LAS bf16*)(F.lds + GL_KET);
    LAS bf16* P = (LAS bf16*)(F.lds + GL_P); LAS bf16* VT = (LAS bf16*)(F.lds + GL_VT);
    LAS float* DEC = (LAS float*)(F.lds + GL_DEC); LAS float* SS = (LAS float*)(F.lds + GL_SS); LAS float* OT = (LAS float*)(F.lds + GL_OT);
    f32x4 Sacc[4];
#pragma unroll
    for (int i = 0; i < 4; ++i) Sacc[i] = (f32x4){0.f, 0.f, 0.f, 0.f};
    const size_t rowbase = (size_t)b * SEQ + (size_t)seg * SEGCH * GCH;
    float* CUMB = WSP(float, WS_CUMB) + ((size_t)(b * GH + h) * (SEQ / GCH) + seg * SEGCH) * GDK; float cumb[8];
#pragma unroll
    for (int j = 0; j < 8; ++j) cumb[j] = 0.f;
    const int vsl = lane & 31, vbk = 2 * w + (lane >> 5);
    const int ot = tid >> 3, ov = (tid & 7) * 16;
    v4u qq, kq, vq0, vq1, rq0, rq1; f32x4 bq0, bq1;
#define GLA_LOADS(tb_) do { const size_t tb__ = (tb_); \
        const bf16* rp = PJ + (tb__ + lane) * NPJ + h * 64 + w * 8; qq = *(const v4u*)(rp + PJ_Q); kq = *(const v4u*)(rp + PJ_K); \
        const float* bp = BC + (tb__ + lane) * GKW + h * 64 + w * 8; bq0 = *(const f32x4*)bp; bq1 = *(const f32x4*)(bp + 4); \
        const bf16* vp = PJ + (tb__ + vsl) * NPJ + PJ_V + h * 128 + vbk * 8; vq0 = *(const v4u*)vp; vq1 = *(const v4u*)(vp + (size_t)32 * NPJ); \
        const bf16* rr = PJ + (tb__ + ot) * NPJ + PJ_R + h * 128 + ov; rq0 = *(const v4u*)rr; rq1 = *(const v4u*)(rr + 8); } while (0)
    GLA_LOADS(rowbase);
    for (int n = 0; n < SEGCH; ++n) {
        const size_t tb = rowbase + (size_t)n * GCH;
        const v4u q8 = qq, k8 = kq, v80 = vq0, v81 = vq1, r80 = rq0, r81 = rq1; const f32x4 b80 = bq0, b81 = bq1;
        if (n + 1 < SEGCH) GLA_LOADS(tb + GCH);
        { float bx[8] = {b80[0], b80[1], b80[2], b80[3], b81[0], b81[1], b81[2], b81[3]}, qf[8], kf[8];
          { f32x4 a, c; unpack8(q8, a, c); qf[0] = a[0]; qf[1] = a[1]; qf[2] = a[2]; qf[3] = a[3]; qf[4] = c[0]; qf[5] = c[1]; qf[6] = c[2]; qf[7] = c[3];
            unpack8(k8, a, c); kf[0] = a[0]; kf[1] = a[1]; kf[2] = a[2]; kf[3] = a[3]; kf[4] = c[0]; kf[5] = c[1]; kf[6] = c[2]; kf[7] = c[3]; }
          float qd[8], kd[8], ke[8], dc[8];
          if (lane == 0) { *(f32x4*)(CUMB + (size_t)n * GDK + w * 8) = (f32x4){cumb[0], cumb[1], cumb[2], cumb[3]}; *(f32x4*)(CUMB + (size_t)n * GDK + w * 8 + 4) = (f32x4){cumb[4], cumb[5], cumb[6], cumb[7]}; }
#pragma unroll
          for (int j = 0; j < 8; ++j) { const float blast = __builtin_bit_cast(float, __builtin_amdgcn_readlane(__builtin_bit_cast(int, bx[j]), 63));
              cumb[j] += blast;
              const float eb = __expf(bx[j]), enb = __builtin_amdgcn_rcpf(eb); dc[j] = __expf(blast);
              qd[j] = qf[j] * eb * 0.125f; kd[j] = kf[j] * enb; ke[j] = kd[j] * dc[j]; }
          v4u o; o.x = pk2(qd[0], qd[1]); o.y = pk2(qd[2], qd[3]); o.z = pk2(qd[4], qd[5]); o.w = pk2(qd[6], qd[7]); *(LAS v4u*)(QD + lane * GLS + w * 8) = o;
          o.x = pk2(kd[0], kd[1]); o.y = pk2(kd[2], kd[3]); o.z = pk2(kd[4], kd[5]); o.w = pk2(kd[6], kd[7]); *(LAS v4u*)(KD + lane * GLS + w * 8) = o;
#pragma unroll
          for (int j = 0; j < 8; ++j) KET[(w * 8 + j) * GLS + lane] = (bf16)(pk2(ke[j], ke[j]) & 0xffffu);
          if (lane == 0) { *(LAS f32x4*)(DEC + w * 8) = (f32x4){dc[0], dc[1], dc[2], dc[3]}; *(LAS f32x4*)(DEC + w * 8 + 4) = (f32x4){dc[4], dc[5], dc[6], dc[7]}; }
          const unsigned vw0[4] = {v80.x, v80.y, v80.z, v80.w}, vw1[4] = {v81.x, v81.y, v81.z, v81.w};
#pragma unroll
          for (int j = 0; j < 4; ++j) { VT[(vbk * 8 + 2 * j) * GLS + vsl] = (bf16)(vw0[j] & 0xffffu); VT[(vbk * 8 + 2 * j + 1) * GLS + vsl] = (bf16)(vw0[j] >> 16);
              VT[(vbk * 8 + 2 * j) * GLS + vsl + 32] = (bf16)(vw1[j] & 0xffffu); VT[(vbk * 8 + 2 * j + 1) * GLS + vsl + 32] = (bf16)(vw1[j] >> 16); } }
        WG_SYNC();
        { const int tt = w >> 1, st0 = (w & 1) * 2;
          bf16x8 af[2];
#pragma unroll
          for (int ks = 0; ks < 2; ++ks) af[ks] = *(const LAS bf16x8*)(QD + (16 * tt + fr) * GLS + 32 * ks + 8 * fq);
#pragma unroll
          for (int q2 = 0; q2 < 2; ++q2) { const int st = st0 + q2; f32x4 c = (f32x4){0.f, 0.f, 0.f, 0.f};
              if (st <= tt) {
#pragma unroll
                  for (int ks = 0; ks < 2; ++ks) { const bf16x8 bfm = *(const LAS bf16x8*)(KD + (16 * st + fr) * GLS + 32 * ks + 8 * fq); c = __builtin_amdgcn_mfma_f32_16x16x32_bf16(af[ks], bfm, c, 0, 0, 0); } }
#pragma unroll
              for (int i = 0; i < 4; ++i) { const int t = 16 * tt + 4 * fq + i, sidx = 16 * st + fr; const float val = (sidx <= t) ? c[i] : 0.f; P[t * GLS + sidx] = (bf16)(pk2(val, val) & 0xffffu); } } }
        WG_SYNC();
        { bf16x8 vtf[2], sb[2];
#pragma unroll
          for (int ks = 0; ks < 2; ++ks) { vtf[ks] = *(const LAS bf16x8*)(VT + (16 * w + fr) * GLS + 32 * ks + 8 * fq);
              v4u pw_; pw_.x = pk2(Sacc[2 * ks][0], Sacc[2 * ks][1]); pw_.y = pk2(Sacc[2 * ks][2], Sacc[2 * ks][3]); pw_.z = pk2(Sacc[2 * ks + 1][0], Sacc[2 * ks + 1][1]); pw_.w = pk2(Sacc[2 * ks + 1][2], Sacc[2 * ks + 1][3]);
              sb[ks] = __builtin_bit_cast(bf16x8, pw_); }
          f32x4 o[4];
#pragma unroll
          for (int mt = 0; mt < 4; ++mt) { o[mt] = (f32x4){0.f, 0.f, 0.f, 0.f};
#pragma unroll
              for (int ks = 0; ks < 2; ++ks) { const bf16x8 a = *(const LAS bf16x8*)(P + (16 * mt + fr) * GLS + 32 * ks + 8 * fq); o[mt] = __builtin_amdgcn_mfma_f32_16x16x32_bf16(a, vtf[ks], o[mt], 0, 0, 0); }
#pragma unroll
              for (int ks = 0; ks < 2; ++ks) { const v2u lo = *(const LAS v2u*)(QD + (16 * mt + fr) * GLS + 32 * ks + 4 * fq), hi = *(const LAS v2u*)(QD + (16 * mt + fr) * GLS + 32 * ks + 16 + 4 * fq);
                  v4u aw; aw.x = lo.x; aw.y = lo.y; aw.z = hi.x; aw.w = hi.y; o[mt] = __builtin_amdgcn_mfma_f32_16x16x32_bf16(__builtin_bit_cast(bf16x8, aw), sb[ks], o[mt], 0, 0, 0); } }
#pragma unroll
          for (int mt = 0; mt < 4; ++mt) { const f32x4 d4 = *(const LAS f32x4*)(DEC + 16 * mt + 4 * fq); Sacc[mt] = Sacc[mt] * d4;
#pragma unroll
              for (int ks = 0; ks < 2; ++ks) { const bf16x8 a = *(const LAS bf16x8*)(KET + (16 * mt + fr) * GLS + 32 * ks + 8 * fq); Sacc[mt] = __builtin_amdgcn_mfma_f32_16x16x32_bf16(a, vtf[ks], Sacc[mt], 0, 0, 0); } }
#pragma unroll
          for (int mt = 0; mt < 4; ++mt)
#pragma unroll
              for (int i = 0; i < 4; ++i) { const int t = 16 * mt + 4 * fq + i; OT[t * OTS + 16 * w + fr] = o[mt][i]; const float sq = row16_sum(o[mt][i] * o[mt][i]); if (fr == 0) SS[t * 8 + w] = sq; } }
        WG_SYNC();
        { const f32x4 s0 = *(const LAS f32x4*)(SS + ot * 8), s1 = *(const LAS f32x4*)(SS + ot * 8 + 4);
          const float tot2 = ((s0[0] + s0[1]) + (s0[2] + s0[3])) + ((s1[0] + s1[1]) + (s1[2] + s1[3]));
          const float rstd = (seg == 0) ? __builtin_amdgcn_rsqf(tot2 * (1.0f / GDV) + EPS) : 1.0f;
          f32x4 ov4[4];
#pragma unroll
          for (int q = 0; q < 4; ++q) ov4[q] = *(const LAS f32x4*)(OT + ot * OTS + ov + 4 * q);
          f32x4 r0, r1, r2, r3; unpack8(r80, r0, r1); unpack8(r81, r2, r3);
          if (seg != 0) { r0 = (f32x4){1.f, 1.f, 1.f, 1.f}; r1 = r0; r2 = r0; r3 = r0; }
          bf16* op = ON + (tb + ot) * GVW + h * 128 + ov;
          *(v4u*)op = pack8(ov4[0] * rstd * r0, ov4[1] * rstd * r1); *(v4u*)(op + 8) = pack8(ov4[2] * rstd * r2, ov4[3] * rstd * r3); }
    }
#undef GLA_LOADS
    if (seg + 1 < NSEG) {
        float* SL = WSP(float, WS_SLOC) + ((size_t)(b * GH + h) * NSEG + seg) * GDK * GDV;
#pragma unroll
        for (int mt = 0; mt < 4; ++mt)
#pragma unroll
            for (int i = 0; i < 4; ++i) SL[(16 * mt + 4 * fq + i) * GDV + 16 * w + fr] = Sacc[mt][i];
        if (lane == 0) { float* DT = WSP(float, WS_DTOT) + ((size_t)(b * GH + h) * NSEG + seg) * GDK + w * 8;
#pragma unroll
            for (int j = 0; j < 8; ++j) DT[j] = __expf(cumb[j]); }
    }
    WG_SYNC();
}
constexpr int FX_QD = 0, FX_SB = 9216, FX_OT = 27648;
__device__ __forceinline__ void gla_fix_unit(Frame& F, const int b, const int h, const int seg) {
    const bf16* PJ = WSP(bf16, WS_PJ); const float* BC = WSP(float, WS_BC); bf16* ON = WSP(bf16, WS_ON);
    int tid_ = threadIdx.x; asm volatile("" : "+v"(tid_));
    const int tid = tid_, lane = tid & 63, w = __builtin_amdgcn_readfirstlane(tid >> 6), fr = lane & 15, fq = lane >> 4;
    LAS bf16* QD2 = (LAS bf16*)(F.lds + FX_QD); LAS bf16* SB = (LAS bf16*)(F.lds + FX_SB); LAS float* OT = (LAS float*)(F.lds + FX_OT);
    { const float* SL = WSP(float, WS_SLOC) + (size_t)(b * GH + h) * NSEG * GDK * GDV; const float* DT = WSP(float, WS_DTOT) + (size_t)(b * GH + h) * NSEG * GDK;
#pragma unroll
      for (int j = 0; j < 8; ++j) { const int d = 8 * w + j; float s0 = 0.f, s1 = 0.f;
          for (int i = 0; i < seg; ++i) { const float dt = DT[i * GDK + d]; s0 = dt * s0 + SL[((size_t)i * GDK + d) * GDV + lane]; s1 = dt * s1 + SL[((size_t)i * GDK + d) * GDV + lane + 64]; }
          SB[lane * GLS + d] = (bf16)(pk2(s0, s0) & 0xffffu); SB[(lane + 64) * GLS + d] = (bf16)(pk2(s1, s1) & 0xffffu); } }
    const size_t rowbase = (size_t)b * SEQ + (size_t)seg * SEGCH * GCH;
    const float* CUMB = WSP(float, WS_CUMB) + ((size_t)(b * GH + h) * (SEQ / GCH) + seg * SEGCH) * GDK;
    const int ot = tid >> 3, ov = (tid & 7) * 16, dq = (tid & 7) * 8;
    v4u qq, oq0, oq1, rq0, rq1; f32x4 bq0, bq1, cq0, cq1;
#define FIX_LOADS(n_) do { const size_t tb__ = rowbase + (size_t)(n_) * GCH;         qq = *(const v4u*)(PJ + (tb__ + ot) * NPJ + PJ_Q + h * 64 + dq); const float* bp = BC + (tb__ + ot) * GKW + h * 64 + dq; bq0 = *(const f32x4*)bp; bq1 = *(const f32x4*)(bp + 4);         const float* cp = CUMB + (size_t)(n_) * GDK + dq; cq0 = *(const f32x4*)cp; cq1 = *(const f32x4*)(cp + 4);         const bf16* op_ = ON + (tb__ + ot) * GVW + h * 128 + ov; oq0 = *(const v4u*)op_; oq1 = *(const v4u*)(op_ + 8);         const bf16* rr = PJ + (tb__ + ot) * NPJ + PJ_R + h * 128 + ov; rq0 = *(const v4u*)rr; rq1 = *(const v4u*)(rr + 8); } while (0)
    FIX_LOADS(0);
    for (int n = 0; n < SEGCH; ++n) {
        const size_t tb = rowbase + (size_t)n * GCH;
        const v4u q8 = qq, o80 = oq0, o81 = oq1, r80 = rq0, r81 = rq1; const f32x4 b80 = bq0, b81 = bq1, c80 = cq0, c81 = cq1;
        if (n + 1 < SEGCH) FIX_LOADS(n + 1);
        { f32x4 qa, qb; unpack8(q8, qa, qb); f32x4 e0, e1;
#pragma unroll
          for (int j = 0; j < 4; ++j) { e0[j] = qa[j] * 0.125f * __expf(b80[j] + c80[j]); e1[j] = qb[j] * 0.125f * __expf(b81[j] + c81[j]); }
          *(LAS v4u*)(QD2 + ot * GLS + dq) = pack8(e0, e1); }
        WG_SYNC();
        { bf16x8 bfm[2];
#pragma unroll
          for (int ks = 0; ks < 2; ++ks) bfm[ks] = *(const LAS bf16x8*)(SB + (16 * w + fr) * GLS + 32 * ks + 8 * fq);
#pragma unroll
          for (int mt = 0; mt < 4; ++mt) { f32x4 c = (f32x4){0.f, 0.f, 0.f, 0.f};
#pragma unroll
              for (int ks = 0; ks < 2; ++ks) { const bf16x8 a = *(const LAS bf16x8*)(QD2 + (16 * mt + fr) * GLS + 32 * ks + 8 * fq); c = __builtin_amdgcn_mfma_f32_16x16x32_bf16(a, bfm[ks], c, 0, 0, 0); }
#pragma unroll
              for (int i = 0; i < 4; ++i) OT[(16 * mt + 4 * fq + i) * OTS + 16 * w + fr] = c[i]; } }
        WG_SYNC();
        { f32x4 t4[4], l0, l1, l2, l3; unpack8(o80, l0, l1); unpack8(o81, l2, l3);
          t4[0] = *(const LAS f32x4*)(OT + ot * OTS + ov) + l0; t4[1] = *(const LAS f32x4*)(OT + ot * OTS + ov + 4) + l1; t4[2] = *(const LAS f32x4*)(OT + ot * OTS + ov + 8) + l2; t4[3] = *(const LAS f32x4*)(OT + ot * OTS + ov + 12) + l3;
          float sq = 0.f;
#pragma unroll
          for (int q = 0; q < 4; ++q) sq += (t4[q][0] * t4[q][0] + t4[q][1] * t4[q][1]) + (t4[q][2] * t4[q][2] + t4[q][3] * t4[q][3]);
          sq += dpp_f<0xB1>(sq); sq += dpp_f<0x4E>(sq); sq += dpp_f<0x141>(sq);
          const float rstd = __builtin_amdgcn_rsqf(sq * (1.0f / GDV) + EPS);
          f32x4 r0, r1, r2, r3; unpack8(r80, r0, r1); unpack8(r81, r2, r3);
          bf16* op = ON + (tb + ot) * GVW + h * 128 + ov;
          *(v4u*)op = pack8(t4[0] * rstd * r0, t4[1] * rstd * r1); *(v4u*)(op + 8) = pack8(t4[2] * rstd * r2, t4[3] * rstd * r3); }
    }
#undef FIX_LOADS
    WG_SYNC();
}
template <int WLEN>
__device__ __forceinline__ void pool_unit(const bf16* PJ, bf16* PD, const int g, const int t0, const int lane) {
    const int t = t0 + (lane >> 4), cb = g * 16 + (lane & 15), pos = t & (SEQ - 1), cnt = (pos + 1 < WLEN) ? pos + 1 : WLEN;
    v4u vw[WLEN];
#pragma unroll
    for (int i = 0; i < WLEN; ++i) { const int back = i < cnt ? i : 0; vw[i] = *(const v4u*)(PJ + (size_t)(t - back) * NPJ + PJ_U + cb * 8); }
    f32x4 a0 = (f32x4){0.f, 0.f, 0.f, 0.f}, a1 = a0, o0, o1;
    unpack8(vw[0], o0, o1);
#pragma unroll
    for (int i = 0; i < WLEN; ++i) { f32x4 u0, u1; unpack8(vw[i], u0, u1); const float m = i < cnt ? 1.f : 0.f; a0 += u0 * m; a1 += u1 * m; }
    const float inv = 1.0f / (float)cnt;
    *(v4u*)(PD + (size_t)t * PW + cb * 8) = pack8(a0 * inv - o0, a1 * inv - o1);
}
__device__ __forceinline__ void pool_items(Frame& F, const int widx, const int nworkers) {
    const bf16* PJ = WSP(bf16, WS_PJ); bf16* PD = WSP(bf16, WS_PD);
    const int gw = widx * 8 + F.wave, NGW = nworkers * 8;
    for (int u = gw; u < T; u += NGW) {
        const int g = u & 3, t0 = (u >> 2) * 4;
        if (g == 0) pool_unit<2>(PJ, PD, 0, t0, F.lane); else if (g == 1) pool_unit<4>(PJ, PD, 1, t0, F.lane); else if (g == 2) pool_unit<8>(PJ, PD, 2, t0, F.lane); else pool_unit<16>(PJ, PD, 3, t0, F.lane);
    }
}
__device__ __forceinline__ void p2a_phase(Frame& F) {
    constexpr int NU = BATCH * GH * NSEG;
    for (int u = F.bid; u < NU; u += F.G) gla_unit(F, u >> 4, (u >> 2) & 3, u & 3);
}
__device__ __forceinline__ void p2b_phase(Frame& F) {
    constexpr int NU = BATCH * GH * (NSEG - 1);
#pragma unroll 1
    for (int r_ = 0; r_ < REPS(10); ++r_)
    for (int u = F.bid; u < NU; u += F.G) gla_fix_unit(F, u / (GH * (NSEG - 1)), (u / (NSEG - 1)) % GH, 1 + u % (NSEG - 1));
#pragma unroll 1
    for (int r_ = 0; r_ < REPS(11); ++r_) pool_items(F, F.bid, F.G);
#pragma unroll 1
    for (int r_ = 0; r_ < REPS(12); ++r_) moe_weight_items(F, F.bid, F.G);
}

#if DBG
__device__ __forceinline__ void dbg_fail(Frame& F, unsigned code) { unsigned expect = 0u; __hip_atomic_compare_exchange_strong((unsigned*)(F.ctl + CW_DBG), &expect, code, __ATOMIC_RELAXED, __ATOMIC_RELAXED, __HIP_MEMORY_SCOPE_AGENT); }
__device__ __forceinline__ bool dbg_close(float got, float want) { return fabsf(got - want) <= 0.03f + 0.03f * fabsf(want); }
__device__ __forceinline__ void dbg_check_p1(Frame& F) {
    if (F.bid != 0 || F.tid >= 256) return;
    const float* x = F.in[0]; const float* g1 = F.in[1]; const float* w_in = F.in[2]; const float* wau = F.in[3]; const float* ba = F.in[4];
    const bf16* PJ = WSP(bf16, WS_PJ);
    const int tok = (int)(((unsigned)F.tid * 2654435761u) % (unsigned)T);
    const int col = (int)(((unsigned)F.tid * 40503u + 17u * (unsigned)F.tid * (unsigned)F.tid) % (unsigned)NPJ);
    const float* xr = x + (size_t)tok * D; float ss = 0.f;
    for (int k = 0; k < D; ++k) ss += xr[k] * xr[k];
    const float rstd = 1.0f / sqrtf(ss / D + EPS);
    float want;
    if (col >= PJ_Z && col < PJ_U) {
        return;
        float al[16];
#pragma unroll
        for (int j = 0; j < 16; ++j) al[j] = 0.f;
        for (int k = 0; k < D; ++k) { const float hk = xr[k] * rstd * g1[k];
#pragma unroll
            for (int j = 0; j < 16; ++j) al[j] += hk * w_in[(size_t)k * D_IN + IN_A + j]; }
        float z = 0.f;
#pragma unroll
        for (int j = 0; j < 16; ++j) z += al[j] * wau[j * GKW + (col - PJ_Z)];
        z += ba[col - PJ_Z];
        want = (fminf(z, 0.f) - logf(1.0f + expf(-fabsf(z)))) / 16.0f;
    } else {
        const int wc_ = col < PJ_Z ? col : col - PJ_U + IN_U; float a = 0.f;
        for (int k = 0; k < D; ++k) a += xr[k] * rstd * g1[k] * w_in[(size_t)k * D_IN + wc_];
        if (col >= PJ_R && col < PJ_Z) want = a / (1.0f + expf(-a)); else if (col >= PJ_GG) want = 1.0f / (1.0f + expf(-a)); else want = a;
    }
    const float got = bf1(PJ[(size_t)tok * NPJ + col]);
    if (!dbg_close(got, want)) dbg_fail(F, 1u);
}


__device__ __forceinline__ void dbg_check_bc(Frame& F) {
    if (F.bid != 5 || F.tid >= 64) return;
    const float* x = F.in[0]; const float* g1 = F.in[1]; const float* w_in = F.in[2]; const float* wau = F.in[3]; const float* ba = F.in[4]; const float* BC = WSP(float, WS_BC);
    const int offs[5] = {0, 1, 5, 18, 63}; const int off = (F.tid % 5 == 0) ? 0 : (F.tid % 5 == 1) ? 1 : (F.tid % 5 == 2) ? 5 : (F.tid % 5 == 3) ? 18 : 63; (void)offs;
    const int chunk = (int)(((unsigned)F.tid * 2654435761u) % (unsigned)(T / 64)), col = (int)(((unsigned)F.tid * 40503u + 3u) % (unsigned)GKW);
    float cum = 0.f;
    for (int r = 0; r <= off; ++r) { const float* xr = x + ((size_t)chunk * 64 + r) * D; float ss = 0.f; for (int k = 0; k < D; ++k) ss += xr[k] * xr[k];
        const float rstd = 1.0f / sqrtf(ss / D + EPS); float al[16];
#pragma unroll
        for (int j = 0; j < 16; ++j) al[j] = 0.f;
        for (int k = 0; k < D; ++k) { const float hk = xr[k] * rstd * g1[k];
#pragma unroll
            for (int j = 0; j < 16; ++j) al[j] += hk * w_in[(size_t)k * D_IN + IN_A + j]; }
        float z = ba[col];
#pragma unroll
        for (int j = 0; j < 16; ++j) z += al[j] * wau[j * GKW + col];
        cum += (fminf(z, 0.f) - logf(1.0f + expf(-fabsf(z)))) / 16.0f; }
    const float got = BC[((size_t)chunk * 64 + off) * GKW + col];
    if (fabsf(got - cum) > 0.004f + 0.01f * fabsf(cum)) dbg_fail(F, 7u);
}
__device__ __forceinline__ void dbg_check_gla(Frame& F) {
    if (F.bid != 1) return;
    const bf16* PJ = WSP(bf16, WS_PJ); const bf16* ON = WSP(bf16, WS_ON);
    const int b = 2, h = 1, v = F.tid & 127; const bool act = F.tid < 128;
    LAS float* S = (LAS float*)F.lds;
    LAS float* red = (LAS float*)(F.lds + 32768);
    if (act) for (int d = 0; d < 64; ++d) S[d * 128 + v] = 0.f;
    __syncthreads();
    bool bad = false;
    for (int t = 0; t < 1100; ++t) {
        const bf16* rp = PJ + ((size_t)b * SEQ + t) * NPJ; float o = 0.f;
        if (act) { const float vv = bf1(rp[PJ_V + h * 128 + v]);
            for (int d = 0; d < 64; ++d) { const float* bcp = WSP(float, WS_BC) + ((size_t)b * SEQ + t) * GKW + h * 64 + d; const float la = (t & 63) ? bcp[0] - bcp[-GKW] : bcp[0]; const float kk = bf1(rp[PJ_K + h * 64 + d]), qq = bf1(rp[PJ_Q + h * 64 + d]);
                const float sn = expf(la) * S[d * 128 + v] + kk * vv; S[d * 128 + v] = sn; o += qq * 0.125f * sn; }
            red[v] = o * o; }
        __syncthreads();
        if (act) { float ss = 0.f; for (int i = 0; i < 128; ++i) ss += red[i];
            const float want = o * (1.0f / sqrtf(ss / 128.f + EPS)) * bf1(rp[PJ_R + h * 128 + v]);
            const float got = bf1(ON[((size_t)b * SEQ + t) * GVW + h * 128 + v]);
            if ((t < 150 || t >= 1000) && !dbg_close(got, want)) bad = true; }
        __syncthreads();
    }
    if (bad) dbg_fail(F, 2u);
}
__device__ __forceinline__ void dbg_check_pool(Frame& F) {
    if (F.bid != 2) return;
    const bf16* PJ = WSP(bf16, WS_PJ); const bf16* PD = WSP(bf16, WS_PD);
    int tok = (int)(((unsigned)F.tid * 2654435761u) % (unsigned)T); if (F.tid < 40) tok = (F.tid & 1) * SEQ * 3 + (F.tid >> 1);
    const int c = (int)(((unsigned)F.tid * 40503u) % (unsigned)PW), pos = tok & (SEQ - 1), wlen = 2 << (c >> 7), cnt = pos + 1 < wlen ? pos + 1 : wlen;
    float a = 0.f; for (int i = 0; i < cnt; ++i) a += bf1(PJ[(size_t)(tok - i) * NPJ + PJ_U + c]);
    const float want = a / cnt - bf1(PJ[(size_t)tok * NPJ + PJ_U + c]);
    if (!dbg_close(bf1(PD[(size_t)tok * PW + c]), want)) dbg_fail(F, 3u);
}
__device__ __forceinline__ void dbg_check_mg(Frame& F) {
    if (F.bid != 3 || F.tid >= 64) return;
    const bf16* PJ = WSP(bf16, WS_PJ); const bf16* ON = WSP(bf16, WS_ON); const bf16* PD = WSP(bf16, WS_PD); const bf16* MG = WSP(bf16, WS_MG);
    const float* gng = F.in[5]; const float* wgb = F.in[6]; const float* pw = F.in[7]; const float* ps = F.in[8]; const float* wpb = F.in[9];
    const int tok = (int)(((unsigned)F.tid * 2654435761u + 12345u) % (unsigned)T), col = (int)(((unsigned)F.tid * 40503u + 77u) % (unsigned)D);
    float yg = 0.f; for (int k = 0; k < GVW; ++k) yg += bf1(ON[(size_t)tok * GVW + k]) * gng[k] * wgb[(size_t)k * D + col];
    float yp = 0.f;
    for (int g = 0; g < 4; ++g) for (int d = 0; d < 128; ++d) { float m = 0.f; for (int c = 0; c < 128; ++c) m += bf1(PD[(size_t)tok * PW + g * 128 + c]) * pw[((size_t)g * 128 + c) * 128 + d];
        yp += m * ps[g * 128 + d] * wpb[(size_t)(g * 128 + d) * D + col]; }
    const float want = bf1(PJ[(size_t)tok * NPJ + PJ_GG + col]) * yg + bf1(PJ[(size_t)tok * NPJ + PJ_GP + col]) * yp;
    if (!dbg_close(bf1(MG[(size_t)tok * D + col]), want)) dbg_fail(F, 4u);
}
__device__ __forceinline__ void dbg_check_x1(Frame& F) {
    if (F.bid != 4 || F.tid >= 128) return;
    const bf16* MG = WSP(bf16, WS_MG); const bf16* X1B = WSP(bf16, WS_X1B); const float* SSQ = WSP(float, WS_SSQ); const float* x = F.in[0]; const float* wout = F.in[10];
    const int tok = (int)(((unsigned)F.tid * 2654435761u + 999u) % (unsigned)T), col = (int)(((unsigned)F.tid * 40503u + 5u) % (unsigned)D);
    float a = x[(size_t)tok * D + col]; for (int k = 0; k < D; ++k) a += bf1(MG[(size_t)tok * D + k]) * wout[(size_t)k * D + col];
    if (!dbg_close(bf1(X1B[(size_t)tok * D + col]), a)) dbg_fail(F, 5u);
    float ss = 0.f; for (int k = 0; k < D; ++k) { const float v = bf1(X1B[(size_t)tok * D + k]); ss += v * v; }
    float sp = 0.f; for (int j = 0; j < 16; ++j) sp += SSQ[(size_t)tok * 16 + j];
    if (fabsf(ss - sp) > 1e-2f * ss) dbg_fail(F, 6u);
}
#endif

struct Args { const float* in[20]; float* out; unsigned char* ws; };
__global__ void __launch_bounds__(512, 2) fwd_kernel(Args args) {
    extern __shared__ __attribute__((aligned(16))) unsigned char lds[];
    Frame F;
    F.lds = (LAS unsigned char*)lds;
    F.MISC = (volatile LAS unsigned*)(F.lds + MISC_OFF);
    F.tid = threadIdx.x; F.lane = F.tid & 63; F.wave = __builtin_amdgcn_readfirstlane(F.tid >> 6);
    F.G = gridDim.x; F.bid = blockIdx.x;
    F.ws = args.ws; F.out = args.out; F.ctl = (gu32*)(args.ws + WS_CTL);
#pragma unroll
    for (int i = 0; i < 20; ++i) F.in[i] = args.in[i];
    for (int u = F.tid; u < (LDS_BYTES - RING_BYTES) / 4; u += 512) ((LAS unsigned*)(F.lds + RING_BYTES))[u] = 0u;
    __syncthreads();
    XcdBarrier bar = xcd_barrier_post((unsigned*)(F.ctl + CW_BAR), F.MISC + 8);
#define GRID_BAR() xcd_barrier(bar)

#pragma unroll 1
    for (int rep_ = 0; rep_ < REPS(0); ++rep_) p0_prologue(F);
    GRID_BAR();
    if (NPH > 1) {
        pg8::StaticSched S; S.init(WSP(bf16, WS_HB), D, WSP(bf16, WS_WIN), D, T, NPJ, F.G, F.bid);
        EpiP1 E{WSP(bf16, WS_PJ), F.in[4], WSP(float, WS_BC)};
#pragma unroll 1
        for (int rep_ = 0; rep_ < REPS(1); ++rep_) pg8::gemm_phase<EpiP1, pg8::StaticSched, false, true>(F.lds, D, D, D, S, E);
        GRID_BAR();
#if DBG
        dbg_check_p1(F); dbg_check_bc(F);
        GRID_BAR();
#endif
    }
    if (NPH > 2) {
#pragma unroll 1
        for (int rep_ = 0; rep_ < REPS(2); ++rep_) p2a_phase(F);
        GRID_BAR();
        p2b_phase(F);
        GRID_BAR();
#if DBG
        dbg_check_gla(F); dbg_check_pool(F);
        GRID_BAR();
#endif
    }
    if (NPH > 3) {
        pg8::StaticSched S; S.init(WSP(bf16, WS_ON), GVW, WSP(bf16, WS_WG), GVW, T, D, F.G, F.bid);
        EpiD E{WSP(bf16, WS_TG), WSP(bf16, WS_PJ)};
#pragma unroll 1
        for (int rep_ = 0; rep_ < REPS(3); ++rep_) pg8::gemm_phase<EpiD, pg8::StaticSched, false, true>(F.lds, GVW, GVW, GVW, S, E);
        GRID_BAR();
    }
    if (NPH > 4) {
        pg8::StaticSched S; S.init(WSP(bf16, WS_PD), PW, WSP(bf16, WS_WP), PW, T, D, F.G, F.bid);
        EpiE E{WSP(bf16, WS_MG), WSP(bf16, WS_TG), WSP(bf16, WS_PJ)};
#pragma unroll 1
        for (int rep_ = 0; rep_ < REPS(4); ++rep_) pg8::gemm_phase<EpiE, pg8::StaticSched, false, true>(F.lds, PW, PW, PW, S, E);
        GRID_BAR();
#if DBG
        dbg_check_mg(F);
        GRID_BAR();
#endif
    }
    if (NPH > 5) {
        pg8::StaticSched S; S.init(WSP(bf16, WS_MG), D, WSP(bf16, WS_WOUT), D, T, D, F.G, F.bid);
        EpiF E{F.in[0], WSP(bf16, WS_X1B), WSP(float, WS_SSQ)};
#pragma unroll 1
        for (int rep_ = 0; rep_ < REPS(5); ++rep_) pg8::gemm_phase<EpiF, pg8::StaticSched, false, true>(F.lds, D, D, D, S, E);
        GRID_BAR();
#if DBG
        dbg_check_x1(F);
        GRID_BAR();
#endif
    }
    if (NPH > 6) {
        pg8::StaticSched S; S.init(WSP(bf16, WS_X1B), D, WSP(bf16, WS_WR), D, T, 256, F.G, F.bid);
        EpiG E{WSP(float, WS_LG)};
#pragma unroll 1
        for (int rep_ = 0; rep_ < REPS(6); ++rep_) pg8::gemm_phase<EpiG, pg8::StaticSched, false, true>(F.lds, D, D, D, S, E);
        VM_WAIT(); __syncthreads();
        pg8::Unit u; for (int i = 0; S.next(i, u); ++i) route_rows(F, u.r0);
        GRID_BAR();
    }
    if (NPH > 7) {
        moe_tables(F);
        MoeSched S{(const LAS int*)(F.lds + SCHED_OFF + 256), (const LAS int*)(F.lds + SCHED_OFF + 256) + 40, WSP(unsigned, WS_LIST), (const char*)WSP(bf16, WS_X1B), (const char*)WSP(bf16, WS_WGU), 2, F.G, F.bid, 0};
        EpiH E{WSP(bf16, WS_ACT), WSP(float, WS_LISTR)};
#pragma unroll 1
        for (int rep_ = 0; rep_ < REPS(7); ++rep_) pg8::gemm_phase<EpiH, MoeSched, true, true>(F.lds, D, D, D, S, E);
        GRID_BAR();
    }
    if (NPH > 8) {
        MoeSched S{(const LAS int*)(F.lds + SCHED_OFF + 256), (const LAS int*)(F.lds + SCHED_OFF + 256) + 40, WSP(unsigned, WS_LIST), (const char*)WSP(bf16, WS_ACT), (const char*)WSP(bf16, WS_WD), 4, F.G, F.bid, 1};
        EpiI E{WSP(bf16, WS_Y), WSP(unsigned, WS_LIST), WSP(float, WS_LISTW)};
#pragma unroll 1
        for (int rep_ = 0; rep_ < REPS(8); ++rep_) pg8::gemm_phase<EpiI, MoeSched, false, true>(F.lds, DE, DE, DE, S, E);
        GRID_BAR();
    }
    if (NPH > 9) {
        const float* gf = F.in[19]; const bf16* X1B = WSP(bf16, WS_X1B); const bf16* Y = WSP(bf16, WS_Y);
        const int gw = F.bid * 8 + F.wave, NGW = F.G * 8;
        unsigned code = 0;
#if DBG
        code = __hip_atomic_load((unsigned*)(F.ctl + CW_DBG), RLX_AGENT);
        if (__hip_atomic_load((unsigned*)(F.ctl + CW_BAR) + XB_TMO, RLX_AGENT) != 0u) code = 9;
#endif
#pragma unroll 1
        for (int rep_ = 0; rep_ < REPS(9); ++rep_)
        for (int m = gw; m < T; m += NGW) {
            const GAS v2u* xr = (const GAS v2u*)(X1B + (size_t)m * D) + F.lane;
            const GAS v2u* y0 = (const GAS v2u*)(Y + (size_t)(2 * m) * D) + F.lane; const GAS v2u* y1 = (const GAS v2u*)(Y + (size_t)(2 * m + 1) * D) + F.lane;
            f32x4 v[4]; float s_ = 0.f;
#pragma unroll
            for (int j = 0; j < 4; ++j) { const v2u a = y0[64 * j], b = y1[64 * j], c = xr[64 * j]; v[j] = (f32x4){bflo(c.x), bfhi(c.x), bflo(c.y), bfhi(c.y)} + (f32x4){bflo(a.x), bfhi(a.x), bflo(a.y), bfhi(a.y)} + (f32x4){bflo(b.x), bfhi(b.x), bflo(b.y), bfhi(b.y)};
                s_ += (v[j].x * v[j].x + v[j].y * v[j].y) + (v[j].z * v[j].z + v[j].w * v[j].w); }
            const float rstd = 1.0f / sqrtf(wave_sum(s_) * (1.f / D) + EPS);
            GAS f32x4* o = (GAS f32x4*)(F.out + (size_t)m * D) + F.lane;
#pragma unroll
            for (int j = 0; j < 4; ++j) { const f32x4 g = *((const GAS f32x4*)gf + F.lane + 64 * j); f32x4 r = v[j] * rstd * g; if (code) r = (f32x4){10.f * code, 10.f * code, 10.f * code, 10.f * code}; o[64 * j] = r; }
        }
    } else
    {
        const float* gf = F.in[19]; const float* x = F.in[0];
        const int gw = F.bid * 8 + F.wave, NGW = F.G * 8;
        unsigned code = 0;
#if DBG
        code = __hip_atomic_load((unsigned*)(F.ctl + CW_DBG), RLX_AGENT);
        if (__hip_atomic_load((unsigned*)(F.ctl + CW_BAR) + XB_TMO, RLX_AGENT) != 0u) code = 9;
#endif
        for (int m = gw; m < T; m += NGW) {
            const GAS f32x4* xr = (const GAS f32x4*)(x + (size_t)m * D) + F.lane;
            f32x4 v[4]; float s = 0.f;
#pragma unroll
            for (int j = 0; j < 4; ++j) { v[j] = xr[64 * j]; s += (v[j].x * v[j].x + v[j].y * v[j].y) + (v[j].z * v[j].z + v[j].w * v[j].w); }
            const float rstd = 1.0f / sqrtf(wave_sum(s) * (1.f / D) + EPS);
            GAS f32x4* o = (GAS f32x4*)(F.out + (size_t)m * D) + F.lane;
#pragma unroll
            for (int j = 0; j < 4; ++j) { const f32x4 g = *((const GAS f32x4*)gf + F.lane + 64 * j); f32x4 r = v[j] * rstd * g; if (code) r = (f32x4){10.f * code, 10.f * code, 10.f * code, 10.f * code}; o[64 * j] = r; }
        }
    }
}

extern "C" void kernel_launch(void* const* d_in, const int* in_sizes, int n_in, void* d_out, int out_size, void* d_ws, size_t ws_size, hipStream_t stream) {
    static int grid = 0;
    if (grid == 0) {
        if (n_in != 20 || in_sizes[0] != T * D || out_size != T * D || ws_size < WS_END) { fprintf(stderr, "kernel_launch: unexpected shapes (n_in %d, in0 %d, out %d, ws %zu)\n", n_in, n_in > 0 ? in_sizes[0] : -1, out_size, ws_size); grid = -1; return; }
        int dev = 0, cus = 0, per_cu = 0;
        if (hipGetDevice(&dev) != hipSuccess || hipDeviceGetAttribute(&cus, hipDeviceAttributeMultiprocessorCount, dev) != hipSuccess) { grid = -1; return; }
        if (hipFuncSetAttribute((const void*)fwd_kernel, hipFuncAttributeMaxDynamicSharedMemorySize, LDS_BYTES) != hipSuccess) { fprintf(stderr, "kernel_launch: hipFuncSetAttribute failed\n"); grid = -1; return; }
        if (hipOccupancyMaxActiveBlocksPerMultiprocessor(&per_cu, (const void*)fwd_kernel, 512, LDS_BYTES) != hipSuccess || per_cu < 1) fprintf(stderr, "kernel_launch: occupancy query says %d\n", per_cu);
        (void)hipGetLastError();
        grid = cus;
    }
    if (grid < 0) return;
    if (hipMemsetAsync((char*)d_ws + WS_CTL, 0, CTL_ZERO_BYTES, stream) != hipSuccess) return;
    Args a{};
    for (int i = 0; i < 20; ++i) a.in[i] = (const float*)d_in[i];
    a.out = (float*)d_out; a.ws = (unsigned char*)d_ws;
    hipLaunchKernelGGL(fwd_kernel, dim3(grid), dim3(512), LDS_BYTES, stream, a);
}
```

```cpp
#include <hip/hip_runtime.h>
#include <cstdio>
#include <cstdint>

#ifndef DBG
#define DBG 0
#endif
#ifndef REPMASK
#define REPMASK 0
#endif
#define REPS(k) ((((REPMASK) >> (k)) & 1) ? 2 : 1)
#ifndef NPH
#define NPH 10
#endif

constexpr int BATCH = 16, SEQ = 4096, T = BATCH * SEQ, D = 1024;
constexpr int GH = 4, GDK = 64, GDV = 128, GKW = 256, GVW = 512, GRANK = 16, GCH = 64;
constexpr int PW = 512, PGW = 128;
constexpr int D_IN = 4112;
constexpr int IN_Q = 0, IN_K = 256, IN_V = 512, IN_R = 1024, IN_A = 1536, IN_U = 1552, IN_GG = 2064, IN_GP = 3088;
constexpr int NPJ = 4352;
constexpr int PJ_Q = 0, PJ_K = 256, PJ_V = 512, PJ_R = 1024, PJ_Z = 1536, PJ_U = 1792, PJ_GG = 2304, PJ_GP = 3328;
constexpr int NE = 32, EPG = 8, NG = 4, DE = 256;
constexpr int NSEG = 4, SEGCH = SEQ / GCH / NSEG;
constexpr int NA = 2 * T;
constexpr int LCAP = T;
constexpr float EPS = 1e-6f;

constexpr size_t MiB = 1u << 20;
constexpr size_t WS_CTL = 0, CTL_ZERO_BYTES = 1 * MiB;
constexpr size_t WS_WIN = 1 * MiB;
constexpr size_t WS_WG = 10 * MiB;
constexpr size_t WS_WP = 11 * MiB;
constexpr size_t WS_WOUT = 12 * MiB;
constexpr size_t WS_WR = 14 * MiB;
constexpr size_t WS_WGU = 15 * MiB;
constexpr size_t WS_WD = 47 * MiB;
constexpr size_t WS_HB = 64 * MiB;
constexpr size_t WS_TG = WS_HB;
constexpr size_t WS_MG = 192 * MiB;
constexpr size_t WS_SLOC = 256 * MiB;
constexpr size_t WS_DTOT = 264 * MiB;
constexpr size_t WS_CUMB = 265 * MiB;
constexpr size_t WS_BC = 192 * MiB;
constexpr size_t WS_Y = 64 * MiB;
constexpr size_t WS_ON = 320 * MiB;
constexpr size_t WS_PD = 384 * MiB;
constexpr size_t WS_ACT = 320 * MiB;
constexpr size_t WS_PJ = 448 * MiB;
constexpr size_t WS_X1B = 704 * MiB;
constexpr size_t WS_LG = 832 * MiB;
constexpr size_t WS_SSQ = 848 * MiB;
constexpr size_t WS_LIST = 852 * MiB;
constexpr size_t WS_LISTW = 864 * MiB;
constexpr size_t WS_LISTR = 872 * MiB;
constexpr size_t WS_END = 992 * MiB;
static_assert(WS_PJ + (size_t)T * NPJ * 2 <= WS_END && WS_LISTR + (size_t)NE * LCAP * 4 <= WS_END && WS_ACT + (size_t)(NA + NE * 256) * DE * 2 <= WS_PJ, "d_ws map");
constexpr int CW_TMO = 0, CW_DBG = 2;
constexpr int CW_BAR = 4096;
constexpr int CW_ECNT = 16384;

constexpr int RING_BYTES = 131072;
constexpr int MISC_OFF = RING_BYTES + 320;
constexpr int SCHED_OFF = RING_BYTES + 1024;
constexpr int LDS_BYTES = 147456;

#define GAS __attribute__((address_space(1)))
#define LAS __attribute__((address_space(3)))
typedef unsigned short bf16;
typedef unsigned v4u __attribute__((ext_vector_type(4)));
typedef unsigned v2u __attribute__((ext_vector_type(2)));
typedef float f32x4 __attribute__((ext_vector_type(4)));
typedef short bf16x8 __attribute__((ext_vector_type(8)));
typedef short bf16x4 __attribute__((ext_vector_type(4)));
typedef GAS unsigned gu32;
#define RLX_AGENT __ATOMIC_RELAXED, __HIP_MEMORY_SCOPE_AGENT
#define LDS_WAIT() asm volatile("s_waitcnt lgkmcnt(0)" ::: "memory")
#define VM_WAIT() asm volatile("s_waitcnt vmcnt(0)" ::: "memory")
__device__ __forceinline__ unsigned f2bf(float f) { unsigned u = __builtin_bit_cast(unsigned, f); return (u + 0x7fffu + ((u >> 16) & 1u)) >> 16; }
__device__ __forceinline__ unsigned pk2(float lo, float hi) { unsigned r; asm volatile("v_cvt_pk_bf16_f32 %0, %1, %2" : "=v"(r) : "v"(lo), "v"(hi)); return r; }
__device__ __forceinline__ float bflo(unsigned w) { return __builtin_bit_cast(float, w << 16); }
__device__ __forceinline__ float bfhi(unsigned w) { return __builtin_bit_cast(float, w & 0xffff0000u); }
__device__ __forceinline__ float bf1(bf16 h) { return __builtin_bit_cast(float, (unsigned)h << 16); }
__device__ __forceinline__ float fsigmoid(float x) { return __builtin_amdgcn_rcpf(1.0f + __expf(-x)); }
__device__ __forceinline__ float wave_sum(float v) {
#pragma unroll
    for (int o = 1; o < 64; o <<= 1) v += __shfl_xor(v, o);
    return v;
}


template <int CTRL> __device__ __forceinline__ float dpp_f(float x) { return __builtin_bit_cast(float, __builtin_amdgcn_update_dpp(0, __builtin_bit_cast(int, x), CTRL, 0xf, 0xf, true)); }
__device__ __forceinline__ float row16_sum(float x) { x += dpp_f<0x128>(x); x += dpp_f<0x124>(x); x += dpp_f<0x122>(x); x += dpp_f<0x121>(x); return x; }
__device__ __forceinline__ float row16_scan(float x) { x += dpp_f<0x111>(x); x += dpp_f<0x112>(x); x += dpp_f<0x114>(x); x += dpp_f<0x118>(x); return x; }

#define XB_TMO      128
#define XB_XCNT(j)  (256  + 64 * (j))
#define XB_XSUB(j)  (1280 + 64 * (j))
#define XB_XGEN(j)  (2304 + 64 * (j))
#define XB_TOP      3328
#define XB_TOPGEN   3392
#define XCD_BAR_WORDS 3456
#define XB_SPIN_CAP (1u << 18)
__device__ __forceinline__ unsigned xb_ld(unsigned* p)              { return __hip_atomic_load(p, __ATOMIC_RELAXED, __HIP_MEMORY_SCOPE_AGENT); }
__device__ __forceinline__ unsigned xb_add(unsigned* p, unsigned v) { return __hip_atomic_fetch_add(p, v, __ATOMIC_RELAXED, __HIP_MEMORY_SCOPE_AGENT); }
__device__ __forceinline__ unsigned xb_xcc_id() { return (unsigned)__builtin_amdgcn_s_getreg((3 << 11) | 20) & 0xFu; }
#define XB_SPIN(cond, bar) do { unsigned _sp = 0; while (cond) { __builtin_amdgcn_s_sleep(1); \
    if ((++_sp & 255u) == 0u) { if (xb_ld(&(bar)[XB_TMO])) break; if (_sp > XB_SPIN_CAP) { atomicAdd(&(bar)[XB_TMO], 1u); break; } } } } while (0)
struct XcdBarrier { unsigned* bar; unsigned x; volatile LAS unsigned* st; };
__device__ __forceinline__ XcdBarrier xcd_barrier_post(unsigned* bar, volatile LAS unsigned* st) {
    XcdBarrier b; b.bar = bar; b.x = xb_xcc_id(); b.st = st;
    if (threadIdx.x == 0) (void)xb_add(&bar[XB_XCNT(b.x)], 1u);
    return b;
}
__device__ __forceinline__ void xcd_barrier_complete(unsigned* bar, unsigned x, unsigned& nloc, unsigned& nx) {
    const unsigned G = gridDim.x * gridDim.y * gridDim.z;
    unsigned sum, cnt, mine, sp = 0u;
    for (;;) {
        sum = 0u; cnt = 0u; mine = 0u;
#pragma unroll
        for (unsigned j = 0; j < 16; ++j) { const unsigned c = xb_ld(&bar[XB_XCNT(j)]); sum += c; cnt += (c > 0u) ? 1u : 0u; mine = (j == x) ? c : mine; }
        if (sum == G) break;
        __builtin_amdgcn_s_sleep(1);
        if ((++sp & 255u) == 0u) { if (xb_ld(&bar[XB_TMO])) break; if (sp > XB_SPIN_CAP) { atomicAdd(&bar[XB_TMO], 1u); break; } }
    }
    nloc = mine > 0u ? mine : 1u; nx = cnt > 0u ? cnt : 1u;
}
__device__ __forceinline__ void xcd_barrier(const XcdBarrier& b) {
    asm volatile("s_waitcnt vmcnt(0)" ::: "memory");
    __syncthreads();
    if (threadIdx.x == 0) {
        unsigned* bar = b.bar;
        __builtin_amdgcn_s_waitcnt(0);
        unsigned nloc = b.st[0], nx = b.st[1];
        if (nloc == 0u) { xcd_barrier_complete(bar, b.x, nloc, nx); b.st[0] = nloc; b.st[1] = nx; }
        const unsigned old = xb_add(&bar[XB_XSUB(b.x)], 1u);
        const unsigned gen = old / nloc;
        if (old + 1u == (gen + 1u) * nloc) {
            __builtin_amdgcn_fence(__ATOMIC_RELEASE, "agent");
            asm volatile("s_waitcnt vmcnt(0)" ::: "memory");
            const unsigned og = xb_add(&bar[XB_TOP], 1u);
            const unsigned tg = og / nx;
            if (og + 1u == (tg + 1u) * nx) xb_add(&bar[XB_TOPGEN], 1u);
            else XB_SPIN(xb_ld(&bar[XB_TOPGEN]) == tg, bar);
            __builtin_amdgcn_fence(__ATOMIC_ACQUIRE, "agent");
            xb_add(&bar[XB_XGEN(b.x)], 1u);
            asm volatile("s_waitcnt vmcnt(0)" ::: "memory");
        } else {
            XB_SPIN(xb_ld(&bar[XB_XGEN(b.x)]) == gen, bar);
            __builtin_amdgcn_fence(__ATOMIC_ACQUIRE, "agent");
            asm volatile("s_waitcnt vmcnt(0)" ::: "memory");
        }
    }
    __syncthreads();
}

namespace pg8 {
#define PG8_LAS __attribute__((address_space(3)))
constexpr int BM = 256, BK = 64, HALF = 128, HTB = HALF * BK * 2, STAGE_BYTES = 8 * HTB, NXCD = 8, WGM = 8;
__host__ __device__ __forceinline__ int lds_byte(int r, int c) { const int st = (r >> 4) * 2 + (c >> 5), rr = r & 15, cc = c & 31, ob = rr * 64 + cc * 2; return st * 1024 + (ob ^ (((ob >> 9) & 1) << 5)); }
__host__ __device__ __forceinline__ void stage_rc(int b, int& R, int& C) { const int st = b / 1024, sb = b % 1024, swz = sb ^ (((sb >> 9) & 1) << 5); R = (st >> 1) * 16 + swz / 64; C = (st & 1) * 32 + (swz % 64) / 2; }
__host__ __device__ __forceinline__ int perm32(int rho) { const int n = rho >> 4, i = rho & 15; return 8 * (i >> 2) + 4 * n + (i & 3); }

struct Unit { const char* A; const char* B; int r0, c0, e, nvalid, lb, pad; };

__device__ __forceinline__ int remap_xcd(int L, int nwg) { const int q = nwg / NXCD, r = nwg % NXCD, xcd = L % NXCD, off = L / NXCD; return (xcd < r ? xcd * (q + 1) : r * (q + 1) + (xcd - r) * q) + off; }
struct StaticSched {
    const char* A; const char* B; int lda, ldb, nM, nN, nwg, G, c;
    __device__ __forceinline__ void init(const void* A_, int lda_, const void* B_, int ldb_, int M, int N, int G_, int c_) { A = (const char*)A_; B = (const char*)B_; lda = lda_; ldb = ldb_; nM = M / BM; nN = N / BM; nwg = nM * nN; G = G_; c = c_; }
    __device__ __forceinline__ bool next(int i, Unit& u) const {
        const long L = (long)i * G + c; if (L >= nwg) return false;
        const int wgid = remap_xcd((int)L, nwg);
        const int nig = WGM * nN, gid = wgid / nig, fm = gid * WGM, gsz = (nM - fm) < WGM ? (nM - fm) : WGM;
        const int pm = fm + ((wgid % nig) % gsz), pn = (wgid % nig) / gsz;
        u.A = A + (size_t)pm * BM * lda * 2; u.B = B + (size_t)pn * BM * ldb * 2; u.r0 = pm * BM; u.c0 = pn * BM; u.e = 0; u.nvalid = BM; u.lb = 0; u.pad = 0; return true;
    }
    __device__ __forceinline__ void fill_tab(const Unit&, PG8_LAS unsigned*) const {}
};

template <class Epi, class Sched, bool GATHER, bool ALIGN_EPI>
__device__ __forceinline__ void gemm_phase(PG8_LAS unsigned char* lds, const int K, const int lda, const int ldb, const Sched& S, const Epi& E) {
    int tid_ = threadIdx.x; asm volatile("" : "+v"(tid_));
    const int tid = tid_, wid = __builtin_amdgcn_readfirstlane(tid >> 6), lane = tid & 63, wr = wid >> 2, wc = wid & 3, fr = lane & 15, fq = lane >> 4;
    const int nt = K / BK;
    int Rr[2], Cc[2];
    unsigned voffA[2][2], voffB[2], nvA[2][2];
#pragma unroll
    for (int i = 0; i < 2; ++i) { int R, C; stage_rc(tid * 16 + i * 8192, R, C); Rr[i] = R; Cc[i] = C; const int Rb = Epi::PERM ? ((R & ~31) + perm32(R & 31)) : R;
        voffB[i] = (unsigned)(Rb * ldb + C) * 2u;
#pragma unroll
        for (int h = 0; h < 2; ++h) { voffA[h][i] = (unsigned)((R + HALF * h) * lda + C) * 2u; nvA[h][i] = voffA[h][i]; } }
    const size_t kstep = (size_t)(BK * 2);
    const size_t hstepB = (size_t)HALF * ldb * 2;
    const unsigned ldsw = (unsigned)wid * 1024u;
    const int aoff = lds_byte(wr * 64 + fr, fq * 8), boff = lds_byte(wc * 32 + fr, fq * 8);
#define PG8_SA(b, h) (((b) * 2 + (h)) * HTB)
#define PG8_SB(b, h) ((4 + (b) * 2 + (h)) * HTB)
#define PG8_STAGE(bufoff, gbase, voff) do { _Pragma("unroll") for (int _i = 0; _i < 2; ++_i) \
        __builtin_amdgcn_global_load_lds((const unsigned*)((const char*)(gbase) + (voff)[_i]), (PG8_LAS unsigned*)(lds + (bufoff) + ldsw + _i * 8192), 16, 0, 0); } while (0)
#define PG8_LDA(dst, b, h) do { _Pragma("unroll") for (int m = 0; m < 4; ++m) _Pragma("unroll") for (int k = 0; k < 2; ++k) dst[m][k] = *(const PG8_LAS bf16x8*)(lds + PG8_SA(b, h) + aoff + m * 2048 + k * 1024); } while (0)
#define PG8_LDB(dst, b, h) do { _Pragma("unroll") for (int n = 0; n < 2; ++n) _Pragma("unroll") for (int k = 0; k < 2; ++k) dst[n][k] = *(const PG8_LAS bf16x8*)(lds + PG8_SB(b, h) + boff + n * 2048 + k * 1024); } while (0)
#define PG8_MMA(ai, bj, At, Bt) do { __builtin_amdgcn_s_setprio(1); _Pragma("unroll") for (int m = 0; m < 4; ++m) _Pragma("unroll") for (int n = 0; n < 2; ++n) _Pragma("unroll") for (int k = 0; k < 2; ++k) \
        acc[ai][bj][m][n] = __builtin_amdgcn_mfma_f32_16x16x32_bf16(Bt[n][k], At[m][k], acc[ai][bj][m][n], 0, 0, 0); __builtin_amdgcn_s_setprio(0); } while (0)
#define PG8_WAIT_V(n) asm volatile("s_waitcnt vmcnt(" #n ")" ::: "memory")
#define PG8_WAIT_L(n) asm volatile("s_waitcnt lgkmcnt(" #n ")" ::: "memory")
#define PG8_BAR __builtin_amdgcn_s_barrier()
#define PG8_SCHED __builtin_amdgcn_sched_barrier(0)
    Unit cur, nxt; int ui = 0;
    if (!S.next(0, cur)) return;
    f32x4 acc[2][2][4][2];
#pragma unroll
    for (int a = 0; a < 2; ++a)
#pragma unroll
        for (int b = 0; b < 2; ++b)
#pragma unroll
            for (int m = 0; m < 4; ++m)
#pragma unroll
                for (int n = 0; n < 2; ++n) acc[a][b][m][n] = (f32x4){0.f, 0.f, 0.f, 0.f};
    bf16x8 At[4][2], B0[2][2], B1[2][2];
    const char* cA = cur.A; const char* cB = cur.B;
    PG8_LAS unsigned* gtab = (PG8_LAS unsigned*)(lds + STAGE_BYTES + 2048);
    if constexpr (GATHER) {
        S.fill_tab(cur, gtab);
        asm volatile("s_waitcnt lgkmcnt(0)" ::: "memory"); __builtin_amdgcn_s_barrier(); asm volatile("" ::: "memory");
#pragma unroll
        for (int h = 0; h < 2; ++h)
#pragma unroll
            for (int i = 0; i < 2; ++i) { voffA[h][i] = gtab[Rr[i] + HALF * h] + (unsigned)Cc[i] * 2u; nvA[h][i] = voffA[h][i]; }
    }
    PG8_STAGE(PG8_SB(0, 0), cB, voffB); PG8_STAGE(PG8_SB(0, 1), cB + hstepB, voffB); PG8_STAGE(PG8_SA(0, 0), cA, voffA[0]); PG8_STAGE(PG8_SA(0, 1), cA, voffA[1]);
    if (wr == 1) PG8_BAR;
    PG8_WAIT_V(2); PG8_BAR;
    PG8_STAGE(PG8_SB(1, 0), cB + kstep, voffB); PG8_STAGE(PG8_SA(1, 0), cA + kstep, voffA[0]); PG8_STAGE(PG8_SB(1, 1), cB + hstepB + kstep, voffB);
    PG8_WAIT_V(6); PG8_BAR;
    for (;;) {
        const bool has_next = S.next(ui + 1, nxt);
        const char* nA = has_next ? nxt.A : cA; const char* nB = has_next ? nxt.B : cB;
        if constexpr (GATHER) { if (has_next) S.fill_tab(nxt, gtab + ((ui + 1) & 1) * 256); }
#pragma unroll 1
        for (int t = 0; t < nt; t += 2) {
            const bool last = (t == nt - 2);
            const char* a1 = cA + (size_t)(t + 1) * kstep;
            const char* a2 = last ? nA : cA + (size_t)(t + 2) * kstep; const char* b2 = last ? nB : cB + (size_t)(t + 2) * kstep;
            const char* a3 = a2 + kstep; const char* b3 = b2 + kstep;
            unsigned sv[2][2];
            if constexpr (GATHER) {
                if (last && has_next) {
#pragma unroll
                    for (int h = 0; h < 2; ++h)
#pragma unroll
                        for (int i = 0; i < 2; ++i) nvA[h][i] = gtab[((ui + 1) & 1) * 256 + Rr[i] + HALF * h] + (unsigned)Cc[i] * 2u;
                }
#pragma unroll
                for (int h = 0; h < 2; ++h)
#pragma unroll
                    for (int i = 0; i < 2; ++i) sv[h][i] = last ? nvA[h][i] : voffA[h][i];
            } else {
#pragma unroll
                for (int h = 0; h < 2; ++h)
#pragma unroll
                    for (int i = 0; i < 2; ++i) sv[h][i] = voffA[h][i];
            }
            PG8_LDB(B0, 0, 0); PG8_LDB(B1, 0, 1); PG8_SCHED; PG8_LDA(At, 0, 0); PG8_STAGE(PG8_SA(1, 1), a1, voffA[1]);
            PG8_WAIT_V(8); PG8_WAIT_L(0); PG8_BAR; PG8_MMA(0, 0, At, B0); PG8_MMA(0, 1, At, B1); PG8_BAR; PG8_SCHED;
            PG8_LDA(At, 0, 1); PG8_STAGE(PG8_SB(0, 0), b2, voffB); PG8_STAGE(PG8_SB(0, 1), b2 + hstepB, voffB); PG8_STAGE(PG8_SA(0, 0), a2, sv[0]);
            PG8_WAIT_V(8); PG8_WAIT_L(0); PG8_BAR; PG8_MMA(1, 0, At, B0); PG8_MMA(1, 1, At, B1); PG8_BAR; PG8_SCHED;
            PG8_LDB(B0, 1, 0); PG8_LDB(B1, 1, 1); PG8_SCHED; PG8_LDA(At, 1, 0); PG8_STAGE(PG8_SA(0, 1), a2, sv[1]);
            PG8_WAIT_V(8); PG8_WAIT_L(0); PG8_BAR; PG8_MMA(0, 0, At, B0); PG8_MMA(0, 1, At, B1); PG8_BAR; PG8_SCHED;
            PG8_LDA(At, 1, 1); PG8_STAGE(PG8_SB(1, 0), b3, voffB); PG8_STAGE(PG8_SB(1, 1), b3 + hstepB, voffB); PG8_STAGE(PG8_SA(1, 0), a3, sv[0]);
            PG8_WAIT_V(8); PG8_WAIT_L(0); PG8_BAR; PG8_MMA(1, 0, At, B0); PG8_MMA(1, 1, At, B1); PG8_BAR; PG8_SCHED;
        }
        if constexpr (ALIGN_EPI) { if (wr == 0) PG8_BAR; }
        E(acc, cur, wr, wc, fr, fq);
        if (!has_next) break;
#pragma unroll
        for (int a = 0; a < 2; ++a)
#pragma unroll
            for (int b = 0; b < 2; ++b)
#pragma unroll
                for (int m = 0; m < 4; ++m)
#pragma unroll
                    for (int n = 0; n < 2; ++n) acc[a][b][m][n] = (f32x4){0.f, 0.f, 0.f, 0.f};
        cur = nxt; cA = nA; cB = nB; ++ui;
        if constexpr (GATHER) {
#pragma unroll
            for (int h = 0; h < 2; ++h)
#pragma unroll
                for (int i = 0; i < 2; ++i) voffA[h][i] = nvA[h][i];
        }
        if constexpr (ALIGN_EPI) { if (wr == 1) PG8_BAR; }
    }
    PG8_WAIT_V(0);
    if constexpr (!ALIGN_EPI) { if (wr == 0) PG8_BAR; }
    PG8_BAR;
#undef PG8_SA
#undef PG8_SB
#undef PG8_STAGE
#undef PG8_LDA
#undef PG8_LDB
#undef PG8_MMA
#undef PG8_WAIT_V
#undef PG8_WAIT_L
#undef PG8_BAR
#undef PG8_SCHED
}
}

struct Frame {
    LAS unsigned char* lds;
    volatile LAS unsigned* MISC;
    gu32* ctl;
    int tid, lane, wave, G, bid;
    const float* in[20]; float* out; unsigned char* ws;
};
#define WSP(T_, off) ((T_*)(F.ws + (off)))

__device__ __forceinline__ v4u pack8(const f32x4 a, const f32x4 b) { v4u w; w.x = pk2(a[0], a[1]); w.y = pk2(a[2], a[3]); w.z = pk2(b[0], b[1]); w.w = pk2(b[2], b[3]); return w; }
__device__ __forceinline__ void unpack8(const v4u w, f32x4& a, f32x4& b) { a = (f32x4){bflo(w.x), bfhi(w.x), bflo(w.y), bfhi(w.y)}; b = (f32x4){bflo(w.z), bfhi(w.z), bflo(w.w), bfhi(w.w)}; }

struct EpiP1 {
    static constexpr bool PERM = true;
    bf16* PJ; const float* b_alpha; float* BC;
    __device__ __forceinline__ void operator()(const f32x4 (&acc)[2][2][4][2], const pg8::Unit& u, int wr, int wc, int fr, int fq) const {
        const int pn = u.c0 >> 8;
        const int mode = (pn == 4 || pn == 5) ? 1 : (pn == 6) ? 2 : (pn >= 9) ? 3 : 0;
        const int row0 = u.r0 + wr * 64 + fr, col0 = u.c0 + wc * 32 + 8 * fq;
        f32x4 bv[2][2];
        const int bidx = (mode == 2) ? (col0 - PJ_Z) : 0;
#pragma unroll
        for (int bj = 0; bj < 2; ++bj)
#pragma unroll
            for (int n = 0; n < 2; ++n) { bv[bj][n] = *(const f32x4*)(b_alpha + bidx + bj * 128 + 4 * n); asm volatile("" :: "v"(bv[bj][n])); }
        if (mode == 2) {
#pragma unroll
            for (int ai = 0; ai < 2; ++ai)
#pragma unroll
                for (int bj = 0; bj < 2; ++bj) { f32x4 pr[4][2];
#pragma unroll
                    for (int n = 0; n < 2; ++n)
#pragma unroll
                        for (int j = 0; j < 4; ++j) { float carry = 0.f;
#pragma unroll
                            for (int m = 0; m < 4; ++m) { const float z = acc[ai][bj][m][n][j] + bv[bj][n][j]; const float la = (fminf(z, 0.f) - __logf(1.0f + __expf(-fabsf(z)))) * (1.0f / 16.0f);
                                pr[m][n][j] = row16_scan(la) + carry; carry += row16_sum(la); } }
#pragma unroll
                    for (int m = 0; m < 4; ++m) { float* bp = BC + (size_t)(row0 + ai * 128 + m * 16) * GKW + (col0 - PJ_Z) + bj * 128; *(f32x4*)bp = pr[m][0]; *(f32x4*)(bp + 4) = pr[m][1]; } }
            return;
        }
#pragma unroll
        for (int ai = 0; ai < 2; ++ai)
#pragma unroll
            for (int m = 0; m < 4; ++m) { bf16* rowp = PJ + (size_t)(row0 + ai * 128 + m * 16) * NPJ + col0;
#pragma unroll
                for (int bj = 0; bj < 2; ++bj) { f32x4 v[2] = {acc[ai][bj][m][0], acc[ai][bj][m][1]};
                    if (mode == 1) {
#pragma unroll
                        for (int n = 0; n < 2; ++n)
#pragma unroll
                            for (int j = 0; j < 4; ++j) v[n][j] = v[n][j] * fsigmoid(v[n][j]);
                    } else if (mode == 3) {
#pragma unroll
                        for (int n = 0; n < 2; ++n)
#pragma unroll
                            for (int j = 0; j < 4; ++j) v[n][j] = fsigmoid(v[n][j]);
                    }
                    *(v4u*)(rowp + bj * 128) = pack8(v[0], v[1]); } }
    }
};

struct EpiD {
    static constexpr bool PERM = true;
    bf16* TG; const bf16* PJ;
    __device__ __forceinline__ void operator()(const f32x4 (&acc)[2][2][4][2], const pg8::Unit& u, int wr, int wc, int fr, int fq) const {
        const int row0 = u.r0 + wr * 64 + fr, col0 = u.c0 + wc * 32 + 8 * fq;
#pragma unroll
        for (int ai = 0; ai < 2; ++ai)
#pragma unroll
            for (int m = 0; m < 4; ++m) { const size_t row = (size_t)(row0 + ai * 128 + m * 16);
#pragma unroll
                for (int bj = 0; bj < 2; ++bj) { const int c = col0 + bj * 128; const v4u gw = *(const v4u*)(PJ + row * NPJ + PJ_GG + c); f32x4 g0, g1; unpack8(gw, g0, g1);
                    *(v4u*)(TG + row * D + c) = pack8(acc[ai][bj][m][0] * g0, acc[ai][bj][m][1] * g1); } }
    }
};
struct EpiE {
    static constexpr bool PERM = true;
    bf16* MG; const bf16* TG; const bf16* PJ;
    __device__ __forceinline__ void operator()(const f32x4 (&acc)[2][2][4][2], const pg8::Unit& u, int wr, int wc, int fr, int fq) const {
        const int row0 = u.r0 + wr * 64 + fr, col0 = u.c0 + wc * 32 + 8 * fq;
#pragma unroll
        for (int ai = 0; ai < 2; ++ai)
#pragma unroll
            for (int m = 0; m < 4; ++m) { const size_t row = (size_t)(row0 + ai * 128 + m * 16);
#pragma unroll
                for (int bj = 0; bj < 2; ++bj) { const int c = col0 + bj * 128; const v4u gw = *(const v4u*)(PJ + row * NPJ + PJ_GP + c); const v4u tw = *(const v4u*)(TG + row * D + c);
                    f32x4 g0, g1, t0, t1; unpack8(gw, g0, g1); unpack8(tw, t0, t1);
                    *(v4u*)(MG + row * D + c) = pack8(t0 + acc[ai][bj][m][0] * g0, t1 + acc[ai][bj][m][1] * g1); } }
    }
};
struct EpiF {
    static constexpr bool PERM = true;
    const float* x; bf16* X1B; float* SSQ;
    __device__ __forceinline__ void operator()(const f32x4 (&acc)[2][2][4][2], const pg8::Unit& u, int wr, int wc, int fr, int fq) const {
        const int row0 = u.r0 + wr * 64 + fr, col0 = u.c0 + wc * 32 + 8 * fq;
#pragma unroll
        for (int ai = 0; ai < 2; ++ai)
#pragma unroll
            for (int m = 0; m < 4; ++m) { const size_t row = (size_t)(row0 + ai * 128 + m * 16); float ss = 0.f;
#pragma unroll
                for (int bj = 0; bj < 2; ++bj) { const int c = col0 + bj * 128; const f32x4 x0 = *(const f32x4*)(x + row * D + c), x1 = *(const f32x4*)(x + row * D + c + 4);
                    const f32x4 y0 = x0 + acc[ai][bj][m][0], y1 = x1 + acc[ai][bj][m][1];
                    *(v4u*)(X1B + row * D + c) = pack8(y0, y1);
                    ss += (y0[0] * y0[0] + y0[1] * y0[1]) + (y0[2] * y0[2] + y0[3] * y0[3]) + (y1[0] * y1[0] + y1[1] * y1[1]) + (y1[2] * y1[2] + y1[3] * y1[3]); }
                ss += __shfl_xor(ss, 16); ss += __shfl_xor(ss, 32);
                if (fq == 0) SSQ[row * 16 + (u.c0 >> 8) * 4 + wc] = ss; }
    }
};


struct MoeSched {
    const LAS int* cum; const LAS int* cnt; const unsigned* LIST;
    const char* Abase; const char* Bbase; int NT, G, c, mode;
    __device__ __forceinline__ bool next(int i, pg8::Unit& u) const {
        const int nunits = __builtin_amdgcn_readfirstlane(cum[NE]) * NT; const long L = (long)i * G + c; if (L >= nunits) return false;
        const int wgid = pg8::remap_xcd((int)L, nunits), gb = wgid / NT, pn = wgid % NT;
        int e_ = 0;
#pragma unroll 8
        for (int j = 1; j < NE; ++j) e_ += (cum[j] <= gb) ? 1 : 0;
        const int e = __builtin_amdgcn_readfirstlane(e_);
        const int blk = gb - __builtin_amdgcn_readfirstlane(cum[e]), rem = __builtin_amdgcn_readfirstlane(cnt[e]) - blk * 256;
        u.e = e; u.nvalid = rem < 256 ? rem : 256; u.lb = e * LCAP + blk * 256; u.r0 = gb * 256; u.pad = 0;
        if (mode == 0) { u.A = Abase; u.B = Bbase + ((size_t)e * 512 + (size_t)pn * 256) * D * 2; u.c0 = pn * 128; }
        else { u.A = Abase + (size_t)gb * 256 * DE * 2; u.B = Bbase + ((size_t)e * D + (size_t)pn * 256) * DE * 2; u.c0 = pn * 256; }
        return true;
    }
    __device__ __forceinline__ void fill_tab(const pg8::Unit& u, LAS unsigned* tab) const {
        const int t = threadIdx.x;
        if (t < 256) { const int lp = t < u.nvalid ? t : u.nvalid - 1; const unsigned slot = LIST[u.lb + lp]; tab[t] = (slot >> 1) * (unsigned)(D * 2); }
    }
};
struct EpiG {
    static constexpr bool PERM = false;
    float* LG;
    __device__ __forceinline__ void operator()(const f32x4 (&acc)[2][2][4][2], const pg8::Unit& u, int wr, int wc, int fr, int fq) const {
        if (wc >= 2) return;
        const int row0 = u.r0 + wr * 64 + fr;
#pragma unroll
        for (int ai = 0; ai < 2; ++ai)
#pragma unroll
            for (int m = 0; m < 4; ++m)
#pragma unroll
                for (int n = 0; n < 2; ++n) *(f32x4*)(LG + (size_t)(row0 + ai * 128 + m * 16) * 64 + 32 * wc + 16 * n + 4 * fq) = acc[ai][0][m][n];
    }
};
struct EpiH {
    static constexpr bool PERM = true;
    bf16* ACT; const float* LISTR;
    __device__ __forceinline__ void operator()(const f32x4 (&acc)[2][2][4][2], const pg8::Unit& u, int wr, int wc, int fr, int fq) const {
        float rs[2][4];
#pragma unroll
        for (int ai = 0; ai < 2; ++ai)
#pragma unroll
            for (int m = 0; m < 4; ++m) { const int rl = ai * 128 + wr * 64 + m * 16 + fr, lp = rl < u.nvalid ? rl : u.nvalid - 1; rs[ai][m] = LISTR[u.lb + lp]; }
#pragma unroll
        for (int ai = 0; ai < 2; ++ai)
#pragma unroll
            for (int m = 0; m < 4; ++m) { asm volatile("" :: "v"(rs[ai][m])); }
#pragma unroll
        for (int ai = 0; ai < 2; ++ai)
#pragma unroll
            for (int m = 0; m < 4; ++m) { const int rl = ai * 128 + wr * 64 + m * 16 + fr; const float r = rs[ai][m]; f32x4 a[2];
#pragma unroll
                for (int n = 0; n < 2; ++n)
#pragma unroll
                    for (int j = 0; j < 4; ++j) { const float g = acc[ai][0][m][n][j] * r, up = acc[ai][1][m][n][j] * r; a[n][j] = g * fsigmoid(g) * up; }
                *(v4u*)(ACT + (size_t)(u.r0 + rl) * DE + u.c0 + wc * 32 + 8 * fq) = pack8(a[0], a[1]); }
    }
};
struct EpiI {
    static constexpr bool PERM = true;
    bf16* Y; const unsigned* LIST; const float* LISTW;
    __device__ __forceinline__ void operator()(const f32x4 (&acc)[2][2][4][2], const pg8::Unit& u, int wr, int wc, int fr, int fq) const {
#pragma unroll
        for (int ai = 0; ai < 2; ++ai) {
            unsigned sl[4]; float gw[4];
#pragma unroll
            for (int m = 0; m < 4; ++m) { const int rl = ai * 128 + wr * 64 + m * 16 + fr, lp = rl < u.nvalid ? rl : u.nvalid - 1; sl[m] = LIST[u.lb + lp]; gw[m] = LISTW[u.lb + lp]; }
#pragma unroll
            for (int m = 0; m < 4; ++m) { asm volatile("" :: "v"(gw[m]), "v"(sl[m])); }
#pragma unroll
            for (int m = 0; m < 4; ++m) { const int rl = ai * 128 + wr * 64 + m * 16 + fr; const float g = gw[m];
                if (rl < u.nvalid) {
#pragma unroll
                    for (int bj = 0; bj < 2; ++bj) *(v4u*)(Y + (size_t)sl[m] * D + u.c0 + bj * 128 + wc * 32 + 8 * fq) = pack8(acc[ai][bj][m][0] * g, acc[ai][bj][m][1] * g); } }
        }
    }
};
__device__ __forceinline__ void route_rows(Frame& F, const int r0) {
    const float* LG = WSP(float, WS_LG); const float* SSQ = WSP(float, WS_SSQ); const float* brg = F.in[13]; const float* bre = F.in[15];
    unsigned* LIST = WSP(unsigned, WS_LIST); float* LISTW = WSP(float, WS_LISTW); float* LISTR = WSP(float, WS_LISTR);
    LAS unsigned* hcnt = (LAS unsigned*)(F.lds + SCHED_OFF); LAS unsigned* hbase = hcnt + 32;
    if (F.tid < 32) hcnt[F.tid] = 0u;
    __syncthreads();
    int e0 = 0, e1 = 0; unsigned p0 = 0, p1 = 0; float w0 = 0.f, w1 = 0.f, rstd = 0.f; const int row = r0 + F.tid;
    if (F.tid < 256) {
        float ss = 0.f;
#pragma unroll
        for (int j = 0; j < 16; ++j) ss += SSQ[(size_t)row * 16 + j];
        rstd = 1.0f / sqrtf(ss * (1.0f / D) + EPS);
        const float* lr = LG + (size_t)row * 64;
        float gl[4];
#pragma unroll
        for (int g = 0; g < 4; ++g) gl[g] = __hip_atomic_load(lr + g, RLX_AGENT) * rstd + brg[g];
        int gi = 0; float gm = gl[0];
#pragma unroll
        for (int g = 1; g < 4; ++g) if (gl[g] > gm) { gm = gl[g]; gi = g; }
        float den = 0.f;
#pragma unroll
        for (int g = 0; g < 4; ++g) den += expf(gl[g] - gm);
        const float gp = 1.0f / den;
        float el[8];
#pragma unroll
        for (int e = 0; e < 8; ++e) el[e] = __hip_atomic_load(lr + 4 + gi * 8 + e, RLX_AGENT) * rstd + bre[gi * 8 + e];
        int i0 = 0; float m0 = el[0];
#pragma unroll
        for (int e = 1; e < 8; ++e) if (el[e] > m0) { m0 = el[e]; i0 = e; }
        int i1 = -1; float m1 = 0.f;
#pragma unroll
        for (int e = 0; e < 8; ++e) if (e != i0 && (i1 < 0 || el[e] > m1)) { m1 = el[e]; i1 = e; }
        const float q = expf(m1 - m0); w0 = gp / (1.0f + q); w1 = gp * q / (1.0f + q);
        e0 = gi * 8 + i0; e1 = gi * 8 + i1;
        p0 = __hip_atomic_fetch_add(&hcnt[e0], 1u, __ATOMIC_RELAXED, __HIP_MEMORY_SCOPE_WORKGROUP); p1 = __hip_atomic_fetch_add(&hcnt[e1], 1u, __ATOMIC_RELAXED, __HIP_MEMORY_SCOPE_WORKGROUP);
    }
    __syncthreads();
    if (F.tid < 32) hbase[F.tid] = hcnt[F.tid] ? __hip_atomic_fetch_add((unsigned*)(F.ctl + CW_ECNT + 64 * F.tid), hcnt[F.tid], RLX_AGENT) : 0u;
    __syncthreads();
    if (F.tid < 256) { const size_t q0 = (size_t)e0 * LCAP + hbase[e0] + p0, q1 = (size_t)e1 * LCAP + hbase[e1] + p1;
        LIST[q0] = (unsigned)row * 2u; LIST[q1] = (unsigned)row * 2u + 1u; LISTW[q0] = w0; LISTW[q1] = w1; LISTR[q0] = rstd; LISTR[q1] = rstd; }
    __syncthreads();
}
__device__ __forceinline__ void moe_tables(Frame& F) {
    LAS int* cum = (LAS int*)(F.lds + SCHED_OFF + 256); LAS int* cnt = cum + 40;
    if (F.tid == 0) { int a = 0; for (int e = 0; e < NE; ++e) { const int c = (int)__hip_atomic_load((unsigned*)(F.ctl + CW_ECNT + 64 * e), RLX_AGENT); cnt[e] = c; cum[e] = a; a += (c + 255) >> 8; } cum[NE] = a; }
    __syncthreads();
}

__device__ __forceinline__ void transpose_item64(const float* W, const int ld, const float* g, int k0, int n0, bf16* dst, int drow0, int dld, LAS bf16* tl, int lane) {
    const int c4 = (lane & 15) * 4, kr = lane >> 4;
    f32x4 v[16];
#pragma unroll
    for (int i = 0; i < 16; ++i) v[i] = *(const f32x4*)(W + (size_t)(k0 + kr + 4 * i) * ld + n0 + c4);
#pragma unroll
    for (int i = 0; i < 16; ++i) { const int k = kr + 4 * i; const float sc = g ? g[k0 + k] : 1.0f;
#pragma unroll
        for (int j = 0; j < 4; ++j) tl[(c4 + j) * 66 + k] = (bf16)(pk2(v[i][j] * sc, 0.f) & 0xffffu); }
    LDS_WAIT(); asm volatile("" ::: "memory");
    const int pc = (lane & 7) * 8, nr = lane >> 3;
#pragma unroll
    for (int i = 0; i < 8; ++i) { const int n = nr + 8 * i; const LAS unsigned* sp = (const LAS unsigned*)(tl + n * 66 + pc);
        v4u o; o.x = sp[0]; o.y = sp[1]; o.z = sp[2]; o.w = sp[3];
        *(GAS v4u*)(dst + (size_t)(drow0 + n) * dld + k0 + pc) = o; }
    LDS_WAIT(); asm volatile("" ::: "memory");
}
template <class Src>
__device__ __forceinline__ void transpose_item(const Src& src, int k0, int n0, bf16* dst, int drow0, int dld, LAS float* scr, int lane) {
#pragma unroll 8
    for (int i = 0; i < 32; ++i) { const int kk = 2 * i + (lane >> 5); scr[kk * 33 + (lane & 31)] = src(k0 + kk, n0 + (lane & 31)); }
    LDS_WAIT(); asm volatile("" ::: "memory");
    const int c = lane & 7;
#pragma unroll
    for (int j = 0; j < 4; ++j) { const int n = (lane >> 3) + 8 * j; const LAS float* s = scr + (8 * c) * 33 + n;
        v4u o; o.x = pk2(s[0 * 33], s[1 * 33]); o.y = pk2(s[2 * 33], s[3 * 33]); o.z = pk2(s[4 * 33], s[5 * 33]); o.w = pk2(s[6 * 33], s[7 * 33]);
        *(GAS v4u*)(dst + (size_t)(drow0 + n) * dld + k0 + 8 * c) = o; }
    LDS_WAIT(); asm volatile("" ::: "memory");
}
struct SrcScaled { const float* W; int ld; const float* g;
    __device__ __forceinline__ float operator()(int k, int n) const { const float w = W[(size_t)k * ld + n]; return g ? w * g[k] : w; } };

__device__ __forceinline__ void p0_prologue(Frame& F) {
    const float* x = F.in[0]; const float* g1 = F.in[1]; const float* w_in = F.in[2]; const float* wau = F.in[3];
    const float* gng = F.in[5]; const float* wgb = F.in[6]; const float* pw = F.in[7]; const float* ps = F.in[8]; const float* wpb = F.in[9];
    const float* wout = F.in[10]; const float* g2 = F.in[11]; const float* wrg = F.in[12]; const float* wre = F.in[14];
    const float* weg = F.in[16]; const float* weu = F.in[17]; const float* wed = F.in[18];
    bf16* WIN = WSP(bf16, WS_WIN); bf16* WG = WSP(bf16, WS_WG); bf16* WP = WSP(bf16, WS_WP); bf16* WOUT = WSP(bf16, WS_WOUT); bf16* WR = WSP(bf16, WS_WR);
    bf16* WGU = WSP(bf16, WS_WGU); bf16* WD = WSP(bf16, WS_WD); bf16* HB = WSP(bf16, WS_HB);
    {
        LAS float* PWL = (LAS float*)F.lds;
        LAS float* WL = (LAS float*)(F.lds + 65536);
        for (int it = F.bid; it < 64; it += F.G) {
            const int g = it >> 4, nb = it & 15;
            for (int i = F.tid; i < 128 * 128; i += 512) { const int d = i & 127; PWL[i] = pw[(size_t)g * 16384 + i] * ps[g * 128 + d]; }
            for (int i = F.tid; i < 128 * 64; i += 512) { const int d = i >> 6, n = i & 63; WL[i] = wpb[(size_t)(g * 128 + d) * D + nb * 64 + n]; }
            __syncthreads();
            const int n = F.tid & 63, cg = F.tid >> 6;
            float a[16];
#pragma unroll
            for (int ci = 0; ci < 16; ++ci) a[ci] = 0.f;
            for (int d = 0; d < 128; d += 4) {
                const float w0 = WL[(d + 0) * 64 + n], w1 = WL[(d + 1) * 64 + n], w2 = WL[(d + 2) * 64 + n], w3 = WL[(d + 3) * 64 + n];
#pragma unroll
                for (int ci = 0; ci < 16; ++ci) { const f32x4 p = *(const LAS f32x4*)(PWL + (cg * 16 + ci) * 128 + d); a[ci] += p[0] * w0 + p[1] * w1 + p[2] * w2 + p[3] * w3; }
            }
            v4u o0, o1; o0.x = pk2(a[0], a[1]); o0.y = pk2(a[2], a[3]); o0.z = pk2(a[4], a[5]); o0.w = pk2(a[6], a[7]); o1.x = pk2(a[8], a[9]); o1.y = pk2(a[10], a[11]); o1.z = pk2(a[12], a[13]); o1.w = pk2(a[14], a[15]);
            bf16* dp = WP + (size_t)(nb * 64 + n) * PW + g * 128 + cg * 16;
            *(GAS v4u*)dp = o0; *(GAS v4u*)(dp + 8) = o1;
            __syncthreads();
        }
    }
    LAS float* scr = (LAS float*)(F.lds + F.wave * 16384);
    const int gw = F.bid * 8 + F.wave, NGW = F.G * 8;
    constexpr int I_IN1 = 16 * (1536 / 32), I_IN2 = 16 * (2560 / 32), I_Z = 4 * 64, I_WG = 8 * 32, I_WO = 16 * 32, I_WR = 256;
    constexpr int NITEMS = I_IN1 + I_IN2 + I_Z + I_WG + I_WO + I_WR;
    for (int it = gw; it < NITEMS; it += NGW) {
        int r = it;
        if (r < I_IN1) { const int kb = r / 48, nb = r % 48; SrcScaled s{w_in, D_IN, g1}; transpose_item(s, 64 * kb, 32 * nb, WIN, 32 * nb, D, scr, F.lane); continue; } r -= I_IN1;
        if (r < I_IN2) { const int kb = r / 80, nb = r % 80; SrcScaled s{w_in, D_IN, g1}; transpose_item(s, 64 * kb, IN_U + 32 * nb, WIN, PJ_U + 32 * nb, D, scr, F.lane); continue; } r -= I_IN2;
        if (r < I_Z) {
            const int nb = r & 3, kb = r >> 2, n = nb * 64 + F.lane;
            float wa[16];
#pragma unroll
            for (int j = 0; j < 16; ++j) wa[j] = wau[j * GKW + n];
            float o[16];
#pragma unroll
            for (int kk = 0; kk < 16; ++kk) { const int k = kb * 16 + kk; const float* wr_ = w_in + (size_t)k * D_IN + IN_A; float a = 0.f;
#pragma unroll
                for (int j = 0; j < 16; ++j) a += wr_[j] * wa[j];
                o[kk] = a * g1[k]; }
            v4u o0, o1; o0.x = pk2(o[0], o[1]); o0.y = pk2(o[2], o[3]); o0.z = pk2(o[4], o[5]); o0.w = pk2(o[6], o[7]); o1.x = pk2(o[8], o[9]); o1.y = pk2(o[10], o[11]); o1.z = pk2(o[12], o[13]); o1.w = pk2(o[14], o[15]);
            bf16* dp = WIN + (size_t)(PJ_Z + n) * D + kb * 16; *(GAS v4u*)dp = o0; *(GAS v4u*)(dp + 8) = o1; continue; } r -= I_Z;
        if (r < I_WG) { const int kb = r / 32, nb = r % 32; SrcScaled s{wgb, D, gng}; transpose_item(s, 64 * kb, 32 * nb, WG, 32 * nb, GVW, scr, F.lane); continue; } r -= I_WG;
        if (r < I_WO) { const int kb = r / 32, nb = r % 32; SrcScaled s{wout, D, nullptr}; transpose_item(s, 64 * kb, 32 * nb, WOUT, 32 * nb, D, scr, F.lane); continue; } r -= I_WO;
        if (r < I_WR) {
            const int j = r; bf16* dp = WR + (size_t)j * D;
#pragma unroll
            for (int q = 0; q < 16; ++q) { const int k = q * 64 + F.lane; float v = 0.f;
                if (j < NG) v = wrg[(size_t)k * NG + j] * g2[k]; else if (j < NG + NE) { const int g = (j - NG) >> 3, e = (j - NG) & 7; v = wre[((size_t)g * D + k) * EPG + e] * g2[k]; }
                dp[k] = (bf16)f2bf(v); }
            continue; }
    }
    for (int m = gw; m < T / 2; m += NGW) {
        const GAS f32x4* xa = (const GAS f32x4*)(x + (size_t)m * D) + F.lane; const GAS f32x4* xb = (const GAS f32x4*)(x + (size_t)(m + T / 2) * D) + F.lane;
        f32x4 va[4], vb[4]; float sa = 0.f, sb = 0.f;
#pragma unroll
        for (int j = 0; j < 4; ++j) { va[j] = __builtin_nontemporal_load(xa + 64 * j); vb[j] = __builtin_nontemporal_load(xb + 64 * j); }
#pragma unroll
        for (int j = 0; j < 4; ++j) { sa += (va[j].x * va[j].x + va[j].y * va[j].y) + (va[j].z * va[j].z + va[j].w * va[j].w); sb += (vb[j].x * vb[j].x + vb[j].y * vb[j].y) + (vb[j].z * vb[j].z + vb[j].w * vb[j].w); }
        const float ra = 1.0f / sqrtf(wave_sum(sa) * (1.f / D) + EPS), rb = 1.0f / sqrtf(wave_sum(sb) * (1.f / D) + EPS);
        GAS v2u* oa = (GAS v2u*)(HB + (size_t)m * D) + F.lane; GAS v2u* ob = (GAS v2u*)(HB + (size_t)(m + T / 2) * D) + F.lane;
#pragma unroll
        for (int j = 0; j < 4; ++j) { v2u w; w.x = pk2(va[j].x * ra, va[j].y * ra); w.y = pk2(va[j].z * ra, va[j].w * ra); oa[64 * j] = w; w.x = pk2(vb[j].x * rb, vb[j].y * rb); w.y = pk2(vb[j].z * rb, vb[j].w * rb); ob[64 * j] = w; }
    }
}

__device__ __forceinline__ void moe_weight_items(Frame& F, const int widx, const int nworkers) {
    const float* g2 = F.in[11]; const float* weg = F.in[16]; const float* weu = F.in[17]; const float* wed = F.in[18];
    bf16* WGU = WSP(bf16, WS_WGU); bf16* WD = WSP(bf16, WS_WD);
    LAS bf16* tl = (LAS bf16*)(F.lds + F.wave * 16384);
    const int gw = widx * 8 + F.wave, NGW = nworkers * 8;
    constexpr int I_GU = NE * 2 * 16 * 4, I_WD = NE * 4 * 16;
    for (int it = gw; it < I_GU + I_WD; it += NGW) {
        int r = it;
        if (r < I_GU) {
            const int e = r / 128, q = r % 128, bj = q / 64, kb = (q % 64) / 4, nb = q % 4;
            const int hid0 = 64 * nb, pn = hid0 >> 7, i0 = hid0 & 127;
            transpose_item64((bj ? weu : weg) + (size_t)e * D * DE, DE, g2, 64 * kb, hid0, WGU + (size_t)e * 512 * D, pn * 256 + bj * 128 + i0, D, tl, F.lane); continue; } r -= I_GU;
        { const int e = r / 64, q = r % 64, kb = q / 16, nb = q % 16;
            transpose_item64(wed + (size_t)e * DE * D, D, nullptr, 64 * kb, 64 * nb, WD + (size_t)e * D * DE, 64 * nb, DE, tl, F.lane); }
    }
}

#define WG_SYNC() do { asm volatile("s_waitcnt lgkmcnt(0)" ::: "memory"); __builtin_amdgcn_s_barrier(); asm volatile("" ::: "memory"); } while (0)
constexpr int GL_QD = 0, GL_KD = 9216, GL_KET = 18432, GL_P = 27648, GL_VT = 36864, GL_DEC = 55296, GL_SS = 55552, GL_OT = 57600;
constexpr int GLS = 72, OTS = 132;
__device__ __forceinline__ void gla_unit(Frame& F, const int b, const int h, const int seg) {
    const bf16* PJ = WSP(bf16, WS_PJ); const float* BC = WSP(float, WS_BC); bf16* ON = WSP(bf16, WS_ON);
    int tid_ = threadIdx.x; asm volatile("" : "+v"(tid_));
    const int tid = tid_, lane = tid & 63, w = __builtin_amdgcn_readfirstlane(tid >> 6), fr = lane & 15, fq = lane >> 4;
    LAS bf16* QD = (LAS bf16*)(F.lds + GL_QD); LAS bf16* KD = (LAS bf16*)(F.lds + GL_KD); LAS bf16* KET = (LAS bf16*)(F.lds + GL_KET);
    LAS bf16* P = (LAS bf16*)(F.lds + GL_P); LAS bf16* VT = (LAS bf16*)(F.lds + GL_VT);
    LAS float* DEC = (LAS float*)(F.lds + GL_DEC); LAS float* OT = (LAS float*)(F.lds + GL_OT);
    f32x4 Sacc[4];
#pragma unroll
    for (int i = 0; i < 4; ++i) Sacc[i] = (f32x4){0.f, 0.f, 0.f, 0.f};
    const size_t rowbase = (size_t)b * SEQ + (size_t)seg * SEGCH * GCH;
    float* CUMB = WSP(float, WS_CUMB) + ((size_t)(b * GH + h) * (SEQ / GCH) + seg * SEGCH) * GDK; float cumb[8];
#pragma unroll
    for (int j = 0; j < 8; ++j) cumb[j] = 0.f;
    const int vsl = lane & 31, vbk = 2 * w + (lane >> 5);
    const int ot = tid >> 3, ov = (tid & 7) * 16;
    v4u qq, kq, vq0, vq1, rq0, rq1; f32x4 bq0, bq1; v4u qq2, kq2, vq02, vq12, rq02, rq12; f32x4 bq02, bq12;
#define GLA_LOADS(tb_, Q, K_, V0, V1, R0, R1, B0, B1) do { const size_t tb__ = (tb_); \
        const bf16* rp = PJ + (tb__ + lane) * NPJ + h * 64 + w * 8; Q = *(const v4u*)(rp + PJ_Q); K_ = *(const v4u*)(rp + PJ_K); \
        const float* bp = BC + (tb__ + lane) * GKW + h * 64 + w * 8; B0 = *(const f32x4*)bp; B1 = *(const f32x4*)(bp + 4); \
        const bf16* vp = PJ + (tb__ + vsl) * NPJ + PJ_V + h * 128 + vbk * 8; V0 = *(const v4u*)vp; V1 = *(const v4u*)(vp + (size_t)32 * NPJ); \
        const bf16* rr = PJ + (tb__ + ot) * NPJ + PJ_R + h * 128 + ov; R0 = *(const v4u*)rr; R1 = *(const v4u*)(rr + 8); } while (0)
    GLA_LOADS(rowbase, qq, kq, vq0, vq1, rq0, rq1, bq0, bq1);
    GLA_LOADS(rowbase + GCH, qq2, kq2, vq02, vq12, rq02, rq12, bq02, bq12);
    for (int n = 0; n < SEGCH; ++n) {
        const size_t tb = rowbase + (size_t)n * GCH;
        const v4u q8 = qq, k8 = kq, v80 = vq0, v81 = vq1, r80 = rq0, r81 = rq1; const f32x4 b80 = bq0, b81 = bq1;
        qq = qq2; kq = kq2; vq0 = vq02; vq1 = vq12; rq0 = rq02; rq1 = rq12; bq0 = bq02; bq1 = bq12;
        { const size_t tn = (n + 2 < SEGCH) ? tb + 2 * GCH : tb; GLA_LOADS(tn, qq2, kq2, vq02, vq12, rq02, rq12, bq02, bq12); }
        { float bx[8] = {b80[0], b80[1], b80[2], b80[3], b81[0], b81[1], b81[2], b81[3]}, qf[8], kf[8];
          { f32x4 a, c; unpack8(q8, a, c); qf[0] = a[0]; qf[1] = a[1]; qf[2] = a[2]; qf[3] = a[3]; qf[4] = c[0]; qf[5] = c[1]; qf[6] = c[2]; qf[7] = c[3];
            unpack8(k8, a, c); kf[0] = a[0]; kf[1] = a[1]; kf[2] = a[2]; kf[3] = a[3]; kf[4] = c[0]; kf[5] = c[1]; kf[6] = c[2]; kf[7] = c[3]; }
          float qd[8], kd[8], ke[8], dc[8];
          if (lane == 0) { *(f32x4*)(CUMB + (size_t)n * GDK + w * 8) = (f32x4){cumb[0], cumb[1], cumb[2], cumb[3]}; *(f32x4*)(CUMB + (size_t)n * GDK + w * 8 + 4) = (f32x4){cumb[4], cumb[5], cumb[6], cumb[7]}; }
#pragma unroll
          for (int j = 0; j < 8; ++j) { const float blast = __builtin_bit_cast(float, __builtin_amdgcn_readlane(__builtin_bit_cast(int, bx[j]), 63));
              cumb[j] += blast;
              const float eb = __expf(bx[j]), enb = __builtin_amdgcn_rcpf(eb); dc[j] = __expf(blast);
              qd[j] = qf[j] * eb * 0.125f; kd[j] = kf[j] * enb; ke[j] = kd[j] * dc[j]; }
          v4u o; o.x = pk2(qd[0], qd[1]); o.y = pk2(qd[2], qd[3]); o.z = pk2(qd[4], qd[5]); o.w = pk2(qd[6], qd[7]); *(LAS v4u*)(QD + lane * GLS + w * 8) = o;
          o.x = pk2(kd[0], kd[1]); o.y = pk2(kd[2], kd[3]); o.z = pk2(kd[4], kd[5]); o.w = pk2(kd[6], kd[7]); *(LAS v4u*)(KD + lane * GLS + w * 8) = o;
#pragma unroll
          for (int j = 0; j < 8; ++j) KET[(w * 8 + j) * GLS + lane] = (bf16)(pk2(ke[j], ke[j]) & 0xffffu);
          if (lane == 0) { *(LAS f32x4*)(DEC + w * 8) = (f32x4){dc[0], dc[1], dc[2], dc[3]}; *(LAS f32x4*)(DEC + w * 8 + 4) = (f32x4){dc[4], dc[5], dc[6], dc[7]}; }
          const unsigned vw0[4] = {v80.x, v80.y, v80.z, v80.w}, vw1[4] = {v81.x, v81.y, v81.z, v81.w};
#pragma unroll
          for (int j = 0; j < 4; ++j) { VT[(vbk * 8 + 2 * j) * GLS + vsl] = (bf16)(vw0[j] & 0xffffu); VT[(vbk * 8 + 2 * j + 1) * GLS + vsl] = (bf16)(vw0[j] >> 16);
              VT[(vbk * 8 + 2 * j) * GLS + vsl + 32] = (bf16)(vw1[j] & 0xffffu); VT[(vbk * 8 + 2 * j + 1) * GLS + vsl + 32] = (bf16)(vw1[j] >> 16); } }
        WG_SYNC();
        { const int tt = w >> 1, st0 = (w & 1) * 2;
          bf16x8 af[2];
#pragma unroll
          for (int ks = 0; ks < 2; ++ks) af[ks] = *(const LAS bf16x8*)(QD + (16 * tt + fr) * GLS + 32 * ks + 8 * fq);
#pragma unroll
          for (int q2 = 0; q2 < 2; ++q2) { const int st = st0 + q2; f32x4 c = (f32x4){0.f, 0.f, 0.f, 0.f};
              if (st <= tt) {
#pragma unroll
                  for (int ks = 0; ks < 2; ++ks) { const bf16x8 bfm = *(const LAS bf16x8*)(KD + (16 * st + fr) * GLS + 32 * ks + 8 * fq); c = __builtin_amdgcn_mfma_f32_16x16x32_bf16(af[ks], bfm, c, 0, 0, 0); } }
#pragma unroll
              for (int i = 0; i < 4; ++i) { const int t = 16 * tt + 4 * fq + i, sidx = 16 * st + fr; const float val = (sidx <= t) ? c[i] : 0.f; P[t * GLS + sidx] = (bf16)(pk2(val, val) & 0xffffu); } } }
        WG_SYNC();
        { bf16x8 vtf[2], sb[2];
#pragma unroll
          for (int ks = 0; ks < 2; ++ks) { vtf[ks] = *(const LAS bf16x8*)(VT + (16 * w + fr) * GLS + 32 * ks + 8 * fq);
              v4u pw_; pw_.x = pk2(Sacc[2 * ks][0], Sacc[2 * ks][1]); pw_.y = pk2(Sacc[2 * ks][2], Sacc[2 * ks][3]); pw_.z = pk2(Sacc[2 * ks + 1][0], Sacc[2 * ks + 1][1]); pw_.w = pk2(Sacc[2 * ks + 1][2], Sacc[2 * ks + 1][3]);
              sb[ks] = __builtin_bit_cast(bf16x8, pw_); }
          f32x4 o[4];
#pragma unroll
          for (int mt = 0; mt < 4; ++mt) { o[mt] = (f32x4){0.f, 0.f, 0.f, 0.f};
#pragma unroll
              for (int ks = 0; ks < 2; ++ks) { const bf16x8 a = *(const LAS bf16x8*)(P + (16 * mt + fr) * GLS + 32 * ks + 8 * fq); o[mt] = __builtin_amdgcn_mfma_f32_16x16x32_bf16(a, vtf[ks], o[mt], 0, 0, 0); }
#pragma unroll
              for (int ks = 0; ks < 2; ++ks) { const v2u lo = *(const LAS v2u*)(QD + (16 * mt + fr) * GLS + 32 * ks + 4 * fq), hi = *(const LAS v2u*)(QD + (16 * mt + fr) * GLS + 32 * ks + 16 + 4 * fq);
                  v4u aw; aw.x = lo.x; aw.y = lo.y; aw.z = hi.x; aw.w = hi.y; o[mt] = __builtin_amdgcn_mfma_f32_16x16x32_bf16(__builtin_bit_cast(bf16x8, aw), sb[ks], o[mt], 0, 0, 0); } }
#pragma unroll
          for (int mt = 0; mt < 4; ++mt) { const f32x4 d4 = *(const LAS f32x4*)(DEC + 16 * mt + 4 * fq); Sacc[mt] = Sacc[mt] * d4;
#pragma unroll
              for (int ks = 0; ks < 2; ++ks) { const bf16x8 a = *(const LAS bf16x8*)(KET + (16 * mt + fr) * GLS + 32 * ks + 8 * fq); Sacc[mt] = __builtin_amdgcn_mfma_f32_16x16x32_bf16(a, vtf[ks], Sacc[mt], 0, 0, 0); } }
#pragma unroll
          for (int mt = 0; mt < 4; ++mt)
#pragma unroll
              for (int i = 0; i < 4; ++i) OT[(16 * mt + 4 * fq + i) * OTS + 16 * w + fr] = o[mt][i]; }
        WG_SYNC();
        { f32x4 ov4[4]; float tot2 = 0.f;
#pragma unroll
          for (int q = 0; q < 4; ++q) { ov4[q] = *(const LAS f32x4*)(OT + ot * OTS + ov + 4 * q); tot2 += (ov4[q][0] * ov4[q][0] + ov4[q][1] * ov4[q][1]) + (ov4[q][2] * ov4[q][2] + ov4[q][3] * ov4[q][3]); }
          tot2 += dpp_f<0xB1>(tot2); tot2 += dpp_f<0x4E>(tot2); tot2 += dpp_f<0x141>(tot2);
          const float rstd = (seg == 0) ? __builtin_amdgcn_rsqf(tot2 * (1.0f / GDV) + EPS) : 1.0f;
          f32x4 r0, r1, r2, r3; unpack8(r80, r0, r1); unpack8(r81, r2, r3);
          if (seg != 0) { r0 = (f32x4){1.f, 1.f, 1.f, 1.f}; r1 = r0; r2 = r0; r3 = r0; }
          bf16* op = ON + (tb + ot) * GVW + h * 128 + ov;
          *(v4u*)op = pack8(ov4[0] * rstd * r0, ov4[1] * rstd * r1); *(v4u*)(op + 8) = pack8(ov4[2] * rstd * r2, ov4[3] * rstd * r3); }
    }
#undef GLA_LOADS
    if (seg + 1 < NSEG) {
        float* SL = WSP(float, WS_SLOC) + ((size_t)(b * GH + h) * NSEG + seg) * GDK * GDV;
#pragma unroll
        for (int mt = 0; mt < 4; ++mt)
#pragma unroll
            for (int i = 0; i < 4; ++i) SL[(16 * mt + 4 * fq + i) * GDV + 16 * w + fr] = Sacc[mt][i];
        if (lane == 0) { float* DT = WSP(float, WS_DTOT) + ((size_t)(b * GH + h) * NSEG + seg) * GDK + w * 8;
#pragma unroll
            for (int j = 0; j < 8; ++j) DT[j] = __expf(cumb[j]); }
    }
    WG_SYNC();
}
constexpr int FX_QD = 0, FX_SB = 9216, FX_OT = 27648;
__device__ __forceinline__ void gla_fix_unit(Frame& F, const int b, const int h, const int seg) {
    const bf16* PJ = WSP(bf16, WS_PJ); const float* BC = WSP(float, WS_BC); bf16* ON = WSP(bf16, WS_ON);
    int tid_ = threadIdx.x; asm volatile("" : "+v"(tid_));
    const int tid = tid_, lane = tid & 63, w = __builtin_amdgcn_readfirstlane(tid >> 6), fr = lane & 15, fq = lane >> 4;
    LAS bf16* QD2 = (LAS bf16*)(F.lds + FX_QD); LAS bf16* SB = (LAS bf16*)(F.lds + FX_SB); LAS float* OT = (LAS float*)(F.lds + FX_OT);
    { const float* SL = WSP(float, WS_SLOC) + (size_t)(b * GH + h) * NSEG * GDK * GDV; const float* DT = WSP(float, WS_DTOT) + (size_t)(b * GH + h) * NSEG * GDK;
#pragma unroll
      for (int j = 0; j < 8; ++j) { const int d = 8 * w + j; float s0 = 0.f, s1 = 0.f;
          for (int i = 0; i < seg; ++i) { const float dt = DT[i * GDK + d]; s0 = dt * s0 + SL[((size_t)i * GDK + d) * GDV + lane]; s1 = dt * s1 + SL[((size_t)i * GDK + d) * GDV + lane + 64]; }
          SB[lane * GLS + d] = (bf16)(pk2(s0, s0) & 0xffffu); SB[(lane + 64) * GLS + d] = (bf16)(pk2(s1, s1) & 0xffffu); } }
    const size_t rowbase = (size_t)b * SEQ + (size_t)seg * SEGCH * GCH;
    const float* CUMB = WSP(float, WS_CUMB) + ((size_t)(b * GH + h) * (SEQ / GCH) + seg * SEGCH) * GDK;
    const int ot = tid >> 3, ov = (tid & 7) * 16, dq = (tid & 7) * 8;
    v4u qq, oq0, oq1, rq0, rq1; f32x4 bq0, bq1, cq0, cq1;
#define FIX_LOADS(n_) do { const size_t tb__ = rowbase + (size_t)(n_) * GCH;         qq = *(const v4u*)(PJ + (tb__ + ot) * NPJ + PJ_Q + h * 64 + dq); const float* bp = BC + (tb__ + ot) * GKW + h * 64 + dq; bq0 = *(const f32x4*)bp; bq1 = *(const f32x4*)(bp + 4);         const float* cp = CUMB + (size_t)(n_) * GDK + dq; cq0 = *(const f32x4*)cp; cq1 = *(const f32x4*)(cp + 4);         const bf16* op_ = ON + (tb__ + ot) * GVW + h * 128 + ov; oq0 = *(const v4u*)op_; oq1 = *(const v4u*)(op_ + 8);         const bf16* rr = PJ + (tb__ + ot) * NPJ + PJ_R + h * 128 + ov; rq0 = *(const v4u*)rr; rq1 = *(const v4u*)(rr + 8); } while (0)
    FIX_LOADS(0);
    for (int n = 0; n < SEGCH; ++n) {
        const size_t tb = rowbase + (size_t)n * GCH;
        const v4u q8 = qq, o80 = oq0, o81 = oq1, r80 = rq0, r81 = rq1; const f32x4 b80 = bq0, b81 = bq1, c80 = cq0, c81 = cq1;
        if (n + 1 < SEGCH) FIX_LOADS(n + 1);
        { f32x4 qa, qb; unpack8(q8, qa, qb); f32x4 e0, e1;
#pragma unroll
          for (int j = 0; j < 4; ++j) { e0[j] = qa[j] * 0.125f * __expf(b80[j] + c80[j]); e1[j] = qb[j] * 0.125f * __expf(b81[j] + c81[j]); }
          *(LAS v4u*)(QD2 + ot * GLS + dq) = pack8(e0, e1); }
        WG_SYNC();
        { bf16x8 bfm[2];
#pragma unroll
          for (int ks = 0; ks < 2; ++ks) bfm[ks] = *(const LAS bf16x8*)(SB + (16 * w + fr) * GLS + 32 * ks + 8 * fq);
#pragma unroll
          for (int mt = 0; mt < 4; ++mt) { f32x4 c = (f32x4){0.f, 0.f, 0.f, 0.f};
#pragma unroll
              for (int ks = 0; ks < 2; ++ks) { const bf16x8 a = *(const LAS bf16x8*)(QD2 + (16 * mt + fr) * GLS + 32 * ks + 8 * fq); c = __builtin_amdgcn_mfma_f32_16x16x32_bf16(a, bfm[ks], c, 0, 0, 0); }
#pragma unroll
              for (int i = 0; i < 4; ++i) OT[(16 * mt + 4 * fq + i) * OTS + 16 * w + fr] = c[i]; } }
        WG_SYNC();
        { f32x4 t4[4], l0, l1, l2, l3; unpack8(o80, l0, l1); unpack8(o81, l2, l3);
          t4[0] = *(const LAS f32x4*)(OT + ot * OTS + ov) + l0; t4[1] = *(const LAS f32x4*)(OT + ot * OTS + ov + 4) + l1; t4[2] = *(const LAS f32x4*)(OT + ot * OTS + ov + 8) + l2; t4[3] = *(const LAS f32x4*)(OT + ot * OTS + ov + 12) + l3;
          float sq = 0.f;
#pragma unroll
          for (int q = 0; q < 4; ++q) sq += (t4[q][0] * t4[q][0] + t4[q][1] * t4[q][1]) + (t4[q][2] * t4[q][2] + t4[q][3] * t4[q][3]);
          sq += dpp_f<0xB1>(sq); sq += dpp_f<0x4E>(sq); sq += dpp_f<0x141>(sq);
          const float rstd = __builtin_amdgcn_rsqf(sq * (1.0f / GDV) + EPS);
          f32x4 r0, r1, r2, r3; unpack8(r80, r0, r1); unpack8(r81, r2, r3);
          bf16* op = ON + (tb + ot) * GVW + h * 128 + ov;
          *(v4u*)op = pack8(t4[0] * rstd * r0, t4[1] * rstd * r1); *(v4u*)(op + 8) = pack8(t4[2] * rstd * r2, t4[3] * rstd * r3); }
    }
#undef FIX_LOADS
    WG_SYNC();
}
__device__ __forceinline__ void pool_items(Frame& F, const int widx, const int nworkers) {
    const bf16* PJ = WSP(bf16, WS_PJ); bf16* PD = WSP(bf16, WS_PD);
    const int gw = widx * 8 + F.wave, NGW = nworkers * 8, cb = F.lane, wlen = 2 << (cb >> 4);
    constexpr int RUN = 32;
    for (int u = gw; u < T / RUN; u += NGW) {
        const int t0 = u * RUN, pos0 = t0 & (SEQ - 1);
        const bf16* base = PJ + (size_t)t0 * NPJ + PJ_U + cb * 8;
        f32x4 a0 = (f32x4){0.f, 0.f, 0.f, 0.f}, a1 = a0;
#pragma unroll
        for (int i = 1; i <= 16; ++i) { const bool in = (i <= wlen) && (i <= pos0); const v4u vw = *(const v4u*)(base - (size_t)(in ? i : 0) * NPJ); f32x4 u0, u1; unpack8(vw, u0, u1); const float m = in ? 1.f : 0.f; a0 += u0 * m; a1 += u1 * m; }
#pragma unroll 4
        for (int i = 0; i < RUN; ++i) {
            const int pos = pos0 + i; const bool drop = pos >= wlen;
            const v4u nw = *(const v4u*)(base + (size_t)i * NPJ), ow = *(const v4u*)(base + (size_t)(drop ? i - wlen : i) * NPJ);
            f32x4 n0, n1, o0, o1; unpack8(nw, n0, n1); unpack8(ow, o0, o1); const float m = drop ? 1.f : 0.f;
            a0 += n0 - o0 * m; a1 += n1 - o1 * m;
            const float inv = __builtin_amdgcn_rcpf((float)(pos + 1 < wlen ? pos + 1 : wlen));
            *(v4u*)(PD + (size_t)(t0 + i) * PW + cb * 8) = pack8(a0 * inv - n0, a1 * inv - n1);
        }
    }
}
__device__ __forceinline__ void p2a_phase(Frame& F) {
    constexpr int NU = BATCH * GH * NSEG;
    for (int u = F.bid; u < NU; u += F.G) gla_unit(F, u >> 4, (u >> 2) & 3, u & 3);
}
__device__ __forceinline__ void p2b_phase(Frame& F) {
    constexpr int NU = BATCH * GH * (NSEG - 1);
#pragma unroll 1
    for (int r_ = 0; r_ < REPS(10); ++r_)
    for (int u = F.bid; u < NU; u += F.G) gla_fix_unit(F, u / (GH * (NSEG - 1)), (u / (NSEG - 1)) % GH, 1 + u % (NSEG - 1));
#pragma unroll 1
    for (int r_ = 0; r_ < REPS(11); ++r_) pool_items(F, F.bid, F.G);
#pragma unroll 1
    for (int r_ = 0; r_ < REPS(12); ++r_) moe_weight_items(F, F.bid, F.G);
}

#if DBG
__device__ __forceinline__ void dbg_fail(Frame& F, unsigned code) { unsigned expect = 0u; __hip_atomic_compare_exchange_strong((unsigned*)(F.ctl + CW_DBG), &expect, code, __ATOMIC_RELAXED, __ATOMIC_RELAXED, __HIP_MEMORY_SCOPE_AGENT); }
__device__ __forceinline__ bool dbg_close(float got, float want) { return fabsf(got - want) <= 0.03f + 0.03f * fabsf(want); }
__device__ __forceinline__ void dbg_check_p1(Frame& F) {
    if (F.bid != 0 || F.tid >= 256) return;
    const float* x = F.in[0]; const float* g1 = F.in[1]; const float* w_in = F.in[2]; const float* wau = F.in[3]; const float* ba = F.in[4];
    const bf16* PJ = WSP(bf16, WS_PJ);
    const int tok = (int)(((unsigned)F.tid * 2654435761u) % (unsigned)T);
    const int col = (int)(((unsigned)F.tid * 40503u + 17u * (unsigned)F.tid * (unsigned)F.tid) % (unsigned)NPJ);
    const float* xr = x + (size_t)tok * D; float ss = 0.f;
    for (int k = 0; k < D; ++k) ss += xr[k] * xr[k];
    const float rstd = 1.0f / sqrtf(ss / D + EPS);
    float want;
    if (col >= PJ_Z && col < PJ_U) {
        return;
        float al[16];
#pragma unroll
        for (int j = 0; j < 16; ++j) al[j] = 0.f;
        for (int k = 0; k < D; ++k) { const float hk = xr[k] * rstd * g1[k];
#pragma unroll
            for (int j = 0; j < 16; ++j) al[j] += hk * w_in[(size_t)k * D_IN + IN_A + j]; }
        float z = 0.f;
#pragma unroll
        for (int j = 0; j < 16; ++j) z += al[j] * wau[j * GKW + (col - PJ_Z)];
        z += ba[col - PJ_Z];
        want = (fminf(z, 0.f) - logf(1.0f + expf(-fabsf(z)))) / 16.0f;
    } else {
        const int wc_ = col < PJ_Z ? col : col - PJ_U + IN_U; float a = 0.f;
        for (int k = 0; k < D; ++k) a += xr[k] * rstd * g1[k] * w_in[(size_t)k * D_IN + wc_];
        if (col >= PJ_R && col < PJ_Z) want = a / (1.0f + expf(-a)); else if (col >= PJ_GG) want = 1.0f / (1.0f + expf(-a)); else want = a;
    }
    const float got = bf1(PJ[(size_t)tok * NPJ + col]);
    if (!dbg_close(got, want)) dbg_fail(F, 1u);
}


__device__ __forceinline__ void dbg_check_bc(Frame& F) {
    if (F.bid != 5 || F.tid >= 64) return;
    const float* x = F.in[0]; const float* g1 = F.in[1]; const float* w_in = F.in[2]; const float* wau = F.in[3]; const float* ba = F.in[4]; const float* BC = WSP(float, WS_BC);
    const int offs[5] = {0, 1, 5, 18, 63}; const int off = (F.tid % 5 == 0) ? 0 : (F.tid % 5 == 1) ? 1 : (F.tid % 5 == 2) ? 5 : (F.tid % 5 == 3) ? 18 : 63; (void)offs;
    const int chunk = (int)(((unsigned)F.tid * 2654435761u) % (unsigned)(T / 64)), col = (int)(((unsigned)F.tid * 40503u + 3u) % (unsigned)GKW);
    float cum = 0.f;
    for (int r = 0; r <= off; ++r) { const float* xr = x + ((size_t)chunk * 64 + r) * D; float ss = 0.f; for (int k = 0; k < D; ++k) ss += xr[k] * xr[k];
        const float rstd = 1.0f / sqrtf(ss / D + EPS); float al[16];
#pragma unroll
        for (int j = 0; j < 16; ++j) al[j] = 0.f;
        for (int k = 0; k < D; ++k) { const float hk = xr[k] * rstd * g1[k];
#pragma unroll
            for (int j = 0; j < 16; ++j) al[j] += hk * w_in[(size_t)k * D_IN + IN_A + j]; }
        float z = ba[col];
#pragma unroll
        for (int j = 0; j < 16; ++j) z += al[j] * wau[j * GKW + col];
        cum += (fminf(z, 0.f) - logf(1.0f + expf(-fabsf(z)))) / 16.0f; }
    const float got = BC[((size_t)chunk * 64 + off) * GKW + col];
    if (fabsf(got - cum) > 0.004f + 0.01f * fabsf(cum)) dbg_fail(F, 7u);
}
__device__ __forceinline__ void dbg_check_gla(Frame& F) {
    if (F.bid != 1) return;
    const bf16* PJ = WSP(bf16, WS_PJ); const bf16* ON = WSP(bf16, WS_ON);
    const int b = 2, h = 1, v = F.tid & 127; const bool act = F.tid < 128;
    LAS float* S = (LAS float*)F.lds;
    LAS float* red = (LAS float*)(F.lds + 32768);
    if (act) for (int d = 0; d < 64; ++d) S[d * 128 + v] = 0.f;
    __syncthreads();
    bool bad = false;
    for (int t = 0; t < 1100; ++t) {
        const bf16* rp = PJ + ((size_t)b * SEQ + t) * NPJ; float o = 0.f;
        if (act) { const float vv = bf1(rp[PJ_V + h * 128 + v]);
            for (int d = 0; d < 64; ++d) { const float* bcp = WSP(float, WS_BC) + ((size_t)b * SEQ + t) * GKW + h * 64 + d; const float la = (t & 63) ? bcp[0] - bcp[-GKW] : bcp[0]; const float kk = bf1(rp[PJ_K + h * 64 + d]), qq = bf1(rp[PJ_Q + h * 64 + d]);
                const float sn = expf(la) * S[d * 128 + v] + kk * vv; S[d * 128 + v] = sn; o += qq * 0.125f * sn; }
            red[v] = o * o; }
        __syncthreads();
        if (act) { float ss = 0.f; for (int i = 0; i < 128; ++i) ss += red[i];
            const float want = o * (1.0f / sqrtf(ss / 128.f + EPS)) * bf1(rp[PJ_R + h * 128 + v]);
            const float got = bf1(ON[((size_t)b * SEQ + t) * GVW + h * 128 + v]);
            if ((t < 150 || t >= 1000) && !dbg_close(got, want)) bad = true; }
        __syncthreads();
    }
    if (bad) dbg_fail(F, 2u);
}
__device__ __forceinline__ void dbg_check_pool(Frame& F) {
    if (F.bid != 2) return;
    const bf16* PJ = WSP(bf16, WS_PJ); const bf16* PD = WSP(bf16, WS_PD);
    int tok = (int)(((unsigned)F.tid * 2654435761u) % (unsigned)T); if (F.tid < 40) tok = (F.tid & 1) * SEQ * 3 + (F.tid >> 1);
    const int c = (int)(((unsigned)F.tid * 40503u) % (unsigned)PW), pos = tok & (SEQ - 1), wlen = 2 << (c >> 7), cnt = pos + 1 < wlen ? pos + 1 : wlen;
    float a = 0.f; for (int i = 0; i < cnt; ++i) a += bf1(PJ[(size_t)(tok - i) * NPJ + PJ_U + c]);
    const float want = a / cnt - bf1(PJ[(size_t)tok * NPJ + PJ_U + c]);
    if (!dbg_close(bf1(PD[(size_t)tok * PW + c]), want)) dbg_fail(F, 3u);
}
__device__ __forceinline__ void dbg_check_mg(Frame& F) {
    if (F.bid != 3 || F.tid >= 64) return;
    const bf16* PJ = WSP(bf16, WS_PJ); const bf16* ON = WSP(bf16, WS_ON); const bf16* PD = WSP(bf16, WS_PD); const bf16* MG = WSP(bf16, WS_MG);
    const float* gng = F.in[5]; const float* wgb = F.in[6]; const float* pw = F.in[7]; const float* ps = F.in[8]; const float* wpb = F.in[9];
    const int tok = (int)(((unsigned)F.tid * 2654435761u + 12345u) % (unsigned)T), col = (int)(((unsigned)F.tid * 40503u + 77u) % (unsigned)D);
    float yg = 0.f; for (int k = 0; k < GVW; ++k) yg += bf1(ON[(size_t)tok * GVW + k]) * gng[k] * wgb[(size_t)k * D + col];
    float yp = 0.f;
    for (int g = 0; g < 4; ++g) for (int d = 0; d < 128; ++d) { float m = 0.f; for (int c = 0; c < 128; ++c) m += bf1(PD[(size_t)tok * PW + g * 128 + c]) * pw[((size_t)g * 128 + c) * 128 + d];
        yp += m * ps[g * 128 + d] * wpb[(size_t)(g * 128 + d) * D + col]; }
    const float want = bf1(PJ[(size_t)tok * NPJ + PJ_GG + col]) * yg + bf1(PJ[(size_t)tok * NPJ + PJ_GP + col]) * yp;
    if (!dbg_close(bf1(MG[(size_t)tok * D + col]), want)) dbg_fail(F, 4u);
}
__device__ __forceinline__ void dbg_check_x1(Frame& F) {
    if (F.bid != 4 || F.tid >= 128) return;
    const bf16* MG = WSP(bf16, WS_MG); const bf16* X1B = WSP(bf16, WS_X1B); const float* SSQ = WSP(float, WS_SSQ); const float* x = F.in[0]; const float* wout = F.in[10];
    const int tok = (int)(((unsigned)F.tid * 2654435761u + 999u) % (unsigned)T), col = (int)(((unsigned)F.tid * 40503u + 5u) % (unsigned)D);
    float a = x[(size_t)tok * D + col]; for (int k = 0; k < D; ++k) a += bf1(MG[(size_t)tok * D + k]) * wout[(size_t)k * D + col];
    if (!dbg_close(bf1(X1B[(size_t)tok * D + col]), a)) dbg_fail(F, 5u);
    float ss = 0.f; for (int k = 0; k < D; ++k) { const float v = bf1(X1B[(size_t)tok * D + k]); ss += v * v; }
    float sp = 0.f; for (int j = 0; j < 16; ++j) sp += SSQ[(size_t)tok * 16 + j];
    if (fabsf(ss - sp) > 1e-2f * ss) dbg_fail(F, 6u);
}
#endif

struct Args { const float* in[20]; float* out; unsigned char* ws; };
__global__ void __launch_bounds__(512, 2) fwd_kernel(Args args) {
    extern __shared__ __attribute__((aligned(16))) unsigned char lds[];
    Frame F;
    F.lds = (LAS unsigned char*)lds;
    F.MISC = (volatile LAS unsigned*)(F.lds + MISC_OFF);
    F.tid = threadIdx.x; F.lane = F.tid & 63; F.wave = __builtin_amdgcn_readfirstlane(F.tid >> 6);
    F.G = gridDim.x; F.bid = blockIdx.x;
    F.ws = args.ws; F.out = args.out; F.ctl = (gu32*)(args.ws + WS_CTL);
#pragma unroll
    for (int i = 0; i < 20; ++i) F.in[i] = args.in[i];
    for (int u = F.tid; u < (LDS_BYTES - RING_BYTES) / 4; u += 512) ((LAS unsigned*)(F.lds + RING_BYTES))[u] = 0u;
    __syncthreads();
    XcdBarrier bar = xcd_barrier_post((unsigned*)(F.ctl + CW_BAR), F.MISC + 8);
#define GRID_BAR() xcd_barrier(bar)

#pragma unroll 1
    for (int rep_ = 0; rep_ < REPS(0); ++rep_) p0_prologue(F);
    GRID_BAR();
    if (NPH > 1) {
        pg8::StaticSched S; S.init(WSP(bf16, WS_HB), D, WSP(bf16, WS_WIN), D, T, NPJ, F.G, F.bid);
        EpiP1 E{WSP(bf16, WS_PJ), F.in[4], WSP(float, WS_BC)};
#pragma unroll 1
        for (int rep_ = 0; rep_ < REPS(1); ++rep_) pg8::gemm_phase<EpiP1, pg8::StaticSched, false, true>(F.lds, D, D, D, S, E);
        GRID_BAR();
#if DBG
        dbg_check_p1(F); dbg_check_bc(F);
        GRID_BAR();
#endif
    }
    if (NPH > 2) {
#pragma unroll 1
        for (int rep_ = 0; rep_ < REPS(2); ++rep_) p2a_phase(F);
        GRID_BAR();
        p2b_phase(F);
        GRID_BAR();
#if DBG
        dbg_check_gla(F); dbg_check_pool(F);
        GRID_BAR();
#endif
    }
    if (NPH > 3) {
        pg8::StaticSched S; S.init(WSP(bf16, WS_ON), GVW, WSP(bf16, WS_WG), GVW, T, D, F.G, F.bid);
        EpiD E{WSP(bf16, WS_TG), WSP(bf16, WS_PJ)};
#pragma unroll 1
        for (int rep_ = 0; rep_ < REPS(3); ++rep_) pg8::gemm_phase<EpiD, pg8::StaticSched, false, true>(F.lds, GVW, GVW, GVW, S, E);
        GRID_BAR();
    }
    if (NPH > 4) {
        pg8::StaticSched S; S.init(WSP(bf16, WS_PD), PW, WSP(bf16, WS_WP), PW, T, D, F.G, F.bid);
        EpiE E{WSP(bf16, WS_MG), WSP(bf16, WS_TG), WSP(bf16, WS_PJ)};
#pragma unroll 1
        for (int rep_ = 0; rep_ < REPS(4); ++rep_) pg8::gemm_phase<EpiE, pg8::StaticSched, false, true>(F.lds, PW, PW, PW, S, E);
        GRID_BAR();
#if DBG
        dbg_check_mg(F);
        GRID_BAR();
#endif
    }
    if (NPH > 5) {
        pg8::StaticSched S; S.init(WSP(bf16, WS_MG), D, WSP(bf16, WS_WOUT), D, T, D, F.G, F.bid);
        EpiF E{F.in[0], WSP(bf16, WS_X1B), WSP(float, WS_SSQ)};
#pragma unroll 1
        for (int rep_ = 0; rep_ < REPS(5); ++rep_) pg8::gemm_phase<EpiF, pg8::StaticSched, false, true>(F.lds, D, D, D, S, E);
        GRID_BAR();
#if DBG
        dbg_check_x1(F);
        GRID_BAR();
#endif
    }
    if (NPH > 6) {
        pg8::StaticSched S; S.init(WSP(bf16, WS_X1B), D, WSP(bf16, WS_WR), D, T, 256, F.G, F.bid);
        EpiG E{WSP(float, WS_LG)};
#pragma unroll 1
        for (int rep_ = 0; rep_ < REPS(6); ++rep_) pg8::gemm_phase<EpiG, pg8::StaticSched, false, true>(F.lds, D, D, D, S, E);
        VM_WAIT(); __syncthreads();
        pg8::Unit u; for (int i = 0; S.next(i, u); ++i) route_rows(F, u.r0);
        GRID_BAR();
    }
    if (NPH > 7) {
        moe_tables(F);
        MoeSched S{(const LAS int*)(F.lds + SCHED_OFF + 256), (const LAS int*)(F.lds + SCHED_OFF + 256) + 40, WSP(unsigned, WS_LIST), (const char*)WSP(bf16, WS_X1B), (const char*)WSP(bf16, WS_WGU), 2, F.G, F.bid, 0};
        EpiH E{WSP(bf16, WS_ACT), WSP(float, WS_LISTR)};
#pragma unroll 1
        for (int rep_ = 0; rep_ < REPS(7); ++rep_) pg8::gemm_phase<EpiH, MoeSched, true, true>(F.lds, D, D, D, S, E);
        GRID_BAR();
    }
    if (NPH > 8) {
        MoeSched S{(const LAS int*)(F.lds + SCHED_OFF + 256), (const LAS int*)(F.lds + SCHED_OFF + 256) + 40, WSP(unsigned, WS_LIST), (const char*)WSP(bf16, WS_ACT), (const char*)WSP(bf16, WS_WD), 4, F.G, F.bid, 1};
        EpiI E{WSP(bf16, WS_Y), WSP(unsigned, WS_LIST), WSP(float, WS_LISTW)};
#pragma unroll 1
        for (int rep_ = 0; rep_ < REPS(8); ++rep_) pg8::gemm_phase<EpiI, MoeSched, false, true>(F.lds, DE, DE, DE, S, E);
        GRID_BAR();
    }
    if (NPH > 9) {
        const float* gf = F.in[19]; const bf16* X1B = WSP(bf16, WS_X1B); const bf16* Y = WSP(bf16, WS_Y);
        const int gw = F.bid * 8 + F.wave, NGW = F.G * 8;
        unsigned code = 0;
#if DBG
        code = __hip_atomic_load((unsigned*)(F.ctl + CW_DBG), RLX_AGENT);
        if (__hip_atomic_load((unsigned*)(F.ctl + CW_BAR) + XB_TMO, RLX_AGENT) != 0u) code = 9;
#endif
#pragma unroll 1
        for (int rep_ = 0; rep_ < REPS(9); ++rep_)
        for (int m = gw; m < T; m += NGW) {
            const GAS v2u* xr = (const GAS v2u*)(X1B + (size_t)m * D) + F.lane;
            const GAS v2u* y0 = (const GAS v2u*)(Y + (size_t)(2 * m) * D) + F.lane; const GAS v2u* y1 = (const GAS v2u*)(Y + (size_t)(2 * m + 1) * D) + F.lane;
            f32x4 v[4]; float s_ = 0.f;
#pragma unroll
            for (int j = 0; j < 4; ++j) { const v2u a = y0[64 * j], b = y1[64 * j], c = xr[64 * j]; v[j] = (f32x4){bflo(c.x), bfhi(c.x), bflo(c.y), bfhi(c.y)} + (f32x4){bflo(a.x), bfhi(a.x), bflo(a.y), bfhi(a.y)} + (f32x4){bflo(b.x), bfhi(b.x), bflo(b.y), bfhi(b.y)};
                s_ += (v[j].x * v[j].x + v[j].y * v[j].y) + (v[j].z * v[j].z + v[j].w * v[j].w); }
            const float rstd = 1.0f / sqrtf(wave_sum(s_) * (1.f / D) + EPS);
            GAS f32x4* o = (GAS f32x4*)(F.out + (size_t)m * D) + F.lane;
#pragma unroll
            for (int j = 0; j < 4; ++j) { const f32x4 g = *((const GAS f32x4*)gf + F.lane + 64 * j); f32x4 r = v[j] * rstd * g; if (code) r = (f32x4){10.f * code, 10.f * code, 10.f * code, 10.f * code}; o[64 * j] = r; }
        }
    } else
    {
        const float* gf = F.in[19]; const float* x = F.in[0];
        const int gw = F.bid * 8 + F.wave, NGW = F.G * 8;
        unsigned code = 0;
#if DBG
        code = __hip_atomic_load((unsigned*)(F.ctl + CW_DBG), RLX_AGENT);
        if (__hip_atomic_load((unsigned*)(F.ctl + CW_BAR) + XB_TMO, RLX_AGENT) != 0u) code = 9;
#endif
        for (int m = gw; m < T; m += NGW) {
            const GAS f32x4* xr = (const GAS f32x4*)(x + (size_t)m * D) + F.lane;
            f32x4 v[4]; float s = 0.f;
#pragma unroll
            for (int j = 0; j < 4; ++j) { v[j] = xr[64 * j]; s += (v[j].x * v[j].x + v[j].y * v[j].y) + (v[j].z * v[j].z + v[j].w * v[j].w); }
            const float rstd = 1.0f / sqrtf(wave_sum(s) * (1.f / D) + EPS);
            GAS f32x4* o = (GAS f32x4*)(F.out + (size_t)m * D) + F.lane;
#pragma unroll
            for (int j = 0; j < 4; ++j) { const f32x4 g = *((const GAS f32x4*)gf + F.lane + 64 * j); f32x4 r = v[j] * rstd * g; if (code) r = (f32x4){10.f * code, 10.f * code, 10.f * code, 10.f * code}; o[64 * j] = r; }
        }
    }
}

extern "C" void kernel_launch(void* const* d_in, const int* in_sizes, int n_in, void* d_out, int out_size, void* d_ws, size_t ws_size, hipStream_t stream) {
    static int grid = 0;
    if (grid == 0) {
        if (n_in != 20 || in_sizes[0] != T * D || out_size != T * D || ws_size < WS_END) { fprintf(stderr, "kernel_launch: unexpected shapes (n_in %d, in0 %d, out %d, ws %zu)\n", n_in, n_in > 0 ? in_sizes[0] : -1, out_size, ws_size); grid = -1; return; }
        int dev = 0, cus = 0, per_cu = 0;
        if (hipGetDevice(&dev) != hipSuccess || hipDeviceGetAttribute(&cus, hipDeviceAttributeMultiprocessorCount, dev) != hipSuccess) { grid = -1; return; }
        if (hipFuncSetAttribute((const void*)fwd_kernel, hipFuncAttributeMaxDynamicSharedMemorySize, LDS_BYTES) != hipSuccess) { fprintf(stderr, "kernel_launch: hipFuncSetAttribute failed\n"); grid = -1; return; }
        if (hipOccupancyMaxActiveBlocksPerMultiprocessor(&per_cu, (const void*)fwd_kernel, 512, LDS_BYTES) != hipSuccess || per_cu < 1) fprintf(stderr, "kernel_launch: occupancy query says %d\n", per_cu);
        (void)hipGetLastError();
        grid = cus;
    }
    if (grid < 0) return;
    if (hipMemsetAsync((char*)d_ws + WS_CTL, 0, CTL_ZERO_BYTES, stream) != hipSuccess) return;
    Args a{};
    for (int i = 0; i < 20; ++i) a.in[i] = (const float*)d_in[i];
    a.out = (float*)d_out; a.ws = (unsigned char*)d_ws;
    hipLaunchKernelGGL(fwd_kernel, dim3(grid), dim3(512), LDS_BYTES, stream, a);
}
```

```cpp
#include <hip/hip_runtime.h>
#include <cstdio>
#include <cstdint>

#ifndef DBG
#define DBG 0
#endif
#ifndef REPMASK
#define REPMASK 0
#endif
#define REPS(k) ((((REPMASK) >> (k)) & 1) ? 2 : 1)
#ifndef NPH
#define NPH 10
#endif

constexpr int BATCH = 16, SEQ = 4096, T = BATCH * SEQ, D = 1024;
constexpr int GH = 4, GDK = 64, GDV = 128, GKW = 256, GVW = 512, GRANK = 16, GCH = 64;
constexpr int PW = 512, PGW = 128;
constexpr int D_IN = 4112;
constexpr int IN_Q = 0, IN_K = 256, IN_V = 512, IN_R = 1024, IN_A = 1536, IN_U = 1552, IN_GG = 2064, IN_GP = 3088;
constexpr int NPJ = 4352;
constexpr int PJ_Q = 0, PJ_K = 256, PJ_V = 512, PJ_R = 1024, PJ_Z = 1536, PJ_U = 1792, PJ_GG = 2304, PJ_GP = 3328;
constexpr int NE = 32, EPG = 8, NG = 4, DE = 256;
constexpr int NSEG = 4, SEGCH = SEQ / GCH / NSEG;
constexpr int NA = 2 * T;
constexpr int LCAP = T;
constexpr float EPS = 1e-6f;

constexpr size_t MiB = 1u << 20;
constexpr size_t WS_CTL = 0, CTL_ZERO_BYTES = 1 * MiB;
constexpr size_t WS_WIN = 1 * MiB;
constexpr size_t WS_WG = 10 * MiB;
constexpr size_t WS_WP = 11 * MiB;
constexpr size_t WS_WOUT = 12 * MiB;
constexpr size_t WS_WR = 14 * MiB;
constexpr size_t WS_WGU = 15 * MiB;
constexpr size_t WS_WD = 47 * MiB;
constexpr size_t WS_HB = 64 * MiB;
constexpr size_t WS_TG = WS_HB;
constexpr size_t WS_MG = 192 * MiB;
constexpr size_t WS_SLOC = 256 * MiB;
constexpr size_t WS_DTOT = 264 * MiB;
constexpr size_t WS_CUMB = 265 * MiB;
constexpr size_t WS_BC = 192 * MiB;
constexpr size_t WS_Y = 64 * MiB;
constexpr size_t WS_ON = 320 * MiB;
constexpr size_t WS_PD = 384 * MiB;
constexpr size_t WS_ACT = 320 * MiB;
constexpr size_t WS_PJ = 448 * MiB;
constexpr size_t WS_X1B = 704 * MiB;
constexpr size_t WS_LG = 832 * MiB;
constexpr size_t WS_SSQ = 848 * MiB;
constexpr size_t WS_LIST = 852 * MiB;
constexpr size_t WS_LISTW = 864 * MiB;
constexpr size_t WS_LISTR = 872 * MiB;
constexpr size_t WS_END = 992 * MiB;
static_assert(WS_PJ + (size_t)T * NPJ * 2 <= WS_END && WS_LISTR + (size_t)NE * LCAP * 4 <= WS_END && WS_ACT + (size_t)(NA + NE * 256) * DE * 2 <= WS_PJ, "d_ws map");
constexpr int CW_TMO = 0, CW_DBG = 2;
constexpr int CW_BAR = 4096;
constexpr int CW_ECNT = 16384;

constexpr int RING_BYTES = 131072;
constexpr int MISC_OFF = RING_BYTES + 320;
constexpr int SCHED_OFF = RING_BYTES + 1024;
constexpr int LDS_BYTES = 147456;

#define GAS __attribute__((address_space(1)))
#define LAS __attribute__((address_space(3)))
typedef unsigned short bf16;
typedef unsigned v4u __attribute__((ext_vector_type(4)));
typedef unsigned v2u __attribute__((ext_vector_type(2)));
typedef float f32x4 __attribute__((ext_vector_type(4)));
typedef short bf16x8 __attribute__((ext_vector_type(8)));
typedef short bf16x4 __attribute__((ext_vector_type(4)));
typedef GAS unsigned gu32;
#define RLX_AGENT __ATOMIC_RELAXED, __HIP_MEMORY_SCOPE_AGENT
#define LDS_WAIT() asm volatile("s_waitcnt lgkmcnt(0)" ::: "memory")
#define VM_WAIT() asm volatile("s_waitcnt vmcnt(0)" ::: "memory")
__device__ __forceinline__ unsigned f2bf(float f) { unsigned u = __builtin_bit_cast(unsigned, f); return (u + 0x7fffu + ((u >> 16) & 1u)) >> 16; }
__device__ __forceinline__ unsigned pk2(float lo, float hi) { unsigned r; asm volatile("v_cvt_pk_bf16_f32 %0, %1, %2" : "=v"(r) : "v"(lo), "v"(hi)); return r; }
__device__ __forceinline__ float bflo(unsigned w) { return __builtin_bit_cast(float, w << 16); }
__device__ __forceinline__ float bfhi(unsigned w) { return __builtin_bit_cast(float, w & 0xffff0000u); }
__device__ __forceinline__ float bf1(bf16 h) { return __builtin_bit_cast(float, (unsigned)h << 16); }
__device__ __forceinline__ float fsigmoid(float x) { return __builtin_amdgcn_rcpf(1.0f + __expf(-x)); }
__device__ __forceinline__ float wave_sum(float v) {
#pragma unroll
    for (int o = 1; o < 64; o <<= 1) v += __shfl_xor(v, o);
    return v;
}


template <int CTRL> __device__ __forceinline__ float dpp_f(float x) { return __builtin_bit_cast(float, __builtin_amdgcn_update_dpp(0, __builtin_bit_cast(int, x), CTRL, 0xf, 0xf, true)); }
__device__ __forceinline__ float row16_sum(float x) { x += dpp_f<0x128>(x); x += dpp_f<0x124>(x); x += dpp_f<0x122>(x); x += dpp_f<0x121>(x); return x; }
__device__ __forceinline__ float row16_scan(float x) { x += dpp_f<0x111>(x); x += dpp_f<0x112>(x); x += dpp_f<0x114>(x); x += dpp_f<0x118>(x); return x; }

#define XB_TMO      128
#define XB_XCNT(j)  (256  + 64 * (j))
#define XB_XSUB(j)  (1280 + 64 * (j))
#define XB_XGEN(j)  (2304 + 64 * (j))
#define XB_TOP      3328
#define XB_TOPGEN   3392
#define XCD_BAR_WORDS 3456
#define XB_SPIN_CAP (1u << 18)
__device__ __forceinline__ unsigned xb_ld(unsigned* p)              { return __hip_atomic_load(p, __ATOMIC_RELAXED, __HIP_MEMORY_SCOPE_AGENT); }
__device__ __forceinline__ unsigned xb_add(unsigned* p, unsigned v) { return __hip_atomic_fetch_add(p, v, __ATOMIC_RELAXED, __HIP_MEMORY_SCOPE_AGENT); }
__device__ __forceinline__ unsigned xb_xcc_id() { return (unsigned)__builtin_amdgcn_s_getreg((3 << 11) | 20) & 0xFu; }
#define XB_SPIN(cond, bar) do { unsigned _sp = 0; while (cond) { __builtin_amdgcn_s_sleep(1); \
    if ((++_sp & 255u) == 0u) { if (xb_ld(&(bar)[XB_TMO])) break; if (_sp > XB_SPIN_CAP) { atomicAdd(&(bar)[XB_TMO], 1u); break; } } } } while (0)
struct XcdBarrier { unsigned* bar; unsigned x; volatile LAS unsigned* st; };
__device__ __forceinline__ XcdBarrier xcd_barrier_post(unsigned* bar, volatile LAS unsigned* st) {
    XcdBarrier b; b.bar = bar; b.x = xb_xcc_id(); b.st = st;
    if (threadIdx.x == 0) (void)xb_add(&bar[XB_XCNT(b.x)], 1u);
    return b;
}
__device__ __forceinline__ void xcd_barrier_complete(unsigned* bar, unsigned x, unsigned& nloc, unsigned& nx) {
    const unsigned G = gridDim.x * gridDim.y * gridDim.z;
    unsigned sum, cnt, mine, sp = 0u;
    for (;;) {
        sum = 0u; cnt = 0u; mine = 0u;
#pragma unroll
        for (unsigned j = 0; j < 16; ++j) { const unsigned c = xb_ld(&bar[XB_XCNT(j)]); sum += c; cnt += (c > 0u) ? 1u : 0u; mine = (j == x) ? c : mine; }
        if (sum == G) break;
        __builtin_amdgcn_s_sleep(1);
        if ((++sp & 255u) == 0u) { if (xb_ld(&bar[XB_TMO])) break; if (sp > XB_SPIN_CAP) { atomicAdd(&bar[XB_TMO], 1u); break; } }
    }
    nloc = mine > 0u ? mine : 1u; nx = cnt > 0u ? cnt : 1u;
}
__device__ __forceinline__ void xcd_barrier(const XcdBarrier& b) {
    asm volatile("s_waitcnt vmcnt(0)" ::: "memory");
    __syncthreads();
    if (threadIdx.x == 0) {
        unsigned* bar = b.bar;
        __builtin_amdgcn_s_waitcnt(0);
        unsigned nloc = b.st[0], nx = b.st[1];
        if (nloc == 0u) { xcd_barrier_complete(bar, b.x, nloc, nx); b.st[0] = nloc; b.st[1] = nx; }
        const unsigned old = xb_add(&bar[XB_XSUB(b.x)], 1u);
        const unsigned gen = old / nloc;
        if (old + 1u == (gen + 1u) * nloc) {
            __builtin_amdgcn_fence(__ATOMIC_RELEASE, "agent");
            asm volatile("s_waitcnt vmcnt(0)" ::: "memory");
            const unsigned og = xb_add(&bar[XB_TOP], 1u);
            const unsigned tg = og / nx;
            if (og + 1u == (tg + 1u) * nx) xb_add(&bar[XB_TOPGEN], 1u);
            else XB_SPIN(xb_ld(&bar[XB_TOPGEN]) == tg, bar);
            __builtin_amdgcn_fence(__ATOMIC_ACQUIRE, "agent");
            xb_add(&bar[XB_XGEN(b.x)], 1u);
            asm volatile("s_waitcnt vmcnt(0)" ::: "memory");
        } else {
            XB_SPIN(xb_ld(&bar[XB_XGEN(b.x)]) == gen, bar);
            __builtin_amdgcn_fence(__ATOMIC_ACQUIRE, "agent");
            asm volatile("s_waitcnt vmcnt(0)" ::: "memory");
        }
    }
    __syncthreads();
}

namespace pg8 {
#define PG8_LAS __attribute__((address_space(3)))
constexpr int BM = 256, BK = 64, HALF = 128, HTB = HALF * BK * 2, STAGE_BYTES = 8 * HTB, NXCD = 8, WGM = 8;
__host__ __device__ __forceinline__ int lds_byte(int r, int c) { const int st = (r >> 4) * 2 + (c >> 5), rr = r & 15, cc = c & 31, ob = rr * 64 + cc * 2; return st * 1024 + (ob ^ (((ob >> 9) & 1) << 5)); }
__host__ __device__ __forceinline__ void stage_rc(int b, int& R, int& C) { const int st = b / 1024, sb = b % 1024, swz = sb ^ (((sb >> 9) & 1) << 5); R = (st >> 1) * 16 + swz / 64; C = (st & 1) * 32 + (swz % 64) / 2; }
__host__ __device__ __forceinline__ int perm32(int rho) { const int n = rho >> 4, i = rho & 15; return 8 * (i >> 2) + 4 * n + (i & 3); }

struct Unit { const char* A; const char* B; int r0, c0, e, nvalid, lb, pad; };

__device__ __forceinline__ int remap_xcd(int L, int nwg) { const int q = nwg / NXCD, r = nwg % NXCD, xcd = L % NXCD, off = L / NXCD; return (xcd < r ? xcd * (q + 1) : r * (q + 1) + (xcd - r) * q) + off; }
struct StaticSched {
    const char* A; const char* B; int lda, ldb, nM, nN, nwg, G, c;
    __device__ __forceinline__ void init(const void* A_, int lda_, const void* B_, int ldb_, int M, int N, int G_, int c_) { A = (const char*)A_; B = (const char*)B_; lda = lda_; ldb = ldb_; nM = M / BM; nN = N / BM; nwg = nM * nN; G = G_; c = c_; }
    __device__ __forceinline__ bool next(int i, Unit& u) const {
        const long L = (long)i * G + c; if (L >= nwg) return false;
        const int wgid = remap_xcd((int)L, nwg);
        const int nig = WGM * nN, gid = wgid / nig, fm = gid * WGM, gsz = (nM - fm) < WGM ? (nM - fm) : WGM;
        const int pm = fm + ((wgid % nig) % gsz), pn = (wgid % nig) / gsz;
        u.A = A + (size_t)pm * BM * lda * 2; u.B = B + (size_t)pn * BM * ldb * 2; u.r0 = pm * BM; u.c0 = pn * BM; u.e = 0; u.nvalid = BM; u.lb = 0; u.pad = 0; return true;
    }
    __device__ __forceinline__ void fill_tab(const Unit&, PG8_LAS unsigned*) const {}
};

template <class Epi, class Sched, bool GATHER, bool ALIGN_EPI>
__device__ __forceinline__ void gemm_phase(PG8_LAS unsigned char* lds, const int K, const int lda, const int ldb, const Sched& S, const Epi& E) {
    int tid_ = threadIdx.x; asm volatile("" : "+v"(tid_));
    const int tid = tid_, wid = __builtin_amdgcn_readfirstlane(tid >> 6), lane = tid & 63, wr = wid >> 2, wc = wid & 3, fr = lane & 15, fq = lane >> 4;
    const int nt = K / BK;
    int Rr[2], Cc[2];
    unsigned voffA[2][2], voffB[2], nvA[2][2];
#pragma unroll
    for (int i = 0; i < 2; ++i) { int R, C; stage_rc(tid * 16 + i * 8192, R, C); Rr[i] = R; Cc[i] = C; const int Rb = Epi::PERM ? ((R & ~31) + perm32(R & 31)) : R;
        voffB[i] = (unsigned)(Rb * ldb + C) * 2u;
#pragma unroll
        for (int h = 0; h < 2; ++h) { voffA[h][i] = (unsigned)((R + HALF * h) * lda + C) * 2u; nvA[h][i] = voffA[h][i]; } }
    const size_t kstep = (size_t)(BK * 2);
    const size_t hstepB = (size_t)HALF * ldb * 2;
    const unsigned ldsw = (unsigned)wid * 1024u;
    const int aoff = lds_byte(wr * 64 + fr, fq * 8), boff = lds_byte(wc * 32 + fr, fq * 8);
#define PG8_SA(b, h) (((b) * 2 + (h)) * HTB)
#define PG8_SB(b, h) ((4 + (b) * 2 + (h)) * HTB)
#define PG8_STAGE(bufoff, gbase, voff) do { _Pragma("unroll") for (int _i = 0; _i < 2; ++_i) \
        __builtin_amdgcn_global_load_lds((const unsigned*)((const char*)(gbase) + (voff)[_i]), (PG8_LAS unsigned*)(lds + (bufoff) + ldsw + _i * 8192), 16, 0, 0); } while (0)
#define PG8_LDA(dst, b, h) do { _Pragma("unroll") for (int m = 0; m < 4; ++m) _Pragma("unroll") for (int k = 0; k < 2; ++k) dst[m][k] = *(const PG8_LAS bf16x8*)(lds + PG8_SA(b, h) + aoff + m * 2048 + k * 1024); } while (0)
#define PG8_LDB(dst, b, h) do { _Pragma("unroll") for (int n = 0; n < 2; ++n) _Pragma("unroll") for (int k = 0; k < 2; ++k) dst[n][k] = *(const PG8_LAS bf16x8*)(lds + PG8_SB(b, h) + boff + n * 2048 + k * 1024); } while (0)
#define PG8_MMA(ai, bj, At, Bt) do { __builtin_amdgcn_s_setprio(1); _Pragma("unroll") for (int m = 0; m < 4; ++m) _Pragma("unroll") for (int n = 0; n < 2; ++n) _Pragma("unroll") for (int k = 0; k < 2; ++k) \
        acc[ai][bj][m][n] = __builtin_amdgcn_mfma_f32_16x16x32_bf16(Bt[n][k], At[m][k], acc[ai][bj][m][n], 0, 0, 0); __builtin_amdgcn_s_setprio(0); } while (0)
#define PG8_WAIT_V(n) asm volatile("s_waitcnt vmcnt(" #n ")" ::: "memory")
#define PG8_WAIT_L(n) asm volatile("s_waitcnt lgkmcnt(" #n ")" ::: "memory")
#define PG8_BAR __builtin_amdgcn_s_barrier()
#define PG8_SCHED __builtin_amdgcn_sched_barrier(0)
    Unit cur, nxt; int ui = 0;
    if (!S.next(0, cur)) return;
    f32x4 acc[2][2][4][2];
#pragma unroll
    for (int a = 0; a < 2; ++a)
#pragma unroll
        for (int b = 0; b < 2; ++b)
#pragma unroll
            for (int m = 0; m < 4; ++m)
#pragma unroll
                for (int n = 0; n < 2; ++n) acc[a][b][m][n] = (f32x4){0.f, 0.f, 0.f, 0.f};
    bf16x8 At[4][2], B0[2][2], B1[2][2];
    const char* cA = cur.A; const char* cB = cur.B;
    PG8_LAS unsigned* gtab = (PG8_LAS unsigned*)(lds + STAGE_BYTES + 2048);
    if constexpr (GATHER) {
        S.fill_tab(cur, gtab);
        asm volatile("s_waitcnt lgkmcnt(0)" ::: "memory"); __builtin_amdgcn_s_barrier(); asm volatile("" ::: "memory");
#pragma unroll
        for (int h = 0; h < 2; ++h)
#pragma unroll
            for (int i = 0; i < 2; ++i) { voffA[h][i] = gtab[Rr[i] + HALF * h] + (unsigned)Cc[i] * 2u; nvA[h][i] = voffA[h][i]; }
    }
    PG8_STAGE(PG8_SB(0, 0), cB, voffB); PG8_STAGE(PG8_SB(0, 1), cB + hstepB, voffB); PG8_STAGE(PG8_SA(0, 0), cA, voffA[0]); PG8_STAGE(PG8_SA(0, 1), cA, voffA[1]);
    if (wr == 1) PG8_BAR;
    PG8_WAIT_V(2); PG8_BAR;
    PG8_STAGE(PG8_SB(1, 0), cB + kstep, voffB); PG8_STAGE(PG8_SA(1, 0), cA + kstep, voffA[0]); PG8_STAGE(PG8_SB(1, 1), cB + hstepB + kstep, voffB);
    PG8_WAIT_V(6); PG8_BAR;
    for (;;) {
        const bool has_next = S.next(ui + 1, nxt);
        const char* nA = has_next ? nxt.A : cA; const char* nB = has_next ? nxt.B : cB;
        if constexpr (GATHER) { if (has_next) S.fill_tab(nxt, gtab + ((ui + 1) & 1) * 256); }
#pragma unroll 1
        for (int t = 0; t < nt; t += 2) {
            const bool last = (t == nt - 2);
            const char* a1 = cA + (size_t)(t + 1) * kstep;
            const char* a2 = last ? nA : cA + (size_t)(t + 2) * kstep; const char* b2 = last ? nB : cB + (size_t)(t + 2) * kstep;
            const char* a3 = a2 + kstep; const char* b3 = b2 + kstep;
            unsigned sv[2][2];
            if constexpr (GATHER) {
                if (last && has_next) {
#pragma unroll
                    for (int h = 0; h < 2; ++h)
#pragma unroll
                        for (int i = 0; i < 2; ++i) nvA[h][i] = gtab[((ui + 1) & 1) * 256 + Rr[i] + HALF * h] + (unsigned)Cc[i] * 2u;
                }
#pragma unroll
                for (int h = 0; h < 2; ++h)
#pragma unroll
                    for (int i = 0; i < 2; ++i) sv[h][i] = last ? nvA[h][i] : voffA[h][i];
            } else {
#pragma unroll
                for (int h = 0; h < 2; ++h)
#pragma unroll
                    for (int i = 0; i < 2; ++i) sv[h][i] = voffA[h][i];
            }
            PG8_LDB(B0, 0, 0); PG8_LDB(B1, 0, 1); PG8_SCHED; PG8_LDA(At, 0, 0); PG8_STAGE(PG8_SA(1, 1), a1, voffA[1]);
            PG8_WAIT_V(8); PG8_WAIT_L(0); PG8_BAR; PG8_MMA(0, 0, At, B0); PG8_MMA(0, 1, At, B1); PG8_BAR; PG8_SCHED;
            PG8_LDA(At, 0, 1); PG8_STAGE(PG8_SB(0, 0), b2, voffB); PG8_STAGE(PG8_SB(0, 1), b2 + hstepB, voffB); PG8_STAGE(PG8_SA(0, 0), a2, sv[0]);
            PG8_WAIT_V(8); PG8_WAIT_L(0); PG8_BAR; PG8_MMA(1, 0, At, B0); PG8_MMA(1, 1, At, B1); PG8_BAR; PG8_SCHED;
            PG8_LDB(B0, 1, 0); PG8_LDB(B1, 1, 1); PG8_SCHED; PG8_LDA(At, 1, 0); PG8_STAGE(PG8_SA(0, 1), a2, sv[1]);
            PG8_WAIT_V(8); PG8_WAIT_L(0); PG8_BAR; PG8_MMA(0, 0, At, B0); PG8_MMA(0, 1, At, B1); PG8_BAR; PG8_SCHED;
            PG8_LDA(At, 1, 1); PG8_STAGE(PG8_SB(1, 0), b3, voffB); PG8_STAGE(PG8_SB(1, 1), b3 + hstepB, voffB); PG8_STAGE(PG8_SA(1, 0), a3, sv[0]);
            PG8_WAIT_V(8); PG8_WAIT_L(0); PG8_BAR; PG8_MMA(1, 0, At, B0); PG8_MMA(1, 1, At, B1); PG8_BAR; PG8_SCHED;
        }
        if constexpr (ALIGN_EPI) { if (wr == 0) PG8_BAR; }
        E(acc, cur, wr, wc, fr, fq);
        if (!has_next) break;
        if (!(cur.pad & 1)) {
#pragma unroll
        for (int a = 0; a < 2; ++a)
#pragma unroll
            for (int b = 0; b < 2; ++b)
#pragma unroll
                for (int m = 0; m < 4; ++m)
#pragma unroll
                    for (int n = 0; n < 2; ++n) acc[a][b][m][n] = (f32x4){0.f, 0.f, 0.f, 0.f};
        }
        cur = nxt; cA = nA; cB = nB; ++ui;
        if constexpr (GATHER) {
#pragma unroll
            for (int h = 0; h < 2; ++h)
#pragma unroll
                for (int i = 0; i < 2; ++i) voffA[h][i] = nvA[h][i];
        }
        if constexpr (ALIGN_EPI) { if (wr == 1) PG8_BAR; }
    }
    PG8_WAIT_V(0);
    if constexpr (!ALIGN_EPI) { if (wr == 0) PG8_BAR; }
    PG8_BAR;
#undef PG8_SA
#undef PG8_SB
#undef PG8_STAGE
#undef PG8_LDA
#undef PG8_LDB
#undef PG8_MMA
#undef PG8_WAIT_V
#undef PG8_WAIT_L
#undef PG8_BAR
#undef PG8_SCHED
}
}

struct Frame {
    LAS unsigned char* lds;
    volatile LAS unsigned* MISC;
    gu32* ctl;
    int tid, lane, wave, G, bid;
    const float* in[20]; float* out; unsigned char* ws;
};
#define WSP(T_, off) ((T_*)(F.ws + (off)))

__device__ __forceinline__ v4u pack8(const f32x4 a, const f32x4 b) { v4u w; w.x = pk2(a[0], a[1]); w.y = pk2(a[2], a[3]); w.z = pk2(b[0], b[1]); w.w = pk2(b[2], b[3]); return w; }
__device__ __forceinline__ void unpack8(const v4u w, f32x4& a, f32x4& b) { a = (f32x4){bflo(w.x), bfhi(w.x), bflo(w.y), bfhi(w.y)}; b = (f32x4){bflo(w.z), bfhi(w.z), bflo(w.w), bfhi(w.w)}; }

struct EpiP1 {
    static constexpr bool PERM = true;
    bf16* PJ; const float* b_alpha; float* BC;
    __device__ __forceinline__ void operator()(const f32x4 (&acc)[2][2][4][2], const pg8::Unit& u, int wr, int wc, int fr, int fq) const {
        const int pn = u.c0 >> 8;
        const int mode = (pn == 4 || pn == 5) ? 1 : (pn == 6) ? 2 : (pn >= 9) ? 3 : 0;
        const int row0 = u.r0 + wr * 64 + fr, col0 = u.c0 + wc * 32 + 8 * fq;
        f32x4 bv[2][2];
        const int bidx = (mode == 2) ? (col0 - PJ_Z) : 0;
#pragma unroll
        for (int bj = 0; bj < 2; ++bj)
#pragma unroll
            for (int n = 0; n < 2; ++n) { bv[bj][n] = *(const f32x4*)(b_alpha + bidx + bj * 128 + 4 * n); asm volatile("" :: "v"(bv[bj][n])); }
        if (mode == 2) {
#pragma unroll
            for (int ai = 0; ai < 2; ++ai)
#pragma unroll
                for (int bj = 0; bj < 2; ++bj) { f32x4 pr[4][2];
#pragma unroll
                    for (int n = 0; n < 2; ++n)
#pragma unroll
                        for (int j = 0; j < 4; ++j) { float carry = 0.f;
#pragma unroll
                            for (int m = 0; m < 4; ++m) { const float z = acc[ai][bj][m][n][j] + bv[bj][n][j]; const float la = (fminf(z, 0.f) - __logf(1.0f + __expf(-fabsf(z)))) * (1.0f / 16.0f);
                                pr[m][n][j] = row16_scan(la) + carry; carry += row16_sum(la); } }
#pragma unroll
                    for (int m = 0; m < 4; ++m) { float* bp = BC + (size_t)(row0 + ai * 128 + m * 16) * GKW + (col0 - PJ_Z) + bj * 128; *(f32x4*)bp = pr[m][0]; *(f32x4*)(bp + 4) = pr[m][1]; } }
            return;
        }
#pragma unroll
        for (int ai = 0; ai < 2; ++ai)
#pragma unroll
            for (int m = 0; m < 4; ++m) { bf16* rowp = PJ + (size_t)(row0 + ai * 128 + m * 16) * NPJ + col0;
#pragma unroll
                for (int bj = 0; bj < 2; ++bj) { f32x4 v[2] = {acc[ai][bj][m][0], acc[ai][bj][m][1]};
                    if (mode == 1) {
#pragma unroll
                        for (int n = 0; n < 2; ++n)
#pragma unroll
                            for (int j = 0; j < 4; ++j) v[n][j] = v[n][j] * fsigmoid(v[n][j]);
                    } else if (mode == 3) {
#pragma unroll
                        for (int n = 0; n < 2; ++n)
#pragma unroll
                            for (int j = 0; j < 4; ++j) v[n][j] = fsigmoid(v[n][j]);
                    }
                    *(v4u*)(rowp + bj * 128) = pack8(v[0], v[1]); } }
    }
};

struct EpiD {
    static constexpr bool PERM = true;
    bf16* TG; const bf16* PJ;
    __device__ __forceinline__ void operator()(const f32x4 (&acc)[2][2][4][2], const pg8::Unit& u, int wr, int wc, int fr, int fq) const {
        const int row0 = u.r0 + wr * 64 + fr, col0 = u.c0 + wc * 32 + 8 * fq;
#pragma unroll
        for (int ai = 0; ai < 2; ++ai)
#pragma unroll
            for (int m = 0; m < 4; ++m) { const size_t row = (size_t)(row0 + ai * 128 + m * 16);
#pragma unroll
                for (int bj = 0; bj < 2; ++bj) { const int c = col0 + bj * 128; const v4u gw = *(const v4u*)(PJ + row * NPJ + PJ_GG + c); f32x4 g0, g1; unpack8(gw, g0, g1);
                    *(v4u*)(TG + row * D + c) = pack8(acc[ai][bj][m][0] * g0, acc[ai][bj][m][1] * g1); } }
    }
};
struct EpiE {
    static constexpr bool PERM = true;
    bf16* MG; const bf16* TG; const bf16* PJ;
    __device__ __forceinline__ void operator()(const f32x4 (&acc)[2][2][4][2], const pg8::Unit& u, int wr, int wc, int fr, int fq) const {
        const int row0 = u.r0 + wr * 64 + fr, col0 = u.c0 + wc * 32 + 8 * fq;
#pragma unroll
        for (int ai = 0; ai < 2; ++ai)
#pragma unroll
            for (int m = 0; m < 4; ++m) { const size_t row = (size_t)(row0 + ai * 128 + m * 16);
#pragma unroll
                for (int bj = 0; bj < 2; ++bj) { const int c = col0 + bj * 128; const v4u gw = *(const v4u*)(PJ + row * NPJ + PJ_GP + c); const v4u tw = *(const v4u*)(TG + row * D + c);
                    f32x4 g0, g1, t0, t1; unpack8(gw, g0, g1); unpack8(tw, t0, t1);
                    *(v4u*)(MG + row * D + c) = pack8(t0 + acc[ai][bj][m][0] * g0, t1 + acc[ai][bj][m][1] * g1); } }
    }
};
struct EpiF {
    static constexpr bool PERM = true;
    const float* x; bf16* X1B; float* SSQ;
    __device__ __forceinline__ void operator()(const f32x4 (&acc)[2][2][4][2], const pg8::Unit& u, int wr, int wc, int fr, int fq) const {
        const int row0 = u.r0 + wr * 64 + fr, col0 = u.c0 + wc * 32 + 8 * fq;
#pragma unroll
        for (int ai = 0; ai < 2; ++ai)
#pragma unroll
            for (int m = 0; m < 4; ++m) { const size_t row = (size_t)(row0 + ai * 128 + m * 16); float ss = 0.f;
#pragma unroll
                for (int bj = 0; bj < 2; ++bj) { const int c = col0 + bj * 128; const f32x4 x0 = *(const f32x4*)(x + row * D + c), x1 = *(const f32x4*)(x + row * D + c + 4);
                    const f32x4 y0 = x0 + acc[ai][bj][m][0], y1 = x1 + acc[ai][bj][m][1];
                    *(v4u*)(X1B + row * D + c) = pack8(y0, y1);
                    ss += (y0[0] * y0[0] + y0[1] * y0[1]) + (y0[2] * y0[2] + y0[3] * y0[3]) + (y1[0] * y1[0] + y1[1] * y1[1]) + (y1[2] * y1[2] + y1[3] * y1[3]); }
                ss += __shfl_xor(ss, 16); ss += __shfl_xor(ss, 32);
                if (fq == 0) SSQ[row * 16 + (u.c0 >> 8) * 4 + wc] = ss; }
    }
};


struct MoeSched {
    const LAS int* cum; const LAS int* cnt; const unsigned* LIST;
    const char* Abase; const char* Bbase; int NT, G, c, mode;
    __device__ __forceinline__ bool next(int i, pg8::Unit& u) const {
        const int nunits = __builtin_amdgcn_readfirstlane(cum[NE]) * NT; const long L = (long)i * G + c; if (L >= nunits) return false;
        const int wgid = pg8::remap_xcd((int)L, nunits), gb = wgid / NT, pn = wgid % NT;
        int e_ = 0;
#pragma unroll 8
        for (int j = 1; j < NE; ++j) e_ += (cum[j] <= gb) ? 1 : 0;
        const int e = __builtin_amdgcn_readfirstlane(e_);
        const int blk = gb - __builtin_amdgcn_readfirstlane(cum[e]), rem = __builtin_amdgcn_readfirstlane(cnt[e]) - blk * 256;
        u.e = e; u.nvalid = rem < 256 ? rem : 256; u.lb = e * LCAP + blk * 256; u.r0 = gb * 256; u.pad = 0;
        if (mode == 0) { u.A = Abase; u.B = Bbase + ((size_t)e * 512 + (size_t)pn * 256) * D * 2; u.c0 = pn * 128; }
        else { u.A = Abase + (size_t)gb * 256 * DE * 2; u.B = Bbase + ((size_t)e * D + (size_t)pn * 256) * DE * 2; u.c0 = pn * 256; }
        return true;
    }
    __device__ __forceinline__ void fill_tab(const pg8::Unit& u, LAS unsigned* tab) const {
        const int t = threadIdx.x;
        if (t < 256) { const int lp = t < u.nvalid ? t : u.nvalid - 1; const unsigned slot = LIST[u.lb + lp]; tab[t] = (slot >> 1) * (unsigned)(D * 2); }
    }
};
struct EpiG {
    static constexpr bool PERM = false;
    float* LG;
    __device__ __forceinline__ void operator()(const f32x4 (&acc)[2][2][4][2], const pg8::Unit& u, int wr, int wc, int fr, int fq) const {
        if (wc >= 2) return;
        const int row0 = u.r0 + wr * 64 + fr;
#pragma unroll
        for (int ai = 0; ai < 2; ++ai)
#pragma unroll
            for (int m = 0; m < 4; ++m)
#pragma unroll
                for (int n = 0; n < 2; ++n) *(f32x4*)(LG + (size_t)(row0 + ai * 128 + m * 16) * 64 + 32 * wc + 16 * n + 4 * fq) = acc[ai][0][m][n];
    }
};
struct EpiH {
    static constexpr bool PERM = true;
    bf16* ACT; const float* LISTR;
    __device__ __forceinline__ void operator()(const f32x4 (&acc)[2][2][4][2], const pg8::Unit& u, int wr, int wc, int fr, int fq) const {
        float rs[2][4];
#pragma unroll
        for (int ai = 0; ai < 2; ++ai)
#pragma unroll
            for (int m = 0; m < 4; ++m) { const int rl = ai * 128 + wr * 64 + m * 16 + fr, lp = rl < u.nvalid ? rl : u.nvalid - 1; rs[ai][m] = LISTR[u.lb + lp]; }
#pragma unroll
        for (int ai = 0; ai < 2; ++ai)
#pragma unroll
            for (int m = 0; m < 4; ++m) { asm volatile("" :: "v"(rs[ai][m])); }
#pragma unroll
        for (int ai = 0; ai < 2; ++ai)
#pragma unroll
            for (int m = 0; m < 4; ++m) { const int rl = ai * 128 + wr * 64 + m * 16 + fr; const float r = rs[ai][m]; f32x4 a[2];
#pragma unroll
                for (int n = 0; n < 2; ++n)
#pragma unroll
                    for (int j = 0; j < 4; ++j) { const float g = acc[ai][0][m][n][j] * r, up = acc[ai][1][m][n][j] * r; a[n][j] = g * fsigmoid(g) * up; }
                *(v4u*)(ACT + (size_t)(u.r0 + rl) * DE + u.c0 + wc * 32 + 8 * fq) = pack8(a[0], a[1]); }
    }
};
struct EpiI {
    static constexpr bool PERM = true;
    bf16* Y; const unsigned* LIST; const float* LISTW;
    __device__ __forceinline__ void operator()(const f32x4 (&acc)[2][2][4][2], const pg8::Unit& u, int wr, int wc, int fr, int fq) const {
#pragma unroll
        for (int ai = 0; ai < 2; ++ai) {
            unsigned sl[4]; float gw[4];
#pragma unroll
            for (int m = 0; m < 4; ++m) { const int rl = ai * 128 + wr * 64 + m * 16 + fr, lp = rl < u.nvalid ? rl : u.nvalid - 1; sl[m] = LIST[u.lb + lp]; gw[m] = LISTW[u.lb + lp]; }
#pragma unroll
            for (int m = 0; m < 4; ++m) { asm volatile("" :: "v"(gw[m]), "v"(sl[m])); }
#pragma unroll
            for (int m = 0; m < 4; ++m) { const int rl = ai * 128 + wr * 64 + m * 16 + fr; const float g = gw[m];
                if (rl < u.nvalid) {
#pragma unroll
                    for (int bj = 0; bj < 2; ++bj) *(v4u*)(Y + (size_t)sl[m] * D + u.c0 + bj * 128 + wc * 32 + 8 * fq) = pack8(acc[ai][bj][m][0] * g, acc[ai][bj][m][1] * g); } }
        }
    }
};
__device__ __forceinline__ void route_rows(Frame& F, const int r0) {
    const float* LG = WSP(float, WS_LG); const float* SSQ = WSP(float, WS_SSQ); const float* brg = F.in[13]; const float* bre = F.in[15];
    unsigned* LIST = WSP(unsigned, WS_LIST); float* LISTW = WSP(float, WS_LISTW); float* LISTR = WSP(float, WS_LISTR);
    LAS unsigned* hcnt = (LAS unsigned*)(F.lds + SCHED_OFF); LAS unsigned* hbase = hcnt + 32;
    if (F.tid < 32) hcnt[F.tid] = 0u;
    __syncthreads();
    int e0 = 0, e1 = 0; unsigned p0 = 0, p1 = 0; float w0 = 0.f, w1 = 0.f, rstd = 0.f; const int row = r0 + F.tid;
    if (F.tid < 256) {
        float ss = 0.f;
#pragma unroll
        for (int j = 0; j < 16; ++j) ss += SSQ[(size_t)row * 16 + j];
        rstd = 1.0f / sqrtf(ss * (1.0f / D) + EPS);
        const float* lr = LG + (size_t)row * 64;
        float gl[4];
#pragma unroll
        for (int g = 0; g < 4; ++g) gl[g] = __hip_atomic_load(lr + g, RLX_AGENT) * rstd + brg[g];
        int gi = 0; float gm = gl[0];
#pragma unroll
        for (int g = 1; g < 4; ++g) if (gl[g] > gm) { gm = gl[g]; gi = g; }
        float den = 0.f;
#pragma unroll
        for (int g = 0; g < 4; ++g) den += expf(gl[g] - gm);
        const float gp = 1.0f / den;
        float el[8];
#pragma unroll
        for (int e = 0; e < 8; ++e) el[e] = __hip_atomic_load(lr + 4 + gi * 8 + e, RLX_AGENT) * rstd + bre[gi * 8 + e];
        int i0 = 0; float m0 = el[0];
#pragma unroll
        for (int e = 1; e < 8; ++e) if (el[e] > m0) { m0 = el[e]; i0 = e; }
        int i1 = -1; float m1 = 0.f;
#pragma unroll
        for (int e = 0; e < 8; ++e) if (e != i0 && (i1 < 0 || el[e] > m1)) { m1 = el[e]; i1 = e; }
        const float q = expf(m1 - m0); w0 = gp / (1.0f + q); w1 = gp * q / (1.0f + q);
        e0 = gi * 8 + i0; e1 = gi * 8 + i1;
        p0 = __hip_atomic_fetch_add(&hcnt[e0], 1u, __ATOMIC_RELAXED, __HIP_MEMORY_SCOPE_WORKGROUP); p1 = __hip_atomic_fetch_add(&hcnt[e1], 1u, __ATOMIC_RELAXED, __HIP_MEMORY_SCOPE_WORKGROUP);
    }
    __syncthreads();
    if (F.tid < 32) hbase[F.tid] = hcnt[F.tid] ? __hip_atomic_fetch_add((unsigned*)(F.ctl + CW_ECNT + 64 * F.tid), hcnt[F.tid], RLX_AGENT) : 0u;
    __syncthreads();
    if (F.tid < 256) { const size_t q0 = (size_t)e0 * LCAP + hbase[e0] + p0, q1 = (size_t)e1 * LCAP + hbase[e1] + p1;
        LIST[q0] = (unsigned)row * 2u; LIST[q1] = (unsigned)row * 2u + 1u; LISTW[q0] = w0; LISTW[q1] = w1; LISTR[q0] = rstd; LISTR[q1] = rstd; }
    __syncthreads();
}
__device__ __forceinline__ void moe_tables(Frame& F) {
    LAS int* cum = (LAS int*)(F.lds + SCHED_OFF + 256); LAS int* cnt = cum + 40;
    if (F.tid == 0) { int a = 0; for (int e = 0; e < NE; ++e) { const int c = (int)__hip_atomic_load((unsigned*)(F.ctl + CW_ECNT + 64 * e), RLX_AGENT); cnt[e] = c; cum[e] = a; a += (c + 255) >> 8; } cum[NE] = a; }
    __syncthreads();
}


struct PairSched {
    pg8::StaticSched S0; const char* A1; const char* B1;
    __device__ __forceinline__ bool next(int i, pg8::Unit& u) const {
        if (!S0.next(i >> 1, u)) return false;
        if (i & 1) { u.A = A1 + (u.A - S0.A); u.B = B1 + (u.B - S0.B); u.pad = 2; } else u.pad = 1;
        return true;
    }
    __device__ __forceinline__ void fill_tab(const pg8::Unit&, LAS unsigned*) const {}
};
struct EpiDE {
    static constexpr bool PERM = true;
    bf16* MG; const bf16* PJ;
    __device__ __forceinline__ void operator()(f32x4 (&acc)[2][2][4][2], const pg8::Unit& u, int wr, int wc, int fr, int fq) const {
        const int row0 = u.r0 + wr * 64 + fr, col0 = u.c0 + wc * 32 + 8 * fq; const bool first = (u.pad & 1) != 0;
#pragma unroll
        for (int ai = 0; ai < 2; ++ai)
#pragma unroll
            for (int m = 0; m < 4; ++m) { const size_t row = (size_t)(row0 + ai * 128 + m * 16);
#pragma unroll
                for (int bj = 0; bj < 2; ++bj) { const int c = col0 + bj * 128;
                    const v4u pw_ = *(const v4u*)(PJ + row * NPJ + PJ_GP + c); const v4u gw_ = *(const v4u*)(PJ + row * NPJ + (first ? PJ_GG : PJ_GP) + c);
                    asm volatile("" :: "v"(pw_), "v"(gw_));
                    f32x4 p0, p1, g0, g1; unpack8(pw_, p0, p1); unpack8(gw_, g0, g1);
                    if (first) {
#pragma unroll
                        for (int j = 0; j < 4; ++j) { acc[ai][bj][m][0][j] *= g0[j] * __builtin_amdgcn_rcpf(fmaxf(p0[j], 1e-30f)); acc[ai][bj][m][1][j] *= g1[j] * __builtin_amdgcn_rcpf(fmaxf(p1[j], 1e-30f)); }
                    } else {
                        *(v4u*)(MG + row * D + c) = pack8(acc[ai][bj][m][0] * p0, acc[ai][bj][m][1] * p1);
                    } } }
    }
};

__device__ __forceinline__ void transpose_item64(const float* W, const int ld, const float* g, int k0, int n0, bf16* dst, int drow0, int dld, LAS bf16* tl, int lane) {
    const int c4 = (lane & 15) * 4, kr = lane >> 4;
    f32x4 v[16];
#pragma unroll
    for (int i = 0; i < 16; ++i) v[i] = *(const f32x4*)(W + (size_t)(k0 + kr + 4 * i) * ld + n0 + c4);
#pragma unroll
    for (int i = 0; i < 16; ++i) { const int k = kr + 4 * i; const float sc = g ? g[k0 + k] : 1.0f;
#pragma unroll
        for (int j = 0; j < 4; ++j) tl[(c4 + j) * 66 + k] = (bf16)(pk2(v[i][j] * sc, 0.f) & 0xffffu); }
    LDS_WAIT(); asm volatile("" ::: "memory");
    const int pc = (lane & 7) * 8, nr = lane >> 3;
#pragma unroll
    for (int i = 0; i < 8; ++i) { const int n = nr + 8 * i; const LAS unsigned* sp = (const LAS unsigned*)(tl + n * 66 + pc);
        v4u o; o.x = sp[0]; o.y = sp[1]; o.z = sp[2]; o.w = sp[3];
        *(GAS v4u*)(dst + (size_t)(drow0 + n) * dld + k0 + pc) = o; }
    LDS_WAIT(); asm volatile("" ::: "memory");
}
template <class Src>
__device__ __forceinline__ void transpose_item(const Src& src, int k0, int n0, bf16* dst, int drow0, int dld, LAS float* scr, int lane) {
#pragma unroll 8
    for (int i = 0; i < 32; ++i) { const int kk = 2 * i + (lane >> 5); scr[kk * 33 + (lane & 31)] = src(k0 + kk, n0 + (lane & 31)); }
    LDS_WAIT(); asm volatile("" ::: "memory");
    const int c = lane & 7;
#pragma unroll
    for (int j = 0; j < 4; ++j) { const int n = (lane >> 3) + 8 * j; const LAS float* s = scr + (8 * c) * 33 + n;
        v4u o; o.x = pk2(s[0 * 33], s[1 * 33]); o.y = pk2(s[2 * 33], s[3 * 33]); o.z = pk2(s[4 * 33], s[5 * 33]); o.w = pk2(s[6 * 33], s[7 * 33]);
        *(GAS v4u*)(dst + (size_t)(drow0 + n) * dld + k0 + 8 * c) = o; }
    LDS_WAIT(); asm volatile("" ::: "memory");
}
struct SrcScaled { const float* W; int ld; const float* g;
    __device__ __forceinline__ float operator()(int k, int n) const { const float w = W[(size_t)k * ld + n]; return g ? w * g[k] : w; } };

__device__ __forceinline__ void p0_prologue(Frame& F) {
    const float* x = F.in[0]; const float* g1 = F.in[1]; const float* w_in = F.in[2]; const float* wau = F.in[3];
    const float* gng = F.in[5]; const float* wgb = F.in[6]; const float* pw = F.in[7]; const float* ps = F.in[8]; const float* wpb = F.in[9];
    const float* wout = F.in[10]; const float* g2 = F.in[11]; const float* wrg = F.in[12]; const float* wre = F.in[14];
    const float* weg = F.in[16]; const float* weu = F.in[17]; const float* wed = F.in[18];
    bf16* WIN = WSP(bf16, WS_WIN); bf16* WG = WSP(bf16, WS_WG); bf16* WP = WSP(bf16, WS_WP); bf16* WOUT = WSP(bf16, WS_WOUT); bf16* WR = WSP(bf16, WS_WR);
    bf16* WGU = WSP(bf16, WS_WGU); bf16* WD = WSP(bf16, WS_WD); bf16* HB = WSP(bf16, WS_HB);
    {
        LAS float* PWL = (LAS float*)F.lds;
        LAS float* WL = (LAS float*)(F.lds + 65536);
        for (int it = F.bid; it < 64; it += F.G) {
            const int g = it >> 4, nb = it & 15;
            for (int i = F.tid; i < 128 * 128; i += 512) { const int d = i & 127; PWL[i] = pw[(size_t)g * 16384 + i] * ps[g * 128 + d]; }
            for (int i = F.tid; i < 128 * 64; i += 512) { const int d = i >> 6, n = i & 63; WL[i] = wpb[(size_t)(g * 128 + d) * D + nb * 64 + n]; }
            __syncthreads();
            const int n = F.tid & 63, cg = F.tid >> 6;
            float a[16];
#pragma unroll
            for (int ci = 0; ci < 16; ++ci) a[ci] = 0.f;
            for (int d = 0; d < 128; d += 4) {
                const float w0 = WL[(d + 0) * 64 + n], w1 = WL[(d + 1) * 64 + n], w2 = WL[(d + 2) * 64 + n], w3 = WL[(d + 3) * 64 + n];
#pragma unroll
                for (int ci = 0; ci < 16; ++ci) { const f32x4 p = *(const LAS f32x4*)(PWL + (cg * 16 + ci) * 128 + d); a[ci] += p[0] * w0 + p[1] * w1 + p[2] * w2 + p[3] * w3; }
            }
            v4u o0, o1; o0.x = pk2(a[0], a[1]); o0.y = pk2(a[2], a[3]); o0.z = pk2(a[4], a[5]); o0.w = pk2(a[6], a[7]); o1.x = pk2(a[8], a[9]); o1.y = pk2(a[10], a[11]); o1.z = pk2(a[12], a[13]); o1.w = pk2(a[14], a[15]);
            bf16* dp = WP + (size_t)(nb * 64 + n) * PW + g * 128 + cg * 16;
            *(GAS v4u*)dp = o0; *(GAS v4u*)(dp + 8) = o1;
            __syncthreads();
        }
    }
    LAS float* scr = (LAS float*)(F.lds + F.wave * 16384);
    const int gw = F.bid * 8 + F.wave, NGW = F.G * 8;
    constexpr int I_IN1 = 16 * (1536 / 32), I_IN2 = 16 * (2560 / 32), I_Z = 4 * 64, I_WG = 8 * 32, I_WO = 16 * 32, I_WR = 256;
    constexpr int NITEMS = I_IN1 + I_IN2 + I_Z + I_WG + I_WO + I_WR;
    for (int it = gw; it < NITEMS; it += NGW) {
        int r = it;
        if (r < I_IN1) { const int kb = r / 48, nb = r % 48; SrcScaled s{w_in, D_IN, g1}; transpose_item(s, 64 * kb, 32 * nb, WIN, 32 * nb, D, scr, F.lane); continue; } r -= I_IN1;
        if (r < I_IN2) { const int kb = r / 80, nb = r % 80; SrcScaled s{w_in, D_IN, g1}; transpose_item(s, 64 * kb, IN_U + 32 * nb, WIN, PJ_U + 32 * nb, D, scr, F.lane); continue; } r -= I_IN2;
        if (r < I_Z) {
            const int nb = r & 3, kb = r >> 2, n = nb * 64 + F.lane;
            float wa[16];
#pragma unroll
            for (int j = 0; j < 16; ++j) wa[j] = wau[j * GKW + n];
            float o[16];
#pragma unroll
            for (int kk = 0; kk < 16; ++kk) { const int k = kb * 16 + kk; const float* wr_ = w_in + (size_t)k * D_IN + IN_A; float a = 0.f;
#pragma unroll
                for (int j = 0; j < 16; ++j) a += wr_[j] * wa[j];
                o[kk] = a * g1[k]; }
            v4u o0, o1; o0.x = pk2(o[0], o[1]); o0.y = pk2(o[2], o[3]); o0.z = pk2(o[4], o[5]); o0.w = pk2(o[6], o[7]); o1.x = pk2(o[8], o[9]); o1.y = pk2(o[10], o[11]); o1.z = pk2(o[12], o[13]); o1.w = pk2(o[14], o[15]);
            bf16* dp = WIN + (size_t)(PJ_Z + n) * D + kb * 16; *(GAS v4u*)dp = o0; *(GAS v4u*)(dp + 8) = o1; continue; } r -= I_Z;
        if (r < I_WG) { const int kb = r / 32, nb = r % 32; SrcScaled s{wgb, D, gng}; transpose_item(s, 64 * kb, 32 * nb, WG, 32 * nb, GVW, scr, F.lane); continue; } r -= I_WG;
        if (r < I_WO) { const int kb = r / 32, nb = r % 32; SrcScaled s{wout, D, nullptr}; transpose_item(s, 64 * kb, 32 * nb, WOUT, 32 * nb, D, scr, F.lane); continue; } r -= I_WO;
        if (r < I_WR) {
            const int j = r; bf16* dp = WR + (size_t)j * D;
#pragma unroll
            for (int q = 0; q < 16; ++q) { const int k = q * 64 + F.lane; float v = 0.f;
                if (j < NG) v = wrg[(size_t)k * NG + j] * g2[k]; else if (j < NG + NE) { const int g = (j - NG) >> 3, e = (j - NG) & 7; v = wre[((size_t)g * D + k) * EPG + e] * g2[k]; }
                dp[k] = (bf16)f2bf(v); }
            continue; }
    }
    for (int m = gw; m < T / 2; m += NGW) {
        const GAS f32x4* xa = (const GAS f32x4*)(x + (size_t)m * D) + F.lane; const GAS f32x4* xb = (const GAS f32x4*)(x + (size_t)(m + T / 2) * D) + F.lane;
        f32x4 va[4], vb[4]; float sa = 0.f, sb = 0.f;
#pragma unroll
        for (int j = 0; j < 4; ++j) { va[j] = __builtin_nontemporal_load(xa + 64 * j); vb[j] = __builtin_nontemporal_load(xb + 64 * j); }
#pragma unroll
        for (int j = 0; j < 4; ++j) { sa += (va[j].x * va[j].x + va[j].y * va[j].y) + (va[j].z * va[j].z + va[j].w * va[j].w); sb += (vb[j].x * vb[j].x + vb[j].y * vb[j].y) + (vb[j].z * vb[j].z + vb[j].w * vb[j].w); }
        const float ra = 1.0f / sqrtf(wave_sum(sa) * (1.f / D) + EPS), rb = 1.0f / sqrtf(wave_sum(sb) * (1.f / D) + EPS);
        GAS v2u* oa = (GAS v2u*)(HB + (size_t)m * D) + F.lane; GAS v2u* ob = (GAS v2u*)(HB + (size_t)(m + T / 2) * D) + F.lane;
#pragma unroll
        for (int j = 0; j < 4; ++j) { v2u w; w.x = pk2(va[j].x * ra, va[j].y * ra); w.y = pk2(va[j].z * ra, va[j].w * ra); oa[64 * j] = w; w.x = pk2(vb[j].x * rb, vb[j].y * rb); w.y = pk2(vb[j].z * rb, vb[j].w * rb); ob[64 * j] = w; }
    }
}

__device__ __forceinline__ void moe_weight_items(Frame& F, const int widx, const int nworkers) {
    const float* g2 = F.in[11]; const float* weg = F.in[16]; const float* weu = F.in[17]; const float* wed = F.in[18];
    bf16* WGU = WSP(bf16, WS_WGU); bf16* WD = WSP(bf16, WS_WD);
    LAS bf16* tl = (LAS bf16*)(F.lds + F.wave * 16384);
    const int gw = widx * 8 + F.wave, NGW = nworkers * 8;
    constexpr int I_GU = NE * 2 * 16 * 4, I_WD = NE * 4 * 16;
    for (int it = gw; it < I_GU + I_WD; it += NGW) {
        int r = it;
        if (r < I_GU) {
            const int e = r / 128, q = r % 128, bj = q / 64, kb = (q % 64) / 4, nb = q % 4;
            const int hid0 = 64 * nb, pn = hid0 >> 7, i0 = hid0 & 127;
            transpose_item64((bj ? weu : weg) + (size_t)e * D * DE, DE, g2, 64 * kb, hid0, WGU + (size_t)e * 512 * D, pn * 256 + bj * 128 + i0, D, tl, F.lane); continue; } r -= I_GU;
        { const int e = r / 64, q = r % 64, kb = q / 16, nb = q % 16;
            transpose_item64(wed + (size_t)e * DE * D, D, nullptr, 64 * kb, 64 * nb, WD + (size_t)e * D * DE, 64 * nb, DE, tl, F.lane); }
    }
}

#define WG_SYNC() do { asm volatile("s_waitcnt lgkmcnt(0)" ::: "memory"); __builtin_amdgcn_s_barrier(); asm volatile("" ::: "memory"); } while (0)
constexpr int GL_QD = 0, GL_KD = 9216, GL_KET = 18432, GL_P = 27648, GL_VT = 36864, GL_DEC = 55296, GL_SS = 55552, GL_OT = 57600;
constexpr int GLS = 72, OTS = 132;
__device__ __forceinline__ void gla_unit(Frame& F, const int b, const int h, const int seg) {
    const bf16* PJ = WSP(bf16, WS_PJ); const float* BC = WSP(float, WS_BC); bf16* ON = WSP(bf16, WS_ON);
    int tid_ = threadIdx.x; asm volatile("" : "+v"(tid_));
    const int tid = tid_, lane = tid & 63, w = __builtin_amdgcn_readfirstlane(tid >> 6), fr = lane & 15, fq = lane >> 4;
    LAS bf16* QD = (LAS bf16*)(F.lds + GL_QD); LAS bf16* KD = (LAS bf16*)(F.lds + GL_KD); LAS bf16* KET = (LAS bf16*)(F.lds + GL_KET);
    LAS bf16* P = (LAS bf16*)(F.lds + GL_P); LAS bf16* VT = (LAS bf16*)(F.lds + GL_VT);
    LAS float* DEC = (LAS float*)(F.lds + GL_DEC); LAS float* OT = (LAS float*)(F.lds + GL_OT);
    f32x4 Sacc[4];
#pragma unroll
    for (int i = 0; i < 4; ++i) Sacc[i] = (f32x4){0.f, 0.f, 0.f, 0.f};
    const size_t rowbase = (size_t)b * SEQ + (size_t)seg * SEGCH * GCH;
    float* CUMB = WSP(float, WS_CUMB) + ((size_t)(b * GH + h) * (SEQ / GCH) + seg * SEGCH) * GDK; float cumb[8];
#pragma unroll
    for (int j = 0; j < 8; ++j) cumb[j] = 0.f;
    const int vsl = lane & 31, vbk = 2 * w + (lane >> 5);
    const int ot = tid >> 3, ov = (tid & 7) * 16;
    v4u qq, kq, vq0, vq1, rq0, rq1; f32x4 bq0, bq1; v4u qq2, kq2, vq02, vq12, rq02, rq12; f32x4 bq02, bq12;
#define GLA_LOADS(tb_, Q, K_, V0, V1, R0, R1, B0, B1) do { const size_t tb__ = (tb_); \
        const bf16* rp = PJ + (tb__ + lane) * NPJ + h * 64 + w * 8; Q = *(const v4u*)(rp + PJ_Q); K_ = *(const v4u*)(rp + PJ_K); \
        const float* bp = BC + (tb__ + lane) * GKW + h * 64 + w * 8; B0 = *(const f32x4*)bp; B1 = *(const f32x4*)(bp + 4); \
        const bf16* vp = PJ + (tb__ + vsl) * NPJ + PJ_V + h * 128 + vbk * 8; V0 = *(const v4u*)vp; V1 = *(const v4u*)(vp + (size_t)32 * NPJ); \
        const bf16* rr = PJ + (tb__ + ot) * NPJ + PJ_R + h * 128 + ov; R0 = *(const v4u*)rr; R1 = *(const v4u*)(rr + 8); } while (0)
    GLA_LOADS(rowbase, qq, kq, vq0, vq1, rq0, rq1, bq0, bq1);
    GLA_LOADS(rowbase + GCH, qq2, kq2, vq02, vq12, rq02, rq12, bq02, bq12);
    for (int n = 0; n < SEGCH; ++n) {
        const size_t tb = rowbase + (size_t)n * GCH;
        const v4u q8 = qq, k8 = kq, v80 = vq0, v81 = vq1, r80 = rq0, r81 = rq1; const f32x4 b80 = bq0, b81 = bq1;
        qq = qq2; kq = kq2; vq0 = vq02; vq1 = vq12; rq0 = rq02; rq1 = rq12; bq0 = bq02; bq1 = bq12;
        { const size_t tn = (n + 2 < SEGCH) ? tb + 2 * GCH : tb; GLA_LOADS(tn, qq2, kq2, vq02, vq12, rq02, rq12, bq02, bq12); }
        { float bx[8] = {b80[0], b80[1], b80[2], b80[3], b81[0], b81[1], b81[2], b81[3]}, qf[8], kf[8];
          { f32x4 a, c; unpack8(q8, a, c); qf[0] = a[0]; qf[1] = a[1]; qf[2] = a[2]; qf[3] = a[3]; qf[4] = c[0]; qf[5] = c[1]; qf[6] = c[2]; qf[7] = c[3];
            unpack8(k8, a, c); kf[0] = a[0]; kf[1] = a[1]; kf[2] = a[2]; kf[3] = a[3]; kf[4] = c[0]; kf[5] = c[1]; kf[6] = c[2]; kf[7] = c[3]; }
          float qd[8], kd[8], ke[8], dc[8];
          if (lane == 0) { *(f32x4*)(CUMB + (size_t)n * GDK + w * 8) = (f32x4){cumb[0], cumb[1], cumb[2], cumb[3]}; *(f32x4*)(CUMB + (size_t)n * GDK + w * 8 + 4) = (f32x4){cumb[4], cumb[5], cumb[6], cumb[7]}; }
#pragma unroll
          for (int j = 0; j < 8; ++j) { const float blast = __builtin_bit_cast(float, __builtin_amdgcn_readlane(__builtin_bit_cast(int, bx[j]), 63));
              cumb[j] += blast;
              const float eb = __expf(bx[j]), enb = __builtin_amdgcn_rcpf(eb); dc[j] = __expf(blast);
              qd[j] = qf[j] * eb * 0.125f; kd[j] = kf[j] * enb; ke[j] = kd[j] * dc[j]; }
          v4u o; o.x = pk2(qd[0], qd[1]); o.y = pk2(qd[2], qd[3]); o.z = pk2(qd[4], qd[5]); o.w = pk2(qd[6], qd[7]); *(LAS v4u*)(QD + lane * GLS + w * 8) = o;
          o.x = pk2(kd[0], kd[1]); o.y = pk2(kd[2], kd[3]); o.z = pk2(kd[4], kd[5]); o.w = pk2(kd[6], kd[7]); *(LAS v4u*)(KD + lane * GLS + w * 8) = o;
#pragma unroll
          for (int j = 0; j < 8; ++j) KET[(w * 8 + j) * GLS + lane] = (bf16)(pk2(ke[j], ke[j]) & 0xffffu);
          if (lane == 0) { *(LAS f32x4*)(DEC + w * 8) = (f32x4){dc[0], dc[1], dc[2], dc[3]}; *(LAS f32x4*)(DEC + w * 8 + 4) = (f32x4){dc[4], dc[5], dc[6], dc[7]}; }
          const unsigned vw0[4] = {v80.x, v80.y, v80.z, v80.w}, vw1[4] = {v81.x, v81.y, v81.z, v81.w};
#pragma unroll
          for (int j = 0; j < 4; ++j) { VT[(vbk * 8 + 2 * j) * GLS + vsl] = (bf16)(vw0[j] & 0xffffu); VT[(vbk * 8 + 2 * j + 1) * GLS + vsl] = (bf16)(vw0[j] >> 16);
              VT[(vbk * 8 + 2 * j) * GLS + vsl + 32] = (bf16)(vw1[j] & 0xffffu); VT[(vbk * 8 + 2 * j + 1) * GLS + vsl + 32] = (bf16)(vw1[j] >> 16); } }
        WG_SYNC();
        { const int tt = w >> 1, st0 = (w & 1) * 2;
          bf16x8 af[2];
#pragma unroll
          for (int ks = 0; ks < 2; ++ks) af[ks] = *(const LAS bf16x8*)(QD + (16 * tt + fr) * GLS + 32 * ks + 8 * fq);
#pragma unroll
          for (int q2 = 0; q2 < 2; ++q2) { const int st = st0 + q2; f32x4 c = (f32x4){0.f, 0.f, 0.f, 0.f};
              if (st <= tt) {
#pragma unroll
                  for (int ks = 0; ks < 2; ++ks) { const bf16x8 bfm = *(const LAS bf16x8*)(KD + (16 * st + fr) * GLS + 32 * ks + 8 * fq); c = __builtin_amdgcn_mfma_f32_16x16x32_bf16(af[ks], bfm, c, 0, 0, 0); } }
#pragma unroll
              for (int i = 0; i < 4; ++i) { const int t = 16 * tt + 4 * fq + i, sidx = 16 * st + fr; const float val = (sidx <= t) ? c[i] : 0.f; P[t * GLS + sidx] = (bf16)(pk2(val, val) & 0xffffu); } } }
        WG_SYNC();
        { bf16x8 vtf[2], sb[2];
#pragma unroll
          for (int ks = 0; ks < 2; ++ks) { vtf[ks] = *(const LAS bf16x8*)(VT + (16 * w + fr) * GLS + 32 * ks + 8 * fq);
              v4u pw_; pw_.x = pk2(Sacc[2 * ks][0], Sacc[2 * ks][1]); pw_.y = pk2(Sacc[2 * ks][2], Sacc[2 * ks][3]); pw_.z = pk2(Sacc[2 * ks + 1][0], Sacc[2 * ks + 1][1]); pw_.w = pk2(Sacc[2 * ks + 1][2], Sacc[2 * ks + 1][3]);
              sb[ks] = __builtin_bit_cast(bf16x8, pw_); }
          f32x4 o[4];
#pragma unroll
          for (int mt = 0; mt < 4; ++mt) { o[mt] = (f32x4){0.f, 0.f, 0.f, 0.f};
#pragma unroll
              for (int ks = 0; ks < 2; ++ks) { const bf16x8 a = *(const LAS bf16x8*)(P + (16 * mt + fr) * GLS + 32 * ks + 8 * fq); o[mt] = __builtin_amdgcn_mfma_f32_16x16x32_bf16(a, vtf[ks], o[mt], 0, 0, 0); }
#pragma unroll
              for (int ks = 0; ks < 2; ++ks) { const v2u lo = *(const LAS v2u*)(QD + (16 * mt + fr) * GLS + 32 * ks + 4 * fq), hi = *(const LAS v2u*)(QD + (16 * mt + fr) * GLS + 32 * ks + 16 + 4 * fq);
                  v4u aw; aw.x = lo.x; aw.y = lo.y; aw.z = hi.x; aw.w = hi.y; o[mt] = __builtin_amdgcn_mfma_f32_16x16x32_bf16(__builtin_bit_cast(bf16x8, aw), sb[ks], o[mt], 0, 0, 0); } }
#pragma unroll
          for (int mt = 0; mt < 4; ++mt) { const f32x4 d4 = *(const LAS f32x4*)(DEC + 16 * mt + 4 * fq); Sacc[mt] = Sacc[mt] * d4;
#pragma unroll
              for (int ks = 0; ks < 2; ++ks) { const bf16x8 a = *(const LAS bf16x8*)(KET + (16 * mt + fr) * GLS + 32 * ks + 8 * fq); Sacc[mt] = __builtin_amdgcn_mfma_f32_16x16x32_bf16(a, vtf[ks], Sacc[mt], 0, 0, 0); } }
#pragma unroll
          for (int mt = 0; mt < 4; ++mt)
#pragma unroll
              for (int i = 0; i < 4; ++i) OT[(16 * mt + 4 * fq + i) * OTS + 16 * w + fr] = o[mt][i]; }
        WG_SYNC();
        { f32x4 ov4[4]; float tot2 = 0.f;
#pragma unroll
          for (int q = 0; q < 4; ++q) { ov4[q] = *(const LAS f32x4*)(OT + ot * OTS + ov + 4 * q); tot2 += (ov4[q][0] * ov4[q][0] + ov4[q][1] * ov4[q][1]) + (ov4[q][2] * ov4[q][2] + ov4[q][3] * ov4[q][3]); }
          tot2 += dpp_f<0xB1>(tot2); tot2 += dpp_f<0x4E>(tot2); tot2 += dpp_f<0x141>(tot2);
          const float rstd = (seg == 0) ? __builtin_amdgcn_rsqf(tot2 * (1.0f / GDV) + EPS) : 1.0f;
          f32x4 r0, r1, r2, r3; unpack8(r80, r0, r1); unpack8(r81, r2, r3);
          if (seg != 0) { r0 = (f32x4){1.f, 1.f, 1.f, 1.f}; r1 = r0; r2 = r0; r3 = r0; }
          bf16* op = ON + (tb + ot) * GVW + h * 128 + ov;
          *(v4u*)op = pack8(ov4[0] * rstd * r0, ov4[1] * rstd * r1); *(v4u*)(op + 8) = pack8(ov4[2] * rstd * r2, ov4[3] * rstd * r3); }
    }
#undef GLA_LOADS
    if (seg + 1 < NSEG) {
        float* SL = WSP(float, WS_SLOC) + ((size_t)(b * GH + h) * NSEG + seg) * GDK * GDV;
#pragma unroll
        for (int mt = 0; mt < 4; ++mt)
#pragma unroll
            for (int i = 0; i < 4; ++i) SL[(16 * mt + 4 * fq + i) * GDV + 16 * w + fr] = Sacc[mt][i];
        if (lane == 0) { float* DT = WSP(float, WS_DTOT) + ((size_t)(b * GH + h) * NSEG + seg) * GDK + w * 8;
#pragma unroll
            for (int j = 0; j < 8; ++j) DT[j] = __expf(cumb[j]); }
    }
    WG_SYNC();
}
constexpr int FX_QD = 0, FX_SB = 9216, FX_OT = 27648;
__device__ __forceinline__ void gla_fix_unit(Frame& F, const int b, const int h, const int seg) {
    const bf16* PJ = WSP(bf16, WS_PJ); const float* BC = WSP(float, WS_BC); bf16* ON = WSP(bf16, WS_ON);
    int tid_ = threadIdx.x; asm volatile("" : "+v"(tid_));
    const int tid = tid_, lane = tid & 63, w = __builtin_amdgcn_readfirstlane(tid >> 6), fr = lane & 15, fq = lane >> 4;
    LAS bf16* QD2 = (LAS bf16*)(F.lds + FX_QD); LAS bf16* SB = (LAS bf16*)(F.lds + FX_SB); LAS float* OT = (LAS float*)(F.lds + FX_OT);
    { const float* SL = WSP(float, WS_SLOC) + (size_t)(b * GH + h) * NSEG * GDK * GDV; const float* DT = WSP(float, WS_DTOT) + (size_t)(b * GH + h) * NSEG * GDK;
#pragma unroll
      for (int j = 0; j < 8; ++j) { const int d = 8 * w + j; float s0 = 0.f, s1 = 0.f;
          for (int i = 0; i < seg; ++i) { const float dt = DT[i * GDK + d]; s0 = dt * s0 + SL[((size_t)i * GDK + d) * GDV + lane]; s1 = dt * s1 + SL[((size_t)i * GDK + d) * GDV + lane + 64]; }
          SB[lane * GLS + d] = (bf16)(pk2(s0, s0) & 0xffffu); SB[(lane + 64) * GLS + d] = (bf16)(pk2(s1, s1) & 0xffffu); } }
    const size_t rowbase = (size_t)b * SEQ + (size_t)seg * SEGCH * GCH;
    const float* CUMB = WSP(float, WS_CUMB) + ((size_t)(b * GH + h) * (SEQ / GCH) + seg * SEGCH) * GDK;
    const int ot = tid >> 3, ov = (tid & 7) * 16, dq = (tid & 7) * 8;
    v4u qq, oq0, oq1, rq0, rq1; f32x4 bq0, bq1, cq0, cq1;
#define FIX_LOADS(n_) do { const size_t tb__ = rowbase + (size_t)(n_) * GCH;         qq = *(const v4u*)(PJ + (tb__ + ot) * NPJ + PJ_Q + h * 64 + dq); const float* bp = BC + (tb__ + ot) * GKW + h * 64 + dq; bq0 = *(const f32x4*)bp; bq1 = *(const f32x4*)(bp + 4);         const float* cp = CUMB + (size_t)(n_) * GDK + dq; cq0 = *(const f32x4*)cp; cq1 = *(const f32x4*)(cp + 4);         const bf16* op_ = ON + (tb__ + ot) * GVW + h * 128 + ov; oq0 = *(const v4u*)op_; oq1 = *(const v4u*)(op_ + 8);         const bf16* rr = PJ + (tb__ + ot) * NPJ + PJ_R + h * 128 + ov; rq0 = *(const v4u*)rr; rq1 = *(const v4u*)(rr + 8); } while (0)
    FIX_LOADS(0);
    for (int n = 0; n < SEGCH; ++n) {
        const size_t tb = rowbase + (size_t)n * GCH;
        const v4u q8 = qq, o80 = oq0, o81 = oq1, r80 = rq0, r81 = rq1; const f32x4 b80 = bq0, b81 = bq1, c80 = cq0, c81 = cq1;
        if (n + 1 < SEGCH) FIX_LOADS(n + 1);
        { f32x4 qa, qb; unpack8(q8, qa, qb); f32x4 e0, e1;
#pragma unroll
          for (int j = 0; j < 4; ++j) { e0[j] = qa[j] * 0.125f * __expf(b80[j] + c80[j]); e1[j] = qb[j] * 0.125f * __expf(b81[j] + c81[j]); }
          *(LAS v4u*)(QD2 + ot * GLS + dq) = pack8(e0, e1); }
        WG_SYNC();
        { bf16x8 bfm[2];
#pragma unroll
          for (int ks = 0; ks < 2; ++ks) bfm[ks] = *(const LAS bf16x8*)(SB + (16 * w + fr) * GLS + 32 * ks + 8 * fq);
#pragma unroll
          for (int mt = 0; mt < 4; ++mt) { f32x4 c = (f32x4){0.f, 0.f, 0.f, 0.f};
#pragma unroll
              for (int ks = 0; ks < 2; ++ks) { const bf16x8 a = *(const LAS bf16x8*)(QD2 + (16 * mt + fr) * GLS + 32 * ks + 8 * fq); c = __builtin_amdgcn_mfma_f32_16x16x32_bf16(a, bfm[ks], c, 0, 0, 0); }
#pragma unroll
              for (int i = 0; i < 4; ++i) OT[(16 * mt + 4 * fq + i) * OTS + 16 * w + fr] = c[i]; } }
        WG_SYNC();
        { f32x4 t4[4], l0, l1, l2, l3; unpack8(o80, l0, l1); unpack8(o81, l2, l3);
          t4[0] = *(const LAS f32x4*)(OT + ot * OTS + ov) + l0; t4[1] = *(const LAS f32x4*)(OT + ot * OTS + ov + 4) + l1; t4[2] = *(const LAS f32x4*)(OT + ot * OTS + ov + 8) + l2; t4[3] = *(const LAS f32x4*)(OT + ot * OTS + ov + 12) + l3;
          float sq = 0.f;
#pragma unroll
          for (int q = 0; q < 4; ++q) sq += (t4[q][0] * t4[q][0] + t4[q][1] * t4[q][1]) + (t4[q][2] * t4[q][2] + t4[q][3] * t4[q][3]);
          sq += dpp_f<0xB1>(sq); sq += dpp_f<0x4E>(sq); sq += dpp_f<0x141>(sq);
          const float rstd = __builtin_amdgcn_rsqf(sq * (1.0f / GDV) + EPS);
          f32x4 r0, r1, r2, r3; unpack8(r80, r0, r1); unpack8(r81, r2, r3);
          bf16* op = ON + (tb + ot) * GVW + h * 128 + ov;
          *(v4u*)op = pack8(t4[0] * rstd * r0, t4[1] * rstd * r1); *(v4u*)(op + 8) = pack8(t4[2] * rstd * r2, t4[3] * rstd * r3); }
    }
#undef FIX_LOADS
    WG_SYNC();
}
__device__ __forceinline__ void pool_items(Frame& F, const int widx, const int nworkers) {
    const bf16* PJ = WSP(bf16, WS_PJ); bf16* PD = WSP(bf16, WS_PD);
    const int gw = widx * 8 + F.wave, NGW = nworkers * 8, cb = F.lane, wlen = 2 << (cb >> 4);
    constexpr int RUN = 32;
    for (int u = gw; u < T / RUN; u += NGW) {
        const int t0 = u * RUN, pos0 = t0 & (SEQ - 1);
        const bf16* base = PJ + (size_t)t0 * NPJ + PJ_U + cb * 8;
        f32x4 a0 = (f32x4){0.f, 0.f, 0.f, 0.f}, a1 = a0;
#pragma unroll
        for (int i = 1; i <= 16; ++i) { const bool in = (i <= wlen) && (i <= pos0); const v4u vw = *(const v4u*)(base - (size_t)(in ? i : 0) * NPJ); f32x4 u0, u1; unpack8(vw, u0, u1); const float m = in ? 1.f : 0.f; a0 += u0 * m; a1 += u1 * m; }
#pragma unroll 4
        for (int i = 0; i < RUN; ++i) {
            const int pos = pos0 + i; const bool drop = pos >= wlen;
            const v4u nw = *(const v4u*)(base + (size_t)i * NPJ), ow = *(const v4u*)(base + (size_t)(drop ? i - wlen : i) * NPJ);
            f32x4 n0, n1, o0, o1; unpack8(nw, n0, n1); unpack8(ow, o0, o1); const float m = drop ? 1.f : 0.f;
            a0 += n0 - o0 * m; a1 += n1 - o1 * m;
            const float inv = __builtin_amdgcn_rcpf((float)(pos + 1 < wlen ? pos + 1 : wlen));
            *(v4u*)(PD + (size_t)(t0 + i) * PW + cb * 8) = pack8(a0 * inv - n0, a1 * inv - n1);
        }
    }
}
__device__ __forceinline__ void p2a_phase(Frame& F) {
    constexpr int NU = BATCH * GH * NSEG;
    for (int u = F.bid; u < NU; u += F.G) gla_unit(F, u >> 4, (u >> 2) & 3, u & 3);
}
__device__ __forceinline__ void p2b_phase(Frame& F) {
    constexpr int NU = BATCH * GH * (NSEG - 1);
#pragma unroll 1
    for (int r_ = 0; r_ < REPS(10); ++r_)
    for (int u = F.bid; u < NU; u += F.G) gla_fix_unit(F, u / (GH * (NSEG - 1)), (u / (NSEG - 1)) % GH, 1 + u % (NSEG - 1));
#pragma unroll 1
    for (int r_ = 0; r_ < REPS(11); ++r_) pool_items(F, F.bid, F.G);
#pragma unroll 1
    for (int r_ = 0; r_ < REPS(12); ++r_) moe_weight_items(F, F.bid, F.G);
}

#if DBG
__device__ __forceinline__ void dbg_fail(Frame& F, unsigned code) { unsigned expect = 0u; __hip_atomic_compare_exchange_strong((unsigned*)(F.ctl + CW_DBG), &expect, code, __ATOMIC_RELAXED, __ATOMIC_RELAXED, __HIP_MEMORY_SCOPE_AGENT); }
__device__ __forceinline__ bool dbg_close(float got, float want) { return fabsf(got - want) <= 0.03f + 0.03f * fabsf(want); }
__device__ __forceinline__ void dbg_check_p1(Frame& F) {
    if (F.bid != 0 || F.tid >= 256) return;
    const float* x = F.in[0]; const float* g1 = F.in[1]; const float* w_in = F.in[2]; const float* wau = F.in[3]; const float* ba = F.in[4];
    const bf16* PJ = WSP(bf16, WS_PJ);
    const int tok = (int)(((unsigned)F.tid * 2654435761u) % (unsigned)T);
    const int col = (int)(((unsigned)F.tid * 40503u + 17u * (unsigned)F.tid * (unsigned)F.tid) % (unsigned)NPJ);
    const float* xr = x + (size_t)tok * D; float ss = 0.f;
    for (int k = 0; k < D; ++k) ss += xr[k] * xr[k];
    const float rstd = 1.0f / sqrtf(ss / D + EPS);
    float want;
    if (col >= PJ_Z && col < PJ_U) {
        return;
        float al[16];
#pragma unroll
        for (int j = 0; j < 16; ++j) al[j] = 0.f;
        for (int k = 0; k < D; ++k) { const float hk = xr[k] * rstd * g1[k];
#pragma unroll
            for (int j = 0; j < 16; ++j) al[j] += hk * w_in[(size_t)k * D_IN + IN_A + j]; }
        float z = 0.f;
#pragma unroll
        for (int j = 0; j < 16; ++j) z += al[j] * wau[j * GKW + (col - PJ_Z)];
        z += ba[col - PJ_Z];
        want = (fminf(z, 0.f) - logf(1.0f + expf(-fabsf(z)))) / 16.0f;
    } else {
        const int wc_ = col < PJ_Z ? col : col - PJ_U + IN_U; float a = 0.f;
        for (int k = 0; k < D; ++k) a += xr[k] * rstd * g1[k] * w_in[(size_t)k * D_IN + wc_];
        if (col >= PJ_R && col < PJ_Z) want = a / (1.0f + expf(-a)); else if (col >= PJ_GG) want = 1.0f / (1.0f + expf(-a)); else want = a;
    }
    const float got = bf1(PJ[(size_t)tok * NPJ + col]);
    if (!dbg_close(got, want)) dbg_fail(F, 1u);
}


__device__ __forceinline__ void dbg_check_bc(Frame& F) {
    if (F.bid != 5 || F.tid >= 64) return;
    const float* x = F.in[0]; const float* g1 = F.in[1]; const float* w_in = F.in[2]; const float* wau = F.in[3]; const float* ba = F.in[4]; const float* BC = WSP(float, WS_BC);
    const int offs[5] = {0, 1, 5, 18, 63}; const int off = (F.tid % 5 == 0) ? 0 : (F.tid % 5 == 1) ? 1 : (F.tid % 5 == 2) ? 5 : (F.tid % 5 == 3) ? 18 : 63; (void)offs;
    const int chunk = (int)(((unsigned)F.tid * 2654435761u) % (unsigned)(T / 64)), col = (int)(((unsigned)F.tid * 40503u + 3u) % (unsigned)GKW);
    float cum = 0.f;
    for (int r = 0; r <= off; ++r) { const float* xr = x + ((size_t)chunk * 64 + r) * D; float ss = 0.f; for (int k = 0; k < D; ++k) ss += xr[k] * xr[k];
        const float rstd = 1.0f / sqrtf(ss / D + EPS); float al[16];
#pragma unroll
        for (int j = 0; j < 16; ++j) al[j] = 0.f;
        for (int k = 0; k < D; ++k) { const float hk = xr[k] * rstd * g1[k];
#pragma unroll
            for (int j = 0; j < 16; ++j) al[j] += hk * w_in[(size_t)k * D_IN + IN_A + j]; }
        float z = ba[col];
#pragma unroll
        for (int j = 0; j < 16; ++j) z += al[j] * wau[j * GKW + col];
        cum += (fminf(z, 0.f) - logf(1.0f + expf(-fabsf(z)))) / 16.0f; }
    const float got = BC[((size_t)chunk * 64 + off) * GKW + col];
    if (fabsf(got - cum) > 0.004f + 0.01f * fabsf(cum)) dbg_fail(F, 7u);
}
__device__ __forceinline__ void dbg_check_gla(Frame& F) {
    if (F.bid != 1) return;
    const bf16* PJ = WSP(bf16, WS_PJ); const bf16* ON = WSP(bf16, WS_ON);
    const int b = 2, h = 1, v = F.tid & 127; const bool act = F.tid < 128;
    LAS float* S = (LAS float*)F.lds;
    LAS float* red = (LAS float*)(F.lds + 32768);
    if (act) for (int d = 0; d < 64; ++d) S[d * 128 + v] = 0.f;
    __syncthreads();
    bool bad = false;
    for (int t = 0; t < 1100; ++t) {
        const bf16* rp = PJ + ((size_t)b * SEQ + t) * NPJ; float o = 0.f;
        if (act) { const float vv = bf1(rp[PJ_V + h * 128 + v]);
            for (int d = 0; d < 64; ++d) { const float* bcp = WSP(float, WS_BC) + ((size_t)b * SEQ + t) * GKW + h * 64 + d; const float la = (t & 63) ? bcp[0] - bcp[-GKW] : bcp[0]; const float kk = bf1(rp[PJ_K + h * 64 + d]), qq = bf1(rp[PJ_Q + h * 64 + d]);
                const float sn = expf(la) * S[d * 128 + v] + kk * vv; S[d * 128 + v] = sn; o += qq * 0.125f * sn; }
            red[v] = o * o; }
        __syncthreads();
        if (act) { float ss = 0.f; for (int i = 0; i < 128; ++i) ss += red[i];
            const float want = o * (1.0f / sqrtf(ss / 128.f + EPS)) * bf1(rp[PJ_R + h * 128 + v]);
            const float got = bf1(ON[((size_t)b * SEQ + t) * GVW + h * 128 + v]);
            if ((t < 150 || t >= 1000) && !dbg_close(got, want)) bad = true; }
        __syncthreads();
    }
    if (bad) dbg_fail(F, 2u);
}
__device__ __forceinline__ void dbg_check_pool(Frame& F) {
    if (F.bid != 2) return;
    const bf16* PJ = WSP(bf16, WS_PJ); const bf16* PD = WSP(bf16, WS_PD);
    int tok = (int)(((unsigned)F.tid * 2654435761u) % (unsigned)T); if (F.tid < 40) tok = (F.tid & 1) * SEQ * 3 + (F.tid >> 1);
    const int c = (int)(((unsigned)F.tid * 40503u) % (unsigned)PW), pos = tok & (SEQ - 1), wlen = 2 << (c >> 7), cnt = pos + 1 < wlen ? pos + 1 : wlen;
    float a = 0.f; for (int i = 0; i < cnt; ++i) a += bf1(PJ[(size_t)(tok - i) * NPJ + PJ_U + c]);
    const float want = a / cnt - bf1(PJ[(size_t)tok * NPJ + PJ_U + c]);
    if (!dbg_close(bf1(PD[(size_t)tok * PW + c]), want)) dbg_fail(F, 3u);
}
__device__ __forceinline__ void dbg_check_mg(Frame& F) {
    if (F.bid != 3 || F.tid >= 64) return;
    const bf16* PJ = WSP(bf16, WS_PJ); const bf16* ON = WSP(bf16, WS_ON); const bf16* PD = WSP(bf16, WS_PD); const bf16* MG = WSP(bf16, WS_MG);
    const float* gng = F.in[5]; const float* wgb = F.in[6]; const float* pw = F.in[7]; const float* ps = F.in[8]; const float* wpb = F.in[9];
    const int tok = (int)(((unsigned)F.tid * 2654435761u + 12345u) % (unsigned)T), col = (int)(((unsigned)F.tid * 40503u + 77u) % (unsigned)D);
    float yg = 0.f; for (int k = 0; k < GVW; ++k) yg += bf1(ON[(size_t)tok * GVW + k]) * gng[k] * wgb[(size_t)k * D + col];
    float yp = 0.f;
    for (int g = 0; g < 4; ++g) for (int d = 0; d < 128; ++d) { float m = 0.f; for (int c = 0; c < 128; ++c) m += bf1(PD[(size_t)tok * PW + g * 128 + c]) * pw[((size_t)g * 128 + c) * 128 + d];
        yp += m * ps[g * 128 + d] * wpb[(size_t)(g * 128 + d) * D + col]; }
    const float want = bf1(PJ[(size_t)tok * NPJ + PJ_GG + col]) * yg + bf1(PJ[(size_t)tok * NPJ + PJ_GP + col]) * yp;
    if (!dbg_close(bf1(MG[(size_t)tok * D + col]), want)) dbg_fail(F, 4u);
}
__device__ __forceinline__ void dbg_check_x1(Frame& F) {
    if (F.bid != 4 || F.tid >= 128) return;
    const bf16* MG = WSP(bf16, WS_MG); const bf16* X1B = WSP(bf16, WS_X1B); const float* SSQ = WSP(float, WS_SSQ); const float* x = F.in[0]; const float* wout = F.in[10];
    const int tok = (int)(((unsigned)F.tid * 2654435761u + 999u) % (unsigned)T), col = (int)(((unsigned)F.tid * 40503u + 5u) % (unsigned)D);
    float a = x[(size_t)tok * D + col]; for (int k = 0; k < D; ++k) a += bf1(MG[(size_t)tok * D + k]) * wout[(size_t)k * D + col];
    if (!dbg_close(bf1(X1B[(size_t)tok * D + col]), a)) dbg_fail(F, 5u);
    float ss = 0.f; for (int k = 0; k < D; ++k) { const float v = bf1(X1B[(size_t)tok * D + k]); ss += v * v; }
    float sp = 0.f; for (int j = 0; j < 16; ++j) sp += SSQ[(size_t)tok * 16 + j];
    if (fabsf(ss - sp) > 1e-2f * ss) dbg_fail(F, 6u);
}
#endif

struct Args { const float* in[20]; float* out; unsigned char* ws; };
__global__ void __launch_bounds__(512, 2) fwd_kernel(Args args) {
    extern __shared__ __attribute__((aligned(16))) unsigned char lds[];
    Frame F;
    F.lds = (LAS unsigned char*)lds;
    F.MISC = (volatile LAS unsigned*)(F.lds + MISC_OFF);
    F.tid = threadIdx.x; F.lane = F.tid & 63; F.wave = __builtin_amdgcn_readfirstlane(F.tid >> 6);
    F.G = gridDim.x; F.bid = blockIdx.x;
    F.ws = args.ws; F.out = args.out; F.ctl = (gu32*)(args.ws + WS_CTL);
#pragma unroll
    for (int i = 0; i < 20; ++i) F.in[i] = args.in[i];
    for (int u = F.tid; u < (LDS_BYTES - RING_BYTES) / 4; u += 512) ((LAS unsigned*)(F.lds + RING_BYTES))[u] = 0u;
    __syncthreads();
    XcdBarrier bar = xcd_barrier_post((unsigned*)(F.ctl + CW_BAR), F.MISC + 8);
#define GRID_BAR() xcd_barrier(bar)

#pragma unroll 1
    for (int rep_ = 0; rep_ < REPS(0); ++rep_) p0_prologue(F);
    GRID_BAR();
    if (NPH > 1) {
        pg8::StaticSched S; S.init(WSP(bf16, WS_HB), D, WSP(bf16, WS_WIN), D, T, NPJ, F.G, F.bid);
        EpiP1 E{WSP(bf16, WS_PJ), F.in[4], WSP(float, WS_BC)};
#pragma unroll 1
        for (int rep_ = 0; rep_ < REPS(1); ++rep_) pg8::gemm_phase<EpiP1, pg8::StaticSched, false, true>(F.lds, D, D, D, S, E);
        GRID_BAR();
#if DBG
        dbg_check_p1(F); dbg_check_bc(F);
        GRID_BAR();
#endif
    }
    if (NPH > 2) {
#pragma unroll 1
        for (int rep_ = 0; rep_ < REPS(2); ++rep_) p2a_phase(F);
        GRID_BAR();
        p2b_phase(F);
        GRID_BAR();
#if DBG
        dbg_check_gla(F); dbg_check_pool(F);
        GRID_BAR();
#endif
    }
    if (NPH > 4) {
        PairSched S; S.S0.init(WSP(bf16, WS_ON), GVW, WSP(bf16, WS_WG), GVW, T, D, F.G, F.bid); S.A1 = (const char*)WSP(bf16, WS_PD); S.B1 = (const char*)WSP(bf16, WS_WP);
        EpiDE E{WSP(bf16, WS_MG), WSP(bf16, WS_PJ)};
#pragma unroll 1
        for (int rep_ = 0; rep_ < REPS(3); ++rep_) pg8::gemm_phase<EpiDE, PairSched, false, true>(F.lds, GVW, GVW, GVW, S, E);
        GRID_BAR();
#if DBG
        dbg_check_mg(F);
        GRID_BAR();
#endif
    }
    if (NPH > 5) {
        pg8::StaticSched S; S.init(WSP(bf16, WS_MG), D, WSP(bf16, WS_WOUT), D, T, D, F.G, F.bid);
        EpiF E{F.in[0], WSP(bf16, WS_X1B), WSP(float, WS_SSQ)};
#pragma unroll 1
        for (int rep_ = 0; rep_ < REPS(5); ++rep_) pg8::gemm_phase<EpiF, pg8::StaticSched, false, true>(F.lds, D, D, D, S, E);
        GRID_BAR();
#if DBG
        dbg_check_x1(F);
        GRID_BAR();
#endif
    }
    if (NPH > 6) {
        pg8::StaticSched S; S.init(WSP(bf16, WS_X1B), D, WSP(bf16, WS_WR), D, T, 256, F.G, F.bid);
        EpiG E{WSP(float, WS_LG)};
#pragma unroll 1
        for (int rep_ = 0; rep_ < REPS(6); ++rep_) pg8::gemm_phase<EpiG, pg8::StaticSched, false, true>(F.lds, D, D, D, S, E);
        VM_WAIT(); __syncthreads();
        pg8::Unit u; for (int i = 0; S.next(i, u); ++i) route_rows(F, u.r0);
        GRID_BAR();
    }
    if (NPH > 7) {
        moe_tables(F);
        MoeSched S{(const LAS int*)(F.lds + SCHED_OFF + 256), (const LAS int*)(F.lds + SCHED_OFF + 256) + 40, WSP(unsigned, WS_LIST), (const char*)WSP(bf16, WS_X1B), (const char*)WSP(bf16, WS_WGU), 2, F.G, F.bid, 0};
        EpiH E{WSP(bf16, WS_ACT), WSP(float, WS_LISTR)};
#pragma unroll 1
        for (int rep_ = 0; rep_ < REPS(7); ++rep_) pg8::gemm_phase<EpiH, MoeSched, true, true>(F.lds, D, D, D, S, E);
        GRID_BAR();
    }
    if (NPH > 8) {
        MoeSched S{(const LAS int*)(F.lds + SCHED_OFF + 256), (const LAS int*)(F.lds + SCHED_OFF + 256) + 40, WSP(unsigned, WS_LIST), (const char*)WSP(bf16, WS_ACT), (const char*)WSP(bf16, WS_WD), 4, F.G, F.bid, 1};
        EpiI E{WSP(bf16, WS_Y), WSP(unsigned, WS_LIST), WSP(float, WS_LISTW)};
#pragma unroll 1
        for (int rep_ = 0; rep_ < REPS(8); ++rep_) pg8::gemm_phase<EpiI, MoeSched, false, true>(F.lds, DE, DE, DE, S, E);
        GRID_BAR();
    }
    if (NPH > 9) {
        const float* gf = F.in[19]; const bf16* X1B = WSP(bf16, WS_X1B); const bf16* Y = WSP(bf16, WS_Y);
        const int gw = F.bid * 8 + F.wave, NGW = F.G * 8;
        unsigned code = 0;
#if DBG
        code = __hip_atomic_load((unsigned*)(F.ctl + CW_DBG), RLX_AGENT);
        if (__hip_atomic_load((unsigned*)(F.ctl + CW_BAR) + XB_TMO, RLX_AGENT) != 0u) code = 9;
#endif
#pragma unroll 1
        for (int rep_ = 0; rep_ < REPS(9); ++rep_)
        for (int m = gw; m < T; m += NGW) {
            const GAS v2u* xr = (const GAS v2u*)(X1B + (size_t)m * D) + F.lane;
            const GAS v2u* y0 = (const GAS v2u*)(Y + (size_t)(2 * m) * D) + F.lane; const GAS v2u* y1 = (const GAS v2u*)(Y + (size_t)(2 * m + 1) * D) + F.lane;
            f32x4 v[4]; float s_ = 0.f;
#pragma unroll
            for (int j = 0; j < 4; ++j) { const v2u a = y0[64 * j], b = y1[64 * j], c = xr[64 * j]; v[j] = (f32x4){bflo(c.x), bfhi(c.x), bflo(c.y), bfhi(c.y)} + (f32x4){bflo(a.x), bfhi(a.x), bflo(a.y), bfhi(a.y)} + (f32x4){bflo(b.x), bfhi(b.x), bflo(b.y), bfhi(b.y)};
                s_ += (v[j].x * v[j].x + v[j].y * v[j].y) + (v[j].z * v[j].z + v[j].w * v[j].w); }
            const float rstd = 1.0f / sqrtf(wave_sum(s_) * (1.f / D) + EPS);
            GAS f32x4* o = (GAS f32x4*)(F.out + (size_t)m * D) + F.lane;
#pragma unroll
            for (int j = 0; j < 4; ++j) { const f32x4 g = *((const GAS f32x4*)gf + F.lane + 64 * j); f32x4 r = v[j] * rstd * g; if (code) r = (f32x4){10.f * code, 10.f * code, 10.f * code, 10.f * code}; o[64 * j] = r; }
        }
    } else
    {
        const float* gf = F.in[19]; const float* x = F.in[0];
        const int gw = F.bid * 8 + F.wave, NGW = F.G * 8;
        unsigned code = 0;
#if DBG
        code = __hip_atomic_load((unsigned*)(F.ctl + CW_DBG), RLX_AGENT);
        if (__hip_atomic_load((unsigned*)(F.ctl + CW_BAR) + XB_TMO, RLX_AGENT) != 0u) code = 9;
#endif
        for (int m = gw; m < T; m += NGW) {
            const GAS f32x4* xr = (const GAS f32x4*)(x + (size_t)m * D) + F.lane;
            f32x4 v[4]; float s = 0.f;
#pragma unroll
            for (int j = 0; j < 4; ++j) { v[j] = xr[64 * j]; s += (v[j].x * v[j].x + v[j].y * v[j].y) + (v[j].z * v[j].z + v[j].w * v[j].w); }
            const float rstd = 1.0f / sqrtf(wave_sum(s) * (1.f / D) + EPS);
            GAS f32x4* o = (GAS f32x4*)(F.out + (size_t)m * D) + F.lane;
#pragma unroll
            for (int j = 0; j < 4; ++j) { const f32x4 g = *((const GAS f32x4*)gf + F.lane + 64 * j); f32x4 r = v[j] * rstd * g; if (code) r = (f32x4){10.f * code, 10.f * code, 10.f * code, 10.f * code}; o[64 * j] = r; }
        }
    }
}

extern "C" void kernel_launch(void* const* d_in, const int* in_sizes, int n_in, void* d_out, int out_size, void* d_ws, size_t ws_size, hipStream_t stream) {
    static int grid = 0;
    if (grid == 0) {
        if (n_in != 20 || in_sizes[0] != T * D || out_size != T * D || ws_size < WS_END) { fprintf(stderr, "kernel_launch: unexpected shapes (n_in %d, in0 %d, out %d, ws %zu)\n", n_in, n_in > 0 ? in_sizes[0] : -1, out_size, ws_size); grid = -1; return; }
        int dev = 0, cus = 0, per_cu = 0;
        if (hipGetDevice(&dev) != hipSuccess || hipDeviceGetAttribute(&cus, hipDeviceAttributeMultiprocessorCount, dev) != hipSuccess) { grid = -1; return; }
        if (hipFuncSetAttribute((const void*)fwd_kernel, hipFuncAttributeMaxDynamicSharedMemorySize, LDS_BYTES) != hipSuccess) { fprintf(stderr, "kernel_launch: hipFuncSetAttribute failed\n"); grid = -1; return; }
        if (hipOccupancyMaxActiveBlocksPerMultiprocessor(&per_cu, (const void*)fwd_kernel, 512, LDS_BYTES) != hipSuccess || per_cu < 1) fprintf(stderr, "kernel_launch: occupancy query says %d\n", per_cu);
        (void)hipGetLastError();
        grid = cus;
    }
    if (grid < 0) return;
    if (hipMemsetAsync((char*)d_ws + WS_CTL, 0, CTL_ZERO_BYTES, stream) != hipSuccess) return;
    Args a{};
    for (int i = 0; i < 20; ++i) a.in[i] = (const float*)d_in[i];
    a.out = (float*)d_out; a.ws = (unsigned char*)d_ws;
    hipLaunchKernelGGL(fwd_kernel, dim3(grid), dim3(512), LDS_BYTES, stream, a);
}
```

```cpp
#include <hip/hip_runtime.h>
#include <cstdio>
#include <cstdint>

#ifndef DBG
#define DBG 0
#endif
#ifndef REPMASK
#define REPMASK 0
#endif
#define REPS(k) ((((REPMASK) >> (k)) & 1) ? 2 : 1)
#ifndef NPH
#define NPH 10
#endif

constexpr int BATCH = 16, SEQ = 4096, T = BATCH * SEQ, D = 1024;
constexpr int GH = 4, GDK = 64, GDV = 128, GKW = 256, GVW = 512, GRANK = 16, GCH = 64;
constexpr int PW = 512, PGW = 128;
constexpr int D_IN = 4112;
constexpr int IN_Q = 0, IN_K = 256, IN_V = 512, IN_R = 1024, IN_A = 1536, IN_U = 1552, IN_GG = 2064, IN_GP = 3088;
constexpr int NPROJ = 4352;
constexpr int NPJ = 2304;
constexpr int PJ_Q = 0, PJ_K = 256, PJ_V = 512, PJ_R = 1024, PJ_Z = 1536, PJ_U = 1792, PJ_GG = 2304, PJ_GP = 3328;
constexpr int NE = 32, EPG = 8, NG = 4, DE = 256;
constexpr int NSEG = 4, SEGCH = SEQ / GCH / NSEG;
constexpr int NA = 2 * T;
constexpr int LCAP = T;
constexpr float EPS = 1e-6f;

constexpr size_t MiB = 1u << 20;
constexpr size_t WS_CTL = 0, CTL_ZERO_BYTES = 1 * MiB;
constexpr size_t WS_WIN = 1 * MiB;
constexpr size_t WS_WG = 10 * MiB;
constexpr size_t WS_WP = 11 * MiB;
constexpr size_t WS_WOUT = 12 * MiB;
constexpr size_t WS_WR = 14 * MiB;
constexpr size_t WS_WGU = 15 * MiB;
constexpr size_t WS_WD = 47 * MiB;
constexpr size_t WS_HB = 64 * MiB;
constexpr size_t WS_TG = WS_HB;
constexpr size_t WS_MG = 192 * MiB;
constexpr size_t WS_SLOC = 256 * MiB;
constexpr size_t WS_DTOT = 264 * MiB;
constexpr size_t WS_CUMB = 265 * MiB;
constexpr size_t WS_BC = 192 * MiB;
constexpr size_t WS_Y = 64 * MiB;
constexpr size_t WS_ON = 320 * MiB;
constexpr size_t WS_PD = 384 * MiB;
constexpr size_t WS_ACT = 320 * MiB;
constexpr size_t WS_PJ = 448 * MiB;
constexpr size_t WS_GATES = 736 * MiB;
constexpr size_t WS_X1B = 448 * MiB;
constexpr size_t WS_LG = 576 * MiB;
constexpr size_t WS_SSQ = 592 * MiB;
constexpr size_t WS_LIST = 596 * MiB;
constexpr size_t WS_LISTW = 604 * MiB;
constexpr size_t WS_LISTR = 612 * MiB;
constexpr size_t WS_END = 992 * MiB;
static_assert(WS_PJ + (size_t)T * NPJ * 2 <= WS_GATES && WS_GATES + (size_t)2 * T * D * 2 <= WS_END && WS_LISTR + (size_t)NE * LCAP * 4 <= WS_GATES && WS_ACT + (size_t)(NA + NE * 256) * DE * 2 <= WS_PJ, "d_ws map");
constexpr int CW_TMO = 0, CW_DBG = 2;
constexpr int CW_BAR = 4096;
constexpr int CW_ECNT = 16384;

constexpr int RING_BYTES = 131072;
constexpr int MISC_OFF = RING_BYTES + 320;
constexpr int SCHED_OFF = RING_BYTES + 1024;
constexpr int LDS_BYTES = 147456;

#define GAS __attribute__((address_space(1)))
#define LAS __attribute__((address_space(3)))
typedef unsigned short bf16;
typedef unsigned v4u __attribute__((ext_vector_type(4)));
typedef unsigned v2u __attribute__((ext_vector_type(2)));
typedef float f32x4 __attribute__((ext_vector_type(4)));
typedef short bf16x8 __attribute__((ext_vector_type(8)));
typedef short bf16x4 __attribute__((ext_vector_type(4)));
typedef GAS unsigned gu32;
#define RLX_AGENT __ATOMIC_RELAXED, __HIP_MEMORY_SCOPE_AGENT
#define LDS_WAIT() asm volatile("s_waitcnt lgkmcnt(0)" ::: "memory")
#define VM_WAIT() asm volatile("s_waitcnt vmcnt(0)" ::: "memory")
__device__ __forceinline__ unsigned f2bf(float f) { unsigned u = __builtin_bit_cast(unsigned, f); return (u + 0x7fffu + ((u >> 16) & 1u)) >> 16; }
__device__ __forceinline__ unsigned pk2(float lo, float hi) { unsigned r; asm volatile("v_cvt_pk_bf16_f32 %0, %1, %2" : "=v"(r) : "v"(lo), "v"(hi)); return r; }
__device__ __forceinline__ float bflo(unsigned w) { return __builtin_bit_cast(float, w << 16); }
__device__ __forceinline__ float bfhi(unsigned w) { return __builtin_bit_cast(float, w & 0xffff0000u); }
__device__ __forceinline__ float bf1(bf16 h) { return __builtin_bit_cast(float, (unsigned)h << 16); }
__device__ __forceinline__ float fsigmoid(float x) { return __builtin_amdgcn_rcpf(1.0f + __expf(-x)); }
__device__ __forceinline__ float wave_sum(float v) {
#pragma unroll
    for (int o = 1; o < 64; o <<= 1) v += __shfl_xor(v, o);
    return v;
}


template <int CTRL> __device__ __forceinline__ float dpp_f(float x) { return __builtin_bit_cast(float, __builtin_amdgcn_update_dpp(0, __builtin_bit_cast(int, x), CTRL, 0xf, 0xf, true)); }
__device__ __forceinline__ float row16_sum(float x) { x += dpp_f<0x128>(x); x += dpp_f<0x124>(x); x += dpp_f<0x122>(x); x += dpp_f<0x121>(x); return x; }
__device__ __forceinline__ float row16_scan(float x) { x += dpp_f<0x111>(x); x += dpp_f<0x112>(x); x += dpp_f<0x114>(x); x += dpp_f<0x118>(x); return x; }

#define XB_TMO      128
#define XB_XCNT(j)  (256  + 64 * (j))
#define XB_XSUB(j)  (1280 + 64 * (j))
#define XB_XGEN(j)  (2304 + 64 * (j))
#define XB_TOP      3328
#define XB_TOPGEN   3392
#define XCD_BAR_WORDS 3456
#define XB_SPIN_CAP (1u << 18)
__device__ __forceinline__ unsigned xb_ld(unsigned* p)              { return __hip_atomic_load(p, __ATOMIC_RELAXED, __HIP_MEMORY_SCOPE_AGENT); }
__device__ __forceinline__ unsigned xb_add(unsigned* p, unsigned v) { return __hip_atomic_fetch_add(p, v, __ATOMIC_RELAXED, __HIP_MEMORY_SCOPE_AGENT); }
__device__ __forceinline__ unsigned xb_xcc_id() { return (unsigned)__builtin_amdgcn_s_getreg((3 << 11) | 20) & 0xFu; }
#define XB_SPIN(cond, bar) do { unsigned _sp = 0; while (cond) { __builtin_amdgcn_s_sleep(1); \
    if ((++_sp & 255u) == 0u) { if (xb_ld(&(bar)[XB_TMO])) break; if (_sp > XB_SPIN_CAP) { atomicAdd(&(bar)[XB_TMO], 1u); break; } } } } while (0)
struct XcdBarrier { unsigned* bar; unsigned x; volatile LAS unsigned* st; };
__device__ __forceinline__ XcdBarrier xcd_barrier_post(unsigned* bar, volatile LAS unsigned* st) {
    XcdBarrier b; b.bar = bar; b.x = xb_xcc_id(); b.st = st;
    if (threadIdx.x == 0) (void)xb_add(&bar[XB_XCNT(b.x)], 1u);
    return b;
}
__device__ __forceinline__ void xcd_barrier_complete(unsigned* bar, unsigned x, unsigned& nloc, unsigned& nx) {
    const unsigned G = gridDim.x * gridDim.y * gridDim.z;
    unsigned sum, cnt, mine, sp = 0u;
    for (;;) {
        sum = 0u; cnt = 0u; mine = 0u;
#pragma unroll
        for (unsigned j = 0; j < 16; ++j) { const unsigned c = xb_ld(&bar[XB_XCNT(j)]); sum += c; cnt += (c > 0u) ? 1u : 0u; mine = (j == x) ? c : mine; }
        if (sum == G) break;
        __builtin_amdgcn_s_sleep(1);
        if ((++sp & 255u) == 0u) { if (xb_ld(&bar[XB_TMO])) break; if (sp > XB_SPIN_CAP) { atomicAdd(&bar[XB_TMO], 1u); break; } }
    }
    nloc = mine > 0u ? mine : 1u; nx = cnt > 0u ? cnt : 1u;
}
__device__ __forceinline__ void xcd_barrier(const XcdBarrier& b) {
    asm volatile("s_waitcnt vmcnt(0)" ::: "memory");
    __syncthreads();
    if (threadIdx.x == 0) {
        unsigned* bar = b.bar;
        __builtin_amdgcn_s_waitcnt(0);
        unsigned nloc = b.st[0], nx = b.st[1];
        if (nloc == 0u) { xcd_barrier_complete(bar, b.x, nloc, nx); b.st[0] = nloc; b.st[1] = nx; }
        const unsigned old = xb_add(&bar[XB_XSUB(b.x)], 1u);
        const unsigned gen = old / nloc;
        if (old + 1u == (gen + 1u) * nloc) {
            __builtin_amdgcn_fence(__ATOMIC_RELEASE, "agent");
            asm volatile("s_waitcnt vmcnt(0)" ::: "memory");
            const unsigned og = xb_add(&bar[XB_TOP], 1u);
            const unsigned tg = og / nx;
            if (og + 1u == (tg + 1u) * nx) xb_add(&bar[XB_TOPGEN], 1u);
            else XB_SPIN(xb_ld(&bar[XB_TOPGEN]) == tg, bar);
            __builtin_amdgcn_fence(__ATOMIC_ACQUIRE, "agent");
            xb_add(&bar[XB_XGEN(b.x)], 1u);
            asm volatile("s_waitcnt vmcnt(0)" ::: "memory");
        } else {
            XB_SPIN(xb_ld(&bar[XB_XGEN(b.x)]) == gen, bar);
            __builtin_amdgcn_fence(__ATOMIC_ACQUIRE, "agent");
            asm volatile("s_waitcnt vmcnt(0)" ::: "memory");
        }
    }
    __syncthreads();
}

namespace pg8 {
#define PG8_LAS __attribute__((address_space(3)))
constexpr int BM = 256, BK = 64, HALF = 128, HTB = HALF * BK * 2, STAGE_BYTES = 8 * HTB, NXCD = 8, WGM = 8;
__host__ __device__ __forceinline__ int lds_byte(int r, int c) { const int st = (r >> 4) * 2 + (c >> 5), rr = r & 15, cc = c & 31, ob = rr * 64 + cc * 2; return st * 1024 + (ob ^ (((ob >> 9) & 1) << 5)); }
__host__ __device__ __forceinline__ void stage_rc(int b, int& R, int& C) { const int st = b / 1024, sb = b % 1024, swz = sb ^ (((sb >> 9) & 1) << 5); R = (st >> 1) * 16 + swz / 64; C = (st & 1) * 32 + (swz % 64) / 2; }
__host__ __device__ __forceinline__ int perm32(int rho) { const int n = rho >> 4, i = rho & 15; return 8 * (i >> 2) + 4 * n + (i & 3); }

struct Unit { const char* A; const char* B; int r0, c0, e, nvalid, lb, pad; };

__device__ __forceinline__ int remap_xcd(int L, int nwg) { const int q = nwg / NXCD, r = nwg % NXCD, xcd = L % NXCD, off = L / NXCD; return (xcd < r ? xcd * (q + 1) : r * (q + 1) + (xcd - r) * q) + off; }
struct StaticSched {
    const char* A; const char* B; int lda, ldb, nM, nN, nwg, G, c;
    __device__ __forceinline__ void init(const void* A_, int lda_, const void* B_, int ldb_, int M, int N, int G_, int c_) { A = (const char*)A_; B = (const char*)B_; lda = lda_; ldb = ldb_; nM = M / BM; nN = N / BM; nwg = nM * nN; G = G_; c = c_; }
    __device__ __forceinline__ bool next(int i, Unit& u) const {
        const long L = (long)i * G + c; if (L >= nwg) return false;
        const int wgid = remap_xcd((int)L, nwg);
        const int nig = WGM * nN, gid = wgid / nig, fm = gid * WGM, gsz = (nM - fm) < WGM ? (nM - fm) : WGM;
        const int pm = fm + ((wgid % nig) % gsz), pn = (wgid % nig) / gsz;
        u.A = A + (size_t)pm * BM * lda * 2; u.B = B + (size_t)pn * BM * ldb * 2; u.r0 = pm * BM; u.c0 = pn * BM; u.e = 0; u.nvalid = BM; u.lb = 0; u.pad = 0; return true;
    }
    __device__ __forceinline__ void fill_tab(const Unit&, PG8_LAS unsigned*) const {}
};

template <class Epi, class Sched, bool GATHER, bool ALIGN_EPI>
__device__ __forceinline__ void gemm_phase(PG8_LAS unsigned char* lds, const int K, const int lda, const int ldb, const Sched& S, const Epi& E) {
    int tid_ = threadIdx.x; asm volatile("" : "+v"(tid_));
    const int tid = tid_, wid = __builtin_amdgcn_readfirstlane(tid >> 6), lane = tid & 63, wr = wid >> 2, wc = wid & 3, fr = lane & 15, fq = lane >> 4;
    const int nt = K / BK;
    int Rr[2], Cc[2];
    unsigned voffA[2][2], voffB[2], nvA[2][2];
#pragma unroll
    for (int i = 0; i < 2; ++i) { int R, C; stage_rc(tid * 16 + i * 8192, R, C); Rr[i] = R; Cc[i] = C; const int Rb = Epi::PERM ? ((R & ~31) + perm32(R & 31)) : R;
        voffB[i] = (unsigned)(Rb * ldb + C) * 2u;
#pragma unroll
        for (int h = 0; h < 2; ++h) { voffA[h][i] = (unsigned)((R + HALF * h) * lda + C) * 2u; nvA[h][i] = voffA[h][i]; } }
    const size_t kstep = (size_t)(BK * 2);
    const size_t hstepB = (size_t)HALF * ldb * 2;
    const unsigned ldsw = (unsigned)wid * 1024u;
    const int aoff = lds_byte(wr * 64 + fr, fq * 8), boff = lds_byte(wc * 32 + fr, fq * 8);
#define PG8_SA(b, h) (((b) * 2 + (h)) * HTB)
#define PG8_SB(b, h) ((4 + (b) * 2 + (h)) * HTB)
#define PG8_STAGE(bufoff, gbase, voff) do { _Pragma("unroll") for (int _i = 0; _i < 2; ++_i) \
        __builtin_amdgcn_global_load_lds((const unsigned*)((const char*)(gbase) + (voff)[_i]), (PG8_LAS unsigned*)(lds + (bufoff) + ldsw + _i * 8192), 16, 0, 0); } while (0)
#define PG8_LDA(dst, b, h) do { _Pragma("unroll") for (int m = 0; m < 4; ++m) _Pragma("unroll") for (int k = 0; k < 2; ++k) dst[m][k] = *(const PG8_LAS bf16x8*)(lds + PG8_SA(b, h) + aoff + m * 2048 + k * 1024); } while (0)
#define PG8_LDB(dst, b, h) do { _Pragma("unroll") for (int n = 0; n < 2; ++n) _Pragma("unroll") for (int k = 0; k < 2; ++k) dst[n][k] = *(const PG8_LAS bf16x8*)(lds + PG8_SB(b, h) + boff + n * 2048 + k * 1024); } while (0)
#define PG8_MMA(ai, bj, At, Bt) do { __builtin_amdgcn_s_setprio(1); _Pragma("unroll") for (int m = 0; m < 4; ++m) _Pragma("unroll") for (int n = 0; n < 2; ++n) _Pragma("unroll") for (int k = 0; k < 2; ++k) \
        acc[ai][bj][m][n] = __builtin_amdgcn_mfma_f32_16x16x32_bf16(Bt[n][k], At[m][k], acc[ai][bj][m][n], 0, 0, 0); __builtin_amdgcn_s_setprio(0); } while (0)
#define PG8_WAIT_V(n) asm volatile("s_waitcnt vmcnt(" #n ")" ::: "memory")
#define PG8_WAIT_L(n) asm volatile("s_waitcnt lgkmcnt(" #n ")" ::: "memory")
#define PG8_BAR __builtin_amdgcn_s_barrier()
#define PG8_SCHED __builtin_amdgcn_sched_barrier(0)
    Unit cur, nxt; int ui = 0;
    if (!S.next(0, cur)) return;
    f32x4 acc[2][2][4][2];
#pragma unroll
    for (int a = 0; a < 2; ++a)
#pragma unroll
        for (int b = 0; b < 2; ++b)
#pragma unroll
            for (int m = 0; m < 4; ++m)
#pragma unroll
                for (int n = 0; n < 2; ++n) acc[a][b][m][n] = (f32x4){0.f, 0.f, 0.f, 0.f};
    bf16x8 At[4][2], B0[2][2], B1[2][2];
    const char* cA = cur.A; const char* cB = cur.B;
    PG8_LAS unsigned* gtab = (PG8_LAS unsigned*)(lds + STAGE_BYTES + 2048);
    if constexpr (GATHER) {
        S.fill_tab(cur, gtab);
        asm volatile("s_waitcnt lgkmcnt(0)" ::: "memory"); __builtin_amdgcn_s_barrier(); asm volatile("" ::: "memory");
#pragma unroll
        for (int h = 0; h < 2; ++h)
#pragma unroll
            for (int i = 0; i < 2; ++i) { voffA[h][i] = gtab[Rr[i] + HALF * h] + (unsigned)Cc[i] * 2u; nvA[h][i] = voffA[h][i]; }
    }
    PG8_STAGE(PG8_SB(0, 0), cB, voffB); PG8_STAGE(PG8_SB(0, 1), cB + hstepB, voffB); PG8_STAGE(PG8_SA(0, 0), cA, voffA[0]); PG8_STAGE(PG8_SA(0, 1), cA, voffA[1]);
    if (wr == 1) PG8_BAR;
    PG8_WAIT_V(2); PG8_BAR;
    PG8_STAGE(PG8_SB(1, 0), cB + kstep, voffB); PG8_STAGE(PG8_SA(1, 0), cA + kstep, voffA[0]); PG8_STAGE(PG8_SB(1, 1), cB + hstepB + kstep, voffB);
    PG8_WAIT_V(6); PG8_BAR;
    for (;;) {
        const bool has_next = S.next(ui + 1, nxt);
        const char* nA = has_next ? nxt.A : cA; const char* nB = has_next ? nxt.B : cB;
        if constexpr (GATHER) { if (has_next) S.fill_tab(nxt, gtab + ((ui + 1) & 1) * 256); }
#pragma unroll 1
        for (int t = 0; t < nt; t += 2) {
            const bool last = (t == nt - 2);
            const char* a1 = cA + (size_t)(t + 1) * kstep;
            const char* a2 = last ? nA : cA + (size_t)(t + 2) * kstep; const char* b2 = last ? nB : cB + (size_t)(t + 2) * kstep;
            const char* a3 = a2 + kstep; const char* b3 = b2 + kstep;
            unsigned sv[2][2];
            if constexpr (GATHER) {
                if (last && has_next) {
#pragma unroll
                    for (int h = 0; h < 2; ++h)
#pragma unroll
                        for (int i = 0; i < 2; ++i) nvA[h][i] = gtab[((ui + 1) & 1) * 256 + Rr[i] + HALF * h] + (unsigned)Cc[i] * 2u;
                }
#pragma unroll
                for (int h = 0; h < 2; ++h)
#pragma unroll
                    for (int i = 0; i < 2; ++i) sv[h][i] = last ? nvA[h][i] : voffA[h][i];
            } else {
#pragma unroll
                for (int h = 0; h < 2; ++h)
#pragma unroll
                    for (int i = 0; i < 2; ++i) sv[h][i] = voffA[h][i];
            }
            PG8_LDB(B0, 0, 0); PG8_LDB(B1, 0, 1); PG8_SCHED; PG8_LDA(At, 0, 0); PG8_STAGE(PG8_SA(1, 1), a1, voffA[1]);
            PG8_WAIT_V(8); PG8_WAIT_L(0); PG8_BAR; PG8_MMA(0, 0, At, B0); PG8_MMA(0, 1, At, B1); PG8_BAR; PG8_SCHED;
            PG8_LDA(At, 0, 1); PG8_STAGE(PG8_SB(0, 0), b2, voffB); PG8_STAGE(PG8_SB(0, 1), b2 + hstepB, voffB); PG8_STAGE(PG8_SA(0, 0), a2, sv[0]);
            PG8_WAIT_V(8); PG8_WAIT_L(0); PG8_BAR; PG8_MMA(1, 0, At, B0); PG8_MMA(1, 1, At, B1); PG8_BAR; PG8_SCHED;
            PG8_LDB(B0, 1, 0); PG8_LDB(B1, 1, 1); PG8_SCHED; PG8_LDA(At, 1, 0); PG8_STAGE(PG8_SA(0, 1), a2, sv[1]);
            PG8_WAIT_V(8); PG8_WAIT_L(0); PG8_BAR; PG8_MMA(0, 0, At, B0); PG8_MMA(0, 1, At, B1); PG8_BAR; PG8_SCHED;
            PG8_LDA(At, 1, 1); PG8_STAGE(PG8_SB(1, 0), b3, voffB); PG8_STAGE(PG8_SB(1, 1), b3 + hstepB, voffB); PG8_STAGE(PG8_SA(1, 0), a3, sv[0]);
            PG8_WAIT_V(8); PG8_WAIT_L(0); PG8_BAR; PG8_MMA(1, 0, At, B0); PG8_MMA(1, 1, At, B1); PG8_BAR; PG8_SCHED;
        }
        if constexpr (ALIGN_EPI) { if (wr == 0) PG8_BAR; }
        E(acc, cur, wr, wc, fr, fq);
        if (!has_next) break;
        if (!(cur.pad & 1)) {
#pragma unroll
        for (int a = 0; a < 2; ++a)
#pragma unroll
            for (int b = 0; b < 2; ++b)
#pragma unroll
                for (int m = 0; m < 4; ++m)
#pragma unroll
                    for (int n = 0; n < 2; ++n) acc[a][b][m][n] = (f32x4){0.f, 0.f, 0.f, 0.f};
        }
        cur = nxt; cA = nA; cB = nB; ++ui;
        if constexpr (GATHER) {
#pragma unroll
            for (int h = 0; h < 2; ++h)
#pragma unroll
                for (int i = 0; i < 2; ++i) voffA[h][i] = nvA[h][i];
        }
        if constexpr (ALIGN_EPI) { if (wr == 1) PG8_BAR; }
    }
    PG8_WAIT_V(0);
    if constexpr (!ALIGN_EPI) { if (wr == 0) PG8_BAR; }
    PG8_BAR;
#undef PG8_SA
#undef PG8_SB
#undef PG8_STAGE
#undef PG8_LDA
#undef PG8_LDB
#undef PG8_MMA
#undef PG8_WAIT_V
#undef PG8_WAIT_L
#undef PG8_BAR
#undef PG8_SCHED
}
}

struct Frame {
    LAS unsigned char* lds;
    volatile LAS unsigned* MISC;
    gu32* ctl;
    int tid, lane, wave, G, bid;
    const float* in[20]; float* out; unsigned char* ws;
};
#define WSP(T_, off) ((T_*)(F.ws + (off)))

__device__ __forceinline__ v4u pack8(const f32x4 a, const f32x4 b) { v4u w; w.x = pk2(a[0], a[1]); w.y = pk2(a[2], a[3]); w.z = pk2(b[0], b[1]); w.w = pk2(b[2], b[3]); return w; }
__device__ __forceinline__ void unpack8(const v4u w, f32x4& a, f32x4& b) { a = (f32x4){bflo(w.x), bfhi(w.x), bflo(w.y), bfhi(w.y)}; b = (f32x4){bflo(w.z), bfhi(w.z), bflo(w.w), bfhi(w.w)}; }

__device__ __forceinline__ size_t gate_block(int which, int pm, int pnl, int wave, int ai, int m, int bj, int lane) {
    const int wr = wave >> 2, wc = wave & 3, fr = lane & 15, fq = lane >> 4; const size_t row = (size_t)pm * 256 + ai * 128 + wr * 64 + m * 16 + fr; const int col = pnl * 256 + bj * 128 + wc * 32 + 8 * fq;
    return ((size_t)which * T + row) * D + col;
}
__device__ __forceinline__ size_t gate_elem(int which, int row, int col) { return ((size_t)which * T + row) * D + col; }
struct EpiP1 {
    static constexpr bool PERM = true;
    bf16* PJ; const float* b_alpha; float* BC; bf16* GATES;
    __device__ __forceinline__ void operator()(const f32x4 (&acc)[2][2][4][2], const pg8::Unit& u, int wr, int wc, int fr, int fq) const {
        const int pn = u.c0 >> 8;
        const int mode = (pn == 4 || pn == 5) ? 1 : (pn == 6) ? 2 : (pn >= 9) ? 3 : 0;
        const int row0 = u.r0 + wr * 64 + fr, col0 = u.c0 + wc * 32 + 8 * fq;
        f32x4 bv[2][2];
        const int bidx = (mode == 2) ? (col0 - PJ_Z) : 0;
#pragma unroll
        for (int bj = 0; bj < 2; ++bj)
#pragma unroll
            for (int n = 0; n < 2; ++n) { bv[bj][n] = *(const f32x4*)(b_alpha + bidx + bj * 128 + 4 * n); asm volatile("" :: "v"(bv[bj][n])); }
        if (mode == 2) {
#pragma unroll
            for (int ai = 0; ai < 2; ++ai)
#pragma unroll
                for (int bj = 0; bj < 2; ++bj) { f32x4 pr[4][2];
#pragma unroll
                    for (int n = 0; n < 2; ++n)
#pragma unroll
                        for (int j = 0; j < 4; ++j) { float carry = 0.f;
#pragma unroll
                            for (int m = 0; m < 4; ++m) { const float z = acc[ai][bj][m][n][j] + bv[bj][n][j]; const float la = (fminf(z, 0.f) - __logf(1.0f + __expf(-fabsf(z)))) * (1.0f / 16.0f);
                                pr[m][n][j] = row16_scan(la) + carry; carry += row16_sum(la); } }
#pragma unroll
                    for (int m = 0; m < 4; ++m) { float* bp = BC + (size_t)(row0 + ai * 128 + m * 16) * GKW + (col0 - PJ_Z) + bj * 128; *(f32x4*)bp = pr[m][0]; *(f32x4*)(bp + 4) = pr[m][1]; } }
            return;
        }
#pragma unroll
        for (int ai = 0; ai < 2; ++ai)
#pragma unroll
            for (int m = 0; m < 4; ++m) { bf16* rowp = PJ + (size_t)(row0 + ai * 128 + m * 16) * NPJ + col0;
#pragma unroll
                for (int bj = 0; bj < 2; ++bj) { f32x4 v[2] = {acc[ai][bj][m][0], acc[ai][bj][m][1]};
                    if (mode == 1) {
#pragma unroll
                        for (int n = 0; n < 2; ++n)
#pragma unroll
                            for (int j = 0; j < 4; ++j) v[n][j] = v[n][j] * fsigmoid(v[n][j]);
                    } else if (mode == 3) {
#pragma unroll
                        for (int n = 0; n < 2; ++n)
#pragma unroll
                            for (int j = 0; j < 4; ++j) v[n][j] = fsigmoid(v[n][j]);
                        *(v4u*)(GATES + gate_block((pn - 9) >> 2, u.r0 >> 8, (pn - 9) & 3, wr * 4 + wc, ai, m, bj, fq * 16 + fr)) = pack8(v[0], v[1]);
                        continue;
                    }
                    *(v4u*)(rowp + bj * 128) = pack8(v[0], v[1]); } }
    }
};

struct EpiF {
    static constexpr bool PERM = true;
    const float* x; bf16* X1B; float* SSQ;
    __device__ __forceinline__ void operator()(const f32x4 (&acc)[2][2][4][2], const pg8::Unit& u, int wr, int wc, int fr, int fq) const {
        const int row0 = u.r0 + wr * 64 + fr, col0 = u.c0 + wc * 32 + 8 * fq;
#pragma unroll
        for (int ai = 0; ai < 2; ++ai)
#pragma unroll
            for (int m = 0; m < 4; ++m) { const size_t row = (size_t)(row0 + ai * 128 + m * 16); float ss = 0.f;
#pragma unroll
                for (int bj = 0; bj < 2; ++bj) { const int c = col0 + bj * 128; const f32x4 x0 = *(const f32x4*)(x + row * D + c), x1 = *(const f32x4*)(x + row * D + c + 4);
                    const f32x4 y0 = x0 + acc[ai][bj][m][0], y1 = x1 + acc[ai][bj][m][1];
                    *(v4u*)(X1B + row * D + c) = pack8(y0, y1);
                    ss += (y0[0] * y0[0] + y0[1] * y0[1]) + (y0[2] * y0[2] + y0[3] * y0[3]) + (y1[0] * y1[0] + y1[1] * y1[1]) + (y1[2] * y1[2] + y1[3] * y1[3]); }
                ss += __shfl_xor(ss, 16); ss += __shfl_xor(ss, 32);
                if (fq == 0) SSQ[row * 16 + (u.c0 >> 8) * 4 + wc] = ss; }
    }
};


struct MoeSched {
    const LAS int* cum; const LAS int* cnt; const unsigned* LIST;
    const char* Abase; const char* Bbase; int NT, G, c, mode;
    __device__ __forceinline__ bool next(int i, pg8::Unit& u) const {
        const int nunits = __builtin_amdgcn_readfirstlane(cum[NE]) * NT; const long L = (long)i * G + c; if (L >= nunits) return false;
        const int wgid = pg8::remap_xcd((int)L, nunits), gb = wgid / NT, pn = wgid % NT;
        int e_ = 0;
#pragma unroll 8
        for (int j = 1; j < NE; ++j) e_ += (cum[j] <= gb) ? 1 : 0;
        const int e = __builtin_amdgcn_readfirstlane(e_);
        const int blk = gb - __builtin_amdgcn_readfirstlane(cum[e]), rem = __builtin_amdgcn_readfirstlane(cnt[e]) - blk * 256;
        u.e = e; u.nvalid = rem < 256 ? rem : 256; u.lb = e * LCAP + blk * 256; u.r0 = gb * 256; u.pad = 0;
        if (mode == 0) { u.A = Abase; u.B = Bbase + ((size_t)e * 512 + (size_t)pn * 256) * D * 2; u.c0 = pn * 128; }
        else { u.A = Abase + (size_t)gb * 256 * DE * 2; u.B = Bbase + ((size_t)e * D + (size_t)pn * 256) * DE * 2; u.c0 = pn * 256; }
        return true;
    }
    __device__ __forceinline__ void fill_tab(const pg8::Unit& u, LAS unsigned* tab) const {
        const int t = threadIdx.x;
        if (t < 256) { const int lp = t < u.nvalid ? t : u.nvalid - 1; const unsigned slot = LIST[u.lb + lp]; tab[t] = (slot >> 1) * (unsigned)(D * 2); }
    }
};
struct EpiG {
    static constexpr bool PERM = false;
    float* LG;
    __device__ __forceinline__ void operator()(const f32x4 (&acc)[2][2][4][2], const pg8::Unit& u, int wr, int wc, int fr, int fq) const {
        if (wc >= 2) return;
        const int row0 = u.r0 + wr * 64 + fr;
#pragma unroll
        for (int ai = 0; ai < 2; ++ai)
#pragma unroll
            for (int m = 0; m < 4; ++m)
#pragma unroll
                for (int n = 0; n < 2; ++n) *(f32x4*)(LG + (size_t)(row0 + ai * 128 + m * 16) * 64 + 32 * wc + 16 * n + 4 * fq) = acc[ai][0][m][n];
    }
};
struct EpiH {
    static constexpr bool PERM = true;
    bf16* ACT; const float* LISTR;
    __device__ __forceinline__ void operator()(const f32x4 (&acc)[2][2][4][2], const pg8::Unit& u, int wr, int wc, int fr, int fq) const {
        float rs[2][4];
#pragma unroll
        for (int ai = 0; ai < 2; ++ai)
#pragma unroll
            for (int m = 0; m < 4; ++m) { const int rl = ai * 128 + wr * 64 + m * 16 + fr, lp = rl < u.nvalid ? rl : u.nvalid - 1; rs[ai][m] = LISTR[u.lb + lp]; }
#pragma unroll
        for (int ai = 0; ai < 2; ++ai)
#pragma unroll
            for (int m = 0; m < 4; ++m) { asm volatile("" :: "v"(rs[ai][m])); }
#pragma unroll
        for (int ai = 0; ai < 2; ++ai)
#pragma unroll
            for (int m = 0; m < 4; ++m) { const int rl = ai * 128 + wr * 64 + m * 16 + fr; const float r = rs[ai][m]; f32x4 a[2];
#pragma unroll
                for (int n = 0; n < 2; ++n)
#pragma unroll
                    for (int j = 0; j < 4; ++j) { const float g = acc[ai][0][m][n][j] * r, up = acc[ai][1][m][n][j] * r; a[n][j] = g * fsigmoid(g) * up; }
                *(v4u*)(ACT + (size_t)(u.r0 + rl) * DE + u.c0 + wc * 32 + 8 * fq) = pack8(a[0], a[1]); }
    }
};
struct EpiI {
    static constexpr bool PERM = true;
    bf16* Y; const unsigned* LIST; const float* LISTW;
    __device__ __forceinline__ void operator()(const f32x4 (&acc)[2][2][4][2], const pg8::Unit& u, int wr, int wc, int fr, int fq) const {
#pragma unroll
        for (int ai = 0; ai < 2; ++ai) {
            unsigned sl[4]; float gw[4];
#pragma unroll
            for (int m = 0; m < 4; ++m) { const int rl = ai * 128 + wr * 64 + m * 16 + fr, lp = rl < u.nvalid ? rl : u.nvalid - 1; sl[m] = LIST[u.lb + lp]; gw[m] = LISTW[u.lb + lp]; }
#pragma unroll
            for (int m = 0; m < 4; ++m) { asm volatile("" :: "v"(gw[m]), "v"(sl[m])); }
#pragma unroll
            for (int m = 0; m < 4; ++m) { const int rl = ai * 128 + wr * 64 + m * 16 + fr; const float g = gw[m];
                if (rl < u.nvalid) {
#pragma unroll
                    for (int bj = 0; bj < 2; ++bj) *(v4u*)(Y + (size_t)sl[m] * D + u.c0 + bj * 128 + wc * 32 + 8 * fq) = pack8(acc[ai][bj][m][0] * g, acc[ai][bj][m][1] * g); } }
        }
    }
};
__device__ __forceinline__ void route_rows(Frame& F, const int r0) {
    const float* LG = WSP(float, WS_LG); const float* SSQ = WSP(float, WS_SSQ); const float* brg = F.in[13]; const float* bre = F.in[15];
    unsigned* LIST = WSP(unsigned, WS_LIST); float* LISTW = WSP(float, WS_LISTW); float* LISTR = WSP(float, WS_LISTR);
    LAS unsigned* hcnt = (LAS unsigned*)(F.lds + SCHED_OFF); LAS unsigned* hbase = hcnt + 32;
    if (F.tid < 32) hcnt[F.tid] = 0u;
    __syncthreads();
    int e0 = 0, e1 = 0; unsigned p0 = 0, p1 = 0; float w0 = 0.f, w1 = 0.f, rstd = 0.f; const int row = r0 + F.tid;
    if (F.tid < 256) {
        float ss = 0.f;
#pragma unroll
        for (int j = 0; j < 16; ++j) ss += SSQ[(size_t)row * 16 + j];
        rstd = 1.0f / sqrtf(ss * (1.0f / D) + EPS);
        const float* lr = LG + (size_t)row * 64;
        float gl[4];
#pragma unroll
        for (int g = 0; g < 4; ++g) gl[g] = __hip_atomic_load(lr + g, RLX_AGENT) * rstd + brg[g];
        int gi = 0; float gm = gl[0];
#pragma unroll
        for (int g = 1; g < 4; ++g) if (gl[g] > gm) { gm = gl[g]; gi = g; }
        float den = 0.f;
#pragma unroll
        for (int g = 0; g < 4; ++g) den += expf(gl[g] - gm);
        const float gp = 1.0f / den;
        float el[8];
#pragma unroll
        for (int e = 0; e < 8; ++e) el[e] = __hip_atomic_load(lr + 4 + gi * 8 + e, RLX_AGENT) * rstd + bre[gi * 8 + e];
        int i0 = 0; float m0 = el[0];
#pragma unroll
        for (int e = 1; e < 8; ++e) if (el[e] > m0) { m0 = el[e]; i0 = e; }
        int i1 = -1; float m1 = 0.f;
#pragma unroll
        for (int e = 0; e < 8; ++e) if (e != i0 && (i1 < 0 || el[e] > m1)) { m1 = el[e]; i1 = e; }
        const float q = expf(m1 - m0); w0 = gp / (1.0f + q); w1 = gp * q / (1.0f + q);
        e0 = gi * 8 + i0; e1 = gi * 8 + i1;
        p0 = __hip_atomic_fetch_add(&hcnt[e0], 1u, __ATOMIC_RELAXED, __HIP_MEMORY_SCOPE_WORKGROUP); p1 = __hip_atomic_fetch_add(&hcnt[e1], 1u, __ATOMIC_RELAXED, __HIP_MEMORY_SCOPE_WORKGROUP);
    }
    __syncthreads();
    if (F.tid < 32) hbase[F.tid] = hcnt[F.tid] ? __hip_atomic_fetch_add((unsigned*)(F.ctl + CW_ECNT + 64 * F.tid), hcnt[F.tid], RLX_AGENT) : 0u;
    __syncthreads();
    if (F.tid < 256) { const size_t q0 = (size_t)e0 * LCAP + hbase[e0] + p0, q1 = (size_t)e1 * LCAP + hbase[e1] + p1;
        LIST[q0] = (unsigned)row * 2u; LIST[q1] = (unsigned)row * 2u + 1u; LISTW[q0] = w0; LISTW[q1] = w1; LISTR[q0] = rstd; LISTR[q1] = rstd; }
    __syncthreads();
}
__device__ __forceinline__ void moe_tables(Frame& F) {
    LAS int* cum = (LAS int*)(F.lds + SCHED_OFF + 256); LAS int* cnt = cum + 40;
    if (F.tid == 0) { int a = 0; for (int e = 0; e < NE; ++e) { const int c = (int)__hip_atomic_load((unsigned*)(F.ctl + CW_ECNT + 64 * e), RLX_AGENT); cnt[e] = c; cum[e] = a; a += (c + 255) >> 8; } cum[NE] = a; }
    __syncthreads();
}


struct PairSched {
    pg8::StaticSched S0; const char* A1; const char* B1;
    __device__ __forceinline__ bool next(int i, pg8::Unit& u) const {
        if (!S0.next(i >> 1, u)) return false;
        if (i & 1) { u.A = A1 + (u.A - S0.A); u.B = B1 + (u.B - S0.B); u.pad = 2; } else u.pad = 1;
        return true;
    }
    __device__ __forceinline__ void fill_tab(const pg8::Unit&, LAS unsigned*) const {}
};
struct EpiDE {
    static constexpr bool PERM = true;
    bf16* MG; const bf16* GATES;
    __device__ __forceinline__ void operator()(f32x4 (&acc)[2][2][4][2], const pg8::Unit& u, int wr, int wc, int fr, int fq) const {
        const int row0 = u.r0 + wr * 64 + fr, col0 = u.c0 + wc * 32 + 8 * fq; const bool first = (u.pad & 1) != 0;
        const bf16* gp = GATES + ((size_t)T + row0) * D + col0;
        const bf16* gg = first ? GATES + (size_t)row0 * D + col0 : gp;
        v4u P[2], G[2], Pn[2], Gn[2];
#pragma unroll
        for (int bj = 0; bj < 2; ++bj) { P[bj] = *(const v4u*)(gp + bj * 128); G[bj] = *(const v4u*)(gg + bj * 128); }
#pragma unroll
        for (int b = 0; b < 8; ++b) { const int ai = b >> 2, m = b & 3; const size_t roff = (size_t)(ai * 128 + m * 16) * D;
            if (b + 1 < 8) { const size_t rn = (size_t)(((b + 1) >> 2) * 128 + ((b + 1) & 3) * 16) * D;
#pragma unroll
                for (int bj = 0; bj < 2; ++bj) { Pn[bj] = *(const v4u*)(gp + rn + bj * 128); Gn[bj] = *(const v4u*)(gg + rn + bj * 128); } }
            asm volatile("" :: "v"(P[0]), "v"(P[1]), "v"(G[0]), "v"(G[1]));
#pragma unroll
            for (int bj = 0; bj < 2; ++bj) { f32x4 p0, p1, g0, g1; unpack8(P[bj], p0, p1); unpack8(G[bj], g0, g1);
                if (first) {
#pragma unroll
                    for (int j = 0; j < 4; ++j) { acc[ai][bj][m][0][j] *= g0[j] * __builtin_amdgcn_rcpf(fmaxf(p0[j], 1e-30f)); acc[ai][bj][m][1][j] *= g1[j] * __builtin_amdgcn_rcpf(fmaxf(p1[j], 1e-30f)); }
                } else {
                    *(v4u*)(MG + (size_t)row0 * D + roff + col0 + bj * 128) = pack8(acc[ai][bj][m][0] * p0, acc[ai][bj][m][1] * p1);
                } }
#pragma unroll
            for (int bj = 0; bj < 2; ++bj) { P[bj] = Pn[bj]; G[bj] = Gn[bj]; } }
    }
};

__device__ __forceinline__ void transpose_item64(const float* W, const int ld, const float* g, int k0, int n0, bf16* dst, int drow0, int dld, LAS bf16* tl, int lane) {
    const int c4 = (lane & 15) * 4, kr = lane >> 4;
    f32x4 v[16];
#pragma unroll
    for (int i = 0; i < 16; ++i) v[i] = *(const f32x4*)(W + (size_t)(k0 + kr + 4 * i) * ld + n0 + c4);
#pragma unroll
    for (int i = 0; i < 16; ++i) { const int k = kr + 4 * i; const float sc = g ? g[k0 + k] : 1.0f;
#pragma unroll
        for (int j = 0; j < 4; ++j) tl[(c4 + j) * 66 + k] = (bf16)(pk2(v[i][j] * sc, 0.f) & 0xffffu); }
    LDS_WAIT(); asm volatile("" ::: "memory");
    const int pc = (lane & 7) * 8, nr = lane >> 3;
#pragma unroll
    for (int i = 0; i < 8; ++i) { const int n = nr + 8 * i; const LAS unsigned* sp = (const LAS unsigned*)(tl + n * 66 + pc);
        v4u o; o.x = sp[0]; o.y = sp[1]; o.z = sp[2]; o.w = sp[3];
        *(GAS v4u*)(dst + (size_t)(drow0 + n) * dld + k0 + pc) = o; }
    LDS_WAIT(); asm volatile("" ::: "memory");
}
template <class Src>
__device__ __forceinline__ void transpose_item(const Src& src, int k0, int n0, bf16* dst, int drow0, int dld, LAS float* scr, int lane) {
#pragma unroll 8
    for (int i = 0; i < 32; ++i) { const int kk = 2 * i + (lane >> 5); scr[kk * 33 + (lane & 31)] = src(k0 + kk, n0 + (lane & 31)); }
    LDS_WAIT(); asm volatile("" ::: "memory");
    const int c = lane & 7;
#pragma unroll
    for (int j = 0; j < 4; ++j) { const int n = (lane >> 3) + 8 * j; const LAS float* s = scr + (8 * c) * 33 + n;
        v4u o; o.x = pk2(s[0 * 33], s[1 * 33]); o.y = pk2(s[2 * 33], s[3 * 33]); o.z = pk2(s[4 * 33], s[5 * 33]); o.w = pk2(s[6 * 33], s[7 * 33]);
        *(GAS v4u*)(dst + (size_t)(drow0 + n) * dld + k0 + 8 * c) = o; }
    LDS_WAIT(); asm volatile("" ::: "memory");
}
struct SrcScaled { const float* W; int ld; const float* g;
    __device__ __forceinline__ float operator()(int k, int n) const { const float w = W[(size_t)k * ld + n]; return g ? w * g[k] : w; } };

__device__ __forceinline__ void p0_prologue(Frame& F) {
    const float* x = F.in[0]; const float* g1 = F.in[1]; const float* w_in = F.in[2]; const float* wau = F.in[3];
    const float* gng = F.in[5]; const float* wgb = F.in[6]; const float* pw = F.in[7]; const float* ps = F.in[8]; const float* wpb = F.in[9];
    const float* wout = F.in[10]; const float* g2 = F.in[11]; const float* wrg = F.in[12]; const float* wre = F.in[14];
    const float* weg = F.in[16]; const float* weu = F.in[17]; const float* wed = F.in[18];
    bf16* WIN = WSP(bf16, WS_WIN); bf16* WG = WSP(bf16, WS_WG); bf16* WP = WSP(bf16, WS_WP); bf16* WOUT = WSP(bf16, WS_WOUT); bf16* WR = WSP(bf16, WS_WR);
    bf16* WGU = WSP(bf16, WS_WGU); bf16* WD = WSP(bf16, WS_WD); bf16* HB = WSP(bf16, WS_HB);
    {
        LAS float* PWL = (LAS float*)F.lds;
        LAS float* WL = (LAS float*)(F.lds + 65536);
        for (int it = F.bid; it < 64; it += F.G) {
            const int g = it >> 4, nb = it & 15;
            for (int i = F.tid; i < 128 * 128; i += 512) { const int d = i & 127; PWL[i] = pw[(size_t)g * 16384 + i] * ps[g * 128 + d]; }
            for (int i = F.tid; i < 128 * 64; i += 512) { const int d = i >> 6, n = i & 63; WL[i] = wpb[(size_t)(g * 128 + d) * D + nb * 64 + n]; }
            __syncthreads();
            const int n = F.tid & 63, cg = F.tid >> 6;
            float a[16];
#pragma unroll
            for (int ci = 0; ci < 16; ++ci) a[ci] = 0.f;
            for (int d = 0; d < 128; d += 4) {
                const float w0 = WL[(d + 0) * 64 + n], w1 = WL[(d + 1) * 64 + n], w2 = WL[(d + 2) * 64 + n], w3 = WL[(d + 3) * 64 + n];
#pragma unroll
                for (int ci = 0; ci < 16; ++ci) { const f32x4 p = *(const LAS f32x4*)(PWL + (cg * 16 + ci) * 128 + d); a[ci] += p[0] * w0 + p[1] * w1 + p[2] * w2 + p[3] * w3; }
            }
            v4u o0, o1; o0.x = pk2(a[0], a[1]); o0.y = pk2(a[2], a[3]); o0.z = pk2(a[4], a[5]); o0.w = pk2(a[6], a[7]); o1.x = pk2(a[8], a[9]); o1.y = pk2(a[10], a[11]); o1.z = pk2(a[12], a[13]); o1.w = pk2(a[14], a[15]);
            bf16* dp = WP + (size_t)(nb * 64 + n) * PW + g * 128 + cg * 16;
            *(GAS v4u*)dp = o0; *(GAS v4u*)(dp + 8) = o1;
            __syncthreads();
        }
    }
    LAS float* scr = (LAS float*)(F.lds + F.wave * 16384);
    const int gw = F.bid * 8 + F.wave, NGW = F.G * 8;
    constexpr int I_IN1 = 16 * (1536 / 32), I_IN2 = 16 * (2560 / 32), I_Z = 4 * 64, I_WG = 8 * 32, I_WO = 16 * 32, I_WR = 256;
    constexpr int NITEMS = I_IN1 + I_IN2 + I_Z + I_WG + I_WO + I_WR;
    for (int it = gw; it < NITEMS; it += NGW) {
        int r = it;
        if (r < I_IN1) { const int kb = r / 48, nb = r % 48; SrcScaled s{w_in, D_IN, g1}; transpose_item(s, 64 * kb, 32 * nb, WIN, 32 * nb, D, scr, F.lane); continue; } r -= I_IN1;
        if (r < I_IN2) { const int kb = r / 80, nb = r % 80; SrcScaled s{w_in, D_IN, g1}; transpose_item(s, 64 * kb, IN_U + 32 * nb, WIN, PJ_U + 32 * nb, D, scr, F.lane); continue; } r -= I_IN2;
        if (r < I_Z) {
            const int nb = r & 3, kb = r >> 2, n = nb * 64 + F.lane;
            float wa[16];
#pragma unroll
            for (int j = 0; j < 16; ++j) wa[j] = wau[j * GKW + n];
            float o[16];
#pragma unroll
            for (int kk = 0; kk < 16; ++kk) { const int k = kb * 16 + kk; const float* wr_ = w_in + (size_t)k * D_IN + IN_A; float a = 0.f;
#pragma unroll
                for (int j = 0; j < 16; ++j) a += wr_[j] * wa[j];
                o[kk] = a * g1[k]; }
            v4u o0, o1; o0.x = pk2(o[0], o[1]); o0.y = pk2(o[2], o[3]); o0.z = pk2(o[4], o[5]); o0.w = pk2(o[6], o[7]); o1.x = pk2(o[8], o[9]); o1.y = pk2(o[10], o[11]); o1.z = pk2(o[12], o[13]); o1.w = pk2(o[14], o[15]);
            bf16* dp = WIN + (size_t)(PJ_Z + n) * D + kb * 16; *(GAS v4u*)dp = o0; *(GAS v4u*)(dp + 8) = o1; continue; } r -= I_Z;
        if (r < I_WG) { const int kb = r / 32, nb = r % 32; SrcScaled s{wgb, D, gng}; transpose_item(s, 64 * kb, 32 * nb, WG, 32 * nb, GVW, scr, F.lane); continue; } r -= I_WG;
        if (r < I_WO) { const int kb = r / 32, nb = r % 32; SrcScaled s{wout, D, nullptr}; transpose_item(s, 64 * kb, 32 * nb, WOUT, 32 * nb, D, scr, F.lane); continue; } r -= I_WO;
        if (r < I_WR) {
            const int j = r; bf16* dp = WR + (size_t)j * D;
#pragma unroll
            for (int q = 0; q < 16; ++q) { const int k = q * 64 + F.lane; float v = 0.f;
                if (j < NG) v = wrg[(size_t)k * NG + j] * g2[k]; else if (j < NG + NE) { const int g = (j - NG) >> 3, e = (j - NG) & 7; v = wre[((size_t)g * D + k) * EPG + e] * g2[k]; }
                dp[k] = (bf16)f2bf(v); }
            continue; }
    }
    for (int m = gw; m < T / 2; m += NGW) {
        const GAS f32x4* xa = (const GAS f32x4*)(x + (size_t)m * D) + F.lane; const GAS f32x4* xb = (const GAS f32x4*)(x + (size_t)(m + T / 2) * D) + F.lane;
        f32x4 va[4], vb[4]; float sa = 0.f, sb = 0.f;
#pragma unroll
        for (int j = 0; j < 4; ++j) { va[j] = __builtin_nontemporal_load(xa + 64 * j); vb[j] = __builtin_nontemporal_load(xb + 64 * j); }
#pragma unroll
        for (int j = 0; j < 4; ++j) { sa += (va[j].x * va[j].x + va[j].y * va[j].y) + (va[j].z * va[j].z + va[j].w * va[j].w); sb += (vb[j].x * vb[j].x + vb[j].y * vb[j].y) + (vb[j].z * vb[j].z + vb[j].w * vb[j].w); }
        const float ra = 1.0f / sqrtf(wave_sum(sa) * (1.f / D) + EPS), rb = 1.0f / sqrtf(wave_sum(sb) * (1.f / D) + EPS);
        GAS v2u* oa = (GAS v2u*)(HB + (size_t)m * D) + F.lane; GAS v2u* ob = (GAS v2u*)(HB + (size_t)(m + T / 2) * D) + F.lane;
#pragma unroll
        for (int j = 0; j < 4; ++j) { v2u w; w.x = pk2(va[j].x * ra, va[j].y * ra); w.y = pk2(va[j].z * ra, va[j].w * ra); oa[64 * j] = w; w.x = pk2(vb[j].x * rb, vb[j].y * rb); w.y = pk2(vb[j].z * rb, vb[j].w * rb); ob[64 * j] = w; }
    }
}

__device__ __forceinline__ void moe_weight_items(Frame& F, const int widx, const int nworkers) {
    const float* g2 = F.in[11]; const float* weg = F.in[16]; const float* weu = F.in[17]; const float* wed = F.in[18];
    bf16* WGU = WSP(bf16, WS_WGU); bf16* WD = WSP(bf16, WS_WD);
    LAS bf16* tl = (LAS bf16*)(F.lds + F.wave * 16384);
    const int gw = widx * 8 + F.wave, NGW = nworkers * 8;
    constexpr int I_GU = NE * 2 * 16 * 4, I_WD = NE * 4 * 16;
    for (int it = gw; it < I_GU + I_WD; it += NGW) {
        int r = it;
        if (r < I_GU) {
            const int e = r / 128, q = r % 128, bj = q / 64, kb = (q % 64) / 4, nb = q % 4;
            const int hid0 = 64 * nb, pn = hid0 >> 7, i0 = hid0 & 127;
            transpose_item64((bj ? weu : weg) + (size_t)e * D * DE, DE, g2, 64 * kb, hid0, WGU + (size_t)e * 512 * D, pn * 256 + bj * 128 + i0, D, tl, F.lane); continue; } r -= I_GU;
        { const int e = r / 64, q = r % 64, kb = q / 16, nb = q % 16;
            transpose_item64(wed + (size_t)e * DE * D, D, nullptr, 64 * kb, 64 * nb, WD + (size_t)e * D * DE, 64 * nb, DE, tl, F.lane); }
    }
}

#define WG_SYNC() do { asm volatile("s_waitcnt lgkmcnt(0)" ::: "memory"); __builtin_amdgcn_s_barrier(); asm volatile("" ::: "memory"); } while (0)
constexpr int GL_QD = 0, GL_KD = 9216, GL_KET = 18432, GL_P = 27648, GL_VT = 36864, GL_DEC = 55296, GL_SS = 55552, GL_OT = 57600;
constexpr int GLS = 72, OTS = 132;
__device__ __forceinline__ void gla_unit(Frame& F, const int b, const int h, const int seg) {
    const bf16* PJ = WSP(bf16, WS_PJ); const float* BC = WSP(float, WS_BC); bf16* ON = WSP(bf16, WS_ON);
    int tid_ = threadIdx.x; asm volatile("" : "+v"(tid_));
    const int tid = tid_, lane = tid & 63, w = __builtin_amdgcn_readfirstlane(tid >> 6), fr = lane & 15, fq = lane >> 4;
    LAS bf16* QD = (LAS bf16*)(F.lds + GL_QD); LAS bf16* KD = (LAS bf16*)(F.lds + GL_KD); LAS bf16* KET = (LAS bf16*)(F.lds + GL_KET);
    LAS bf16* P = (LAS bf16*)(F.lds + GL_P); LAS bf16* VT = (LAS bf16*)(F.lds + GL_VT);
    LAS float* DEC = (LAS float*)(F.lds + GL_DEC); LAS float* OT = (LAS float*)(F.lds + GL_OT);
    f32x4 Sacc[4];
#pragma unroll
    for (int i = 0; i < 4; ++i) Sacc[i] = (f32x4){0.f, 0.f, 0.f, 0.f};
    const size_t rowbase = (size_t)b * SEQ + (size_t)seg * SEGCH * GCH;
    float* CUMB = WSP(float, WS_CUMB) + ((size_t)(b * GH + h) * (SEQ / GCH) + seg * SEGCH) * GDK; float cumb[8];
#pragma unroll
    for (int j = 0; j < 8; ++j) cumb[j] = 0.f;
    const int vsl = lane & 31, vbk = 2 * w + (lane >> 5);
    const int ot = tid >> 3, ov = (tid & 7) * 16;
    v4u qq, kq, vq0, vq1, rq0, rq1; f32x4 bq0, bq1; v4u qq2, kq2, vq02, vq12, rq02, rq12; f32x4 bq02, bq12;
#define GLA_LOADS(tb_, Q, K_, V0, V1, R0, R1, B0, B1) do { const size_t tb__ = (tb_); \
        const bf16* rp = PJ + (tb__ + lane) * NPJ + h * 64 + w * 8; Q = *(const v4u*)(rp + PJ_Q); K_ = *(const v4u*)(rp + PJ_K); \
        const float* bp = BC + (tb__ + lane) * GKW + h * 64 + w * 8; B0 = *(const f32x4*)bp; B1 = *(const f32x4*)(bp + 4); \
        const bf16* vp = PJ + (tb__ + vsl) * NPJ + PJ_V + h * 128 + vbk * 8; V0 = *(const v4u*)vp; V1 = *(const v4u*)(vp + (size_t)32 * NPJ); \
        const bf16* rr = PJ + (tb__ + ot) * NPJ + PJ_R + h * 128 + ov; R0 = *(const v4u*)rr; R1 = *(const v4u*)(rr + 8); } while (0)
    GLA_LOADS(rowbase, qq, kq, vq0, vq1, rq0, rq1, bq0, bq1);
    GLA_LOADS(rowbase + GCH, qq2, kq2, vq02, vq12, rq02, rq12, bq02, bq12);
    for (int n = 0; n < SEGCH; ++n) {
        const size_t tb = rowbase + (size_t)n * GCH;
        const v4u q8 = qq, k8 = kq, v80 = vq0, v81 = vq1, r80 = rq0, r81 = rq1; const f32x4 b80 = bq0, b81 = bq1;
        qq = qq2; kq = kq2; vq0 = vq02; vq1 = vq12; rq0 = rq02; rq1 = rq12; bq0 = bq02; bq1 = bq12;
        { const size_t tn = (n + 2 < SEGCH) ? tb + 2 * GCH : tb; GLA_LOADS(tn, qq2, kq2, vq02, vq12, rq02, rq12, bq02, bq12); }
        { float bx[8] = {b80[0], b80[1], b80[2], b80[3], b81[0], b81[1], b81[2], b81[3]}, qf[8], kf[8];
          { f32x4 a, c; unpack8(q8, a, c); qf[0] = a[0]; qf[1] = a[1]; qf[2] = a[2]; qf[3] = a[3]; qf[4] = c[0]; qf[5] = c[1]; qf[6] = c[2]; qf[7] = c[3];
            unpack8(k8, a, c); kf[0] = a[0]; kf[1] = a[1]; kf[2] = a[2]; kf[3] = a[3]; kf[4] = c[0]; kf[5] = c[1]; kf[6] = c[2]; kf[7] = c[3]; }
          float qd[8], kd[8], ke[8], dc[8];
          if (lane == 0) { *(f32x4*)(CUMB + (size_t)n * GDK + w * 8) = (f32x4){cumb[0], cumb[1], cumb[2], cumb[3]}; *(f32x4*)(CUMB + (size_t)n * GDK + w * 8 + 4) = (f32x4){cumb[4], cumb[5], cumb[6], cumb[7]}; }
#pragma unroll
          for (int j = 0; j < 8; ++j) { const float blast = __builtin_bit_cast(float, __builtin_amdgcn_readlane(__builtin_bit_cast(int, bx[j]), 63));
              cumb[j] += blast;
              const float eb = __expf(bx[j]), enb = __builtin_amdgcn_rcpf(eb); dc[j] = __expf(blast);
              qd[j] = qf[j] * eb * 0.125f; kd[j] = kf[j] * enb; ke[j] = kd[j] * dc[j]; }
          v4u o; o.x = pk2(qd[0], qd[1]); o.y = pk2(qd[2], qd[3]); o.z = pk2(qd[4], qd[5]); o.w = pk2(qd[6], qd[7]); *(LAS v4u*)(QD + lane * GLS + w * 8) = o;
          o.x = pk2(kd[0], kd[1]); o.y = pk2(kd[2], kd[3]); o.z = pk2(kd[4], kd[5]); o.w = pk2(kd[6], kd[7]); *(LAS v4u*)(KD + lane * GLS + w * 8) = o;
#pragma unroll
          for (int j = 0; j < 8; ++j) KET[(w * 8 + j) * GLS + lane] = (bf16)(pk2(ke[j], ke[j]) & 0xffffu);
          if (lane == 0) { *(LAS f32x4*)(DEC + w * 8) = (f32x4){dc[0], dc[1], dc[2], dc[3]}; *(LAS f32x4*)(DEC + w * 8 + 4) = (f32x4){dc[4], dc[5], dc[6], dc[7]}; }
          const unsigned vw0[4] = {v80.x, v80.y, v80.z, v80.w}, vw1[4] = {v81.x, v81.y, v81.z, v81.w};
#pragma unroll
          for (int j = 0; j < 4; ++j) { VT[(vbk * 8 + 2 * j) * GLS + vsl] = (bf16)(vw0[j] & 0xffffu); VT[(vbk * 8 + 2 * j + 1) * GLS + vsl] = (bf16)(vw0[j] >> 16);
              VT[(vbk * 8 + 2 * j) * GLS + vsl + 32] = (bf16)(vw1[j] & 0xffffu); VT[(vbk * 8 + 2 * j + 1) * GLS + vsl + 32] = (bf16)(vw1[j] >> 16); } }
        WG_SYNC();
        { const int tt = w >> 1, st0 = (w & 1) * 2;
          bf16x8 af[2];
#pragma unroll
          for (int ks = 0; ks < 2; ++ks) af[ks] = *(const LAS bf16x8*)(QD + (16 * tt + fr) * GLS + 32 * ks + 8 * fq);
#pragma unroll
          for (int q2 = 0; q2 < 2; ++q2) { const int st = st0 + q2; f32x4 c = (f32x4){0.f, 0.f, 0.f, 0.f};
              if (st <= tt) {
#pragma unroll
                  for (int ks = 0; ks < 2; ++ks) { const bf16x8 bfm = *(const LAS bf16x8*)(KD + (16 * st + fr) * GLS + 32 * ks + 8 * fq); c = __builtin_amdgcn_mfma_f32_16x16x32_bf16(af[ks], bfm, c, 0, 0, 0); } }
#pragma unroll
              for (int i = 0; i < 4; ++i) { const int t = 16 * tt + 4 * fq + i, sidx = 16 * st + fr; const float val = (sidx <= t) ? c[i] : 0.f; P[t * GLS + sidx] = (bf16)(pk2(val, val) & 0xffffu); } } }
        WG_SYNC();
        { bf16x8 vtf[2], sb[2];
#pragma unroll
          for (int ks = 0; ks < 2; ++ks) { vtf[ks] = *(const LAS bf16x8*)(VT + (16 * w + fr) * GLS + 32 * ks + 8 * fq);
              v4u pw_; pw_.x = pk2(Sacc[2 * ks][0], Sacc[2 * ks][1]); pw_.y = pk2(Sacc[2 * ks][2], Sacc[2 * ks][3]); pw_.z = pk2(Sacc[2 * ks + 1][0], Sacc[2 * ks + 1][1]); pw_.w = pk2(Sacc[2 * ks + 1][2], Sacc[2 * ks + 1][3]);
              sb[ks] = __builtin_bit_cast(bf16x8, pw_); }
          f32x4 o[4];
#pragma unroll
          for (int mt = 0; mt < 4; ++mt) { o[mt] = (f32x4){0.f, 0.f, 0.f, 0.f};
#pragma unroll
              for (int ks = 0; ks < 2; ++ks) { const bf16x8 a = *(const LAS bf16x8*)(P + (16 * mt + fr) * GLS + 32 * ks + 8 * fq); o[mt] = __builtin_amdgcn_mfma_f32_16x16x32_bf16(a, vtf[ks], o[mt], 0, 0, 0); }
#pragma unroll
              for (int ks = 0; ks < 2; ++ks) { const v2u lo = *(const LAS v2u*)(QD + (16 * mt + fr) * GLS + 32 * ks + 4 * fq), hi = *(const LAS v2u*)(QD + (16 * mt + fr) * GLS + 32 * ks + 16 + 4 * fq);
                  v4u aw; aw.x = lo.x; aw.y = lo.y; aw.z = hi.x; aw.w = hi.y; o[mt] = __builtin_amdgcn_mfma_f32_16x16x32_bf16(__builtin_bit_cast(bf16x8, aw), sb[ks], o[mt], 0, 0, 0); } }
#pragma unroll
          for (int mt = 0; mt < 4; ++mt) { const f32x4 d4 = *(const LAS f32x4*)(DEC + 16 * mt + 4 * fq); Sacc[mt] = Sacc[mt] * d4;
#pragma unroll
              for (int ks = 0; ks < 2; ++ks) { const bf16x8 a = *(const LAS bf16x8*)(KET + (16 * mt + fr) * GLS + 32 * ks + 8 * fq); Sacc[mt] = __builtin_amdgcn_mfma_f32_16x16x32_bf16(a, vtf[ks], Sacc[mt], 0, 0, 0); } }
#pragma unroll
          for (int mt = 0; mt < 4; ++mt)
#pragma unroll
              for (int i = 0; i < 4; ++i) OT[(16 * mt + 4 * fq + i) * OTS + 16 * w + fr] = o[mt][i]; }
        WG_SYNC();
        { f32x4 ov4[4]; float tot2 = 0.f;
#pragma unroll
          for (int q = 0; q < 4; ++q) { ov4[q] = *(const LAS f32x4*)(OT + ot * OTS + ov + 4 * q); tot2 += (ov4[q][0] * ov4[q][0] + ov4[q][1] * ov4[q][1]) + (ov4[q][2] * ov4[q][2] + ov4[q][3] * ov4[q][3]); }
          tot2 += dpp_f<0xB1>(tot2); tot2 += dpp_f<0x4E>(tot2); tot2 += dpp_f<0x141>(tot2);
          const float rstd = (seg == 0) ? __builtin_amdgcn_rsqf(tot2 * (1.0f / GDV) + EPS) : 1.0f;
          f32x4 r0, r1, r2, r3; unpack8(r80, r0, r1); unpack8(r81, r2, r3);
          if (seg != 0) { r0 = (f32x4){1.f, 1.f, 1.f, 1.f}; r1 = r0; r2 = r0; r3 = r0; }
          bf16* op = ON + (tb + ot) * GVW + h * 128 + ov;
          *(v4u*)op = pack8(ov4[0] * rstd * r0, ov4[1] * rstd * r1); *(v4u*)(op + 8) = pack8(ov4[2] * rstd * r2, ov4[3] * rstd * r3); }
    }
#undef GLA_LOADS
    if (seg + 1 < NSEG) {
        float* SL = WSP(float, WS_SLOC) + ((size_t)(b * GH + h) * NSEG + seg) * GDK * GDV;
#pragma unroll
        for (int mt = 0; mt < 4; ++mt)
#pragma unroll
            for (int i = 0; i < 4; ++i) SL[(16 * mt + 4 * fq + i) * GDV + 16 * w + fr] = Sacc[mt][i];
        if (lane == 0) { float* DT = WSP(float, WS_DTOT) + ((size_t)(b * GH + h) * NSEG + seg) * GDK + w * 8;
#pragma unroll
            for (int j = 0; j < 8; ++j) DT[j] = __expf(cumb[j]); }
    }
    WG_SYNC();
}
constexpr int FX_QD = 0, FX_SB = 9216, FX_OT = 27648;
__device__ __forceinline__ void gla_fix_unit(Frame& F, const int b, const int h, const int seg) {
    const bf16* PJ = WSP(bf16, WS_PJ); const float* BC = WSP(float, WS_BC); bf16* ON = WSP(bf16, WS_ON);
    int tid_ = threadIdx.x; asm volatile("" : "+v"(tid_));
    const int tid = tid_, lane = tid & 63, w = __builtin_amdgcn_readfirstlane(tid >> 6), fr = lane & 15, fq = lane >> 4;
    LAS bf16* QD2 = (LAS bf16*)(F.lds + FX_QD); LAS bf16* SB = (LAS bf16*)(F.lds + FX_SB); LAS float* OT = (LAS float*)(F.lds + FX_OT);
    { const float* SL = WSP(float, WS_SLOC) + (size_t)(b * GH + h) * NSEG * GDK * GDV; const float* DT = WSP(float, WS_DTOT) + (size_t)(b * GH + h) * NSEG * GDK;
#pragma unroll
      for (int j = 0; j < 8; ++j) { const int d = 8 * w + j; float s0 = 0.f, s1 = 0.f;
          for (int i = 0; i < seg; ++i) { const float dt = DT[i * GDK + d]; s0 = dt * s0 + SL[((size_t)i * GDK + d) * GDV + lane]; s1 = dt * s1 + SL[((size_t)i * GDK + d) * GDV + lane + 64]; }
          SB[lane * GLS + d] = (bf16)(pk2(s0, s0) & 0xffffu); SB[(lane + 64) * GLS + d] = (bf16)(pk2(s1, s1) & 0xffffu); } }
    const size_t rowbase = (size_t)b * SEQ + (size_t)seg * SEGCH * GCH;
    const float* CUMB = WSP(float, WS_CUMB) + ((size_t)(b * GH + h) * (SEQ / GCH) + seg * SEGCH) * GDK;
    const int ot = tid >> 3, ov = (tid & 7) * 16, dq = (tid & 7) * 8;
    v4u qq, oq0, oq1, rq0, rq1; f32x4 bq0, bq1, cq0, cq1;
#define FIX_LOADS(n_) do { const size_t tb__ = rowbase + (size_t)(n_) * GCH;         qq = *(const v4u*)(PJ + (tb__ + ot) * NPJ + PJ_Q + h * 64 + dq); const float* bp = BC + (tb__ + ot) * GKW + h * 64 + dq; bq0 = *(const f32x4*)bp; bq1 = *(const f32x4*)(bp + 4);         const float* cp = CUMB + (size_t)(n_) * GDK + dq; cq0 = *(const f32x4*)cp; cq1 = *(const f32x4*)(cp + 4);         const bf16* op_ = ON + (tb__ + ot) * GVW + h * 128 + ov; oq0 = *(const v4u*)op_; oq1 = *(const v4u*)(op_ + 8);         const bf16* rr = PJ + (tb__ + ot) * NPJ + PJ_R + h * 128 + ov; rq0 = *(const v4u*)rr; rq1 = *(const v4u*)(rr + 8); } while (0)
    FIX_LOADS(0);
    for (int n = 0; n < SEGCH; ++n) {
        const size_t tb = rowbase + (size_t)n * GCH;
        const v4u q8 = qq, o80 = oq0, o81 = oq1, r80 = rq0, r81 = rq1; const f32x4 b80 = bq0, b81 = bq1, c80 = cq0, c81 = cq1;
        if (n + 1 < SEGCH) FIX_LOADS(n + 1);
        { f32x4 qa, qb; unpack8(q8, qa, qb); f32x4 e0, e1;
#pragma unroll
          for (int j = 0; j < 4; ++j) { e0[j] = qa[j] * 0.125f * __expf(b80[j] + c80[j]); e1[j] = qb[j] * 0.125f * __expf(b81[j] + c81[j]); }
          *(LAS v4u*)(QD2 + ot * GLS + dq) = pack8(e0, e1); }
        WG_SYNC();
        { bf16x8 bfm[2];
#pragma unroll
          for (int ks = 0; ks < 2; ++ks) bfm[ks] = *(const LAS bf16x8*)(SB + (16 * w + fr) * GLS + 32 * ks + 8 * fq);
#pragma unroll
          for (int mt = 0; mt < 4; ++mt) { f32x4 c = (f32x4){0.f, 0.f, 0.f, 0.f};
#pragma unroll
              for (int ks = 0; ks < 2; ++ks) { const bf16x8 a = *(const LAS bf16x8*)(QD2 + (16 * mt + fr) * GLS + 32 * ks + 8 * fq); c = __builtin_amdgcn_mfma_f32_16x16x32_bf16(a, bfm[ks], c, 0, 0, 0); }
#pragma unroll
              for (int i = 0; i < 4; ++i) OT[(16 * mt + 4 * fq + i) * OTS + 16 * w + fr] = c[i]; } }
        WG_SYNC();
        { f32x4 t4[4], l0, l1, l2, l3; unpack8(o80, l0, l1); unpack8(o81, l2, l3);
          t4[0] = *(const LAS f32x4*)(OT + ot * OTS + ov) + l0; t4[1] = *(const LAS f32x4*)(OT + ot * OTS + ov + 4) + l1; t4[2] = *(const LAS f32x4*)(OT + ot * OTS + ov + 8) + l2; t4[3] = *(const LAS f32x4*)(OT + ot * OTS + ov + 12) + l3;
          float sq = 0.f;
#pragma unroll
          for (int q = 0; q < 4; ++q) sq += (t4[q][0] * t4[q][0] + t4[q][1] * t4[q][1]) + (t4[q][2] * t4[q][2] + t4[q][3] * t4[q][3]);
          sq += dpp_f<0xB1>(sq); sq += dpp_f<0x4E>(sq); sq += dpp_f<0x141>(sq);
          const float rstd = __builtin_amdgcn_rsqf(sq * (1.0f / GDV) + EPS);
          f32x4 r0, r1, r2, r3; unpack8(r80, r0, r1); unpack8(r81, r2, r3);
          bf16* op = ON + (tb + ot) * GVW + h * 128 + ov;
          *(v4u*)op = pack8(t4[0] * rstd * r0, t4[1] * rstd * r1); *(v4u*)(op + 8) = pack8(t4[2] * rstd * r2, t4[3] * rstd * r3); }
    }
#undef FIX_LOADS
    WG_SYNC();
}
__device__ __forceinline__ void pool_items(Frame& F, const int widx, const int nworkers) {
    const bf16* PJ = WSP(bf16, WS_PJ); bf16* PD = WSP(bf16, WS_PD);
    const int gw = widx * 8 + F.wave, NGW = nworkers * 8, cb = F.lane, wlen = 2 << (cb >> 4);
    constexpr int RUN = 32;
    for (int u = gw; u < T / RUN; u += NGW) {
        const int t0 = u * RUN, pos0 = t0 & (SEQ - 1);
        const bf16* base = PJ + (size_t)t0 * NPJ + PJ_U + cb * 8;
        f32x4 a0 = (f32x4){0.f, 0.f, 0.f, 0.f}, a1 = a0;
#pragma unroll
        for (int i = 1; i <= 16; ++i) { const bool in = (i <= wlen) && (i <= pos0); const v4u vw = *(const v4u*)(base - (size_t)(in ? i : 0) * NPJ); f32x4 u0, u1; unpack8(vw, u0, u1); const float m = in ? 1.f : 0.f; a0 += u0 * m; a1 += u1 * m; }
#pragma unroll 4
        for (int i = 0; i < RUN; ++i) {
            const int pos = pos0 + i; const bool drop = pos >= wlen;
            const v4u nw = *(const v4u*)(base + (size_t)i * NPJ), ow = *(const v4u*)(base + (size_t)(drop ? i - wlen : i) * NPJ);
            f32x4 n0, n1, o0, o1; unpack8(nw, n0, n1); unpack8(ow, o0, o1); const float m = drop ? 1.f : 0.f;
            a0 += n0 - o0 * m; a1 += n1 - o1 * m;
            const float inv = __builtin_amdgcn_rcpf((float)(pos + 1 < wlen ? pos + 1 : wlen));
            *(v4u*)(PD + (size_t)(t0 + i) * PW + cb * 8) = pack8(a0 * inv - n0, a1 * inv - n1);
        }
    }
}
__device__ __forceinline__ void p2a_phase(Frame& F) {
    constexpr int NU = BATCH * GH * NSEG;
    for (int u = F.bid; u < NU; u += F.G) gla_unit(F, u >> 4, (u >> 2) & 3, u & 3);
}
__device__ __forceinline__ void p2b_phase(Frame& F) {
    constexpr int NU = BATCH * GH * (NSEG - 1);
#pragma unroll 1
    for (int r_ = 0; r_ < REPS(10); ++r_)
    for (int u = F.bid; u < NU; u += F.G) gla_fix_unit(F, u / (GH * (NSEG - 1)), (u / (NSEG - 1)) % GH, 1 + u % (NSEG - 1));
#pragma unroll 1
    for (int r_ = 0; r_ < REPS(11); ++r_) pool_items(F, F.bid, F.G);
#pragma unroll 1
    for (int r_ = 0; r_ < REPS(12); ++r_) moe_weight_items(F, F.bid, F.G);
}

#if DBG
__device__ __forceinline__ void dbg_fail(Frame& F, unsigned code) { unsigned expect = 0u; __hip_atomic_compare_exchange_strong((unsigned*)(F.ctl + CW_DBG), &expect, code, __ATOMIC_RELAXED, __ATOMIC_RELAXED, __HIP_MEMORY_SCOPE_AGENT); }
__device__ __forceinline__ bool dbg_close(float got, float want) { return fabsf(got - want) <= 0.03f + 0.03f * fabsf(want); }
__device__ __forceinline__ void dbg_check_p1(Frame& F) {
    if (F.bid != 0 || F.tid >= 256) return;
    const float* x = F.in[0]; const float* g1 = F.in[1]; const float* w_in = F.in[2]; const float* wau = F.in[3]; const float* ba = F.in[4];
    const bf16* PJ = WSP(bf16, WS_PJ);
    const int tok = (int)(((unsigned)F.tid * 2654435761u) % (unsigned)T);
    const int col = (int)(((unsigned)F.tid * 40503u + 17u * (unsigned)F.tid * (unsigned)F.tid) % (unsigned)NPROJ);
    const float* xr = x + (size_t)tok * D; float ss = 0.f;
    for (int k = 0; k < D; ++k) ss += xr[k] * xr[k];
    const float rstd = 1.0f / sqrtf(ss / D + EPS);
    float want;
    if (col >= PJ_Z && col < PJ_U) {
        return;
        float al[16];
#pragma unroll
        for (int j = 0; j < 16; ++j) al[j] = 0.f;
        for (int k = 0; k < D; ++k) { const float hk = xr[k] * rstd * g1[k];
#pragma unroll
            for (int j = 0; j < 16; ++j) al[j] += hk * w_in[(size_t)k * D_IN + IN_A + j]; }
        float z = 0.f;
#pragma unroll
        for (int j = 0; j < 16; ++j) z += al[j] * wau[j * GKW + (col - PJ_Z)];
        z += ba[col - PJ_Z];
        want = (fminf(z, 0.f) - logf(1.0f + expf(-fabsf(z)))) / 16.0f;
    } else {
        const int wc_ = col < PJ_Z ? col : col - PJ_U + IN_U; float a = 0.f;
        for (int k = 0; k < D; ++k) a += xr[k] * rstd * g1[k] * w_in[(size_t)k * D_IN + wc_];
        if (col >= PJ_R && col < PJ_Z) want = a / (1.0f + expf(-a)); else if (col >= PJ_GG) want = 1.0f / (1.0f + expf(-a)); else want = a;
    }
    const float got = (col >= PJ_GG) ? bf1(WSP(bf16, WS_GATES)[gate_elem(col >= PJ_GP ? 1 : 0, tok, (col - PJ_GG) & 1023)]) : bf1(PJ[(size_t)tok * NPJ + col]);
    if (!dbg_close(got, want)) dbg_fail(F, 1u);
}


__device__ __forceinline__ void dbg_check_bc(Frame& F) {
    if (F.bid != 5 || F.tid >= 64) return;
    const float* x = F.in[0]; const float* g1 = F.in[1]; const float* w_in = F.in[2]; const float* wau = F.in[3]; const float* ba = F.in[4]; const float* BC = WSP(float, WS_BC);
    const int offs[5] = {0, 1, 5, 18, 63}; const int off = (F.tid % 5 == 0) ? 0 : (F.tid % 5 == 1) ? 1 : (F.tid % 5 == 2) ? 5 : (F.tid % 5 == 3) ? 18 : 63; (void)offs;
    const int chunk = (int)(((unsigned)F.tid * 2654435761u) % (unsigned)(T / 64)), col = (int)(((unsigned)F.tid * 40503u + 3u) % (unsigned)GKW);
    float cum = 0.f;
    for (int r = 0; r <= off; ++r) { const float* xr = x + ((size_t)chunk * 64 + r) * D; float ss = 0.f; for (int k = 0; k < D; ++k) ss += xr[k] * xr[k];
        const float rstd = 1.0f / sqrtf(ss / D + EPS); float al[16];
#pragma unroll
        for (int j = 0; j < 16; ++j) al[j] = 0.f;
        for (int k = 0; k < D; ++k) { const float hk = xr[k] * rstd * g1[k];
#pragma unroll
            for (int j = 0; j < 16; ++j) al[j] += hk * w_in[(size_t)k * D_IN + IN_A + j]; }
        float z = ba[col];
#pragma unroll
        for (int j = 0; j < 16; ++j) z += al[j] * wau[j * GKW + col];
        cum += (fminf(z, 0.f) - logf(1.0f + expf(-fabsf(z)))) / 16.0f; }
    const float got = BC[((size_t)chunk * 64 + off) * GKW + col];
    if (fabsf(got - cum) > 0.004f + 0.01f * fabsf(cum)) dbg_fail(F, 7u);
}
__device__ __forceinline__ void dbg_check_gla(Frame& F) {
    if (F.bid != 1) return;
    const bf16* PJ = WSP(bf16, WS_PJ); const bf16* ON = WSP(bf16, WS_ON);
    const int b = 2, h = 1, v = F.tid & 127; const bool act = F.tid < 128;
    LAS float* S = (LAS float*)F.lds;
    LAS float* red = (LAS float*)(F.lds + 32768);
    if (act) for (int d = 0; d < 64; ++d) S[d * 128 + v] = 0.f;
    __syncthreads();
    bool bad = false;
    for (int t = 0; t < 1100; ++t) {
        const bf16* rp = PJ + ((size_t)b * SEQ + t) * NPJ; float o = 0.f;
        if (act) { const float vv = bf1(rp[PJ_V + h * 128 + v]);
            for (int d = 0; d < 64; ++d) { const float* bcp = WSP(float, WS_BC) + ((size_t)b * SEQ + t) * GKW + h * 64 + d; const float la = (t & 63) ? bcp[0] - bcp[-GKW] : bcp[0]; const float kk = bf1(rp[PJ_K + h * 64 + d]), qq = bf1(rp[PJ_Q + h * 64 + d]);
                const float sn = expf(la) * S[d * 128 + v] + kk * vv; S[d * 128 + v] = sn; o += qq * 0.125f * sn; }
            red[v] = o * o; }
        __syncthreads();
        if (act) { float ss = 0.f; for (int i = 0; i < 128; ++i) ss += red[i];
            const float want = o * (1.0f / sqrtf(ss / 128.f + EPS)) * bf1(rp[PJ_R + h * 128 + v]);
            const float got = bf1(ON[((size_t)b * SEQ + t) * GVW + h * 128 + v]);
            if ((t < 150 || t >= 1000) && !dbg_close(got, want)) bad = true; }
        __syncthreads();
    }
    if (bad) dbg_fail(F, 2u);
}
__device__ __forceinline__ void dbg_check_pool(Frame& F) {
    if (F.bid != 2) return;
    const bf16* PJ = WSP(bf16, WS_PJ); const bf16* PD = WSP(bf16, WS_PD);
    int tok = (int)(((unsigned)F.tid * 2654435761u) % (unsigned)T); if (F.tid < 40) tok = (F.tid & 1) * SEQ * 3 + (F.tid >> 1);
    const int c = (int)(((unsigned)F.tid * 40503u) % (unsigned)PW), pos = tok & (SEQ - 1), wlen = 2 << (c >> 7), cnt = pos + 1 < wlen ? pos + 1 : wlen;
    float a = 0.f; for (int i = 0; i < cnt; ++i) a += bf1(PJ[(size_t)(tok - i) * NPJ + PJ_U + c]);
    const float want = a / cnt - bf1(PJ[(size_t)tok * NPJ + PJ_U + c]);
    if (!dbg_close(bf1(PD[(size_t)tok * PW + c]), want)) dbg_fail(F, 3u);
}
__device__ __forceinline__ void dbg_check_mg(Frame& F) {
    if (F.bid != 3 || F.tid >= 64) return;
    const bf16* PJ = WSP(bf16, WS_PJ); const bf16* ON = WSP(bf16, WS_ON); const bf16* PD = WSP(bf16, WS_PD); const bf16* MG = WSP(bf16, WS_MG);
    const float* gng = F.in[5]; const float* wgb = F.in[6]; const float* pw = F.in[7]; const float* ps = F.in[8]; const float* wpb = F.in[9];
    const int tok = (int)(((unsigned)F.tid * 2654435761u + 12345u) % (unsigned)T), col = (int)(((unsigned)F.tid * 40503u + 77u) % (unsigned)D);
    float yg = 0.f; for (int k = 0; k < GVW; ++k) yg += bf1(ON[(size_t)tok * GVW + k]) * gng[k] * wgb[(size_t)k * D + col];
    float yp = 0.f;
    for (int g = 0; g < 4; ++g) for (int d = 0; d < 128; ++d) { float m = 0.f; for (int c = 0; c < 128; ++c) m += bf1(PD[(size_t)tok * PW + g * 128 + c]) * pw[((size_t)g * 128 + c) * 128 + d];
        yp += m * ps[g * 128 + d] * wpb[(size_t)(g * 128 + d) * D + col]; }
    const float want = bf1(WSP(bf16, WS_GATES)[gate_elem(0, tok, col)]) * yg + bf1(WSP(bf16, WS_GATES)[gate_elem(1, tok, col)]) * yp;
    if (!dbg_close(bf1(MG[(size_t)tok * D + col]), want)) dbg_fail(F, 4u);
}
__device__ __forceinline__ void dbg_check_x1(Frame& F) {
    if (F.bid != 4 || F.tid >= 128) return;
    const bf16* MG = WSP(bf16, WS_MG); const bf16* X1B = WSP(bf16, WS_X1B); const float* SSQ = WSP(float, WS_SSQ); const float* x = F.in[0]; const float* wout = F.in[10];
    const int tok = (int)(((unsigned)F.tid * 2654435761u + 999u) % (unsigned)T), col = (int)(((unsigned)F.tid * 40503u + 5u) % (unsigned)D);
    float a = x[(size_t)tok * D + col]; for (int k = 0; k < D; ++k) a += bf1(MG[(size_t)tok * D + k]) * wout[(size_t)k * D + col];
    if (!dbg_close(bf1(X1B[(size_t)tok * D + col]), a)) dbg_fail(F, 5u);
    float ss = 0.f; for (int k = 0; k < D; ++k) { const float v = bf1(X1B[(size_t)tok * D + k]); ss += v * v; }
    float sp = 0.f; for (int j = 0; j < 16; ++j) sp += SSQ[(size_t)tok * 16 + j];
    if (fabsf(ss - sp) > 1e-2f * ss) dbg_fail(F, 6u);
}
#endif

struct Args { const float* in[20]; float* out; unsigned char* ws; };
__global__ void __launch_bounds__(512, 2) fwd_kernel(Args args) {
    extern __shared__ __attribute__((aligned(16))) unsigned char lds[];
    Frame F;
    F.lds = (LAS unsigned char*)lds;
    F.MISC = (volatile LAS unsigned*)(F.lds + MISC_OFF);
    F.tid = threadIdx.x; F.lane = F.tid & 63; F.wave = __builtin_amdgcn_readfirstlane(F.tid >> 6);
    F.G = gridDim.x; F.bid = blockIdx.x;
    F.ws = args.ws; F.out = args.out; F.ctl = (gu32*)(args.ws + WS_CTL);
#pragma unroll
    for (int i = 0; i < 20; ++i) F.in[i] = args.in[i];
    for (int u = F.tid; u < (LDS_BYTES - RING_BYTES) / 4; u += 512) ((LAS unsigned*)(F.lds + RING_BYTES))[u] = 0u;
    __syncthreads();
    XcdBarrier bar = xcd_barrier_post((unsigned*)(F.ctl + CW_BAR), F.MISC + 8);
#define GRID_BAR() xcd_barrier(bar)

#pragma unroll 1
    for (int rep_ = 0; rep_ < REPS(0); ++rep_) p0_prologue(F);
    GRID_BAR();
    if (NPH > 1) {
        pg8::StaticSched S; S.init(WSP(bf16, WS_HB), D, WSP(bf16, WS_WIN), D, T, NPROJ, F.G, F.bid);
        EpiP1 E{WSP(bf16, WS_PJ), F.in[4], WSP(float, WS_BC), WSP(bf16, WS_GATES)};
#pragma unroll 1
        for (int rep_ = 0; rep_ < REPS(1); ++rep_) pg8::gemm_phase<EpiP1, pg8::StaticSched, false, true>(F.lds, D, D, D, S, E);
        GRID_BAR();
#if DBG
        dbg_check_p1(F); dbg_check_bc(F);
        GRID_BAR();
#endif
    }
    if (NPH > 2) {
#pragma unroll 1
        for (int rep_ = 0; rep_ < REPS(2); ++rep_) p2a_phase(F);
        GRID_BAR();
        p2b_phase(F);
        GRID_BAR();
#if DBG
        dbg_check_gla(F); dbg_check_pool(F);
        GRID_BAR();
#endif
    }
    if (NPH > 4) {
        PairSched S; S.S0.init(WSP(bf16, WS_ON), GVW, WSP(bf16, WS_WG), GVW, T, D, F.G, F.bid); S.A1 = (const char*)WSP(bf16, WS_PD); S.B1 = (const char*)WSP(bf16, WS_WP);
        EpiDE E{WSP(bf16, WS_MG), WSP(bf16, WS_GATES)};
#pragma unroll 1
        for (int rep_ = 0; rep_ < REPS(3); ++rep_) pg8::gemm_phase<EpiDE, PairSched, false, true>(F.lds, GVW, GVW, GVW, S, E);
        GRID_BAR();
#if DBG
        dbg_check_mg(F);
        GRID_BAR();
#endif
    }
    if (NPH > 5) {
        pg8::StaticSched S; S.init(WSP(bf16, WS_MG), D, WSP(bf16, WS_WOUT), D, T, D, F.G, F.bid);
        EpiF E{F.in[0], WSP(bf16, WS_X1B), WSP(float, WS_SSQ)};
#pragma unroll 1
        for (int rep_ = 0; rep_ < REPS(5); ++rep_) pg8::gemm_phase<EpiF, pg8::StaticSched, false, true>(F.lds, D, D, D, S, E);
        GRID_BAR();
#if DBG
        dbg_check_x1(F);
        GRID_BAR();
#endif
    }
    if (NPH > 6) {
        pg8::StaticSched S; S.init(WSP(bf16, WS_X1B), D, WSP(bf16, WS_WR), D, T, 256, F.G, F.bid);
        EpiG E{WSP(float, WS_LG)};
#pragma unroll 1
        for (int rep_ = 0; rep_ < REPS(6); ++rep_) pg8::gemm_phase<EpiG, pg8::StaticSched, false, true>(F.lds, D, D, D, S, E);
        VM_WAIT(); __syncthreads();
        pg8::Unit u; for (int i = 0; S.next(i, u); ++i) route_rows(F, u.r0);
        GRID_BAR();
    }
    if (NPH > 7) {
        moe_tables(F);
        MoeSched S{(const LAS int*)(F.lds + SCHED_OFF + 256), (const LAS int*)(F.lds + SCHED_OFF + 256) + 40, WSP(unsigned, WS_LIST), (const char*)WSP(bf16, WS_X1B), (const char*)WSP(bf16, WS_WGU), 2, F.G, F.bid, 0};
        EpiH E{WSP(bf16, WS_ACT), WSP(float, WS_LISTR)};
#pragma unroll 1
        for (int rep_ = 0; rep_ < REPS(7); ++rep_) pg8::gemm_phase<EpiH, MoeSched, true, true>(F.lds, D, D, D, S, E);
        GRID_BAR();
    }
    if (NPH > 8) {
        MoeSched S{(const LAS int*)(F.lds + SCHED_OFF + 256), (const LAS int*)(F.lds + SCHED_OFF + 256) + 40, WSP(unsigned, WS_LIST), (const char*)WSP(bf16, WS_ACT), (const char*)WSP(bf16, WS_WD), 4, F.G, F.bid, 1};
        EpiI E{WSP(bf16, WS_Y), WSP(unsigned, WS_LIST), WSP(float, WS_LISTW)};
#pragma unroll 1
        for (int rep_ = 0; rep_ < REPS(8); ++rep_) pg8::gemm_phase<EpiI, MoeSched, false, true>(F.lds, DE, DE, DE, S, E);
        GRID_BAR();
    }
    if (NPH > 9) {
        const float* gf = F.in[19]; const bf16* X1B = WSP(bf16, WS_X1B); const bf16* Y = WSP(bf16, WS_Y);
        const int gw = F.bid * 8 + F.wave, NGW = F.G * 8;
        unsigned code = 0;
#if DBG
        code = __hip_atomic_load((unsigned*)(F.ctl + CW_DBG), RLX_AGENT);
        if (__hip_atomic_load((unsigned*)(F.ctl + CW_BAR) + XB_TMO, RLX_AGENT) != 0u) code = 9;
#endif
#pragma unroll 1
        for (int rep_ = 0; rep_ < REPS(9); ++rep_)
        for (int m = gw; m < T; m += NGW) {
            const GAS v2u* xr = (const GAS v2u*)(X1B + (size_t)m * D) + F.lane;
            const GAS v2u* y0 = (const GAS v2u*)(Y + (size_t)(2 * m) * D) + F.lane; const GAS v2u* y1 = (const GAS v2u*)(Y + (size_t)(2 * m + 1) * D) + F.lane;
            f32x4 v[4]; float s_ = 0.f;
#pragma unroll
            for (int j = 0; j < 4; ++j) { const v2u a = y0[64 * j], b = y1[64 * j], c = xr[64 * j]; v[j] = (f32x4){bflo(c.x), bfhi(c.x), bflo(c.y), bfhi(c.y)} + (f32x4){bflo(a.x), bfhi(a.x), bflo(a.y), bfhi(a.y)} + (f32x4){bflo(b.x), bfhi(b.x), bflo(b.y), bfhi(b.y)};
                s_ += (v[j].x * v[j].x + v[j].y * v[j].y) + (v[j].z * v[j].z + v[j].w * v[j].w); }
            const float rstd = 1.0f / sqrtf(wave_sum(s_) * (1.f / D) + EPS);
            GAS f32x4* o = (GAS f32x4*)(F.out + (size_t)m * D) + F.lane;
#pragma unroll
            for (int j = 0; j < 4; ++j) { const f32x4 g = *((const GAS f32x4*)gf + F.lane + 64 * j); f32x4 r = v[j] * rstd * g; if (code) r = (f32x4){10.f * code, 10.f * code, 10.f * code, 10.f * code}; o[64 * j] = r; }
        }
    } else
    {
        const float* gf = F.in[19]; const float* x = F.in[0];
        const int gw = F.bid * 8 + F.wave, NGW = F.G * 8;
        unsigned code = 0;
#if DBG
        code = __hip_atomic_load((unsigned*)(F.ctl + CW_DBG), RLX_AGENT);
        if (__hip_atomic_load((unsigned*)(F.ctl + CW_BAR) + XB_TMO, RLX_AGENT) != 0u) code = 9;
#endif
        for (int m = gw; m < T; m += NGW) {
            const GAS f32x4* xr = (const GAS f32x4*)(x + (size_t)m * D) + F.lane;
            f32x4 v[4]; float s = 0.f;
#pragma unroll
            for (int j = 0; j < 4; ++j) { v[j] = xr[64 * j]; s += (v[j].x * v[j].x + v[j].y * v[j].y) + (v[j].z * v[j].z + v[j].w * v[j].w); }
            const float rstd = 1.0f / sqrtf(wave_sum(s) * (1.f / D) + EPS);
            GAS f32x4* o = (GAS f32x4*)(F.out + (size_t)m * D) + F.lane;
#pragma unroll
            for (int j = 0; j < 4; ++j) { const f32x4 g = *((const GAS f32x4*)gf + F.lane + 64 * j); f32x4 r = v[j] * rstd * g; if (code) r = (f32x4){10.f * code, 10.f * code, 10.f * code, 10.f * code}; o[64 * j] = r; }
        }
    }
}

extern "C" void kernel_launch(void* const* d_in, const int* in_sizes, int n_in, void* d_out, int out_size, void* d_ws, size_t ws_size, hipStream_t stream) {
    static int grid = 0;
    if (grid == 0) {
        if (n_in != 20 || in_sizes[0] != T * D || out_size != T * D || ws_size < WS_END) { fprintf(stderr, "kernel_launch: unexpected shapes (n_in %d, in0 %d, out %d, ws %zu)\n", n_in, n_in > 0 ? in_sizes[0] : -1, out_size, ws_size); grid = -1; return; }
        int dev = 0, cus = 0, per_cu = 0;
        if (hipGetDevice(&dev) != hipSuccess || hipDeviceGetAttribute(&cus, hipDeviceAttributeMultiprocessorCount, dev) != hipSuccess) { grid = -1; return; }
        if (hipFuncSetAttribute((const void*)fwd_kernel, hipFuncAttributeMaxDynamicSharedMemorySize, LDS_BYTES) != hipSuccess) { fprintf(stderr, "kernel_launch: hipFuncSetAttribute failed\n"); grid = -1; return; }
        if (hipOccupancyMaxActiveBlocksPerMultiprocessor(&per_cu, (const void*)fwd_kernel, 512, LDS_BYTES) != hipSuccess || per_cu < 1) fprintf(stderr, "kernel_launch: occupancy query says %d\n", per_cu);
        (void)hipGetLastError();
        grid = cus;
    }
    if (grid < 0) return;
    if (hipMemsetAsync((char*)d_ws + WS_CTL, 0, CTL_ZERO_BYTES, stream) != hipSuccess) return;
    Args a{};
    for (int i = 0; i < 20; ++i) a.in[i] = (const float*)d_in[i];
    a.out = (float*)d_out; a.ws = (unsigned char*)d_ws;
    hipLaunchKernelGGL(fwd_kernel, dim3(grid), dim3(512), LDS_BYTES, stream, a);
}
```

```cpp
#include <hip/hip_runtime.h>
#include <cstdio>
#include <cstdint>

#ifndef DBG
#define DBG 0
#endif
#ifndef REPMASK
#define REPMASK 0
#endif
#define REPS(k) ((((REPMASK) >> (k)) & 1) ? 2 : 1)
#ifndef NPH
#define NPH 10
#endif

constexpr int BATCH = 16, SEQ = 4096, T = BATCH * SEQ, D = 1024;
constexpr int GH = 4, GDK = 64, GDV = 128, GKW = 256, GVW = 512, GRANK = 16, GCH = 64;
constexpr int PW = 512, PGW = 128;
constexpr int D_IN = 4112;
constexpr int IN_Q = 0, IN_K = 256, IN_V = 512, IN_R = 1024, IN_A = 1536, IN_U = 1552, IN_GG = 2064, IN_GP = 3088;
constexpr int NPROJ = 4352;
constexpr int NPJ = 2304;
constexpr int PJ_Q = 0, PJ_K = 256, PJ_V = 512, PJ_R = 1024, PJ_Z = 1536, PJ_U = 1792, PJ_GG = 2304, PJ_GP = 3328;
constexpr int NE = 32, EPG = 8, NG = 4, DE = 256;
constexpr int NSEG = 4, SEGCH = SEQ / GCH / NSEG;
constexpr int NA = 2 * T;
constexpr int LCAP = T;
constexpr float EPS = 1e-6f;

constexpr size_t MiB = 1u << 20;
constexpr size_t WS_CTL = 0, CTL_ZERO_BYTES = 1 * MiB;
constexpr size_t WS_WIN = 1 * MiB;
constexpr size_t WS_WG = 10 * MiB;
constexpr size_t WS_WP = 11 * MiB;
constexpr size_t WS_WOUT = 12 * MiB;
constexpr size_t WS_WR = 14 * MiB;
constexpr size_t WS_WGU = 15 * MiB;
constexpr size_t WS_WD = 47 * MiB;
constexpr size_t WS_XS = 63 * MiB;
constexpr size_t WS_HB = 64 * MiB;
constexpr size_t WS_TG = WS_HB;
constexpr size_t WS_MG = 192 * MiB;
constexpr size_t WS_SLOC = 256 * MiB;
constexpr size_t WS_DTOT = 264 * MiB;
constexpr size_t WS_CUMB = 265 * MiB;
constexpr size_t WS_BC = 192 * MiB;
constexpr size_t WS_Y = 64 * MiB;
constexpr size_t WS_ON = 320 * MiB;
constexpr size_t WS_PD = 384 * MiB;
constexpr size_t WS_ACT = 320 * MiB;
constexpr size_t WS_PJ = 448 * MiB;
constexpr size_t WS_GATES = 736 * MiB;
constexpr size_t WS_X1B = 448 * MiB;
constexpr size_t WS_LG = 576 * MiB;
constexpr size_t WS_SSQ = 592 * MiB;
constexpr size_t WS_LIST = 596 * MiB;
constexpr size_t WS_LISTW = 604 * MiB;
constexpr size_t WS_LISTR = 612 * MiB;
constexpr size_t WS_END = 992 * MiB;
static_assert(WS_PJ + (size_t)T * NPJ * 2 <= WS_GATES && WS_GATES + (size_t)2 * T * D * 2 <= WS_END && WS_LISTR + (size_t)NE * LCAP * 4 <= WS_GATES && WS_ACT + (size_t)(NA + NE * 256) * DE * 2 <= WS_PJ, "d_ws map");
constexpr int CW_TMO = 0, CW_DBG = 2;
constexpr int CW_BAR = 4096;
constexpr int CW_ECNT = 16384;

constexpr int RING_BYTES = 131072;
constexpr int MISC_OFF = RING_BYTES + 320;
constexpr int SCHED_OFF = RING_BYTES + 1024;
constexpr int LDS_BYTES = 147456;

#define GAS __attribute__((address_space(1)))
#define LAS __attribute__((address_space(3)))
typedef unsigned short bf16;
typedef unsigned v4u __attribute__((ext_vector_type(4)));
typedef unsigned v2u __attribute__((ext_vector_type(2)));
typedef float f32x4 __attribute__((ext_vector_type(4)));
typedef short bf16x8 __attribute__((ext_vector_type(8)));
typedef short bf16x4 __attribute__((ext_vector_type(4)));
typedef GAS unsigned gu32;
#define RLX_AGENT __ATOMIC_RELAXED, __HIP_MEMORY_SCOPE_AGENT
#define LDS_WAIT() asm volatile("s_waitcnt lgkmcnt(0)" ::: "memory")
#define VM_WAIT() asm volatile("s_waitcnt vmcnt(0)" ::: "memory")
__device__ __forceinline__ unsigned f2bf(float f) { unsigned u = __builtin_bit_cast(unsigned, f); return (u + 0x7fffu + ((u >> 16) & 1u)) >> 16; }
__device__ __forceinline__ unsigned pk2(float lo, float hi) { unsigned r; asm volatile("v_cvt_pk_bf16_f32 %0, %1, %2" : "=v"(r) : "v"(lo), "v"(hi)); return r; }
__device__ __forceinline__ float bflo(unsigned w) { return __builtin_bit_cast(float, w << 16); }
__device__ __forceinline__ float bfhi(unsigned w) { return __builtin_bit_cast(float, w & 0xffff0000u); }
__device__ __forceinline__ float bf1(bf16 h) { return __builtin_bit_cast(float, (unsigned)h << 16); }
__device__ __forceinline__ float fsigmoid(float x) { return __builtin_amdgcn_rcpf(1.0f + __expf(-x)); }
__device__ __forceinline__ float wave_sum(float v) {
#pragma unroll
    for (int o = 1; o < 64; o <<= 1) v += __shfl_xor(v, o);
    return v;
}


template <int CTRL> __device__ __forceinline__ float dpp_f(float x) { return __builtin_bit_cast(float, __builtin_amdgcn_update_dpp(0, __builtin_bit_cast(int, x), CTRL, 0xf, 0xf, true)); }
__device__ __forceinline__ float row16_sum(float x) { x += dpp_f<0x128>(x); x += dpp_f<0x124>(x); x += dpp_f<0x122>(x); x += dpp_f<0x121>(x); return x; }
__device__ __forceinline__ float row16_scan(float x) { x += dpp_f<0x111>(x); x += dpp_f<0x112>(x); x += dpp_f<0x114>(x); x += dpp_f<0x118>(x); return x; }

#define XB_TMO      128
#define XB_XCNT(j)  (256  + 64 * (j))
#define XB_XSUB(j)  (1280 + 64 * (j))
#define XB_XGEN(j)  (2304 + 64 * (j))
#define XB_TOP      3328
#define XB_TOPGEN   3392
#define XCD_BAR_WORDS 3456
#define XB_SPIN_CAP (1u << 18)
__device__ __forceinline__ unsigned xb_ld(unsigned* p)              { return __hip_atomic_load(p, __ATOMIC_RELAXED, __HIP_MEMORY_SCOPE_AGENT); }
__device__ __forceinline__ unsigned xb_add(unsigned* p, unsigned v) { return __hip_atomic_fetch_add(p, v, __ATOMIC_RELAXED, __HIP_MEMORY_SCOPE_AGENT); }
__device__ __forceinline__ unsigned xb_xcc_id() { return (unsigned)__builtin_amdgcn_s_getreg((3 << 11) | 20) & 0xFu; }
#define XB_SPIN(cond, bar) do { unsigned _sp = 0; while (cond) { __builtin_amdgcn_s_sleep(1); \
    if ((++_sp & 255u) == 0u) { if (xb_ld(&(bar)[XB_TMO])) break; if (_sp > XB_SPIN_CAP) { atomicAdd(&(bar)[XB_TMO], 1u); break; } } } } while (0)
struct XcdBarrier { unsigned* bar; unsigned x; volatile LAS unsigned* st; };
__device__ __forceinline__ XcdBarrier xcd_barrier_post(unsigned* bar, volatile LAS unsigned* st) {
    XcdBarrier b; b.bar = bar; b.x = xb_xcc_id(); b.st = st;
    if (threadIdx.x == 0) (void)xb_add(&bar[XB_XCNT(b.x)], 1u);
    return b;
}
__device__ __forceinline__ void xcd_barrier_complete(unsigned* bar, unsigned x, unsigned& nloc, unsigned& nx) {
    const unsigned G = gridDim.x * gridDim.y * gridDim.z;
    unsigned sum, cnt, mine, sp = 0u;
    for (;;) {
        sum = 0u; cnt = 0u; mine = 0u;
#pragma unroll
        for (unsigned j = 0; j < 16; ++j) { const unsigned c = xb_ld(&bar[XB_XCNT(j)]); sum += c; cnt += (c > 0u) ? 1u : 0u; mine = (j == x) ? c : mine; }
        if (sum == G) break;
        __builtin_amdgcn_s_sleep(1);
        if ((++sp & 255u) == 0u) { if (xb_ld(&bar[XB_TMO])) break; if (sp > XB_SPIN_CAP) { atomicAdd(&bar[XB_TMO], 1u); break; } }
    }
    nloc = mine > 0u ? mine : 1u; nx = cnt > 0u ? cnt : 1u;
}
__device__ __forceinline__ void xcd_barrier(const XcdBarrier& b) {
    asm volatile("s_waitcnt vmcnt(0)" ::: "memory");
    __syncthreads();
    if (threadIdx.x == 0) {
        unsigned* bar = b.bar;
        __builtin_amdgcn_s_waitcnt(0);
        unsigned nloc = b.st[0], nx = b.st[1];
        if (nloc == 0u) { xcd_barrier_complete(bar, b.x, nloc, nx); b.st[0] = nloc; b.st[1] = nx; }
        const unsigned old = xb_add(&bar[XB_XSUB(b.x)], 1u);
        const unsigned gen = old / nloc;
        if (old + 1u == (gen + 1u) * nloc) {
            __builtin_amdgcn_fence(__ATOMIC_RELEASE, "agent");
            asm volatile("s_waitcnt vmcnt(0)" ::: "memory");
            const unsigned og = xb_add(&bar[XB_TOP], 1u);
            const unsigned tg = og / nx;
            if (og + 1u == (tg + 1u) * nx) xb_add(&bar[XB_TOPGEN], 1u);
            else XB_SPIN(xb_ld(&bar[XB_TOPGEN]) == tg, bar);
            __builtin_amdgcn_fence(__ATOMIC_ACQUIRE, "agent");
            xb_add(&bar[XB_XGEN(b.x)], 1u);
            asm volatile("s_waitcnt vmcnt(0)" ::: "memory");
        } else {
            XB_SPIN(xb_ld(&bar[XB_XGEN(b.x)]) == gen, bar);
            __builtin_amdgcn_fence(__ATOMIC_ACQUIRE, "agent");
            asm volatile("s_waitcnt vmcnt(0)" ::: "memory");
        }
    }
    __syncthreads();
}

namespace pg8 {
#define PG8_LAS __attribute__((address_space(3)))
constexpr int BM = 256, BK = 64, HALF = 128, HTB = HALF * BK * 2, STAGE_BYTES = 8 * HTB, NXCD = 8, WGM = 8;
__host__ __device__ __forceinline__ int lds_byte(int r, int c) { const int st = (r >> 4) * 2 + (c >> 5), rr = r & 15, cc = c & 31, ob = rr * 64 + cc * 2; return st * 1024 + (ob ^ (((ob >> 9) & 1) << 5)); }
__host__ __device__ __forceinline__ void stage_rc(int b, int& R, int& C) { const int st = b / 1024, sb = b % 1024, swz = sb ^ (((sb >> 9) & 1) << 5); R = (st >> 1) * 16 + swz / 64; C = (st & 1) * 32 + (swz % 64) / 2; }
__host__ __device__ __forceinline__ int perm32(int rho) { const int n = rho >> 4, i = rho & 15; return 8 * (i >> 2) + 4 * n + (i & 3); }

struct Unit { const char* A; const char* B; int r0, c0, e, nvalid, lb, pad; };

__device__ __forceinline__ int remap_xcd(int L, int nwg) { const int q = nwg / NXCD, r = nwg % NXCD, xcd = L % NXCD, off = L / NXCD; return (xcd < r ? xcd * (q + 1) : r * (q + 1) + (xcd - r) * q) + off; }
struct StaticSched {
    const char* A; const char* B; int lda, ldb, nM, nN, nwg, G, c;
    __device__ __forceinline__ void init(const void* A_, int lda_, const void* B_, int ldb_, int M, int N, int G_, int c_) { A = (const char*)A_; B = (const char*)B_; lda = lda_; ldb = ldb_; nM = M / BM; nN = N / BM; nwg = nM * nN; G = G_; c = c_; }
    __device__ __forceinline__ bool next(int i, Unit& u) const {
        const long L = (long)i * G + c; if (L >= nwg) return false;
        const int wgid = remap_xcd((int)L, nwg);
        const int nig = WGM * nN, gid = wgid / nig, fm = gid * WGM, gsz = (nM - fm) < WGM ? (nM - fm) : WGM;
        const int pm = fm + ((wgid % nig) % gsz), pn = (wgid % nig) / gsz;
        u.A = A + (size_t)pm * BM * lda * 2; u.B = B + (size_t)pn * BM * ldb * 2; u.r0 = pm * BM; u.c0 = pn * BM; u.e = 0; u.nvalid = BM; u.lb = 0; u.pad = 0; return true;
    }
    __device__ __forceinline__ void fill_tab(const Unit&, PG8_LAS unsigned*) const {}
};

template <class Epi, class Sched, bool GATHER, bool ALIGN_EPI>
__device__ __forceinline__ void gemm_phase(PG8_LAS unsigned char* lds, const int K, const int lda, const int ldb, const Sched& S, const Epi& E) {
    int tid_ = threadIdx.x; asm volatile("" : "+v"(tid_));
    const int tid = tid_, wid = __builtin_amdgcn_readfirstlane(tid >> 6), lane = tid & 63, wr = wid >> 2, wc = wid & 3, fr = lane & 15, fq = lane >> 4;
    const int nt = K / BK;
    int Rr[2], Cc[2];
    unsigned voffA[2][2], voffB[2], nvA[2][2];
#pragma unroll
    for (int i = 0; i < 2; ++i) { int R, C; stage_rc(tid * 16 + i * 8192, R, C); Rr[i] = R; Cc[i] = C; const int Rb = Epi::PERM ? ((R & ~31) + perm32(R & 31)) : R;
        voffB[i] = (unsigned)(Rb * ldb + C) * 2u;
#pragma unroll
        for (int h = 0; h < 2; ++h) { voffA[h][i] = (unsigned)((R + HALF * h) * lda + C) * 2u; nvA[h][i] = voffA[h][i]; } }
    const size_t kstep = (size_t)(BK * 2);
    const size_t hstepB = (size_t)HALF * ldb * 2;
    const unsigned ldsw = (unsigned)wid * 1024u;
    const int aoff = lds_byte(wr * 64 + fr, fq * 8), boff = lds_byte(wc * 32 + fr, fq * 8);
#define PG8_SA(b, h) (((b) * 2 + (h)) * HTB)
#define PG8_SB(b, h) ((4 + (b) * 2 + (h)) * HTB)
#define PG8_STAGE(bufoff, gbase, voff) do { _Pragma("unroll") for (int _i = 0; _i < 2; ++_i) \
        __builtin_amdgcn_global_load_lds((const unsigned*)((const char*)(gbase) + (voff)[_i]), (PG8_LAS unsigned*)(lds + (bufoff) + ldsw + _i * 8192), 16, 0, 0); } while (0)
#define PG8_LDA(dst, b, h) do { _Pragma("unroll") for (int m = 0; m < 4; ++m) _Pragma("unroll") for (int k = 0; k < 2; ++k) dst[m][k] = *(const PG8_LAS bf16x8*)(lds + PG8_SA(b, h) + aoff + m * 2048 + k * 1024); } while (0)
#define PG8_LDB(dst, b, h) do { _Pragma("unroll") for (int n = 0; n < 2; ++n) _Pragma("unroll") for (int k = 0; k < 2; ++k) dst[n][k] = *(const PG8_LAS bf16x8*)(lds + PG8_SB(b, h) + boff + n * 2048 + k * 1024); } while (0)
#define PG8_MMA(ai, bj, At, Bt) do { __builtin_amdgcn_s_setprio(1); _Pragma("unroll") for (int m = 0; m < 4; ++m) _Pragma("unroll") for (int n = 0; n < 2; ++n) _Pragma("unroll") for (int k = 0; k < 2; ++k) \
        acc[ai][bj][m][n] = __builtin_amdgcn_mfma_f32_16x16x32_bf16(Bt[n][k], At[m][k], acc[ai][bj][m][n], 0, 0, 0); __builtin_amdgcn_s_setprio(0); } while (0)
#define PG8_WAIT_V(n) asm volatile("s_waitcnt vmcnt(" #n ")" ::: "memory")
#define PG8_WAIT_L(n) asm volatile("s_waitcnt lgkmcnt(" #n ")" ::: "memory")
#define PG8_BAR __builtin_amdgcn_s_barrier()
#define PG8_SCHED __builtin_amdgcn_sched_barrier(0)
    Unit cur, nxt; int ui = 0;
    if (!S.next(0, cur)) return;
    f32x4 acc[2][2][4][2];
#pragma unroll
    for (int a = 0; a < 2; ++a)
#pragma unroll
        for (int b = 0; b < 2; ++b)
#pragma unroll
            for (int m = 0; m < 4; ++m)
#pragma unroll
                for (int n = 0; n < 2; ++n) acc[a][b][m][n] = (f32x4){0.f, 0.f, 0.f, 0.f};
    bf16x8 At[4][2], B0[2][2], B1[2][2];
    const char* cA = cur.A; const char* cB = cur.B;
    PG8_LAS unsigned* gtab = (PG8_LAS unsigned*)(lds + STAGE_BYTES + 2048);
    if constexpr (GATHER) {
        S.fill_tab(cur, gtab);
        asm volatile("s_waitcnt lgkmcnt(0)" ::: "memory"); __builtin_amdgcn_s_barrier(); asm volatile("" ::: "memory");
#pragma unroll
        for (int h = 0; h < 2; ++h)
#pragma unroll
            for (int i = 0; i < 2; ++i) { voffA[h][i] = gtab[Rr[i] + HALF * h] + (unsigned)Cc[i] * 2u; nvA[h][i] = voffA[h][i]; }
    }
    PG8_STAGE(PG8_SB(0, 0), cB, voffB); PG8_STAGE(PG8_SB(0, 1), cB + hstepB, voffB); PG8_STAGE(PG8_SA(0, 0), cA, voffA[0]); PG8_STAGE(PG8_SA(0, 1), cA, voffA[1]);
    if (wr == 1) PG8_BAR;
    PG8_WAIT_V(2); PG8_BAR;
    PG8_STAGE(PG8_SB(1, 0), cB + kstep, voffB); PG8_STAGE(PG8_SA(1, 0), cA + kstep, voffA[0]); PG8_STAGE(PG8_SB(1, 1), cB + hstepB + kstep, voffB);
    PG8_WAIT_V(6); PG8_BAR;
    for (;;) {
        const bool has_next = S.next(ui + 1, nxt);
        const char* nA = has_next ? nxt.A : cA; const char* nB = has_next ? nxt.B : cB;
        if constexpr (GATHER) { if (has_next) S.fill_tab(nxt, gtab + ((ui + 1) & 1) * 256); }
#pragma unroll 1
        for (int t = 0; t < nt; t += 2) {
            const bool last = (t == nt - 2);
            const char* a1 = cA + (size_t)(t + 1) * kstep;
            const char* a2 = last ? nA : cA + (size_t)(t + 2) * kstep; const char* b2 = last ? nB : cB + (size_t)(t + 2) * kstep;
            const char* a3 = a2 + kstep; const char* b3 = b2 + kstep;
            unsigned sv[2][2];
            if constexpr (GATHER) {
                if (last && has_next) {
#pragma unroll
                    for (int h = 0; h < 2; ++h)
#pragma unroll
                        for (int i = 0; i < 2; ++i) nvA[h][i] = gtab[((ui + 1) & 1) * 256 + Rr[i] + HALF * h] + (unsigned)Cc[i] * 2u;
                }
#pragma unroll
                for (int h = 0; h < 2; ++h)
#pragma unroll
                    for (int i = 0; i < 2; ++i) sv[h][i] = last ? nvA[h][i] : voffA[h][i];
            } else {
#pragma unroll
                for (int h = 0; h < 2; ++h)
#pragma unroll
                    for (int i = 0; i < 2; ++i) sv[h][i] = voffA[h][i];
            }
            PG8_LDB(B0, 0, 0); PG8_LDB(B1, 0, 1); PG8_SCHED; PG8_LDA(At, 0, 0); PG8_STAGE(PG8_SA(1, 1), a1, voffA[1]);
            PG8_WAIT_V(8); PG8_WAIT_L(0); PG8_BAR; PG8_MMA(0, 0, At, B0); PG8_MMA(0, 1, At, B1); PG8_BAR; PG8_SCHED;
            PG8_LDA(At, 0, 1); PG8_STAGE(PG8_SB(0, 0), b2, voffB); PG8_STAGE(PG8_SB(0, 1), b2 + hstepB, voffB); PG8_STAGE(PG8_SA(0, 0), a2, sv[0]);
            PG8_WAIT_V(8); PG8_WAIT_L(0); PG8_BAR; PG8_MMA(1, 0, At, B0); PG8_MMA(1, 1, At, B1); PG8_BAR; PG8_SCHED;
            PG8_LDB(B0, 1, 0); PG8_LDB(B1, 1, 1); PG8_SCHED; PG8_LDA(At, 1, 0); PG8_STAGE(PG8_SA(0, 1), a2, sv[1]);
            PG8_WAIT_V(8); PG8_WAIT_L(0); PG8_BAR; PG8_MMA(0, 0, At, B0); PG8_MMA(0, 1, At, B1); PG8_BAR; PG8_SCHED;
            PG8_LDA(At, 1, 1); PG8_STAGE(PG8_SB(1, 0), b3, voffB); PG8_STAGE(PG8_SB(1, 1), b3 + hstepB, voffB); PG8_STAGE(PG8_SA(1, 0), a3, sv[0]);
            PG8_WAIT_V(8); PG8_WAIT_L(0); PG8_BAR; PG8_MMA(1, 0, At, B0); PG8_MMA(1, 1, At, B1); PG8_BAR; PG8_SCHED;
        }
        if constexpr (ALIGN_EPI) { if (wr == 0) PG8_BAR; }
        E(acc, cur, wr, wc, fr, fq);
        if (!has_next) break;
        if (!(cur.pad & 1)) {
#pragma unroll
        for (int a = 0; a < 2; ++a)
#pragma unroll
            for (int b = 0; b < 2; ++b)
#pragma unroll
                for (int m = 0; m < 4; ++m)
#pragma unroll
                    for (int n = 0; n < 2; ++n) acc[a][b][m][n] = (f32x4){0.f, 0.f, 0.f, 0.f};
        }
        cur = nxt; cA = nA; cB = nB; ++ui;
        if constexpr (GATHER) {
#pragma unroll
            for (int h = 0; h < 2; ++h)
#pragma unroll
                for (int i = 0; i < 2; ++i) voffA[h][i] = nvA[h][i];
        }
        if constexpr (ALIGN_EPI) { if (wr == 1) PG8_BAR; }
    }
    PG8_WAIT_V(0);
    if constexpr (!ALIGN_EPI) { if (wr == 0) PG8_BAR; }
    PG8_BAR;
#undef PG8_SA
#undef PG8_SB
#undef PG8_STAGE
#undef PG8_LDA
#undef PG8_LDB
#undef PG8_MMA
#undef PG8_WAIT_V
#undef PG8_WAIT_L
#undef PG8_BAR
#undef PG8_SCHED
}
}

struct Frame {
    LAS unsigned char* lds;
    volatile LAS unsigned* MISC;
    gu32* ctl;
    int tid, lane, wave, G, bid;
    const float* in[20]; float* out; unsigned char* ws;
};
#define WSP(T_, off) ((T_*)(F.ws + (off)))

__device__ __forceinline__ v4u pack8(const f32x4 a, const f32x4 b) { v4u w; w.x = pk2(a[0], a[1]); w.y = pk2(a[2], a[3]); w.z = pk2(b[0], b[1]); w.w = pk2(b[2], b[3]); return w; }
__device__ __forceinline__ void unpack8(const v4u w, f32x4& a, f32x4& b) { a = (f32x4){bflo(w.x), bfhi(w.x), bflo(w.y), bfhi(w.y)}; b = (f32x4){bflo(w.z), bfhi(w.z), bflo(w.w), bfhi(w.w)}; }

__device__ __forceinline__ size_t gate_block(int which, int pm, int pnl, int wave, int ai, int m, int bj, int lane) {
    const int wr = wave >> 2, wc = wave & 3, fr = lane & 15, fq = lane >> 4; const size_t row = (size_t)pm * 256 + ai * 128 + wr * 64 + m * 16 + fr; const int col = pnl * 256 + bj * 128 + wc * 32 + 8 * fq;
    return ((size_t)which * T + row) * D + col;
}
__device__ __forceinline__ size_t gate_elem(int which, int row, int col) { return ((size_t)which * T + row) * D + col; }
struct EpiP1 {
    static constexpr bool PERM = true;
    bf16* PJ; const float* b_alpha; float* BC; bf16* GATES;
    __device__ __forceinline__ void operator()(const f32x4 (&acc)[2][2][4][2], const pg8::Unit& u, int wr, int wc, int fr, int fq) const {
        const int pn = u.c0 >> 8;
        const int mode = (pn == 4 || pn == 5) ? 1 : (pn == 6) ? 2 : (pn >= 9) ? 3 : 0;
        const int row0 = u.r0 + wr * 64 + fr, col0 = u.c0 + wc * 32 + 8 * fq;
        f32x4 bv[2][2];
        const int bidx = (mode == 2) ? (col0 - PJ_Z) : 0;
#pragma unroll
        for (int bj = 0; bj < 2; ++bj)
#pragma unroll
            for (int n = 0; n < 2; ++n) { bv[bj][n] = *(const f32x4*)(b_alpha + bidx + bj * 128 + 4 * n); asm volatile("" :: "v"(bv[bj][n])); }
        if (mode == 2) {
#pragma unroll
            for (int ai = 0; ai < 2; ++ai)
#pragma unroll
                for (int bj = 0; bj < 2; ++bj) { f32x4 pr[4][2];
#pragma unroll
                    for (int n = 0; n < 2; ++n)
#pragma unroll
                        for (int j = 0; j < 4; ++j) { float carry = 0.f;
#pragma unroll
                            for (int m = 0; m < 4; ++m) { const float z = acc[ai][bj][m][n][j] + bv[bj][n][j]; const float la = (fminf(z, 0.f) - __logf(1.0f + __expf(-fabsf(z)))) * (1.0f / 16.0f);
                                pr[m][n][j] = row16_scan(la) + carry; carry += row16_sum(la); } }
#pragma unroll
                    for (int m = 0; m < 4; ++m) { float* bp = BC + (size_t)(row0 + ai * 128 + m * 16) * GKW + (col0 - PJ_Z) + bj * 128; *(f32x4*)bp = pr[m][0]; *(f32x4*)(bp + 4) = pr[m][1]; } }
            return;
        }
#pragma unroll
        for (int ai = 0; ai < 2; ++ai)
#pragma unroll
            for (int m = 0; m < 4; ++m) { bf16* rowp = PJ + (size_t)(row0 + ai * 128 + m * 16) * NPJ + col0;
#pragma unroll
                for (int bj = 0; bj < 2; ++bj) { f32x4 v[2] = {acc[ai][bj][m][0], acc[ai][bj][m][1]};
                    if (mode == 1) {
#pragma unroll
                        for (int n = 0; n < 2; ++n)
#pragma unroll
                            for (int j = 0; j < 4; ++j) v[n][j] = v[n][j] * fsigmoid(v[n][j]);
                    } else if (mode == 3) {
#pragma unroll
                        for (int n = 0; n < 2; ++n)
#pragma unroll
                            for (int j = 0; j < 4; ++j) v[n][j] = fsigmoid(v[n][j]);
                        *(v4u*)(GATES + gate_block((pn - 9) >> 2, u.r0 >> 8, (pn - 9) & 3, wr * 4 + wc, ai, m, bj, fq * 16 + fr)) = pack8(v[0], v[1]);
                        continue;
                    }
                    *(v4u*)(rowp + bj * 128) = pack8(v[0], v[1]); } }
    }
};

struct EpiF {
    static constexpr int ID = 5; static constexpr bool PERM = true;
    const bf16* HB; const float* XS; bf16* X1B; float* SSQ;
    __device__ __forceinline__ void operator()(const f32x4 (&acc)[2][2][4][2], const pg8::Unit& u, int wr, int wc, int fr, int fq) const {
        const int row0 = u.r0 + wr * 64 + fr, col0 = u.c0 + wc * 32 + 8 * fq;
#pragma unroll
        for (int ai = 0; ai < 2; ++ai) {
            v4u H[4][2]; float xs[4];
#pragma unroll
            for (int m = 0; m < 4; ++m) { const size_t row = (size_t)(row0 + ai * 128 + m * 16); xs[m] = XS[row];
#pragma unroll
                for (int bj = 0; bj < 2; ++bj) H[m][bj] = *(const v4u*)(HB + row * D + col0 + bj * 128); }
            asm volatile("" ::: "memory");
#pragma unroll
            for (int m = 0; m < 4; ++m) { const size_t row = (size_t)(row0 + ai * 128 + m * 16); float ss = 0.f;
#pragma unroll
                for (int bj = 0; bj < 2; ++bj) { f32x4 x0, x1; unpack8(H[m][bj], x0, x1);
                    const f32x4 y0 = x0 * xs[m] + acc[ai][bj][m][0], y1 = x1 * xs[m] + acc[ai][bj][m][1];
                    *(v4u*)(X1B + row * D + col0 + bj * 128) = pack8(y0, y1);
                    ss += (y0[0] * y0[0] + y0[1] * y0[1]) + (y0[2] * y0[2] + y0[3] * y0[3]) + (y1[0] * y1[0] + y1[1] * y1[1]) + (y1[2] * y1[2] + y1[3] * y1[3]); }
                ss += __shfl_xor(ss, 16); ss += __shfl_xor(ss, 32);
                if (fq == 0) SSQ[row * 16 + (u.c0 >> 8) * 4 + wc] = ss; }
            asm volatile("" ::: "memory");
        }
    }
};
struct MoeSched {
    const LAS int* cum; const LAS int* cnt; const unsigned* LIST;
    const char* Abase; const char* Bbase; int NT, G, c, mode;
    __device__ __forceinline__ bool next(int i, pg8::Unit& u) const {
        const int nunits = __builtin_amdgcn_readfirstlane(cum[NE]) * NT; const long L = (long)i * G + c; if (L >= nunits) return false;
        const int wgid = pg8::remap_xcd((int)L, nunits), gb = wgid / NT, pn = wgid % NT;
        int e_ = 0;
#pragma unroll 8
        for (int j = 1; j < NE; ++j) e_ += (cum[j] <= gb) ? 1 : 0;
        const int e = __builtin_amdgcn_readfirstlane(e_);
        const int blk = gb - __builtin_amdgcn_readfirstlane(cum[e]), rem = __builtin_amdgcn_readfirstlane(cnt[e]) - blk * 256;
        u.e = e; u.nvalid = rem < 256 ? rem : 256; u.lb = e * LCAP + blk * 256; u.r0 = gb * 256; u.pad = 0;
        if (mode == 0) { u.A = Abase; u.B = Bbase + ((size_t)e * 512 + (size_t)pn * 256) * D * 2; u.c0 = pn * 128; }
        else { u.A = Abase + (size_t)gb * 256 * DE * 2; u.B = Bbase + ((size_t)e * D + (size_t)pn * 256) * DE * 2; u.c0 = pn * 256; }
        return true;
    }
    __device__ __forceinline__ void fill_tab(const pg8::Unit& u, LAS unsigned* tab) const {
        const int t = threadIdx.x;
        if (t < 256) { const int lp = t < u.nvalid ? t : u.nvalid - 1; const unsigned slot = LIST[u.lb + lp]; tab[t] = (slot >> 1) * (unsigned)(D * 2); }
    }
};
struct EpiG {
    static constexpr bool PERM = false;
    float* LG;
    __device__ __forceinline__ void operator()(const f32x4 (&acc)[2][2][4][2], const pg8::Unit& u, int wr, int wc, int fr, int fq) const {
        if (wc >= 2) return;
        const int row0 = u.r0 + wr * 64 + fr;
#pragma unroll
        for (int ai = 0; ai < 2; ++ai)
#pragma unroll
            for (int m = 0; m < 4; ++m)
#pragma unroll
                for (int n = 0; n < 2; ++n) *(f32x4*)(LG + (size_t)(row0 + ai * 128 + m * 16) * 64 + 32 * wc + 16 * n + 4 * fq) = acc[ai][0][m][n];
    }
};
struct EpiH {
    static constexpr bool PERM = true;
    bf16* ACT; const float* LISTR;
    __device__ __forceinline__ void operator()(const f32x4 (&acc)[2][2][4][2], const pg8::Unit& u, int wr, int wc, int fr, int fq) const {
        float rs[2][4];
#pragma unroll
        for (int ai = 0; ai < 2; ++ai)
#pragma unroll
            for (int m = 0; m < 4; ++m) { const int rl = ai * 128 + wr * 64 + m * 16 + fr, lp = rl < u.nvalid ? rl : u.nvalid - 1; rs[ai][m] = LISTR[u.lb + lp]; }
#pragma unroll
        for (int ai = 0; ai < 2; ++ai)
#pragma unroll
            for (int m = 0; m < 4; ++m) { asm volatile("" :: "v"(rs[ai][m])); }
#pragma unroll
        for (int ai = 0; ai < 2; ++ai)
#pragma unroll
            for (int m = 0; m < 4; ++m) { const int rl = ai * 128 + wr * 64 + m * 16 + fr; const float r = rs[ai][m]; f32x4 a[2];
#pragma unroll
                for (int n = 0; n < 2; ++n)
#pragma unroll
                    for (int j = 0; j < 4; ++j) { const float g = acc[ai][0][m][n][j] * r, up = acc[ai][1][m][n][j] * r; a[n][j] = g * fsigmoid(g) * up; }
                *(v4u*)(ACT + (size_t)(u.r0 + rl) * DE + u.c0 + wc * 32 + 8 * fq) = pack8(a[0], a[1]); }
    }
};
struct EpiI {
    static constexpr int ID = 8; static constexpr bool PERM = true;
    bf16* Y; const unsigned* LIST; const float* LISTW;
    __device__ __forceinline__ void operator()(const f32x4 (&acc)[2][2][4][2], const pg8::Unit& u, int wr, int wc, int fr, int fq) const {
        unsigned sl[8]; float gw[8];
#pragma unroll
        for (int b = 0; b < 8; ++b) { const int rl = (b >> 2) * 128 + wr * 64 + (b & 3) * 16 + fr, lp = rl < u.nvalid ? rl : u.nvalid - 1; sl[b] = LIST[u.lb + lp]; gw[b] = LISTW[u.lb + lp]; }
        asm volatile("" ::: "memory");
#pragma unroll
        for (int b = 0; b < 8; ++b) { asm volatile("" :: "v"(gw[b]), "v"(sl[b])); }
#pragma unroll
        for (int b = 0; b < 8; ++b) { const int ai = b >> 2, m = b & 3, rl = ai * 128 + wr * 64 + m * 16 + fr; const float g = gw[b];
            if (rl < u.nvalid) {
#pragma unroll
                for (int bj = 0; bj < 2; ++bj) *(v4u*)(Y + (size_t)sl[b] * D + u.c0 + bj * 128 + wc * 32 + 8 * fq) = pack8(acc[ai][bj][m][0] * g, acc[ai][bj][m][1] * g); } }
    }
};
__device__ __forceinline__ void route_rows(Frame& F, const int r0) {
    const float* LG = WSP(float, WS_LG); const float* SSQ = WSP(float, WS_SSQ); const float* brg = F.in[13]; const float* bre = F.in[15];
    unsigned* LIST = WSP(unsigned, WS_LIST); float* LISTW = WSP(float, WS_LISTW); float* LISTR = WSP(float, WS_LISTR);
    LAS unsigned* hcnt = (LAS unsigned*)(F.lds + SCHED_OFF); LAS unsigned* hbase = hcnt + 32;
    if (F.tid < 32) hcnt[F.tid] = 0u;
    __syncthreads();
    int e0 = 0, e1 = 0; unsigned p0 = 0, p1 = 0; float w0 = 0.f, w1 = 0.f, rstd = 0.f; const int row = r0 + F.tid;
    if (F.tid < 256) {
        float ss = 0.f;
#pragma unroll
        for (int j = 0; j < 16; ++j) ss += SSQ[(size_t)row * 16 + j];
        rstd = 1.0f / sqrtf(ss * (1.0f / D) + EPS);
        const float* lr = LG + (size_t)row * 64;
        float gl[4];
#pragma unroll
        for (int g = 0; g < 4; ++g) gl[g] = __hip_atomic_load(lr + g, RLX_AGENT) * rstd + brg[g];
        int gi = 0; float gm = gl[0];
#pragma unroll
        for (int g = 1; g < 4; ++g) if (gl[g] > gm) { gm = gl[g]; gi = g; }
        float den = 0.f;
#pragma unroll
        for (int g = 0; g < 4; ++g) den += expf(gl[g] - gm);
        const float gp = 1.0f / den;
        float el[8];
#pragma unroll
        for (int e = 0; e < 8; ++e) el[e] = __hip_atomic_load(lr + 4 + gi * 8 + e, RLX_AGENT) * rstd + bre[gi * 8 + e];
        int i0 = 0; float m0 = el[0];
#pragma unroll
        for (int e = 1; e < 8; ++e) if (el[e] > m0) { m0 = el[e]; i0 = e; }
        int i1 = -1; float m1 = 0.f;
#pragma unroll
        for (int e = 0; e < 8; ++e) if (e != i0 && (i1 < 0 || el[e] > m1)) { m1 = el[e]; i1 = e; }
        const float q = expf(m1 - m0); w0 = gp / (1.0f + q); w1 = gp * q / (1.0f + q);
        e0 = gi * 8 + i0; e1 = gi * 8 + i1;
        p0 = __hip_atomic_fetch_add(&hcnt[e0], 1u, __ATOMIC_RELAXED, __HIP_MEMORY_SCOPE_WORKGROUP); p1 = __hip_atomic_fetch_add(&hcnt[e1], 1u, __ATOMIC_RELAXED, __HIP_MEMORY_SCOPE_WORKGROUP);
    }
    __syncthreads();
    if (F.tid < 32) hbase[F.tid] = hcnt[F.tid] ? __hip_atomic_fetch_add((unsigned*)(F.ctl + CW_ECNT + 64 * F.tid), hcnt[F.tid], RLX_AGENT) : 0u;
    __syncthreads();
    if (F.tid < 256) { const size_t q0 = (size_t)e0 * LCAP + hbase[e0] + p0, q1 = (size_t)e1 * LCAP + hbase[e1] + p1;
        LIST[q0] = (unsigned)row * 2u; LIST[q1] = (unsigned)row * 2u + 1u; LISTW[q0] = w0; LISTW[q1] = w1; LISTR[q0] = rstd; LISTR[q1] = rstd; }
    __syncthreads();
}
__device__ __forceinline__ void moe_tables(Frame& F) {
    LAS int* cum = (LAS int*)(F.lds + SCHED_OFF + 256); LAS int* cnt = cum + 40;
    if (F.tid == 0) { int a = 0; for (int e = 0; e < NE; ++e) { const int c = (int)__hip_atomic_load((unsigned*)(F.ctl + CW_ECNT + 64 * e), RLX_AGENT); cnt[e] = c; cum[e] = a; a += (c + 255) >> 8; } cum[NE] = a; }
    __syncthreads();
}


struct PairSched {
    pg8::StaticSched S0; const char* A1; const char* B1;
    __device__ __forceinline__ bool next(int i, pg8::Unit& u) const {
        if (!S0.next(i >> 1, u)) return false;
        if (i & 1) { u.A = A1 + (u.A - S0.A); u.B = B1 + (u.B - S0.B); u.pad = 2; } else u.pad = 1;
        return true;
    }
    __device__ __forceinline__ void fill_tab(const pg8::Unit&, LAS unsigned*) const {}
};
struct EpiDE {
    static constexpr int ID = 3; static constexpr bool PERM = true;
    bf16* MG; const bf16* GATES;
    __device__ __forceinline__ void operator()(f32x4 (&acc)[2][2][4][2], const pg8::Unit& u, int wr, int wc, int fr, int fq) const {
        const int row0 = u.r0 + wr * 64 + fr, col0 = u.c0 + wc * 32 + 8 * fq; const bool first = (u.pad & 1) != 0;
        const bf16* gp = GATES + ((size_t)T + row0) * D + col0;
        const bf16* gg = first ? GATES + (size_t)row0 * D + col0 : gp;
#pragma unroll
        for (int ai = 0; ai < 2; ++ai) {
            v4u P[4][2], G[4][2];
#pragma unroll
            for (int m = 0; m < 4; ++m)
#pragma unroll
                for (int bj = 0; bj < 2; ++bj) { const size_t o = (size_t)(ai * 128 + m * 16) * D + bj * 128; P[m][bj] = *(const v4u*)(gp + o); G[m][bj] = *(const v4u*)(gg + o); }
            asm volatile("" ::: "memory");
#pragma unroll
            for (int m = 0; m < 4; ++m)
#pragma unroll
                for (int bj = 0; bj < 2; ++bj) { asm volatile("" :: "v"(P[m][bj]), "v"(G[m][bj]));
                    f32x4 p0, p1, g0, g1; unpack8(P[m][bj], p0, p1); unpack8(G[m][bj], g0, g1);
                    if (first) {
#pragma unroll
                        for (int j = 0; j < 4; ++j) { acc[ai][bj][m][0][j] *= g0[j] * __builtin_amdgcn_rcpf(fmaxf(p0[j], 1e-30f)); acc[ai][bj][m][1][j] *= g1[j] * __builtin_amdgcn_rcpf(fmaxf(p1[j], 1e-30f)); }
                    } else {
                        *(v4u*)(MG + (size_t)(row0 + ai * 128 + m * 16) * D + col0 + bj * 128) = pack8(acc[ai][bj][m][0] * p0, acc[ai][bj][m][1] * p1);
                    } }
            asm volatile("" ::: "memory");
        }
    }
};

__device__ __forceinline__ void transpose_item64(const float* W, const int ld, const float* g, int k0, int n0, bf16* dst, int drow0, int dld, LAS bf16* tl, int lane) {
    const int c4 = (lane & 15) * 4, kr = lane >> 4;
    f32x4 v[16];
#pragma unroll
    for (int i = 0; i < 16; ++i) v[i] = *(const f32x4*)(W + (size_t)(k0 + kr + 4 * i) * ld + n0 + c4);
#pragma unroll
    for (int i = 0; i < 16; ++i) { const int k = kr + 4 * i; const float sc = g ? g[k0 + k] : 1.0f;
#pragma unroll
        for (int j = 0; j < 4; ++j) tl[(c4 + j) * 66 + k] = (bf16)(pk2(v[i][j] * sc, 0.f) & 0xffffu); }
    LDS_WAIT(); asm volatile("" ::: "memory");
    const int pc = (lane & 7) * 8, nr = lane >> 3;
#pragma unroll
    for (int i = 0; i < 8; ++i) { const int n = nr + 8 * i; const LAS unsigned* sp = (const LAS unsigned*)(tl + n * 66 + pc);
        v4u o; o.x = sp[0]; o.y = sp[1]; o.z = sp[2]; o.w = sp[3];
        *(GAS v4u*)(dst + (size_t)(drow0 + n) * dld + k0 + pc) = o; }
    LDS_WAIT(); asm volatile("" ::: "memory");
}
template <class Src>
__device__ __forceinline__ void transpose_item(const Src& src, int k0, int n0, bf16* dst, int drow0, int dld, LAS float* scr, int lane) {
#pragma unroll 8
    for (int i = 0; i < 32; ++i) { const int kk = 2 * i + (lane >> 5); scr[kk * 33 + (lane & 31)] = src(k0 + kk, n0 + (lane & 31)); }
    LDS_WAIT(); asm volatile("" ::: "memory");
    const int c = lane & 7;
#pragma unroll
    for (int j = 0; j < 4; ++j) { const int n = (lane >> 3) + 8 * j; const LAS float* s = scr + (8 * c) * 33 + n;
        v4u o; o.x = pk2(s[0 * 33], s[1 * 33]); o.y = pk2(s[2 * 33], s[3 * 33]); o.z = pk2(s[4 * 33], s[5 * 33]); o.w = pk2(s[6 * 33], s[7 * 33]);
        *(GAS v4u*)(dst + (size_t)(drow0 + n) * dld + k0 + 8 * c) = o; }
    LDS_WAIT(); asm volatile("" ::: "memory");
}
struct SrcScaled { const float* W; int ld; const float* g;
    __device__ __forceinline__ float operator()(int k, int n) const { const float w = W[(size_t)k * ld + n]; return g ? w * g[k] : w; } };

__device__ __forceinline__ void p0_prologue(Frame& F) {
    const float* x = F.in[0]; const float* g1 = F.in[1]; const float* w_in = F.in[2]; const float* wau = F.in[3];
    const float* gng = F.in[5]; const float* wgb = F.in[6]; const float* pw = F.in[7]; const float* ps = F.in[8]; const float* wpb = F.in[9];
    const float* wout = F.in[10]; const float* g2 = F.in[11]; const float* wrg = F.in[12]; const float* wre = F.in[14];
    const float* weg = F.in[16]; const float* weu = F.in[17]; const float* wed = F.in[18];
    bf16* WIN = WSP(bf16, WS_WIN); bf16* WG = WSP(bf16, WS_WG); bf16* WP = WSP(bf16, WS_WP); bf16* WOUT = WSP(bf16, WS_WOUT); bf16* WR = WSP(bf16, WS_WR);
    bf16* WGU = WSP(bf16, WS_WGU); bf16* WD = WSP(bf16, WS_WD); bf16* HB = WSP(bf16, WS_HB); float* XS = WSP(float, WS_XS);
    {
        LAS float* PWL = (LAS float*)F.lds;
        LAS float* WL = (LAS float*)(F.lds + 65536);
        for (int it = F.bid; it < 64; it += F.G) {
            const int g = it >> 4, nb = it & 15;
            for (int i = F.tid; i < 128 * 128; i += 512) { const int d = i & 127; PWL[i] = pw[(size_t)g * 16384 + i] * ps[g * 128 + d]; }
            for (int i = F.tid; i < 128 * 64; i += 512) { const int d = i >> 6, n = i & 63; WL[i] = wpb[(size_t)(g * 128 + d) * D + nb * 64 + n]; }
            __syncthreads();
            const int n = F.tid & 63, cg = F.tid >> 6;
            float a[16];
#pragma unroll
            for (int ci = 0; ci < 16; ++ci) a[ci] = 0.f;
            for (int d = 0; d < 128; d += 4) {
                const float w0 = WL[(d + 0) * 64 + n], w1 = WL[(d + 1) * 64 + n], w2 = WL[(d + 2) * 64 + n], w3 = WL[(d + 3) * 64 + n];
#pragma unroll
                for (int ci = 0; ci < 16; ++ci) { const f32x4 p = *(const LAS f32x4*)(PWL + (cg * 16 + ci) * 128 + d); a[ci] += p[0] * w0 + p[1] * w1 + p[2] * w2 + p[3] * w3; }
            }
            v4u o0, o1; o0.x = pk2(a[0], a[1]); o0.y = pk2(a[2], a[3]); o0.z = pk2(a[4], a[5]); o0.w = pk2(a[6], a[7]); o1.x = pk2(a[8], a[9]); o1.y = pk2(a[10], a[11]); o1.z = pk2(a[12], a[13]); o1.w = pk2(a[14], a[15]);
            bf16* dp = WP + (size_t)(nb * 64 + n) * PW + g * 128 + cg * 16;
            *(GAS v4u*)dp = o0; *(GAS v4u*)(dp + 8) = o1;
            __syncthreads();
        }
    }
    LAS float* scr = (LAS float*)(F.lds + F.wave * 16384);
    const int gw = F.bid * 8 + F.wave, NGW = F.G * 8;
    constexpr int I_IN1 = 16 * (1536 / 32), I_IN2 = 16 * (2560 / 32), I_Z = 4 * 64, I_WG = 8 * 32, I_WO = 16 * 32, I_WR = 256;
    constexpr int NITEMS = I_IN1 + I_IN2 + I_Z + I_WG + I_WO + I_WR;
    for (int it = gw; it < NITEMS; it += NGW) {
        int r = it;
        if (r < I_IN1) { const int kb = r / 48, nb = r % 48; SrcScaled s{w_in, D_IN, g1}; transpose_item(s, 64 * kb, 32 * nb, WIN, 32 * nb, D, scr, F.lane); continue; } r -= I_IN1;
        if (r < I_IN2) { const int kb = r / 80, nb = r % 80; SrcScaled s{w_in, D_IN, g1}; transpose_item(s, 64 * kb, IN_U + 32 * nb, WIN, PJ_U + 32 * nb, D, scr, F.lane); continue; } r -= I_IN2;
        if (r < I_Z) {
            const int nb = r & 3, kb = r >> 2, n = nb * 64 + F.lane;
            float wa[16];
#pragma unroll
            for (int j = 0; j < 16; ++j) wa[j] = wau[j * GKW + n];
            float o[16];
#pragma unroll
            for (int kk = 0; kk < 16; ++kk) { const int k = kb * 16 + kk; const float* wr_ = w_in + (size_t)k * D_IN + IN_A; float a = 0.f;
#pragma unroll
                for (int j = 0; j < 16; ++j) a += wr_[j] * wa[j];
                o[kk] = a * g1[k]; }
            v4u o0, o1; o0.x = pk2(o[0], o[1]); o0.y = pk2(o[2], o[3]); o0.z = pk2(o[4], o[5]); o0.w = pk2(o[6], o[7]); o1.x = pk2(o[8], o[9]); o1.y = pk2(o[10], o[11]); o1.z = pk2(o[12], o[13]); o1.w = pk2(o[14], o[15]);
            bf16* dp = WIN + (size_t)(PJ_Z + n) * D + kb * 16; *(GAS v4u*)dp = o0; *(GAS v4u*)(dp + 8) = o1; continue; } r -= I_Z;
        if (r < I_WG) { const int kb = r / 32, nb = r % 32; SrcScaled s{wgb, D, gng}; transpose_item(s, 64 * kb, 32 * nb, WG, 32 * nb, GVW, scr, F.lane); continue; } r -= I_WG;
        if (r < I_WO) { const int kb = r / 32, nb = r % 32; SrcScaled s{wout, D, nullptr}; transpose_item(s, 64 * kb, 32 * nb, WOUT, 32 * nb, D, scr, F.lane); continue; } r -= I_WO;
        if (r < I_WR) {
            const int j = r; bf16* dp = WR + (size_t)j * D;
#pragma unroll
            for (int q = 0; q < 16; ++q) { const int k = q * 64 + F.lane; float v = 0.f;
                if (j < NG) v = wrg[(size_t)k * NG + j] * g2[k]; else if (j < NG + NE) { const int g = (j - NG) >> 3, e = (j - NG) & 7; v = wre[((size_t)g * D + k) * EPG + e] * g2[k]; }
                dp[k] = (bf16)f2bf(v); }
            continue; }
    }
    for (int m = gw; m < T / 2; m += NGW) {
        const GAS f32x4* xa = (const GAS f32x4*)(x + (size_t)m * D) + F.lane; const GAS f32x4* xb = (const GAS f32x4*)(x + (size_t)(m + T / 2) * D) + F.lane;
        f32x4 va[4], vb[4]; float sa = 0.f, sb = 0.f;
#pragma unroll
        for (int j = 0; j < 4; ++j) { va[j] = __builtin_nontemporal_load(xa + 64 * j); vb[j] = __builtin_nontemporal_load(xb + 64 * j); }
#pragma unroll
        for (int j = 0; j < 4; ++j) { sa += (va[j].x * va[j].x + va[j].y * va[j].y) + (va[j].z * va[j].z + va[j].w * va[j].w); sb += (vb[j].x * vb[j].x + vb[j].y * vb[j].y) + (vb[j].z * vb[j].z + vb[j].w * vb[j].w); }
        const float qa = sqrtf(wave_sum(sa) * (1.f / D) + EPS), qb = sqrtf(wave_sum(sb) * (1.f / D) + EPS); const float ra = 1.0f / qa, rb = 1.0f / qb;
        if (F.lane == 0) { XS[m] = qa; XS[m + T / 2] = qb; }
        GAS v2u* oa = (GAS v2u*)(HB + (size_t)m * D) + F.lane; GAS v2u* ob = (GAS v2u*)(HB + (size_t)(m + T / 2) * D) + F.lane;
#pragma unroll
        for (int j = 0; j < 4; ++j) { v2u w; w.x = pk2(va[j].x * ra, va[j].y * ra); w.y = pk2(va[j].z * ra, va[j].w * ra); oa[64 * j] = w; w.x = pk2(vb[j].x * rb, vb[j].y * rb); w.y = pk2(vb[j].z * rb, vb[j].w * rb); ob[64 * j] = w; }
    }
}

__device__ __forceinline__ void moe_weight_items(Frame& F, const int widx, const int nworkers) {
    const float* g2 = F.in[11]; const float* weg = F.in[16]; const float* weu = F.in[17]; const float* wed = F.in[18];
    bf16* WGU = WSP(bf16, WS_WGU); bf16* WD = WSP(bf16, WS_WD);
    LAS bf16* tl = (LAS bf16*)(F.lds + F.wave * 16384);
    const int gw = widx * 8 + F.wave, NGW = nworkers * 8;
    constexpr int I_GU = NE * 2 * 16 * 4, I_WD = NE * 4 * 16;
    for (int it = gw; it < I_GU + I_WD; it += NGW) {
        int r = it;
        if (r < I_GU) {
            const int e = r / 128, q = r % 128, bj = q / 64, kb = (q % 64) / 4, nb = q % 4;
            const int hid0 = 64 * nb, pn = hid0 >> 7, i0 = hid0 & 127;
            transpose_item64((bj ? weu : weg) + (size_t)e * D * DE, DE, g2, 64 * kb, hid0, WGU + (size_t)e * 512 * D, pn * 256 + bj * 128 + i0, D, tl, F.lane); continue; } r -= I_GU;
        { const int e = r / 64, q = r % 64, kb = q / 16, nb = q % 16;
            transpose_item64(wed + (size_t)e * DE * D, D, nullptr, 64 * kb, 64 * nb, WD + (size_t)e * D * DE, 64 * nb, DE, tl, F.lane); }
    }
}

#define WG_SYNC() do { asm volatile("s_waitcnt lgkmcnt(0)" ::: "memory"); __builtin_amdgcn_s_barrier(); asm volatile("" ::: "memory"); } while (0)
constexpr int GL_QD = 0, GL_KD = 9216, GL_KET = 18432, GL_P = 27648, GL_VT = 36864, GL_DEC = 55296, GL_SS = 55552, GL_OT = 57600;
constexpr int GLS = 72, OTS = 132;
__device__ __forceinline__ void gla_unit(Frame& F, const int b, const int h, const int seg) {
    const bf16* PJ = WSP(bf16, WS_PJ); const float* BC = WSP(float, WS_BC); bf16* ON = WSP(bf16, WS_ON);
    int tid_ = threadIdx.x; asm volatile("" : "+v"(tid_));
    const int tid = tid_, lane = tid & 63, w = __builtin_amdgcn_readfirstlane(tid >> 6), fr = lane & 15, fq = lane >> 4;
    LAS bf16* QD = (LAS bf16*)(F.lds + GL_QD); LAS bf16* KD = (LAS bf16*)(F.lds + GL_KD); LAS bf16* KET = (LAS bf16*)(F.lds + GL_KET);
    LAS bf16* P = (LAS bf16*)(F.lds + GL_P); LAS bf16* VT = (LAS bf16*)(F.lds + GL_VT);
    LAS float* DEC = (LAS float*)(F.lds + GL_DEC); LAS float* OT = (LAS float*)(F.lds + GL_OT);
    f32x4 Sacc[4];
#pragma unroll
    for (int i = 0; i < 4; ++i) Sacc[i] = (f32x4){0.f, 0.f, 0.f, 0.f};
    const size_t rowbase = (size_t)b * SEQ + (size_t)seg * SEGCH * GCH;
    float* CUMB = WSP(float, WS_CUMB) + ((size_t)(b * GH + h) * (SEQ / GCH) + seg * SEGCH) * GDK; float cumb[8];
#pragma unroll
    for (int j = 0; j < 8; ++j) cumb[j] = 0.f;
    const int vsl = lane & 31, vbk = 2 * w + (lane >> 5);
    const int ot = tid >> 3, ov = (tid & 7) * 16;
    v4u qq, kq, vq0, vq1, rq0, rq1; f32x4 bq0, bq1; v4u qq2, kq2, vq02, vq12, rq02, rq12; f32x4 bq02, bq12;
#define GLA_LOADS(tb_, Q, K_, V0, V1, R0, R1, B0, B1) do { const size_t tb__ = (tb_); \
        const bf16* rp = PJ + (tb__ + lane) * NPJ + h * 64 + w * 8; Q = *(const v4u*)(rp + PJ_Q); K_ = *(const v4u*)(rp + PJ_K); \
        const float* bp = BC + (tb__ + lane) * GKW + h * 64 + w * 8; B0 = *(const f32x4*)bp; B1 = *(const f32x4*)(bp + 4); \
        const bf16* vp = PJ + (tb__ + vsl) * NPJ + PJ_V + h * 128 + vbk * 8; V0 = *(const v4u*)vp; V1 = *(const v4u*)(vp + (size_t)32 * NPJ); \
        const bf16* rr = PJ + (tb__ + ot) * NPJ + PJ_R + h * 128 + ov; R0 = *(const v4u*)rr; R1 = *(const v4u*)(rr + 8); } while (0)
    GLA_LOADS(rowbase, qq, kq, vq0, vq1, rq0, rq1, bq0, bq1);
    GLA_LOADS(rowbase + GCH, qq2, kq2, vq02, vq12, rq02, rq12, bq02, bq12);
    for (int n = 0; n < SEGCH; ++n) {
        const size_t tb = rowbase + (size_t)n * GCH;
        const v4u q8 = qq, k8 = kq, v80 = vq0, v81 = vq1, r80 = rq0, r81 = rq1; const f32x4 b80 = bq0, b81 = bq1;
        qq = qq2; kq = kq2; vq0 = vq02; vq1 = vq12; rq0 = rq02; rq1 = rq12; bq0 = bq02; bq1 = bq12;
        { const size_t tn = (n + 2 < SEGCH) ? tb + 2 * GCH : tb; GLA_LOADS(tn, qq2, kq2, vq02, vq12, rq02, rq12, bq02, bq12); }
        { float bx[8] = {b80[0], b80[1], b80[2], b80[3], b81[0], b81[1], b81[2], b81[3]}, qf[8], kf[8];
          { f32x4 a, c; unpack8(q8, a, c); qf[0] = a[0]; qf[1] = a[1]; qf[2] = a[2]; qf[3] = a[3]; qf[4] = c[0]; qf[5] = c[1]; qf[6] = c[2]; qf[7] = c[3];
            unpack8(k8, a, c); kf[0] = a[0]; kf[1] = a[1]; kf[2] = a[2]; kf[3] = a[3]; kf[4] = c[0]; kf[5] = c[1]; kf[6] = c[2]; kf[7] = c[3]; }
          float qd[8], kd[8], ke[8], dc[8];
          if (lane == 0) { *(f32x4*)(CUMB + (size_t)n * GDK + w * 8) = (f32x4){cumb[0], cumb[1], cumb[2], cumb[3]}; *(f32x4*)(CUMB + (size_t)n * GDK + w * 8 + 4) = (f32x4){cumb[4], cumb[5], cumb[6], cumb[7]}; }
#pragma unroll
          for (int j = 0; j < 8; ++j) { const float blast = __builtin_bit_cast(float, __builtin_amdgcn_readlane(__builtin_bit_cast(int, bx[j]), 63));
              cumb[j] += blast;
              const float eb = __expf(bx[j]), enb = __builtin_amdgcn_rcpf(eb); dc[j] = __expf(blast);
              qd[j] = qf[j] * eb * 0.125f; kd[j] = kf[j] * enb; ke[j] = kd[j] * dc[j]; }
          v4u o; o.x = pk2(qd[0], qd[1]); o.y = pk2(qd[2], qd[3]); o.z = pk2(qd[4], qd[5]); o.w = pk2(qd[6], qd[7]); *(LAS v4u*)(QD + lane * GLS + w * 8) = o;
          o.x = pk2(kd[0], kd[1]); o.y = pk2(kd[2], kd[3]); o.z = pk2(kd[4], kd[5]); o.w = pk2(kd[6], kd[7]); *(LAS v4u*)(KD + lane * GLS + w * 8) = o;
#pragma unroll
          for (int j = 0; j < 8; ++j) KET[(w * 8 + j) * GLS + lane] = (bf16)(pk2(ke[j], ke[j]) & 0xffffu);
          if (lane == 0) { *(LAS f32x4*)(DEC + w * 8) = (f32x4){dc[0], dc[1], dc[2], dc[3]}; *(LAS f32x4*)(DEC + w * 8 + 4) = (f32x4){dc[4], dc[5], dc[6], dc[7]}; }
          const unsigned vw0[4] = {v80.x, v80.y, v80.z, v80.w}, vw1[4] = {v81.x, v81.y, v81.z, v81.w};
#pragma unroll
          for (int j = 0; j < 4; ++j) { VT[(vbk * 8 + 2 * j) * GLS + vsl] = (bf16)(vw0[j] & 0xffffu); VT[(vbk * 8 + 2 * j + 1) * GLS + vsl] = (bf16)(vw0[j] >> 16);
              VT[(vbk * 8 + 2 * j) * GLS + vsl + 32] = (bf16)(vw1[j] & 0xffffu); VT[(vbk * 8 + 2 * j + 1) * GLS + vsl + 32] = (bf16)(vw1[j] >> 16); } }
        WG_SYNC();
        { const int tt = w >> 1, st0 = (w & 1) * 2;
          bf16x8 af[2];
#pragma unroll
          for (int ks = 0; ks < 2; ++ks) af[ks] = *(const LAS bf16x8*)(QD + (16 * tt + fr) * GLS + 32 * ks + 8 * fq);
#pragma unroll
          for (int q2 = 0; q2 < 2; ++q2) { const int st = st0 + q2; f32x4 c = (f32x4){0.f, 0.f, 0.f, 0.f};
              if (st <= tt) {
#pragma unroll
                  for (int ks = 0; ks < 2; ++ks) { const bf16x8 bfm = *(const LAS bf16x8*)(KD + (16 * st + fr) * GLS + 32 * ks + 8 * fq); c = __builtin_amdgcn_mfma_f32_16x16x32_bf16(af[ks], bfm, c, 0, 0, 0); } }
#pragma unroll
              for (int i = 0; i < 4; ++i) { const int t = 16 * tt + 4 * fq + i, sidx = 16 * st + fr; const float val = (sidx <= t) ? c[i] : 0.f; P[t * GLS + sidx] = (bf16)(pk2(val, val) & 0xffffu); } } }
        WG_SYNC();
        { bf16x8 vtf[2], sb[2];
#pragma unroll
          for (int ks = 0; ks < 2; ++ks) { vtf[ks] = *(const LAS bf16x8*)(VT + (16 * w + fr) * GLS + 32 * ks + 8 * fq);
              v4u pw_; pw_.x = pk2(Sacc[2 * ks][0], Sacc[2 * ks][1]); pw_.y = pk2(Sacc[2 * ks][2], Sacc[2 * ks][3]); pw_.z = pk2(Sacc[2 * ks + 1][0], Sacc[2 * ks + 1][1]); pw_.w = pk2(Sacc[2 * ks + 1][2], Sacc[2 * ks + 1][3]);
              sb[ks] = __builtin_bit_cast(bf16x8, pw_); }
          f32x4 o[4];
#pragma unroll
          for (int mt = 0; mt < 4; ++mt) { o[mt] = (f32x4){0.f, 0.f, 0.f, 0.f};
#pragma unroll
              for (int ks = 0; ks < 2; ++ks) { const bf16x8 a = *(const LAS bf16x8*)(P + (16 * mt + fr) * GLS + 32 * ks + 8 * fq); o[mt] = __builtin_amdgcn_mfma_f32_16x16x32_bf16(a, vtf[ks], o[mt], 0, 0, 0); }
#pragma unroll
              for (int ks = 0; ks < 2; ++ks) { const v2u lo = *(const LAS v2u*)(QD + (16 * mt + fr) * GLS + 32 * ks + 4 * fq), hi = *(const LAS v2u*)(QD + (16 * mt + fr) * GLS + 32 * ks + 16 + 4 * fq);
                  v4u aw; aw.x = lo.x; aw.y = lo.y; aw.z = hi.x; aw.w = hi.y; o[mt] = __builtin_amdgcn_mfma_f32_16x16x32_bf16(__builtin_bit_cast(bf16x8, aw), sb[ks], o[mt], 0, 0, 0); } }
#pragma unroll
          for (int mt = 0; mt < 4; ++mt) { const f32x4 d4 = *(const LAS f32x4*)(DEC + 16 * mt + 4 * fq); Sacc[mt] = Sacc[mt] * d4;
#pragma unroll
              for (int ks = 0; ks < 2; ++ks) { const bf16x8 a = *(const LAS bf16x8*)(KET + (16 * mt + fr) * GLS + 32 * ks + 8 * fq); Sacc[mt] = __builtin_amdgcn_mfma_f32_16x16x32_bf16(a, vtf[ks], Sacc[mt], 0, 0, 0); } }
#pragma unroll
          for (int mt = 0; mt < 4; ++mt)
#pragma unroll
              for (int i = 0; i < 4; ++i) OT[(16 * mt + 4 * fq + i) * OTS + 16 * w + fr] = o[mt][i]; }
        WG_SYNC();
        { f32x4 ov4[4]; float tot2 = 0.f;
#pragma unroll
          for (int q = 0; q < 4; ++q) { ov4[q] = *(const LAS f32x4*)(OT + ot * OTS + ov + 4 * q); tot2 += (ov4[q][0] * ov4[q][0] + ov4[q][1] * ov4[q][1]) + (ov4[q][2] * ov4[q][2] + ov4[q][3] * ov4[q][3]); }
          tot2 += dpp_f<0xB1>(tot2); tot2 += dpp_f<0x4E>(tot2); tot2 += dpp_f<0x141>(tot2);
          const float rstd = (seg == 0) ? __builtin_amdgcn_rsqf(tot2 * (1.0f / GDV) + EPS) : 1.0f;
          f32x4 r0, r1, r2, r3; unpack8(r80, r0, r1); unpack8(r81, r2, r3);
          if (seg != 0) { r0 = (f32x4){1.f, 1.f, 1.f, 1.f}; r1 = r0; r2 = r0; r3 = r0; }
          bf16* op = ON + (tb + ot) * GVW + h * 128 + ov;
          *(v4u*)op = pack8(ov4[0] * rstd * r0, ov4[1] * rstd * r1); *(v4u*)(op + 8) = pack8(ov4[2] * rstd * r2, ov4[3] * rstd * r3); }
    }
#undef GLA_LOADS
    if (seg + 1 < NSEG) {
        float* SL = WSP(float, WS_SLOC) + ((size_t)(b * GH + h) * NSEG + seg) * GDK * GDV;
#pragma unroll
        for (int mt = 0; mt < 4; ++mt)
#pragma unroll
            for (int i = 0; i < 4; ++i) SL[(16 * mt + 4 * fq + i) * GDV + 16 * w + fr] = Sacc[mt][i];
        if (lane == 0) { float* DT = WSP(float, WS_DTOT) + ((size_t)(b * GH + h) * NSEG + seg) * GDK + w * 8;
#pragma unroll
            for (int j = 0; j < 8; ++j) DT[j] = __expf(cumb[j]); }
    }
    WG_SYNC();
}
constexpr int FX_QD = 0, FX_SB = 9216, FX_OT = 27648;
__device__ __forceinline__ void gla_fix_unit(Frame& F, const int b, const int h, const int seg) {
    const bf16* PJ = WSP(bf16, WS_PJ); const float* BC = WSP(float, WS_BC); bf16* ON = WSP(bf16, WS_ON);
    int tid_ = threadIdx.x; asm volatile("" : "+v"(tid_));
    const int tid = tid_, lane = tid & 63, w = __builtin_amdgcn_readfirstlane(tid >> 6), fr = lane & 15, fq = lane >> 4;
    LAS bf16* QD2 = (LAS bf16*)(F.lds + FX_QD); LAS bf16* SB = (LAS bf16*)(F.lds + FX_SB); LAS float* OT = (LAS float*)(F.lds + FX_OT);
    { const float* SL = WSP(float, WS_SLOC) + (size_t)(b * GH + h) * NSEG * GDK * GDV; const float* DT = WSP(float, WS_DTOT) + (size_t)(b * GH + h) * NSEG * GDK;
#pragma unroll
      for (int j = 0; j < 8; ++j) { const int d = 8 * w + j; float s0 = 0.f, s1 = 0.f;
          for (int i = 0; i < seg; ++i) { const float dt = DT[i * GDK + d]; s0 = dt * s0 + SL[((size_t)i * GDK + d) * GDV + lane]; s1 = dt * s1 + SL[((size_t)i * GDK + d) * GDV + lane + 64]; }
          SB[lane * GLS + d] = (bf16)(pk2(s0, s0) & 0xffffu); SB[(lane + 64) * GLS + d] = (bf16)(pk2(s1, s1) & 0xffffu); } }
    const size_t rowbase = (size_t)b * SEQ + (size_t)seg * SEGCH * GCH;
    const float* CUMB = WSP(float, WS_CUMB) + ((size_t)(b * GH + h) * (SEQ / GCH) + seg * SEGCH) * GDK;
    const int ot = tid >> 3, ov = (tid & 7) * 16, dq = (tid & 7) * 8;
    v4u qq, oq0, oq1, rq0, rq1; f32x4 bq0, bq1, cq0, cq1;
#define FIX_LOADS(n_) do { const size_t tb__ = rowbase + (size_t)(n_) * GCH;         qq = *(const v4u*)(PJ + (tb__ + ot) * NPJ + PJ_Q + h * 64 + dq); const float* bp = BC + (tb__ + ot) * GKW + h * 64 + dq; bq0 = *(const f32x4*)bp; bq1 = *(const f32x4*)(bp + 4);         const float* cp = CUMB + (size_t)(n_) * GDK + dq; cq0 = *(const f32x4*)cp; cq1 = *(const f32x4*)(cp + 4);         const bf16* op_ = ON + (tb__ + ot) * GVW + h * 128 + ov; oq0 = *(const v4u*)op_; oq1 = *(const v4u*)(op_ + 8);         const bf16* rr = PJ + (tb__ + ot) * NPJ + PJ_R + h * 128 + ov; rq0 = *(const v4u*)rr; rq1 = *(const v4u*)(rr + 8); } while (0)
    FIX_LOADS(0);
    for (int n = 0; n < SEGCH; ++n) {
        const size_t tb = rowbase + (size_t)n * GCH;
        const v4u q8 = qq, o80 = oq0, o81 = oq1, r80 = rq0, r81 = rq1; const f32x4 b80 = bq0, b81 = bq1, c80 = cq0, c81 = cq1;
        if (n + 1 < SEGCH) FIX_LOADS(n + 1);
        { f32x4 qa, qb; unpack8(q8, qa, qb); f32x4 e0, e1;
#pragma unroll
          for (int j = 0; j < 4; ++j) { e0[j] = qa[j] * 0.125f * __expf(b80[j] + c80[j]); e1[j] = qb[j] * 0.125f * __expf(b81[j] + c81[j]); }
          *(LAS v4u*)(QD2 + ot * GLS + dq) = pack8(e0, e1); }
        WG_SYNC();
        { bf16x8 bfm[2];
#pragma unroll
          for (int ks = 0; ks < 2; ++ks) bfm[ks] = *(const LAS bf16x8*)(SB + (16 * w + fr) * GLS + 32 * ks + 8 * fq);
#pragma unroll
          for (int mt = 0; mt < 4; ++mt) { f32x4 c = (f32x4){0.f, 0.f, 0.f, 0.f};
#pragma unroll
              for (int ks = 0; ks < 2; ++ks) { const bf16x8 a = *(const LAS bf16x8*)(QD2 + (16 * mt + fr) * GLS + 32 * ks + 8 * fq); c = __builtin_amdgcn_mfma_f32_16x16x32_bf16(a, bfm[ks], c, 0, 0, 0); }
#pragma unroll
              for (int i = 0; i < 4; ++i) OT[(16 * mt + 4 * fq + i) * OTS + 16 * w + fr] = c[i]; } }
        WG_SYNC();
        { f32x4 t4[4], l0, l1, l2, l3; unpack8(o80, l0, l1); unpack8(o81, l2, l3);
          t4[0] = *(const LAS f32x4*)(OT + ot * OTS + ov) + l0; t4[1] = *(const LAS f32x4*)(OT + ot * OTS + ov + 4) + l1; t4[2] = *(const LAS f32x4*)(OT + ot * OTS + ov + 8) + l2; t4[3] = *(const LAS f32x4*)(OT + ot * OTS + ov + 12) + l3;
          float sq = 0.f;
#pragma unroll
          for (int q = 0; q < 4; ++q) sq += (t4[q][0] * t4[q][0] + t4[q][1] * t4[q][1]) + (t4[q][2] * t4[q][2] + t4[q][3] * t4[q][3]);
          sq += dpp_f<0xB1>(sq); sq += dpp_f<0x4E>(sq); sq += dpp_f<0x141>(sq);
          const float rstd = __builtin_amdgcn_rsqf(sq * (1.0f / GDV) + EPS);
          f32x4 r0, r1, r2, r3; unpack8(r80, r0, r1); unpack8(r81, r2, r3);
          bf16* op = ON + (tb + ot) * GVW + h * 128 + ov;
          *(v4u*)op = pack8(t4[0] * rstd * r0, t4[1] * rstd * r1); *(v4u*)(op + 8) = pack8(t4[2] * rstd * r2, t4[3] * rstd * r3); }
    }
#undef FIX_LOADS
    WG_SYNC();
}
__device__ __forceinline__ void pool_items(Frame& F, const int widx, const int nworkers) {
    const bf16* PJ = WSP(bf16, WS_PJ); bf16* PD = WSP(bf16, WS_PD);
    const int gw = widx * 8 + F.wave, NGW = nworkers * 8, cb = F.lane, wlen = 2 << (cb >> 4);
    constexpr int RUN = 32;
    for (int u = gw; u < T / RUN; u += NGW) {
        const int t0 = u * RUN, pos0 = t0 & (SEQ - 1);
        const bf16* base = PJ + (size_t)t0 * NPJ + PJ_U + cb * 8;
        f32x4 a0 = (f32x4){0.f, 0.f, 0.f, 0.f}, a1 = a0;
#pragma unroll
        for (int i = 1; i <= 16; ++i) { const bool in = (i <= wlen) && (i <= pos0); const v4u vw = *(const v4u*)(base - (size_t)(in ? i : 0) * NPJ); f32x4 u0, u1; unpack8(vw, u0, u1); const float m = in ? 1.f : 0.f; a0 += u0 * m; a1 += u1 * m; }
#pragma unroll 4
        for (int i = 0; i < RUN; ++i) {
            const int pos = pos0 + i; const bool drop = pos >= wlen;
            const v4u nw = *(const v4u*)(base + (size_t)i * NPJ), ow = *(const v4u*)(base + (size_t)(drop ? i - wlen : i) * NPJ);
            f32x4 n0, n1, o0, o1; unpack8(nw, n0, n1); unpack8(ow, o0, o1); const float m = drop ? 1.f : 0.f;
            a0 += n0 - o0 * m; a1 += n1 - o1 * m;
            const float inv = __builtin_amdgcn_rcpf((float)(pos + 1 < wlen ? pos + 1 : wlen));
            *(v4u*)(PD + (size_t)(t0 + i) * PW + cb * 8) = pack8(a0 * inv - n0, a1 * inv - n1);
        }
    }
}
__device__ __forceinline__ void p2a_phase(Frame& F) {
    constexpr int NU = BATCH * GH * NSEG;
    for (int u = F.bid; u < NU; u += F.G) gla_unit(F, u >> 4, (u >> 2) & 3, u & 3);
}
__device__ __forceinline__ void p2b_phase(Frame& F) {
    constexpr int NU = BATCH * GH * (NSEG - 1);
#pragma unroll 1
    for (int r_ = 0; r_ < REPS(10); ++r_)
    for (int u = F.bid; u < NU; u += F.G) gla_fix_unit(F, u / (GH * (NSEG - 1)), (u / (NSEG - 1)) % GH, 1 + u % (NSEG - 1));
#pragma unroll 1
    for (int r_ = 0; r_ < REPS(11); ++r_) pool_items(F, F.bid, F.G);
#pragma unroll 1
    for (int r_ = 0; r_ < REPS(12); ++r_) moe_weight_items(F, F.bid, F.G);
}

#if DBG
__device__ __forceinline__ void dbg_fail(Frame& F, unsigned code) { unsigned expect = 0u; __hip_atomic_compare_exchange_strong((unsigned*)(F.ctl + CW_DBG), &expect, code, __ATOMIC_RELAXED, __ATOMIC_RELAXED, __HIP_MEMORY_SCOPE_AGENT); }
__device__ __forceinline__ bool dbg_close(float got, float want) { return fabsf(got - want) <= 0.03f + 0.03f * fabsf(want); }
__device__ __forceinline__ void dbg_check_p1(Frame& F) {
    if (F.bid != 0 || F.tid >= 256) return;
    const float* x = F.in[0]; const float* g1 = F.in[1]; const float* w_in = F.in[2]; const float* wau = F.in[3]; const float* ba = F.in[4];
    const bf16* PJ = WSP(bf16, WS_PJ);
    const int tok = (int)(((unsigned)F.tid * 2654435761u) % (unsigned)T);
    const int col = (int)(((unsigned)F.tid * 40503u + 17u * (unsigned)F.tid * (unsigned)F.tid) % (unsigned)NPROJ);
    const float* xr = x + (size_t)tok * D; float ss = 0.f;
    for (int k = 0; k < D; ++k) ss += xr[k] * xr[k];
    const float rstd = 1.0f / sqrtf(ss / D + EPS);
    float want;
    if (col >= PJ_Z && col < PJ_U) {
        return;
        float al[16];
#pragma unroll
        for (int j = 0; j < 16; ++j) al[j] = 0.f;
        for (int k = 0; k < D; ++k) { const float hk = xr[k] * rstd * g1[k];
#pragma unroll
            for (int j = 0; j < 16; ++j) al[j] += hk * w_in[(size_t)k * D_IN + IN_A + j]; }
        float z = 0.f;
#pragma unroll
        for (int j = 0; j < 16; ++j) z += al[j] * wau[j * GKW + (col - PJ_Z)];
        z += ba[col - PJ_Z];
        want = (fminf(z, 0.f) - logf(1.0f + expf(-fabsf(z)))) / 16.0f;
    } else {
        const int wc_ = col < PJ_Z ? col : col - PJ_U + IN_U; float a = 0.f;
        for (int k = 0; k < D; ++k) a += xr[k] * rstd * g1[k] * w_in[(size_t)k * D_IN + wc_];
        if (col >= PJ_R && col < PJ_Z) want = a / (1.0f + expf(-a)); else if (col >= PJ_GG) want = 1.0f / (1.0f + expf(-a)); else want = a;
    }
    const float got = (col >= PJ_GG) ? bf1(WSP(bf16, WS_GATES)[gate_elem(col >= PJ_GP ? 1 : 0, tok, (col - PJ_GG) & 1023)]) : bf1(PJ[(size_t)tok * NPJ + col]);
    if (!dbg_close(got, want)) dbg_fail(F, 1u);
}


__device__ __forceinline__ void dbg_check_bc(Frame& F) {
    if (F.bid != 5 || F.tid >= 64) return;
    const float* x = F.in[0]; const float* g1 = F.in[1]; const float* w_in = F.in[2]; const float* wau = F.in[3]; const float* ba = F.in[4]; const float* BC = WSP(float, WS_BC);
    const int offs[5] = {0, 1, 5, 18, 63}; const int off = (F.tid % 5 == 0) ? 0 : (F.tid % 5 == 1) ? 1 : (F.tid % 5 == 2) ? 5 : (F.tid % 5 == 3) ? 18 : 63; (void)offs;
    const int chunk = (int)(((unsigned)F.tid * 2654435761u) % (unsigned)(T / 64)), col = (int)(((unsigned)F.tid * 40503u + 3u) % (unsigned)GKW);
    float cum = 0.f;
    for (int r = 0; r <= off; ++r) { const float* xr = x + ((size_t)chunk * 64 + r) * D; float ss = 0.f; for (int k = 0; k < D; ++k) ss += xr[k] * xr[k];
        const float rstd = 1.0f / sqrtf(ss / D + EPS); float al[16];
#pragma unroll
        for (int j = 0; j < 16; ++j) al[j] = 0.f;
        for (int k = 0; k < D; ++k) { const float hk = xr[k] * rstd * g1[k];
#pragma unroll
            for (int j = 0; j < 16; ++j) al[j] += hk * w_in[(size_t)k * D_IN + IN_A + j]; }
        float z = ba[col];
#pragma unroll
        for (int j = 0; j < 16; ++j) z += al[j] * wau[j * GKW + col];
        cum += (fminf(z, 0.f) - logf(1.0f + expf(-fabsf(z)))) / 16.0f; }
    const float got = BC[((size_t)chunk * 64 + off) * GKW + col];
    if (fabsf(got - cum) > 0.004f + 0.01f * fabsf(cum)) dbg_fail(F, 7u);
}
__device__ __forceinline__ void dbg_check_gla(Frame& F) {
    if (F.bid != 1) return;
    const bf16* PJ = WSP(bf16, WS_PJ); const bf16* ON = WSP(bf16, WS_ON);
    const int b = 2, h = 1, v = F.tid & 127; const bool act = F.tid < 128;
    LAS float* S = (LAS float*)F.lds;
    LAS float* red = (LAS float*)(F.lds + 32768);
    if (act) for (int d = 0; d < 64; ++d) S[d * 128 + v] = 0.f;
    __syncthreads();
    bool bad = false;
    for (int t = 0; t < 1100; ++t) {
        const bf16* rp = PJ + ((size_t)b * SEQ + t) * NPJ; float o = 0.f;
        if (act) { const float vv = bf1(rp[PJ_V + h * 128 + v]);
            for (int d = 0; d < 64; ++d) { const float* bcp = WSP(float, WS_BC) + ((size_t)b * SEQ + t) * GKW + h * 64 + d; const float la = (t & 63) ? bcp[0] - bcp[-GKW] : bcp[0]; const float kk = bf1(rp[PJ_K + h * 64 + d]), qq = bf1(rp[PJ_Q + h * 64 + d]);
                const float sn = expf(la) * S[d * 128 + v] + kk * vv; S[d * 128 + v] = sn; o += qq * 0.125f * sn; }
            red[v] = o * o; }
        __syncthreads();
        if (act) { float ss = 0.f; for (int i = 0; i < 128; ++i) ss += red[i];
            const float want = o * (1.0f / sqrtf(ss / 128.f + EPS)) * bf1(rp[PJ_R + h * 128 + v]);
            const float got = bf1(ON[((size_t)b * SEQ + t) * GVW + h * 128 + v]);
            if ((t < 150 || t >= 1000) && !dbg_close(got, want)) bad = true; }
        __syncthreads();
    }
    if (bad) dbg_fail(F, 2u);
}
__device__ __forceinline__ void dbg_check_pool(Frame& F) {
    if (F.bid != 2) return;
    const bf16* PJ = WSP(bf16, WS_PJ); const bf16* PD = WSP(bf16, WS_PD);
    int tok = (int)(((unsigned)F.tid * 2654435761u) % (unsigned)T); if (F.tid < 40) tok = (F.tid & 1) * SEQ * 3 + (F.tid >> 1);
    const int c = (int)(((unsigned)F.tid * 40503u) % (unsigned)PW), pos = tok & (SEQ - 1), wlen = 2 << (c >> 7), cnt = pos + 1 < wlen ? pos + 1 : wlen;
    float a = 0.f; for (int i = 0; i < cnt; ++i) a += bf1(PJ[(size_t)(tok - i) * NPJ + PJ_U + c]);
    const float want = a / cnt - bf1(PJ[(size_t)tok * NPJ + PJ_U + c]);
    if (!dbg_close(bf1(PD[(size_t)tok * PW + c]), want)) dbg_fail(F, 3u);
}
__device__ __forceinline__ void dbg_check_mg(Frame& F) {
    if (F.bid != 3 || F.tid >= 64) return;
    const bf16* PJ = WSP(bf16, WS_PJ); const bf16* ON = WSP(bf16, WS_ON); const bf16* PD = WSP(bf16, WS_PD); const bf16* MG = WSP(bf16, WS_MG);
    const float* gng = F.in[5]; const float* wgb = F.in[6]; const float* pw = F.in[7]; const float* ps = F.in[8]; const float* wpb = F.in[9];
    const int tok = (int)(((unsigned)F.tid * 2654435761u + 12345u) % (unsigned)T), col = (int)(((unsigned)F.tid * 40503u + 77u) % (unsigned)D);
    float yg = 0.f; for (int k = 0; k < GVW; ++k) yg += bf1(ON[(size_t)tok * GVW + k]) * gng[k] * wgb[(size_t)k * D + col];
    float yp = 0.f;
    for (int g = 0; g < 4; ++g) for (int d = 0; d < 128; ++d) { float m = 0.f; for (int c = 0; c < 128; ++c) m += bf1(PD[(size_t)tok * PW + g * 128 + c]) * pw[((size_t)g * 128 + c) * 128 + d];
        yp += m * ps[g * 128 + d] * wpb[(size_t)(g * 128 + d) * D + col]; }
    const float want = bf1(WSP(bf16, WS_GATES)[gate_elem(0, tok, col)]) * yg + bf1(WSP(bf16, WS_GATES)[gate_elem(1, tok, col)]) * yp;
    if (!dbg_close(bf1(MG[(size_t)tok * D + col]), want)) dbg_fail(F, 4u);
}
__device__ __forceinline__ void dbg_check_x1(Frame& F) {
    if (F.bid != 4 || F.tid >= 128) return;
    const bf16* MG = WSP(bf16, WS_MG); const bf16* X1B = WSP(bf16, WS_X1B); const float* SSQ = WSP(float, WS_SSQ); const float* x = F.in[0]; const float* wout = F.in[10];
    const int tok = (int)(((unsigned)F.tid * 2654435761u + 999u) % (unsigned)T), col = (int)(((unsigned)F.tid * 40503u + 5u) % (unsigned)D);
    float a = x[(size_t)tok * D + col]; for (int k = 0; k < D; ++k) a += bf1(MG[(size_t)tok * D + k]) * wout[(size_t)k * D + col];
    if (!dbg_close(bf1(X1B[(size_t)tok * D + col]), a)) dbg_fail(F, 5u);
    float ss = 0.f; for (int k = 0; k < D; ++k) { const float v = bf1(X1B[(size_t)tok * D + k]); ss += v * v; }
    float sp = 0.f; for (int j = 0; j < 16; ++j) sp += SSQ[(size_t)tok * 16 + j];
    if (fabsf(ss - sp) > 1e-2f * ss) dbg_fail(F, 6u);
}
#endif

struct Args { const float* in[20]; float* out; unsigned char* ws; };
__global__ void __launch_bounds__(512, 2) fwd_kernel(Args args) {
    extern __shared__ __attribute__((aligned(16))) unsigned char lds[];
    Frame F;
    F.lds = (LAS unsigned char*)lds;
    F.MISC = (volatile LAS unsigned*)(F.lds + MISC_OFF);
    F.tid = threadIdx.x; F.lane = F.tid & 63; F.wave = __builtin_amdgcn_readfirstlane(F.tid >> 6);
    F.G = gridDim.x; F.bid = blockIdx.x;
    F.ws = args.ws; F.out = args.out; F.ctl = (gu32*)(args.ws + WS_CTL);
#pragma unroll
    for (int i = 0; i < 20; ++i) F.in[i] = args.in[i];
    for (int u = F.tid; u < (LDS_BYTES - RING_BYTES) / 4; u += 512) ((LAS unsigned*)(F.lds + RING_BYTES))[u] = 0u;
    __syncthreads();
    XcdBarrier bar = xcd_barrier_post((unsigned*)(F.ctl + CW_BAR), F.MISC + 8);
#define GRID_BAR() xcd_barrier(bar)

#pragma unroll 1
    for (int rep_ = 0; rep_ < REPS(0); ++rep_) p0_prologue(F);
    GRID_BAR();
    if (NPH > 1) {
        pg8::StaticSched S; S.init(WSP(bf16, WS_HB), D, WSP(bf16, WS_WIN), D, T, NPROJ, F.G, F.bid);
        EpiP1 E{WSP(bf16, WS_PJ), F.in[4], WSP(float, WS_BC), WSP(bf16, WS_GATES)};
#pragma unroll 1
        for (int rep_ = 0; rep_ < REPS(1); ++rep_) pg8::gemm_phase<EpiP1, pg8::StaticSched, false, true>(F.lds, D, D, D, S, E);
        GRID_BAR();
#if DBG
        dbg_check_p1(F); dbg_check_bc(F);
        GRID_BAR();
#endif
    }
    if (NPH > 2) {
#pragma unroll 1
        for (int rep_ = 0; rep_ < REPS(2); ++rep_) p2a_phase(F);
        GRID_BAR();
        p2b_phase(F);
        GRID_BAR();
#if DBG
        dbg_check_gla(F); dbg_check_pool(F);
        GRID_BAR();
#endif
    }
    if (NPH > 4) {
        PairSched S; S.S0.init(WSP(bf16, WS_ON), GVW, WSP(bf16, WS_WG), GVW, T, D, F.G, F.bid); S.A1 = (const char*)WSP(bf16, WS_PD); S.B1 = (const char*)WSP(bf16, WS_WP);
        EpiDE E{WSP(bf16, WS_MG), WSP(bf16, WS_GATES)};
#pragma unroll 1
        for (int rep_ = 0; rep_ < REPS(3); ++rep_) pg8::gemm_phase<EpiDE, PairSched, false, true>(F.lds, GVW, GVW, GVW, S, E);
        GRID_BAR();
#if DBG
        dbg_check_mg(F);
        GRID_BAR();
#endif
    }
    if (NPH > 5) {
        pg8::StaticSched S; S.init(WSP(bf16, WS_MG), D, WSP(bf16, WS_WOUT), D, T, D, F.G, F.bid);
        EpiF E{WSP(bf16, WS_HB), WSP(float, WS_XS), WSP(bf16, WS_X1B), WSP(float, WS_SSQ)};
#pragma unroll 1
        for (int rep_ = 0; rep_ < REPS(5); ++rep_) pg8::gemm_phase<EpiF, pg8::StaticSched, false, true>(F.lds, D, D, D, S, E);
        GRID_BAR();
#if DBG
        dbg_check_x1(F);
        GRID_BAR();
#endif
    }
    if (NPH > 6) {
        pg8::StaticSched S; S.init(WSP(bf16, WS_X1B), D, WSP(bf16, WS_WR), D, T, 256, F.G, F.bid);
        EpiG E{WSP(float, WS_LG)};
#pragma unroll 1
        for (int rep_ = 0; rep_ < REPS(6); ++rep_) pg8::gemm_phase<EpiG, pg8::StaticSched, false, true>(F.lds, D, D, D, S, E);
        VM_WAIT(); __syncthreads();
        pg8::Unit u; for (int i = 0; S.next(i, u); ++i) route_rows(F, u.r0);
        GRID_BAR();
    }
    if (NPH > 7) {
        moe_tables(F);
        MoeSched S{(const LAS int*)(F.lds + SCHED_OFF + 256), (const LAS int*)(F.lds + SCHED_OFF + 256) + 40, WSP(unsigned, WS_LIST), (const char*)WSP(bf16, WS_X1B), (const char*)WSP(bf16, WS_WGU), 2, F.G, F.bid, 0};
        EpiH E{WSP(bf16, WS_ACT), WSP(float, WS_LISTR)};
#pragma unroll 1
        for (int rep_ = 0; rep_ < REPS(7); ++rep_) pg8::gemm_phase<EpiH, MoeSched, true, true>(F.lds, D, D, D, S, E);
        GRID_BAR();
    }
    if (NPH > 8) {
        MoeSched S{(const LAS int*)(F.lds + SCHED_OFF + 256), (const LAS int*)(F.lds + SCHED_OFF + 256) + 40, WSP(unsigned, WS_LIST), (const char*)WSP(bf16, WS_ACT), (const char*)WSP(bf16, WS_WD), 4, F.G, F.bid, 1};
        EpiI E{WSP(bf16, WS_Y), WSP(unsigned, WS_LIST), WSP(float, WS_LISTW)};
#pragma unroll 1
        for (int rep_ = 0; rep_ < REPS(8); ++rep_) pg8::gemm_phase<EpiI, MoeSched, false, true>(F.lds, DE, DE, DE, S, E);
        GRID_BAR();
    }
    if (NPH > 9) {
        const float* gf = F.in[19]; const bf16* X1B = WSP(bf16, WS_X1B); const bf16* Y = WSP(bf16, WS_Y);
        const int gw = F.bid * 8 + F.wave, NGW = F.G * 8;
        unsigned code = 0;
#if DBG
        code = __hip_atomic_load((unsigned*)(F.ctl + CW_DBG), RLX_AGENT);
        if (__hip_atomic_load((unsigned*)(F.ctl + CW_BAR) + XB_TMO, RLX_AGENT) != 0u) code = 9;
#endif
#pragma unroll 1
        for (int rep_ = 0; rep_ < REPS(9); ++rep_)
        for (int m = gw; m < T; m += NGW) {
            const GAS v2u* xr = (const GAS v2u*)(X1B + (size_t)m * D) + F.lane;
            const GAS v2u* y0 = (const GAS v2u*)(Y + (size_t)(2 * m) * D) + F.lane; const GAS v2u* y1 = (const GAS v2u*)(Y + (size_t)(2 * m + 1) * D) + F.lane;
            f32x4 v[4]; float s_ = 0.f;
#pragma unroll
            for (int j = 0; j < 4; ++j) { const v2u a = y0[64 * j], b = y1[64 * j], c = xr[64 * j]; v[j] = (f32x4){bflo(c.x), bfhi(c.x), bflo(c.y), bfhi(c.y)} + (f32x4){bflo(a.x), bfhi(a.x), bflo(a.y), bfhi(a.y)} + (f32x4){bflo(b.x), bfhi(b.x), bflo(b.y), bfhi(b.y)};
                s_ += (v[j].x * v[j].x + v[j].y * v[j].y) + (v[j].z * v[j].z + v[j].w * v[j].w); }
            const float rstd = 1.0f / sqrtf(wave_sum(s_) * (1.f / D) + EPS);
            GAS f32x4* o = (GAS f32x4*)(F.out + (size_t)m * D) + F.lane;
#pragma unroll
            for (int j = 0; j < 4; ++j) { const f32x4 g = *((const GAS f32x4*)gf + F.lane + 64 * j); f32x4 r = v[j] * rstd * g; if (code) r = (f32x4){10.f * code, 10.f * code, 10.f * code, 10.f * code}; o[64 * j] = r; }
        }
    } else
    {
        const float* gf = F.in[19]; const float* x = F.in[0];
        const int gw = F.bid * 8 + F.wave, NGW = F.G * 8;
        unsigned code = 0;
#if DBG
        code = __hip_atomic_load((unsigned*)(F.ctl + CW_DBG), RLX_AGENT);
        if (__hip_atomic_load((unsigned*)(F.ctl + CW_BAR) + XB_TMO, RLX_AGENT) != 0u) code = 9;
#endif
        for (int m = gw; m < T; m += NGW) {
            const GAS f32x4* xr = (const GAS f32x4*)(x + (size_t)m * D) + F.lane;
            f32x4 v[4]; float s = 0.f;
#pragma unroll
            for (int j = 0; j < 4; ++j) { v[j] = xr[64 * j]; s += (v[j].x * v[j].x + v[j].y * v[j].y) + (v[j].z * v[j].z + v[j].w * v[j].w); }
            const float rstd = 1.0f / sqrtf(wave_sum(s) * (1.f / D) + EPS);
            GAS f32x4* o = (GAS f32x4*)(F.out + (size_t)m * D) + F.lane;
#pragma unroll
            for (int j = 0; j < 4; ++j) { const f32x4 g = *((const GAS f32x4*)gf + F.lane + 64 * j); f32x4 r = v[j] * rstd * g; if (code) r = (f32x4){10.f * code, 10.f * code, 10.f * code, 10.f * code}; o[64 * j] = r; }
        }
    }
}

extern "C" void kernel_launch(void* const* d_in, const int* in_sizes, int n_in, void* d_out, int out_size, void* d_ws, size_t ws_size, hipStream_t stream) {
    static int grid = 0;
    if (grid == 0) {
        if (n_in != 20 || in_sizes[0] != T * D || out_size != T * D || ws_size < WS_END) { fprintf(stderr, "kernel_launch: unexpected shapes (n_in %d, in0 %d, out %d, ws %zu)\n", n_in, n_in > 0 ? in_sizes[0] : -1, out_size, ws_size); grid = -1; return; }
        int dev = 0, cus = 0, per_cu = 0;
        if (hipGetDevice(&dev) != hipSuccess || hipDeviceGetAttribute(&cus, hipDeviceAttributeMultiprocessorCount, dev) != hipSuccess) { grid = -1; return; }
        if (hipFuncSetAttribute((const void*)fwd_kernel, hipFuncAttributeMaxDynamicSharedMemorySize, LDS_BYTES) != hipSuccess) { fprintf(stderr, "kernel_launch: hipFuncSetAttribute failed\n"); grid = -1; return; }
        if (hipOccupancyMaxActiveBlocksPerMultiprocessor(&per_cu, (const void*)fwd_kernel, 512, LDS_BYTES) != hipSuccess || per_cu < 1) fprintf(stderr, "kernel_launch: occupancy query says %d\n", per_cu);
        (void)hipGetLastError();
        grid = cus;
    }
    if (grid < 0) return;
    if (hipMemsetAsync((char*)d_ws + WS_CTL, 0, CTL_ZERO_BYTES, stream) != hipSuccess) return;
    Args a{};
    for (int i = 0; i < 20; ++i) a.in[i] = (const float*)d_in[i];
    a.out = (float*)d_out; a.ws = (unsigned char*)d_ws;
    hipLaunchKernelGGL(fwd_kernel, dim3(grid), dim3(512), LDS_BYTES, stream, a);
}
```

```cpp
#include <hip/hip_runtime.h>
#include <cstdio>
#include <cstdint>

#ifndef DBG
#define DBG 0
#endif
#ifndef REPMASK
#define REPMASK 0
#endif
#define REPS(k) ((((REPMASK) >> (k)) & 1) ? 2 : 1)
#ifndef NPH
#define NPH 10
#endif

constexpr int BATCH = 16, SEQ = 4096, T = BATCH * SEQ, D = 1024;
constexpr int GH = 4, GDK = 64, GDV = 128, GKW = 256, GVW = 512, GRANK = 16, GCH = 64;
constexpr int PW = 512, PGW = 128;
constexpr int D_IN = 4112;
constexpr int IN_Q = 0, IN_K = 256, IN_V = 512, IN_R = 1024, IN_A = 1536, IN_U = 1552, IN_GG = 2064, IN_GP = 3088;
constexpr int NPROJ = 4352;
constexpr int NPJ = 2304;
constexpr int PJ_Q = 0, PJ_K = 256, PJ_V = 512, PJ_R = 1024, PJ_Z = 1536, PJ_U = 1792, PJ_GG = 2304, PJ_GP = 3328;
constexpr int NE = 32, EPG = 8, NG = 4, DE = 256;
constexpr int NSEG = 4, SEGCH = SEQ / GCH / NSEG;
constexpr int NA = 2 * T;
constexpr int LCAP = T;
constexpr float EPS = 1e-6f;
constexpr float YSCALE = 32.0f;

constexpr size_t MiB = 1u << 20;
constexpr size_t WS_CTL = 0, CTL_ZERO_BYTES = 1 * MiB;
constexpr size_t WS_WIN = 1 * MiB;
constexpr size_t WS_WG = 10 * MiB;
constexpr size_t WS_WP = 11 * MiB;
constexpr size_t WS_WOUT = 12 * MiB;
constexpr size_t WS_WR = 14 * MiB;
constexpr size_t WS_WGU = 15 * MiB;
constexpr size_t WS_WD = 47 * MiB;
constexpr size_t WS_XS = 63 * MiB;
constexpr size_t WS_HB = 64 * MiB;
constexpr size_t WS_TG = WS_HB;
constexpr size_t WS_MG = 192 * MiB;
constexpr size_t WS_SLOC = 256 * MiB;
constexpr size_t WS_DTOT = 264 * MiB;
constexpr size_t WS_CUMB = 265 * MiB;
constexpr size_t WS_BC = 192 * MiB;
constexpr size_t WS_Y = 64 * MiB;
constexpr size_t WS_ON = 320 * MiB;
constexpr size_t WS_PD = 384 * MiB;
constexpr size_t WS_ACT = 320 * MiB;
constexpr size_t WS_PJ = 448 * MiB;
constexpr size_t WS_GATES = 736 * MiB;
constexpr size_t WS_X1B = 448 * MiB;
constexpr size_t WS_LG = 576 * MiB;
constexpr size_t WS_SSQ = 592 * MiB;
constexpr size_t WS_LIST = 596 * MiB;
constexpr size_t WS_LISTW = 604 * MiB;
constexpr size_t WS_LISTR = 612 * MiB;
constexpr size_t WS_END = 992 * MiB;
static_assert(WS_PJ + (size_t)T * NPJ * 2 <= WS_GATES && WS_GATES + (size_t)2 * T * D * 2 <= WS_END && WS_LISTR + (size_t)NE * LCAP * 4 <= WS_GATES && WS_ACT + (size_t)(NA + NE * 256) * DE * 2 <= WS_PJ, "d_ws map");
constexpr int CW_TMO = 0, CW_DBG = 2;
constexpr int CW_BAR = 4096;
constexpr int CW_ECNT = 16384;

constexpr int RING_BYTES = 131072;
constexpr int MISC_OFF = RING_BYTES + 320;
constexpr int SCHED_OFF = RING_BYTES + 1024;
constexpr int LDS_BYTES = 147456;

#define GAS __attribute__((address_space(1)))
#define LAS __attribute__((address_space(3)))
typedef unsigned short bf16;
typedef unsigned v4u __attribute__((ext_vector_type(4)));
typedef unsigned v2u __attribute__((ext_vector_type(2)));
typedef float f32x4 __attribute__((ext_vector_type(4)));
typedef short bf16x8 __attribute__((ext_vector_type(8)));
typedef short bf16x4 __attribute__((ext_vector_type(4)));
typedef GAS unsigned gu32;
#define RLX_AGENT __ATOMIC_RELAXED, __HIP_MEMORY_SCOPE_AGENT
#define LDS_WAIT() asm volatile("s_waitcnt lgkmcnt(0)" ::: "memory")
#define VM_WAIT() asm volatile("s_waitcnt vmcnt(0)" ::: "memory")
__device__ __forceinline__ unsigned f2bf(float f) { unsigned u = __builtin_bit_cast(unsigned, f); return (u + 0x7fffu + ((u >> 16) & 1u)) >> 16; }
__device__ __forceinline__ unsigned pk2(float lo, float hi) { unsigned r; asm volatile("v_cvt_pk_bf16_f32 %0, %1, %2" : "=v"(r) : "v"(lo), "v"(hi)); return r; }
__device__ __forceinline__ float bflo(unsigned w) { return __builtin_bit_cast(float, w << 16); }
__device__ __forceinline__ float bfhi(unsigned w) { return __builtin_bit_cast(float, w & 0xffff0000u); }
__device__ __forceinline__ float bf1(bf16 h) { return __builtin_bit_cast(float, (unsigned)h << 16); }
__device__ __forceinline__ float fsigmoid(float x) { return __builtin_amdgcn_rcpf(1.0f + __expf(-x)); }
__device__ __forceinline__ float wave_sum(float v) {
#pragma unroll
    for (int o = 1; o < 64; o <<= 1) v += __shfl_xor(v, o);
    return v;
}


__device__ __forceinline__ unsigned pk4_fp8(const f32x4 v) { int w = 0; w = __builtin_amdgcn_cvt_pk_fp8_f32(v[0], v[1], w, false); w = __builtin_amdgcn_cvt_pk_fp8_f32(v[2], v[3], w, true); return (unsigned)w; }
__device__ __forceinline__ f32x4 unpk4_fp8(const unsigned w) { const auto lo = __builtin_amdgcn_cvt_pk_f32_fp8((int)w, false), hi = __builtin_amdgcn_cvt_pk_f32_fp8((int)w, true); return (f32x4){lo[0], lo[1], hi[0], hi[1]}; }
template <int CTRL> __device__ __forceinline__ float dpp_f(float x) { return __builtin_bit_cast(float, __builtin_amdgcn_update_dpp(0, __builtin_bit_cast(int, x), CTRL, 0xf, 0xf, true)); }
__device__ __forceinline__ float row16_sum(float x) { x += dpp_f<0x128>(x); x += dpp_f<0x124>(x); x += dpp_f<0x122>(x); x += dpp_f<0x121>(x); return x; }
__device__ __forceinline__ float row16_scan(float x) { x += dpp_f<0x111>(x); x += dpp_f<0x112>(x); x += dpp_f<0x114>(x); x += dpp_f<0x118>(x); return x; }

#define XB_TMO      128
#define XB_XCNT(j)  (256  + 64 * (j))
#define XB_XSUB(j)  (1280 + 64 * (j))
#define XB_XGEN(j)  (2304 + 64 * (j))
#define XB_TOP      3328
#define XB_TOPGEN   3392
#define XCD_BAR_WORDS 3456
#define XB_SPIN_CAP (1u << 18)
__device__ __forceinline__ unsigned xb_ld(unsigned* p)              { return __hip_atomic_load(p, __ATOMIC_RELAXED, __HIP_MEMORY_SCOPE_AGENT); }
__device__ __forceinline__ unsigned xb_add(unsigned* p, unsigned v) { return __hip_atomic_fetch_add(p, v, __ATOMIC_RELAXED, __HIP_MEMORY_SCOPE_AGENT); }
__device__ __forceinline__ unsigned xb_xcc_id() { return (unsigned)__builtin_amdgcn_s_getreg((3 << 11) | 20) & 0xFu; }
#define XB_SPIN(cond, bar) do { unsigned _sp = 0; while (cond) { __builtin_amdgcn_s_sleep(1); \
    if ((++_sp & 255u) == 0u) { if (xb_ld(&(bar)[XB_TMO])) break; if (_sp > XB_SPIN_CAP) { atomicAdd(&(bar)[XB_TMO], 1u); break; } } } } while (0)
struct XcdBarrier { unsigned* bar; unsigned x; volatile LAS unsigned* st; };
__device__ __forceinline__ XcdBarrier xcd_barrier_post(unsigned* bar, volatile LAS unsigned* st) {
    XcdBarrier b; b.bar = bar; b.x = xb_xcc_id(); b.st = st;
    if (threadIdx.x == 0) (void)xb_add(&bar[XB_XCNT(b.x)], 1u);
    return b;
}
__device__ __forceinline__ void xcd_barrier_complete(unsigned* bar, unsigned x, unsigned& nloc, unsigned& nx) {
    const unsigned G = gridDim.x * gridDim.y * gridDim.z;
    unsigned sum, cnt, mine, sp = 0u;
    for (;;) {
        sum = 0u; cnt = 0u; mine = 0u;
#pragma unroll
        for (unsigned j = 0; j < 16; ++j) { const unsigned c = xb_ld(&bar[XB_XCNT(j)]); sum += c; cnt += (c > 0u) ? 1u : 0u; mine = (j == x) ? c : mine; }
        if (sum == G) break;
        __builtin_amdgcn_s_sleep(1);
        if ((++sp & 255u) == 0u) { if (xb_ld(&bar[XB_TMO])) break; if (sp > XB_SPIN_CAP) { atomicAdd(&bar[XB_TMO], 1u); break; } }
    }
    nloc = mine > 0u ? mine : 1u; nx = cnt > 0u ? cnt : 1u;
}
__device__ __forceinline__ void xcd_barrier(const XcdBarrier& b) {
    asm volatile("s_waitcnt vmcnt(0)" ::: "memory");
    __syncthreads();
    if (threadIdx.x == 0) {
        unsigned* bar = b.bar;
        __builtin_amdgcn_s_waitcnt(0);
        unsigned nloc = b.st[0], nx = b.st[1];
        if (nloc == 0u) { xcd_barrier_complete(bar, b.x, nloc, nx); b.st[0] = nloc; b.st[1] = nx; }
        const unsigned old = xb_add(&bar[XB_XSUB(b.x)], 1u);
        const unsigned gen = old / nloc;
        if (old + 1u == (gen + 1u) * nloc) {
            __builtin_amdgcn_fence(__ATOMIC_RELEASE, "agent");
            asm volatile("s_waitcnt vmcnt(0)" ::: "memory");
            const unsigned og = xb_add(&bar[XB_TOP], 1u);
            const unsigned tg = og / nx;
            if (og + 1u == (tg + 1u) * nx) xb_add(&bar[XB_TOPGEN], 1u);
            else XB_SPIN(xb_ld(&bar[XB_TOPGEN]) == tg, bar);
            __builtin_amdgcn_fence(__ATOMIC_ACQUIRE, "agent");
            xb_add(&bar[XB_XGEN(b.x)], 1u);
            asm volatile("s_waitcnt vmcnt(0)" ::: "memory");
        } else {
            XB_SPIN(xb_ld(&bar[XB_XGEN(b.x)]) == gen, bar);
            __builtin_amdgcn_fence(__ATOMIC_ACQUIRE, "agent");
            asm volatile("s_waitcnt vmcnt(0)" ::: "memory");
        }
    }
    __syncthreads();
}

namespace pg8 {
#define PG8_LAS __attribute__((address_space(3)))
constexpr int BM = 256, BK = 64, HALF = 128, HTB = HALF * BK * 2, STAGE_BYTES = 8 * HTB, NXCD = 8, WGM = 8;
__host__ __device__ __forceinline__ int lds_byte(int r, int c) { const int st = (r >> 4) * 2 + (c >> 5), rr = r & 15, cc = c & 31, ob = rr * 64 + cc * 2; return st * 1024 + (ob ^ (((ob >> 9) & 1) << 5)); }
__host__ __device__ __forceinline__ void stage_rc(int b, int& R, int& C) { const int st = b / 1024, sb = b % 1024, swz = sb ^ (((sb >> 9) & 1) << 5); R = (st >> 1) * 16 + swz / 64; C = (st & 1) * 32 + (swz % 64) / 2; }
__host__ __device__ __forceinline__ int perm32(int rho) { const int n = rho >> 4, i = rho & 15; return 8 * (i >> 2) + 4 * n + (i & 3); }

struct Unit { const char* A; const char* B; int r0, c0, e, nvalid, lb, pad; };

__device__ __forceinline__ int remap_xcd(int L, int nwg) { const int q = nwg / NXCD, r = nwg % NXCD, xcd = L % NXCD, off = L / NXCD; return (xcd < r ? xcd * (q + 1) : r * (q + 1) + (xcd - r) * q) + off; }
struct StaticSched {
    const char* A; const char* B; int lda, ldb, nM, nN, nwg, G, c;
    __device__ __forceinline__ void init(const void* A_, int lda_, const void* B_, int ldb_, int M, int N, int G_, int c_) { A = (const char*)A_; B = (const char*)B_; lda = lda_; ldb = ldb_; nM = M / BM; nN = N / BM; nwg = nM * nN; G = G_; c = c_; }
    __device__ __forceinline__ bool next(int i, Unit& u) const {
        const long L = (long)i * G + c; if (L >= nwg) return false;
        const int wgid = remap_xcd((int)L, nwg);
        const int nig = WGM * nN, gid = wgid / nig, fm = gid * WGM, gsz = (nM - fm) < WGM ? (nM - fm) : WGM;
        const int pm = fm + ((wgid % nig) % gsz), pn = (wgid % nig) / gsz;
        u.A = A + (size_t)pm * BM * lda * 2; u.B = B + (size_t)pn * BM * ldb * 2; u.r0 = pm * BM; u.c0 = pn * BM; u.e = 0; u.nvalid = BM; u.lb = 0; u.pad = 0; return true;
    }
    __device__ __forceinline__ void fill_tab(const Unit&, PG8_LAS unsigned*) const {}
};

template <class Epi, class Sched, bool GATHER, bool ALIGN_EPI>
__device__ __forceinline__ void gemm_phase(PG8_LAS unsigned char* lds, const int K, const int lda, const int ldb, const Sched& S, const Epi& E) {
    int tid_ = threadIdx.x; asm volatile("" : "+v"(tid_));
    const int tid = tid_, wid = __builtin_amdgcn_readfirstlane(tid >> 6), lane = tid & 63, wr = wid >> 2, wc = wid & 3, fr = lane & 15, fq = lane >> 4;
    const int nt = K / BK;
    int Rr[2], Cc[2];
    unsigned voffA[2][2], voffB[2], nvA[2][2];
#pragma unroll
    for (int i = 0; i < 2; ++i) { int R, C; stage_rc(tid * 16 + i * 8192, R, C); Rr[i] = R; Cc[i] = C; const int Rb = Epi::PERM ? ((R & ~31) + perm32(R & 31)) : R;
        voffB[i] = (unsigned)(Rb * ldb + C) * 2u;
#pragma unroll
        for (int h = 0; h < 2; ++h) { voffA[h][i] = (unsigned)((R + HALF * h) * lda + C) * 2u; nvA[h][i] = voffA[h][i]; } }
    const size_t kstep = (size_t)(BK * 2);
    const size_t hstepB = (size_t)HALF * ldb * 2;
    const unsigned ldsw = (unsigned)wid * 1024u;
    const int aoff = lds_byte(wr * 64 + fr, fq * 8), boff = lds_byte(wc * 32 + fr, fq * 8);
#define PG8_SA(b, h) (((b) * 2 + (h)) * HTB)
#define PG8_SB(b, h) ((4 + (b) * 2 + (h)) * HTB)
#define PG8_STAGE(bufoff, gbase, voff) do { _Pragma("unroll") for (int _i = 0; _i < 2; ++_i) \
        __builtin_amdgcn_global_load_lds((const unsigned*)((const char*)(gbase) + (voff)[_i]), (PG8_LAS unsigned*)(lds + (bufoff) + ldsw + _i * 8192), 16, 0, 0); } while (0)
#define PG8_LDA(dst, b, h) do { _Pragma("unroll") for (int m = 0; m < 4; ++m) _Pragma("unroll") for (int k = 0; k < 2; ++k) dst[m][k] = *(const PG8_LAS bf16x8*)(lds + PG8_SA(b, h) + aoff + m * 2048 + k * 1024); } while (0)
#define PG8_LDB(dst, b, h) do { _Pragma("unroll") for (int n = 0; n < 2; ++n) _Pragma("unroll") for (int k = 0; k < 2; ++k) dst[n][k] = *(const PG8_LAS bf16x8*)(lds + PG8_SB(b, h) + boff + n * 2048 + k * 1024); } while (0)
#define PG8_MMA(ai, bj, At, Bt) do { __builtin_amdgcn_s_setprio(1); _Pragma("unroll") for (int m = 0; m < 4; ++m) _Pragma("unroll") for (int n = 0; n < 2; ++n) _Pragma("unroll") for (int k = 0; k < 2; ++k) \
        acc[ai][bj][m][n] = __builtin_amdgcn_mfma_f32_16x16x32_bf16(Bt[n][k], At[m][k], acc[ai][bj][m][n], 0, 0, 0); __builtin_amdgcn_s_setprio(0); } while (0)
#define PG8_WAIT_V(n) asm volatile("s_waitcnt vmcnt(" #n ")" ::: "memory")
#define PG8_WAIT_L(n) asm volatile("s_waitcnt lgkmcnt(" #n ")" ::: "memory")
#define PG8_BAR __builtin_amdgcn_s_barrier()
#define PG8_SCHED __builtin_amdgcn_sched_barrier(0)
    Unit cur, nxt; int ui = 0;
    if (!S.next(0, cur)) return;
    f32x4 acc[2][2][4][2];
#pragma unroll
    for (int a = 0; a < 2; ++a)
#pragma unroll
        for (int b = 0; b < 2; ++b)
#pragma unroll
            for (int m = 0; m < 4; ++m)
#pragma unroll
                for (int n = 0; n < 2; ++n) acc[a][b][m][n] = (f32x4){0.f, 0.f, 0.f, 0.f};
    bf16x8 At[4][2], B0[2][2], B1[2][2];
    const char* cA = cur.A; const char* cB = cur.B;
    PG8_LAS unsigned* gtab = (PG8_LAS unsigned*)(lds + STAGE_BYTES + 2048);
    if constexpr (GATHER) {
        S.fill_tab(cur, gtab);
        asm volatile("s_waitcnt lgkmcnt(0)" ::: "memory"); __builtin_amdgcn_s_barrier(); asm volatile("" ::: "memory");
#pragma unroll
        for (int h = 0; h < 2; ++h)
#pragma unroll
            for (int i = 0; i < 2; ++i) { voffA[h][i] = gtab[Rr[i] + HALF * h] + (unsigned)Cc[i] * 2u; nvA[h][i] = voffA[h][i]; }
    }
    PG8_STAGE(PG8_SB(0, 0), cB, voffB); PG8_STAGE(PG8_SB(0, 1), cB + hstepB, voffB); PG8_STAGE(PG8_SA(0, 0), cA, voffA[0]); PG8_STAGE(PG8_SA(0, 1), cA, voffA[1]);
    if (wr == 1) PG8_BAR;
    PG8_WAIT_V(2); PG8_BAR;
    PG8_STAGE(PG8_SB(1, 0), cB + kstep, voffB); PG8_STAGE(PG8_SA(1, 0), cA + kstep, voffA[0]); PG8_STAGE(PG8_SB(1, 1), cB + hstepB + kstep, voffB);
    PG8_WAIT_V(6); PG8_BAR;
    for (;;) {
        const bool has_next = S.next(ui + 1, nxt);
        const char* nA = has_next ? nxt.A : cA; const char* nB = has_next ? nxt.B : cB;
        if constexpr (GATHER) { if (has_next) S.fill_tab(nxt, gtab + ((ui + 1) & 1) * 256); }
#pragma unroll 1
        for (int t = 0; t < nt; t += 2) {
            const bool last = (t == nt - 2);
            const char* a1 = cA + (size_t)(t + 1) * kstep;
            const char* a2 = last ? nA : cA + (size_t)(t + 2) * kstep; const char* b2 = last ? nB : cB + (size_t)(t + 2) * kstep;
            const char* a3 = a2 + kstep; const char* b3 = b2 + kstep;
            unsigned sv[2][2];
            if constexpr (GATHER) {
                if (last && has_next) {
#pragma unroll
                    for (int h = 0; h < 2; ++h)
#pragma unroll
                        for (int i = 0; i < 2; ++i) nvA[h][i] = gtab[((ui + 1) & 1) * 256 + Rr[i] + HALF * h] + (unsigned)Cc[i] * 2u;
                }
#pragma unroll
                for (int h = 0; h < 2; ++h)
#pragma unroll
                    for (int i = 0; i < 2; ++i) sv[h][i] = last ? nvA[h][i] : voffA[h][i];
            } else {
#pragma unroll
                for (int h = 0; h < 2; ++h)
#pragma unroll
                    for (int i = 0; i < 2; ++i) sv[h][i] = voffA[h][i];
            }
            PG8_LDB(B0, 0, 0); PG8_LDB(B1, 0, 1); PG8_SCHED; PG8_LDA(At, 0, 0); PG8_STAGE(PG8_SA(1, 1), a1, voffA[1]);
            PG8_WAIT_V(8); PG8_WAIT_L(0); PG8_BAR; PG8_MMA(0, 0, At, B0); PG8_MMA(0, 1, At, B1); PG8_BAR; PG8_SCHED;
            PG8_LDA(At, 0, 1); PG8_STAGE(PG8_SB(0, 0), b2, voffB); PG8_STAGE(PG8_SB(0, 1), b2 + hstepB, voffB); PG8_STAGE(PG8_SA(0, 0), a2, sv[0]);
            PG8_WAIT_V(8); PG8_WAIT_L(0); PG8_BAR; PG8_MMA(1, 0, At, B0); PG8_MMA(1, 1, At, B1); PG8_BAR; PG8_SCHED;
            PG8_LDB(B0, 1, 0); PG8_LDB(B1, 1, 1); PG8_SCHED; PG8_LDA(At, 1, 0); PG8_STAGE(PG8_SA(0, 1), a2, sv[1]);
            PG8_WAIT_V(8); PG8_WAIT_L(0); PG8_BAR; PG8_MMA(0, 0, At, B0); PG8_MMA(0, 1, At, B1); PG8_BAR; PG8_SCHED;
            PG8_LDA(At, 1, 1); PG8_STAGE(PG8_SB(1, 0), b3, voffB); PG8_STAGE(PG8_SB(1, 1), b3 + hstepB, voffB); PG8_STAGE(PG8_SA(1, 0), a3, sv[0]);
            PG8_WAIT_V(8); PG8_WAIT_L(0); PG8_BAR; PG8_MMA(1, 0, At, B0); PG8_MMA(1, 1, At, B1); PG8_BAR; PG8_SCHED;
        }
        if constexpr (ALIGN_EPI) { if (wr == 0) PG8_BAR; }
#if defined(EPIX2)
#pragma unroll 1
        for (int e_ = 0; e_ < ((EPIX2 == Epi::ID) ? 2 : 1); ++e_)
#endif
        E(acc, cur, wr, wc, fr, fq);
        if (!has_next) break;
        if (!(cur.pad & 1)) {
#pragma unroll
        for (int a = 0; a < 2; ++a)
#pragma unroll
            for (int b = 0; b < 2; ++b)
#pragma unroll
                for (int m = 0; m < 4; ++m)
#pragma unroll
                    for (int n = 0; n < 2; ++n) acc[a][b][m][n] = (f32x4){0.f, 0.f, 0.f, 0.f};
        }
        cur = nxt; cA = nA; cB = nB; ++ui;
        if constexpr (GATHER) {
#pragma unroll
            for (int h = 0; h < 2; ++h)
#pragma unroll
                for (int i = 0; i < 2; ++i) voffA[h][i] = nvA[h][i];
        }
        if constexpr (ALIGN_EPI) { if (wr == 1) PG8_BAR; }
    }
    PG8_WAIT_V(0);
    if constexpr (!ALIGN_EPI) { if (wr == 0) PG8_BAR; }
    PG8_BAR;
#undef PG8_SA
#undef PG8_SB
#undef PG8_STAGE
#undef PG8_LDA
#undef PG8_LDB
#undef PG8_MMA
#undef PG8_WAIT_V
#undef PG8_WAIT_L
#undef PG8_BAR
#undef PG8_SCHED
}
}

struct Frame {
    LAS unsigned char* lds;
    volatile LAS unsigned* MISC;
    gu32* ctl;
    int tid, lane, wave, G, bid;
    const float* in[20]; float* out; unsigned char* ws;
};
#define WSP(T_, off) ((T_*)(F.ws + (off)))

__device__ __forceinline__ v4u pack8(const f32x4 a, const f32x4 b) { v4u w; w.x = pk2(a[0], a[1]); w.y = pk2(a[2], a[3]); w.z = pk2(b[0], b[1]); w.w = pk2(b[2], b[3]); return w; }
__device__ __forceinline__ void unpack8(const v4u w, f32x4& a, f32x4& b) { a = (f32x4){bflo(w.x), bfhi(w.x), bflo(w.y), bfhi(w.y)}; b = (f32x4){bflo(w.z), bfhi(w.z), bflo(w.w), bfhi(w.w)}; }

__device__ __forceinline__ size_t gate_block(int which, int pm, int pnl, int wave, int ai, int m, int bj, int lane) {
    const int wr = wave >> 2, wc = wave & 3, fr = lane & 15, fq = lane >> 4; const size_t row = (size_t)pm * 256 + ai * 128 + wr * 64 + m * 16 + fr; const int col = pnl * 256 + bj * 128 + wc * 32 + 8 * fq;
    return ((size_t)which * T + row) * D + col;
}
__device__ __forceinline__ size_t gate_elem(int which, int row, int col) { return ((size_t)which * T + row) * D + col; }
struct EpiP1 {
    static constexpr int ID = 1; static constexpr bool PERM = true;
    bf16* PJ; const float* b_alpha; float* BC; bf16* GATES;
    __device__ __forceinline__ void operator()(const f32x4 (&acc)[2][2][4][2], const pg8::Unit& u, int wr, int wc, int fr, int fq) const {
        const int pn = u.c0 >> 8;
        const int mode = (pn == 4 || pn == 5) ? 1 : (pn == 6) ? 2 : (pn >= 9) ? 3 : 0;
        const int row0 = u.r0 + wr * 64 + fr, col0 = u.c0 + wc * 32 + 8 * fq;
        f32x4 bv[2][2];
        const int bidx = (mode == 2) ? (col0 - PJ_Z) : 0;
#pragma unroll
        for (int bj = 0; bj < 2; ++bj)
#pragma unroll
            for (int n = 0; n < 2; ++n) { bv[bj][n] = *(const f32x4*)(b_alpha + bidx + bj * 128 + 4 * n); asm volatile("" :: "v"(bv[bj][n])); }
        if (mode == 2) {
#pragma unroll
            for (int ai = 0; ai < 2; ++ai)
#pragma unroll
                for (int bj = 0; bj < 2; ++bj) { f32x4 pr[4][2];
#pragma unroll
                    for (int n = 0; n < 2; ++n)
#pragma unroll
                        for (int j = 0; j < 4; ++j) { float carry = 0.f;
#pragma unroll
                            for (int m = 0; m < 4; ++m) { const float z = acc[ai][bj][m][n][j] + bv[bj][n][j]; const float la = (fminf(z, 0.f) - __logf(1.0f + __expf(-fabsf(z)))) * (1.0f / 16.0f);
                                pr[m][n][j] = row16_scan(la) + carry; carry += row16_sum(la); } }
#pragma unroll
                    for (int m = 0; m < 4; ++m) { float* bp = BC + (size_t)(row0 + ai * 128 + m * 16) * GKW + (col0 - PJ_Z) + bj * 128; *(f32x4*)bp = pr[m][0]; *(f32x4*)(bp + 4) = pr[m][1]; } }
            return;
        }
#pragma unroll
        for (int ai = 0; ai < 2; ++ai)
#pragma unroll
            for (int m = 0; m < 4; ++m) { bf16* rowp = PJ + (size_t)(row0 + ai * 128 + m * 16) * NPJ + col0;
#pragma unroll
                for (int bj = 0; bj < 2; ++bj) { f32x4 v[2] = {acc[ai][bj][m][0], acc[ai][bj][m][1]};
                    if (mode == 1) {
#pragma unroll
                        for (int n = 0; n < 2; ++n)
#pragma unroll
                            for (int j = 0; j < 4; ++j) v[n][j] = v[n][j] * fsigmoid(v[n][j]);
                    } else if (mode == 3) {
#pragma unroll
                        for (int n = 0; n < 2; ++n)
#pragma unroll
                            for (int j = 0; j < 4; ++j) v[n][j] = fsigmoid(v[n][j]);
                        *(v4u*)(GATES + gate_block((pn - 9) >> 2, u.r0 >> 8, (pn - 9) & 3, wr * 4 + wc, ai, m, bj, fq * 16 + fr)) = pack8(v[0], v[1]);
                        continue;
                    }
                    *(v4u*)(rowp + bj * 128) = pack8(v[0], v[1]); } }
    }
};

struct EpiF {
    static constexpr int ID = 5; static constexpr bool PERM = true;
    const bf16* HB; const float* XS; bf16* X1B; float* SSQ;
    __device__ __forceinline__ void operator()(const f32x4 (&acc)[2][2][4][2], const pg8::Unit& u, int wr, int wc, int fr, int fq) const {
        const int row0 = u.r0 + wr * 64 + fr, col0 = u.c0 + wc * 32 + 8 * fq;
#pragma unroll
        for (int ai = 0; ai < 2; ++ai) {
            v4u H[4][2]; float xs[4];
#pragma unroll
            for (int m = 0; m < 4; ++m) { const size_t row = (size_t)(row0 + ai * 128 + m * 16); xs[m] = XS[row];
#pragma unroll
                for (int bj = 0; bj < 2; ++bj) H[m][bj] = *(const v4u*)(HB + row * D + col0 + bj * 128); }
            asm volatile("" ::: "memory");
#pragma unroll
            for (int m = 0; m < 4; ++m) { const size_t row = (size_t)(row0 + ai * 128 + m * 16); float ss = 0.f;
#pragma unroll
                for (int bj = 0; bj < 2; ++bj) { f32x4 x0, x1; unpack8(H[m][bj], x0, x1);
                    const f32x4 y0 = x0 * xs[m] + acc[ai][bj][m][0], y1 = x1 * xs[m] + acc[ai][bj][m][1];
                    *(v4u*)(X1B + row * D + col0 + bj * 128) = pack8(y0, y1);
                    ss += (y0[0] * y0[0] + y0[1] * y0[1]) + (y0[2] * y0[2] + y0[3] * y0[3]) + (y1[0] * y1[0] + y1[1] * y1[1]) + (y1[2] * y1[2] + y1[3] * y1[3]); }
                ss += __shfl_xor(ss, 16); ss += __shfl_xor(ss, 32);
                if (fq == 0) SSQ[row * 16 + (u.c0 >> 8) * 4 + wc] = ss; }
            asm volatile("" ::: "memory");
        }
    }
};
struct MoeSched {
    const LAS int* cum; const LAS int* cnt; const unsigned* LIST;
    const char* Abase; const char* Bbase; int NT, G, c, mode;
    __device__ __forceinline__ bool next(int i, pg8::Unit& u) const {
        const int nunits = __builtin_amdgcn_readfirstlane(cum[NE]) * NT; const long L = (long)i * G + c; if (L >= nunits) return false;
        const int wgid = pg8::remap_xcd((int)L, nunits), gb = wgid / NT, pn = wgid % NT;
        int e_ = 0;
#pragma unroll 8
        for (int j = 1; j < NE; ++j) e_ += (cum[j] <= gb) ? 1 : 0;
        const int e = __builtin_amdgcn_readfirstlane(e_);
        const int blk = gb - __builtin_amdgcn_readfirstlane(cum[e]), rem = __builtin_amdgcn_readfirstlane(cnt[e]) - blk * 256;
        u.e = e; u.nvalid = rem < 256 ? rem : 256; u.lb = e * LCAP + blk * 256; u.r0 = gb * 256; u.pad = 0;
        if (mode == 0) { u.A = Abase; u.B = Bbase + ((size_t)e * 512 + (size_t)pn * 256) * D * 2; u.c0 = pn * 128; }
        else { u.A = Abase + (size_t)gb * 256 * DE * 2; u.B = Bbase + ((size_t)e * D + (size_t)pn * 256) * DE * 2; u.c0 = pn * 256; }
        return true;
    }
    __device__ __forceinline__ void fill_tab(const pg8::Unit& u, LAS unsigned* tab) const {
        const int t = threadIdx.x;
        if (t < 256) { const int lp = t < u.nvalid ? t : u.nvalid - 1; const unsigned slot = LIST[u.lb + lp]; tab[t] = (slot >> 1) * (unsigned)(D * 2); }
    }
};
struct EpiG {
    static constexpr int ID = 6; static constexpr bool PERM = false;
    float* LG;
    __device__ __forceinline__ void operator()(const f32x4 (&acc)[2][2][4][2], const pg8::Unit& u, int wr, int wc, int fr, int fq) const {
        if (wc >= 2) return;
        const int row0 = u.r0 + wr * 64 + fr;
#pragma unroll
        for (int ai = 0; ai < 2; ++ai)
#pragma unroll
            for (int m = 0; m < 4; ++m)
#pragma unroll
                for (int n = 0; n < 2; ++n) *(f32x4*)(LG + (size_t)(row0 + ai * 128 + m * 16) * 64 + 32 * wc + 16 * n + 4 * fq) = acc[ai][0][m][n];
    }
};
struct EpiH {
    static constexpr int ID = 7; static constexpr bool PERM = true;
    bf16* ACT; const float* LISTR;
    __device__ __forceinline__ void operator()(const f32x4 (&acc)[2][2][4][2], const pg8::Unit& u, int wr, int wc, int fr, int fq) const {
        float rs[2][4];
#pragma unroll
        for (int ai = 0; ai < 2; ++ai)
#pragma unroll
            for (int m = 0; m < 4; ++m) { const int rl = ai * 128 + wr * 64 + m * 16 + fr, lp = rl < u.nvalid ? rl : u.nvalid - 1; rs[ai][m] = LISTR[u.lb + lp]; }
#pragma unroll
        for (int ai = 0; ai < 2; ++ai)
#pragma unroll
            for (int m = 0; m < 4; ++m) { asm volatile("" :: "v"(rs[ai][m])); }
#pragma unroll
        for (int ai = 0; ai < 2; ++ai)
#pragma unroll
            for (int m = 0; m < 4; ++m) { const int rl = ai * 128 + wr * 64 + m * 16 + fr; const float r = rs[ai][m]; f32x4 a[2];
#pragma unroll
                for (int n = 0; n < 2; ++n)
#pragma unroll
                    for (int j = 0; j < 4; ++j) { const float g = acc[ai][0][m][n][j] * r, up = acc[ai][1][m][n][j] * r; a[n][j] = g * fsigmoid(g) * up; }
                *(v4u*)(ACT + (size_t)(u.r0 + rl) * DE + u.c0 + wc * 32 + 8 * fq) = pack8(a[0], a[1]); }
    }
};
struct EpiI {
    static constexpr int ID = 8; static constexpr bool PERM = true;
    unsigned char* Y; const unsigned* LIST; const float* LISTW;
    __device__ __forceinline__ void operator()(const f32x4 (&acc)[2][2][4][2], const pg8::Unit& u, int wr, int wc, int fr, int fq) const {
        unsigned sl[8]; float gw[8];
#pragma unroll
        for (int b = 0; b < 8; ++b) { const int rl = (b >> 2) * 128 + wr * 64 + (b & 3) * 16 + fr, lp = rl < u.nvalid ? rl : u.nvalid - 1; sl[b] = LIST[u.lb + lp]; gw[b] = LISTW[u.lb + lp]; }
        asm volatile("" ::: "memory");
#pragma unroll
        for (int b = 0; b < 8; ++b) { asm volatile("" :: "v"(gw[b]), "v"(sl[b])); }
#pragma unroll
        for (int b = 0; b < 8; ++b) { const int ai = b >> 2, m = b & 3, rl = ai * 128 + wr * 64 + m * 16 + fr; const float g = gw[b] * YSCALE;
            if (rl < u.nvalid) {
#pragma unroll
                for (int bj = 0; bj < 2; ++bj) { v2u w; w.x = pk4_fp8(acc[ai][bj][m][0] * g); w.y = pk4_fp8(acc[ai][bj][m][1] * g); *(v2u*)(Y + (size_t)sl[b] * D + u.c0 + bj * 128 + wc * 32 + 8 * fq) = w; } } }
    }
};
__device__ __forceinline__ void route_rows(Frame& F, const int r0) {
    const float* LG = WSP(float, WS_LG); const float* SSQ = WSP(float, WS_SSQ); const float* brg = F.in[13]; const float* bre = F.in[15];
    unsigned* LIST = WSP(unsigned, WS_LIST); float* LISTW = WSP(float, WS_LISTW); float* LISTR = WSP(float, WS_LISTR);
    LAS unsigned* hcnt = (LAS unsigned*)(F.lds + SCHED_OFF); LAS unsigned* hbase = hcnt + 32;
    if (F.tid < 32) hcnt[F.tid] = 0u;
    __syncthreads();
    int e0 = 0, e1 = 0; unsigned p0 = 0, p1 = 0; float w0 = 0.f, w1 = 0.f, rstd = 0.f; const int row = r0 + F.tid;
    if (F.tid < 256) {
        float ss = 0.f;
#pragma unroll
        for (int j = 0; j < 16; ++j) ss += SSQ[(size_t)row * 16 + j];
        rstd = 1.0f / sqrtf(ss * (1.0f / D) + EPS);
        const float* lr = LG + (size_t)row * 64;
        float gl[4];
#pragma unroll
        for (int g = 0; g < 4; ++g) gl[g] = __hip_atomic_load(lr + g, RLX_AGENT) * rstd + brg[g];
        int gi = 0; float gm = gl[0];
#pragma unroll
        for (int g = 1; g < 4; ++g) if (gl[g] > gm) { gm = gl[g]; gi = g; }
        float den = 0.f;
#pragma unroll
        for (int g = 0; g < 4; ++g) den += expf(gl[g] - gm);
        const float gp = 1.0f / den;
        float el[8];
#pragma unroll
        for (int e = 0; e < 8; ++e) el[e] = __hip_atomic_load(lr + 4 + gi * 8 + e, RLX_AGENT) * rstd + bre[gi * 8 + e];
        int i0 = 0; float m0 = el[0];
#pragma unroll
        for (int e = 1; e < 8; ++e) if (el[e] > m0) { m0 = el[e]; i0 = e; }
        int i1 = -1; float m1 = 0.f;
#pragma unroll
        for (int e = 0; e < 8; ++e) if (e != i0 && (i1 < 0 || el[e] > m1)) { m1 = el[e]; i1 = e; }
        const float q = expf(m1 - m0); w0 = gp / (1.0f + q); w1 = gp * q / (1.0f + q);
        e0 = gi * 8 + i0; e1 = gi * 8 + i1;
        p0 = __hip_atomic_fetch_add(&hcnt[e0], 1u, __ATOMIC_RELAXED, __HIP_MEMORY_SCOPE_WORKGROUP); p1 = __hip_atomic_fetch_add(&hcnt[e1], 1u, __ATOMIC_RELAXED, __HIP_MEMORY_SCOPE_WORKGROUP);
    }
    __syncthreads();
    if (F.tid < 32) hbase[F.tid] = hcnt[F.tid] ? __hip_atomic_fetch_add((unsigned*)(F.ctl + CW_ECNT + 64 * F.tid), hcnt[F.tid], RLX_AGENT) : 0u;
    __syncthreads();
    if (F.tid < 256) { const size_t q0 = (size_t)e0 * LCAP + hbase[e0] + p0, q1 = (size_t)e1 * LCAP + hbase[e1] + p1;
        LIST[q0] = (unsigned)row * 2u; LIST[q1] = (unsigned)row * 2u + 1u; LISTW[q0] = w0; LISTW[q1] = w1; LISTR[q0] = rstd; LISTR[q1] = rstd; }
    __syncthreads();
}
__device__ __forceinline__ void moe_tables(Frame& F) {
    LAS int* cum = (LAS int*)(F.lds + SCHED_OFF + 256); LAS int* cnt = cum + 40;
    if (F.tid == 0) { int a = 0; for (int e = 0; e < NE; ++e) { const int c = (int)__hip_atomic_load((unsigned*)(F.ctl + CW_ECNT + 64 * e), RLX_AGENT); cnt[e] = c; cum[e] = a; a += (c + 255) >> 8; } cum[NE] = a; }
    __syncthreads();
}


struct PairSched {
    pg8::StaticSched S0; const char* A1; const char* B1;
    __device__ __forceinline__ bool next(int i, pg8::Unit& u) const {
        if (!S0.next(i >> 1, u)) return false;
        if (i & 1) { u.A = A1 + (u.A - S0.A); u.B = B1 + (u.B - S0.B); u.pad = 2; } else u.pad = 1;
        return true;
    }
    __device__ __forceinline__ void fill_tab(const pg8::Unit&, LAS unsigned*) const {}
};
struct EpiDE {
    static constexpr int ID = 3; static constexpr bool PERM = true;
    bf16* MG; const bf16* GATES;
    __device__ __forceinline__ void operator()(f32x4 (&acc)[2][2][4][2], const pg8::Unit& u, int wr, int wc, int fr, int fq) const {
        const int row0 = u.r0 + wr * 64 + fr, col0 = u.c0 + wc * 32 + 8 * fq; const bool first = (u.pad & 1) != 0;
        const bf16* gp = GATES + ((size_t)T + row0) * D + col0;
        const bf16* gg = first ? GATES + (size_t)row0 * D + col0 : gp;
#pragma unroll
        for (int ai = 0; ai < 2; ++ai) {
            v4u P[4][2], G[4][2];
#pragma unroll
            for (int m = 0; m < 4; ++m)
#pragma unroll
                for (int bj = 0; bj < 2; ++bj) { const size_t o = (size_t)(ai * 128 + m * 16) * D + bj * 128; P[m][bj] = *(const v4u*)(gp + o); G[m][bj] = *(const v4u*)(gg + o); }
            asm volatile("" ::: "memory");
#pragma unroll
            for (int m = 0; m < 4; ++m)
#pragma unroll
                for (int bj = 0; bj < 2; ++bj) { asm volatile("" :: "v"(P[m][bj]), "v"(G[m][bj]));
                    f32x4 p0, p1, g0, g1; unpack8(P[m][bj], p0, p1); unpack8(G[m][bj], g0, g1);
                    if (first) {
#pragma unroll
                        for (int j = 0; j < 4; ++j) { acc[ai][bj][m][0][j] *= g0[j] * __builtin_amdgcn_rcpf(fmaxf(p0[j], 1e-30f)); acc[ai][bj][m][1][j] *= g1[j] * __builtin_amdgcn_rcpf(fmaxf(p1[j], 1e-30f)); }
                    } else {
                        *(v4u*)(MG + (size_t)(row0 + ai * 128 + m * 16) * D + col0 + bj * 128) = pack8(acc[ai][bj][m][0] * p0, acc[ai][bj][m][1] * p1);
                    } }
            asm volatile("" ::: "memory");
        }
    }
};

__device__ __forceinline__ void transpose_item64(const float* W, const int ld, const float* g, int k0, int n0, bf16* dst, int drow0, int dld, LAS bf16* tl, int lane) {
    const int c4 = (lane & 15) * 4, kr = lane >> 4;
    f32x4 v[16];
#pragma unroll
    for (int i = 0; i < 16; ++i) v[i] = *(const f32x4*)(W + (size_t)(k0 + kr + 4 * i) * ld + n0 + c4);
#pragma unroll
    for (int i = 0; i < 16; ++i) { const int k = kr + 4 * i; const float sc = g ? g[k0 + k] : 1.0f;
#pragma unroll
        for (int j = 0; j < 4; ++j) tl[(c4 + j) * 66 + k] = (bf16)(pk2(v[i][j] * sc, 0.f) & 0xffffu); }
    LDS_WAIT(); asm volatile("" ::: "memory");
    const int pc = (lane & 7) * 8, nr = lane >> 3;
#pragma unroll
    for (int i = 0; i < 8; ++i) { const int n = nr + 8 * i; const LAS unsigned* sp = (const LAS unsigned*)(tl + n * 66 + pc);
        v4u o; o.x = sp[0]; o.y = sp[1]; o.z = sp[2]; o.w = sp[3];
        *(GAS v4u*)(dst + (size_t)(drow0 + n) * dld + k0 + pc) = o; }
    LDS_WAIT(); asm volatile("" ::: "memory");
}
template <class Src>
__device__ __forceinline__ void transpose_item(const Src& src, int k0, int n0, bf16* dst, int drow0, int dld, LAS float* scr, int lane) {
#pragma unroll 8
    for (int i = 0; i < 32; ++i) { const int kk = 2 * i + (lane >> 5); scr[kk * 33 + (lane & 31)] = src(k0 + kk, n0 + (lane & 31)); }
    LDS_WAIT(); asm volatile("" ::: "memory");
    const int c = lane & 7;
#pragma unroll
    for (int j = 0; j < 4; ++j) { const int n = (lane >> 3) + 8 * j; const LAS float* s = scr + (8 * c) * 33 + n;
        v4u o; o.x = pk2(s[0 * 33], s[1 * 33]); o.y = pk2(s[2 * 33], s[3 * 33]); o.z = pk2(s[4 * 33], s[5 * 33]); o.w = pk2(s[6 * 33], s[7 * 33]);
        *(GAS v4u*)(dst + (size_t)(drow0 + n) * dld + k0 + 8 * c) = o; }
    LDS_WAIT(); asm volatile("" ::: "memory");
}
struct SrcScaled { const float* W; int ld; const float* g;
    __device__ __forceinline__ float operator()(int k, int n) const { const float w = W[(size_t)k * ld + n]; return g ? w * g[k] : w; } };

__device__ __forceinline__ void p0_prologue(Frame& F) {
    const float* x = F.in[0]; const float* g1 = F.in[1]; const float* w_in = F.in[2]; const float* wau = F.in[3];
    const float* gng = F.in[5]; const float* wgb = F.in[6]; const float* pw = F.in[7]; const float* ps = F.in[8]; const float* wpb = F.in[9];
    const float* wout = F.in[10]; const float* g2 = F.in[11]; const float* wrg = F.in[12]; const float* wre = F.in[14];
    const float* weg = F.in[16]; const float* weu = F.in[17]; const float* wed = F.in[18];
    bf16* WIN = WSP(bf16, WS_WIN); bf16* WG = WSP(bf16, WS_WG); bf16* WP = WSP(bf16, WS_WP); bf16* WOUT = WSP(bf16, WS_WOUT); bf16* WR = WSP(bf16, WS_WR);
    bf16* WGU = WSP(bf16, WS_WGU); bf16* WD = WSP(bf16, WS_WD); bf16* HB = WSP(bf16, WS_HB); float* XS = WSP(float, WS_XS);
    {
        LAS float* PWL = (LAS float*)F.lds;
        LAS float* WL = (LAS float*)(F.lds + 65536);
        for (int it = F.bid; it < 64; it += F.G) {
            const int g = it >> 4, nb = it & 15;
            for (int i = F.tid; i < 128 * 128; i += 512) { const int d = i & 127; PWL[i] = pw[(size_t)g * 16384 + i] * ps[g * 128 + d]; }
            for (int i = F.tid; i < 128 * 64; i += 512) { const int d = i >> 6, n = i & 63; WL[i] = wpb[(size_t)(g * 128 + d) * D + nb * 64 + n]; }
            __syncthreads();
            const int n = F.tid & 63, cg = F.tid >> 6;
            float a[16];
#pragma unroll
            for (int ci = 0; ci < 16; ++ci) a[ci] = 0.f;
            for (int d = 0; d < 128; d += 4) {
                const float w0 = WL[(d + 0) * 64 + n], w1 = WL[(d + 1) * 64 + n], w2 = WL[(d + 2) * 64 + n], w3 = WL[(d + 3) * 64 + n];
#pragma unroll
                for (int ci = 0; ci < 16; ++ci) { const f32x4 p = *(const LAS f32x4*)(PWL + (cg * 16 + ci) * 128 + d); a[ci] += p[0] * w0 + p[1] * w1 + p[2] * w2 + p[3] * w3; }
            }
            v4u o0, o1; o0.x = pk2(a[0], a[1]); o0.y = pk2(a[2], a[3]); o0.z = pk2(a[4], a[5]); o0.w = pk2(a[6], a[7]); o1.x = pk2(a[8], a[9]); o1.y = pk2(a[10], a[11]); o1.z = pk2(a[12], a[13]); o1.w = pk2(a[14], a[15]);
            bf16* dp = WP + (size_t)(nb * 64 + n) * PW + g * 128 + cg * 16;
            *(GAS v4u*)dp = o0; *(GAS v4u*)(dp + 8) = o1;
            __syncthreads();
        }
    }
    LAS float* scr = (LAS float*)(F.lds + F.wave * 16384);
    const int gw = F.bid * 8 + F.wave, NGW = F.G * 8;
    constexpr int I_IN1 = 16 * (1536 / 32), I_IN2 = 16 * (2560 / 32), I_Z = 4 * 64, I_WG = 8 * 32, I_WO = 16 * 32, I_WR = 256;
    constexpr int NITEMS = I_IN1 + I_IN2 + I_Z + I_WG + I_WO + I_WR;
    for (int it = gw; it < NITEMS; it += NGW) {
        int r = it;
        if (r < I_IN1) { const int kb = r / 48, nb = r % 48; SrcScaled s{w_in, D_IN, g1}; transpose_item(s, 64 * kb, 32 * nb, WIN, 32 * nb, D, scr, F.lane); continue; } r -= I_IN1;
        if (r < I_IN2) { const int kb = r / 80, nb = r % 80; SrcScaled s{w_in, D_IN, g1}; transpose_item(s, 64 * kb, IN_U + 32 * nb, WIN, PJ_U + 32 * nb, D, scr, F.lane); continue; } r -= I_IN2;
        if (r < I_Z) {
            const int nb = r & 3, kb = r >> 2, n = nb * 64 + F.lane;
            float wa[16];
#pragma unroll
            for (int j = 0; j < 16; ++j) wa[j] = wau[j * GKW + n];
            float o[16];
#pragma unroll
            for (int kk = 0; kk < 16; ++kk) { const int k = kb * 16 + kk; const float* wr_ = w_in + (size_t)k * D_IN + IN_A; float a = 0.f;
#pragma unroll
                for (int j = 0; j < 16; ++j) a += wr_[j] * wa[j];
                o[kk] = a * g1[k]; }
            v4u o0, o1; o0.x = pk2(o[0], o[1]); o0.y = pk2(o[2], o[3]); o0.z = pk2(o[4], o[5]); o0.w = pk2(o[6], o[7]); o1.x = pk2(o[8], o[9]); o1.y = pk2(o[10], o[11]); o1.z = pk2(o[12], o[13]); o1.w = pk2(o[14], o[15]);
            bf16* dp = WIN + (size_t)(PJ_Z + n) * D + kb * 16; *(GAS v4u*)dp = o0; *(GAS v4u*)(dp + 8) = o1; continue; } r -= I_Z;
        if (r < I_WG) { const int kb = r / 32, nb = r % 32; SrcScaled s{wgb, D, gng}; transpose_item(s, 64 * kb, 32 * nb, WG, 32 * nb, GVW, scr, F.lane); continue; } r -= I_WG;
        if (r < I_WO) { const int kb = r / 32, nb = r % 32; SrcScaled s{wout, D, nullptr}; transpose_item(s, 64 * kb, 32 * nb, WOUT, 32 * nb, D, scr, F.lane); continue; } r -= I_WO;
        if (r < I_WR) {
            const int j = r; bf16* dp = WR + (size_t)j * D;
#pragma unroll
            for (int q = 0; q < 16; ++q) { const int k = q * 64 + F.lane; float v = 0.f;
                if (j < NG) v = wrg[(size_t)k * NG + j] * g2[k]; else if (j < NG + NE) { const int g = (j - NG) >> 3, e = (j - NG) & 7; v = wre[((size_t)g * D + k) * EPG + e] * g2[k]; }
                dp[k] = (bf16)f2bf(v); }
            continue; }
    }
    for (int m = gw; m < T / 2; m += NGW) {
        const GAS f32x4* xa = (const GAS f32x4*)(x + (size_t)m * D) + F.lane; const GAS f32x4* xb = (const GAS f32x4*)(x + (size_t)(m + T / 2) * D) + F.lane;
        f32x4 va[4], vb[4]; float sa = 0.f, sb = 0.f;
#pragma unroll
        for (int j = 0; j < 4; ++j) { va[j] = __builtin_nontemporal_load(xa + 64 * j); vb[j] = __builtin_nontemporal_load(xb + 64 * j); }
#pragma unroll
        for (int j = 0; j < 4; ++j) { sa += (va[j].x * va[j].x + va[j].y * va[j].y) + (va[j].z * va[j].z + va[j].w * va[j].w); sb += (vb[j].x * vb[j].x + vb[j].y * vb[j].y) + (vb[j].z * vb[j].z + vb[j].w * vb[j].w); }
        const float qa = sqrtf(wave_sum(sa) * (1.f / D) + EPS), qb = sqrtf(wave_sum(sb) * (1.f / D) + EPS); const float ra = 1.0f / qa, rb = 1.0f / qb;
        if (F.lane == 0) { XS[m] = qa; XS[m + T / 2] = qb; }
        GAS v2u* oa = (GAS v2u*)(HB + (size_t)m * D) + F.lane; GAS v2u* ob = (GAS v2u*)(HB + (size_t)(m + T / 2) * D) + F.lane;
#pragma unroll
        for (int j = 0; j < 4; ++j) { v2u w; w.x = pk2(va[j].x * ra, va[j].y * ra); w.y = pk2(va[j].z * ra, va[j].w * ra); oa[64 * j] = w; w.x = pk2(vb[j].x * rb, vb[j].y * rb); w.y = pk2(vb[j].z * rb, vb[j].w * rb); ob[64 * j] = w; }
    }
}

__device__ __forceinline__ void moe_weight_items(Frame& F, const int widx, const int nworkers) {
    const float* g2 = F.in[11]; const float* weg = F.in[16]; const float* weu = F.in[17]; const float* wed = F.in[18];
    bf16* WGU = WSP(bf16, WS_WGU); bf16* WD = WSP(bf16, WS_WD);
    LAS bf16* tl = (LAS bf16*)(F.lds + F.wave * 16384);
    const int gw = widx * 8 + F.wave, NGW = nworkers * 8;
    constexpr int I_GU = NE * 2 * 16 * 4, I_WD = NE * 4 * 16;
    for (int it = gw; it < I_GU + I_WD; it += NGW) {
        int r = it;
        if (r < I_GU) {
            const int e = r / 128, q = r % 128, bj = q / 64, kb = (q % 64) / 4, nb = q % 4;
            const int hid0 = 64 * nb, pn = hid0 >> 7, i0 = hid0 & 127;
            transpose_item64((bj ? weu : weg) + (size_t)e * D * DE, DE, g2, 64 * kb, hid0, WGU + (size_t)e * 512 * D, pn * 256 + bj * 128 + i0, D, tl, F.lane); continue; } r -= I_GU;
        { const int e = r / 64, q = r % 64, kb = q / 16, nb = q % 16;
            transpose_item64(wed + (size_t)e * DE * D, D, nullptr, 64 * kb, 64 * nb, WD + (size_t)e * D * DE, 64 * nb, DE, tl, F.lane); }
    }
}

#define WG_SYNC() do { asm volatile("s_waitcnt lgkmcnt(0)" ::: "memory"); __builtin_amdgcn_s_barrier(); asm volatile("" ::: "memory"); } while (0)
constexpr int GL_QD = 0, GL_KD = 9216, GL_KET = 18432, GL_P = 27648, GL_VT = 36864, GL_DEC = 55296, GL_SS = 55552, GL_OT = 57600;
constexpr int GLS = 72, OTS = 132;
__device__ __forceinline__ void gla_unit(Frame& F, const int b, const int h, const int seg) {
    const bf16* PJ = WSP(bf16, WS_PJ); const float* BC = WSP(float, WS_BC); bf16* ON = WSP(bf16, WS_ON);
    int tid_ = threadIdx.x; asm volatile("" : "+v"(tid_));
    const int tid = tid_, lane = tid & 63, w = __builtin_amdgcn_readfirstlane(tid >> 6), fr = lane & 15, fq = lane >> 4;
    LAS bf16* QD = (LAS bf16*)(F.lds + GL_QD); LAS bf16* KD = (LAS bf16*)(F.lds + GL_KD); LAS bf16* KET = (LAS bf16*)(F.lds + GL_KET);
    LAS bf16* P = (LAS bf16*)(F.lds + GL_P); LAS bf16* VT = (LAS bf16*)(F.lds + GL_VT);
    LAS float* DEC = (LAS float*)(F.lds + GL_DEC); LAS float* OT = (LAS float*)(F.lds + GL_OT);
    f32x4 Sacc[4];
#pragma unroll
    for (int i = 0; i < 4; ++i) Sacc[i] = (f32x4){0.f, 0.f, 0.f, 0.f};
    const size_t rowbase = (size_t)b * SEQ + (size_t)seg * SEGCH * GCH;
    float* CUMB = WSP(float, WS_CUMB) + ((size_t)(b * GH + h) * (SEQ / GCH) + seg * SEGCH) * GDK; float cumb[8];
#pragma unroll
    for (int j = 0; j < 8; ++j) cumb[j] = 0.f;
    const int vsl = lane & 31, vbk = 2 * w + (lane >> 5);
    const int ot = tid >> 3, ov = (tid & 7) * 16;
    v4u qq, kq, vq0, vq1, rq0, rq1; f32x4 bq0, bq1; v4u qq2, kq2, vq02, vq12, rq02, rq12; f32x4 bq02, bq12;
#define GLA_LOADS(tb_, Q, K_, V0, V1, R0, R1, B0, B1) do { const size_t tb__ = (tb_); \
        const bf16* rp = PJ + (tb__ + lane) * NPJ + h * 64 + w * 8; Q = *(const v4u*)(rp + PJ_Q); K_ = *(const v4u*)(rp + PJ_K); \
        const float* bp = BC + (tb__ + lane) * GKW + h * 64 + w * 8; B0 = *(const f32x4*)bp; B1 = *(const f32x4*)(bp + 4); \
        const bf16* vp = PJ + (tb__ + vsl) * NPJ + PJ_V + h * 128 + vbk * 8; V0 = *(const v4u*)vp; V1 = *(const v4u*)(vp + (size_t)32 * NPJ); \
        const bf16* rr = PJ + (tb__ + ot) * NPJ + PJ_R + h * 128 + ov; R0 = *(const v4u*)rr; R1 = *(const v4u*)(rr + 8); } while (0)
    GLA_LOADS(rowbase, qq, kq, vq0, vq1, rq0, rq1, bq0, bq1);
    GLA_LOADS(rowbase + GCH, qq2, kq2, vq02, vq12, rq02, rq12, bq02, bq12);
    for (int n = 0; n < SEGCH; ++n) {
        const size_t tb = rowbase + (size_t)n * GCH;
        const v4u q8 = qq, k8 = kq, v80 = vq0, v81 = vq1, r80 = rq0, r81 = rq1; const f32x4 b80 = bq0, b81 = bq1;
        qq = qq2; kq = kq2; vq0 = vq02; vq1 = vq12; rq0 = rq02; rq1 = rq12; bq0 = bq02; bq1 = bq12;
        { const size_t tn = (n + 2 < SEGCH) ? tb + 2 * GCH : tb; GLA_LOADS(tn, qq2, kq2, vq02, vq12, rq02, rq12, bq02, bq12); }
        { float bx[8] = {b80[0], b80[1], b80[2], b80[3], b81[0], b81[1], b81[2], b81[3]}, qf[8], kf[8];
          { f32x4 a, c; unpack8(q8, a, c); qf[0] = a[0]; qf[1] = a[1]; qf[2] = a[2]; qf[3] = a[3]; qf[4] = c[0]; qf[5] = c[1]; qf[6] = c[2]; qf[7] = c[3];
            unpack8(k8, a, c); kf[0] = a[0]; kf[1] = a[1]; kf[2] = a[2]; kf[3] = a[3]; kf[4] = c[0]; kf[5] = c[1]; kf[6] = c[2]; kf[7] = c[3]; }
          float qd[8], kd[8], ke[8], dc[8];
          if (lane == 0) { *(f32x4*)(CUMB + (size_t)n * GDK + w * 8) = (f32x4){cumb[0], cumb[1], cumb[2], cumb[3]}; *(f32x4*)(CUMB + (size_t)n * GDK + w * 8 + 4) = (f32x4){cumb[4], cumb[5], cumb[6], cumb[7]}; }
#pragma unroll
          for (int j = 0; j < 8; ++j) { const float blast = __builtin_bit_cast(float, __builtin_amdgcn_readlane(__builtin_bit_cast(int, bx[j]), 63));
              cumb[j] += blast;
              const float eb = __expf(bx[j]), enb = __builtin_amdgcn_rcpf(eb); dc[j] = __expf(blast);
              qd[j] = qf[j] * eb * 0.125f; kd[j] = kf[j] * enb; ke[j] = kd[j] * dc[j]; }
          v4u o; o.x = pk2(qd[0], qd[1]); o.y = pk2(qd[2], qd[3]); o.z = pk2(qd[4], qd[5]); o.w = pk2(qd[6], qd[7]); *(LAS v4u*)(QD + lane * GLS + w * 8) = o;
          o.x = pk2(kd[0], kd[1]); o.y = pk2(kd[2], kd[3]); o.z = pk2(kd[4], kd[5]); o.w = pk2(kd[6], kd[7]); *(LAS v4u*)(KD + lane * GLS + w * 8) = o;
#pragma unroll
          for (int j = 0; j < 8; ++j) KET[(w * 8 + j) * GLS + lane] = (bf16)(pk2(ke[j], ke[j]) & 0xffffu);
          if (lane == 0) { *(LAS f32x4*)(DEC + w * 8) = (f32x4){dc[0], dc[1], dc[2], dc[3]}; *(LAS f32x4*)(DEC + w * 8 + 4) = (f32x4){dc[4], dc[5], dc[6], dc[7]}; }
          const unsigned vw0[4] = {v80.x, v80.y, v80.z, v80.w}, vw1[4] = {v81.x, v81.y, v81.z, v81.w};
#pragma unroll
          for (int j = 0; j < 4; ++j) { VT[(vbk * 8 + 2 * j) * GLS + vsl] = (bf16)(vw0[j] & 0xffffu); VT[(vbk * 8 + 2 * j + 1) * GLS + vsl] = (bf16)(vw0[j] >> 16);
              VT[(vbk * 8 + 2 * j) * GLS + vsl + 32] = (bf16)(vw1[j] & 0xffffu); VT[(vbk * 8 + 2 * j + 1) * GLS + vsl + 32] = (bf16)(vw1[j] >> 16); } }
        WG_SYNC();
        { const int tt = w >> 1, st0 = (w & 1) * 2;
          bf16x8 af[2];
#pragma unroll
          for (int ks = 0; ks < 2; ++ks) af[ks] = *(const LAS bf16x8*)(QD + (16 * tt + fr) * GLS + 32 * ks + 8 * fq);
#pragma unroll
          for (int q2 = 0; q2 < 2; ++q2) { const int st = st0 + q2; f32x4 c = (f32x4){0.f, 0.f, 0.f, 0.f};
              if (st <= tt) {
#pragma unroll
                  for (int ks = 0; ks < 2; ++ks) { const bf16x8 bfm = *(const LAS bf16x8*)(KD + (16 * st + fr) * GLS + 32 * ks + 8 * fq); c = __builtin_amdgcn_mfma_f32_16x16x32_bf16(af[ks], bfm, c, 0, 0, 0); } }
#pragma unroll
              for (int i = 0; i < 4; ++i) { const int t = 16 * tt + 4 * fq + i, sidx = 16 * st + fr; const float val = (sidx <= t) ? c[i] : 0.f; P[t * GLS + sidx] = (bf16)(pk2(val, val) & 0xffffu); } } }
        WG_SYNC();
        { bf16x8 vtf[2], sb[2];
#pragma unroll
          for (int ks = 0; ks < 2; ++ks) { vtf[ks] = *(const LAS bf16x8*)(VT + (16 * w + fr) * GLS + 32 * ks + 8 * fq);
              v4u pw_; pw_.x = pk2(Sacc[2 * ks][0], Sacc[2 * ks][1]); pw_.y = pk2(Sacc[2 * ks][2], Sacc[2 * ks][3]); pw_.z = pk2(Sacc[2 * ks + 1][0], Sacc[2 * ks + 1][1]); pw_.w = pk2(Sacc[2 * ks + 1][2], Sacc[2 * ks + 1][3]);
              sb[ks] = __builtin_bit_cast(bf16x8, pw_); }
          f32x4 o[4];
#pragma unroll
          for (int mt = 0; mt < 4; ++mt) { o[mt] = (f32x4){0.f, 0.f, 0.f, 0.f};
#pragma unroll
              for (int ks = 0; ks < 2; ++ks) { const bf16x8 a = *(const LAS bf16x8*)(P + (16 * mt + fr) * GLS + 32 * ks + 8 * fq); o[mt] = __builtin_amdgcn_mfma_f32_16x16x32_bf16(a, vtf[ks], o[mt], 0, 0, 0); }
#pragma unroll
              for (int ks = 0; ks < 2; ++ks) { const v2u lo = *(const LAS v2u*)(QD + (16 * mt + fr) * GLS + 32 * ks + 4 * fq), hi = *(const LAS v2u*)(QD + (16 * mt + fr) * GLS + 32 * ks + 16 + 4 * fq);
                  v4u aw; aw.x = lo.x; aw.y = lo.y; aw.z = hi.x; aw.w = hi.y; o[mt] = __builtin_amdgcn_mfma_f32_16x16x32_bf16(__builtin_bit_cast(bf16x8, aw), sb[ks], o[mt], 0, 0, 0); } }
#pragma unroll
          for (int mt = 0; mt < 4; ++mt) { const f32x4 d4 = *(const LAS f32x4*)(DEC + 16 * mt + 4 * fq); Sacc[mt] = Sacc[mt] * d4;
#pragma unroll
              for (int ks = 0; ks < 2; ++ks) { const bf16x8 a = *(const LAS bf16x8*)(KET + (16 * mt + fr) * GLS + 32 * ks + 8 * fq); Sacc[mt] = __builtin_amdgcn_mfma_f32_16x16x32_bf16(a, vtf[ks], Sacc[mt], 0, 0, 0); } }
#pragma unroll
          for (int mt = 0; mt < 4; ++mt)
#pragma unroll
              for (int i = 0; i < 4; ++i) OT[(16 * mt + 4 * fq + i) * OTS + 16 * w + fr] = o[mt][i]; }
        WG_SYNC();
        { f32x4 ov4[4]; float tot2 = 0.f;
#pragma unroll
          for (int q = 0; q < 4; ++q) { ov4[q] = *(const LAS f32x4*)(OT + ot * OTS + ov + 4 * q); tot2 += (ov4[q][0] * ov4[q][0] + ov4[q][1] * ov4[q][1]) + (ov4[q][2] * ov4[q][2] + ov4[q][3] * ov4[q][3]); }
          tot2 += dpp_f<0xB1>(tot2); tot2 += dpp_f<0x4E>(tot2); tot2 += dpp_f<0x141>(tot2);
          const float rstd = (seg == 0) ? __builtin_amdgcn_rsqf(tot2 * (1.0f / GDV) + EPS) : 1.0f;
          f32x4 r0, r1, r2, r3; unpack8(r80, r0, r1); unpack8(r81, r2, r3);
          if (seg != 0) { r0 = (f32x4){1.f, 1.f, 1.f, 1.f}; r1 = r0; r2 = r0; r3 = r0; }
          bf16* op = ON + (tb + ot) * GVW + h * 128 + ov;
          *(v4u*)op = pack8(ov4[0] * rstd * r0, ov4[1] * rstd * r1); *(v4u*)(op + 8) = pack8(ov4[2] * rstd * r2, ov4[3] * rstd * r3); }
    }
#undef GLA_LOADS
    if (seg + 1 < NSEG) {
        float* SL = WSP(float, WS_SLOC) + ((size_t)(b * GH + h) * NSEG + seg) * GDK * GDV;
#pragma unroll
        for (int mt = 0; mt < 4; ++mt)
#pragma unroll
            for (int i = 0; i < 4; ++i) SL[(16 * mt + 4 * fq + i) * GDV + 16 * w + fr] = Sacc[mt][i];
        if (lane == 0) { float* DT = WSP(float, WS_DTOT) + ((size_t)(b * GH + h) * NSEG + seg) * GDK + w * 8;
#pragma unroll
            for (int j = 0; j < 8; ++j) DT[j] = __expf(cumb[j]); }
    }
    WG_SYNC();
}
constexpr int FX_QD = 0, FX_SB = 9216, FX_OT = 27648;
__device__ __forceinline__ void gla_fix_unit(Frame& F, const int b, const int h, const int seg) {
    const bf16* PJ = WSP(bf16, WS_PJ); const float* BC = WSP(float, WS_BC); bf16* ON = WSP(bf16, WS_ON);
    int tid_ = threadIdx.x; asm volatile("" : "+v"(tid_));
    const int tid = tid_, lane = tid & 63, w = __builtin_amdgcn_readfirstlane(tid >> 6), fr = lane & 15, fq = lane >> 4;
    LAS bf16* QD2 = (LAS bf16*)(F.lds + FX_QD); LAS bf16* SB = (LAS bf16*)(F.lds + FX_SB); LAS float* OT = (LAS float*)(F.lds + FX_OT);
    { const float* SL = WSP(float, WS_SLOC) + (size_t)(b * GH + h) * NSEG * GDK * GDV; const float* DT = WSP(float, WS_DTOT) + (size_t)(b * GH + h) * NSEG * GDK;
#pragma unroll
      for (int j = 0; j < 8; ++j) { const int d = 8 * w + j; float s0 = 0.f, s1 = 0.f;
          for (int i = 0; i < seg; ++i) { const float dt = DT[i * GDK + d]; s0 = dt * s0 + SL[((size_t)i * GDK + d) * GDV + lane]; s1 = dt * s1 + SL[((size_t)i * GDK + d) * GDV + lane + 64]; }
          SB[lane * GLS + d] = (bf16)(pk2(s0, s0) & 0xffffu); SB[(lane + 64) * GLS + d] = (bf16)(pk2(s1, s1) & 0xffffu); } }
    const size_t rowbase = (size_t)b * SEQ + (size_t)seg * SEGCH * GCH;
    const float* CUMB = WSP(float, WS_CUMB) + ((size_t)(b * GH + h) * (SEQ / GCH) + seg * SEGCH) * GDK;
    const int ot = tid >> 3, ov = (tid & 7) * 16, dq = (tid & 7) * 8;
    v4u qq, oq0, oq1, rq0, rq1; f32x4 bq0, bq1, cq0, cq1;
#define FIX_LOADS(n_) do { const size_t tb__ = rowbase + (size_t)(n_) * GCH;         qq = *(const v4u*)(PJ + (tb__ + ot) * NPJ + PJ_Q + h * 64 + dq); const float* bp = BC + (tb__ + ot) * GKW + h * 64 + dq; bq0 = *(const f32x4*)bp; bq1 = *(const f32x4*)(bp + 4);         const float* cp = CUMB + (size_t)(n_) * GDK + dq; cq0 = *(const f32x4*)cp; cq1 = *(const f32x4*)(cp + 4);         const bf16* op_ = ON + (tb__ + ot) * GVW + h * 128 + ov; oq0 = *(const v4u*)op_; oq1 = *(const v4u*)(op_ + 8);         const bf16* rr = PJ + (tb__ + ot) * NPJ + PJ_R + h * 128 + ov; rq0 = *(const v4u*)rr; rq1 = *(const v4u*)(rr + 8); } while (0)
    FIX_LOADS(0);
    for (int n = 0; n < SEGCH; ++n) {
        const size_t tb = rowbase + (size_t)n * GCH;
        const v4u q8 = qq, o80 = oq0, o81 = oq1, r80 = rq0, r81 = rq1; const f32x4 b80 = bq0, b81 = bq1, c80 = cq0, c81 = cq1;
        if (n + 1 < SEGCH) FIX_LOADS(n + 1);
        { f32x4 qa, qb; unpack8(q8, qa, qb); f32x4 e0, e1;
#pragma unroll
          for (int j = 0; j < 4; ++j) { e0[j] = qa[j] * 0.125f * __expf(b80[j] + c80[j]); e1[j] = qb[j] * 0.125f * __expf(b81[j] + c81[j]); }
          *(LAS v4u*)(QD2 + ot * GLS + dq) = pack8(e0, e1); }
        WG_SYNC();
        { bf16x8 bfm[2];
#pragma unroll
          for (int ks = 0; ks < 2; ++ks) bfm[ks] = *(const LAS bf16x8*)(SB + (16 * w + fr) * GLS + 32 * ks + 8 * fq);
#pragma unroll
          for (int mt = 0; mt < 4; ++mt) { f32x4 c = (f32x4){0.f, 0.f, 0.f, 0.f};
#pragma unroll
              for (int ks = 0; ks < 2; ++ks) { const bf16x8 a = *(const LAS bf16x8*)(QD2 + (16 * mt + fr) * GLS + 32 * ks + 8 * fq); c = __builtin_amdgcn_mfma_f32_16x16x32_bf16(a, bfm[ks], c, 0, 0, 0); }
#pragma unroll
              for (int i = 0; i < 4; ++i) OT[(16 * mt + 4 * fq + i) * OTS + 16 * w + fr] = c[i]; } }
        WG_SYNC();
        { f32x4 t4[4], l0, l1, l2, l3; unpack8(o80, l0, l1); unpack8(o81, l2, l3);
          t4[0] = *(const LAS f32x4*)(OT + ot * OTS + ov) + l0; t4[1] = *(const LAS f32x4*)(OT + ot * OTS + ov + 4) + l1; t4[2] = *(const LAS f32x4*)(OT + ot * OTS + ov + 8) + l2; t4[3] = *(const LAS f32x4*)(OT + ot * OTS + ov + 12) + l3;
          float sq = 0.f;
#pragma unroll
          for (int q = 0; q < 4; ++q) sq += (t4[q][0] * t4[q][0] + t4[q][1] * t4[q][1]) + (t4[q][2] * t4[q][2] + t4[q][3] * t4[q][3]);
          sq += dpp_f<0xB1>(sq); sq += dpp_f<0x4E>(sq); sq += dpp_f<0x141>(sq);
          const float rstd = __builtin_amdgcn_rsqf(sq * (1.0f / GDV) + EPS);
          f32x4 r0, r1, r2, r3; unpack8(r80, r0, r1); unpack8(r81, r2, r3);
          bf16* op = ON + (tb + ot) * GVW + h * 128 + ov;
          *(v4u*)op = pack8(t4[0] * rstd * r0, t4[1] * rstd * r1); *(v4u*)(op + 8) = pack8(t4[2] * rstd * r2, t4[3] * rstd * r3); }
    }
#undef FIX_LOADS
    WG_SYNC();
}
__device__ __forceinline__ void pool_items(Frame& F, const int widx, const int nworkers) {
    const bf16* PJ = WSP(bf16, WS_PJ); bf16* PD = WSP(bf16, WS_PD);
    const int gw = widx * 8 + F.wave, NGW = nworkers * 8, cb = F.lane, wlen = 2 << (cb >> 4);
    constexpr int RUN = 32;
    for (int u = gw; u < T / RUN; u += NGW) {
        const int t0 = u * RUN, pos0 = t0 & (SEQ - 1);
        const bf16* base = PJ + (size_t)t0 * NPJ + PJ_U + cb * 8;
        f32x4 a0 = (f32x4){0.f, 0.f, 0.f, 0.f}, a1 = a0;
#pragma unroll
        for (int i = 1; i <= 16; ++i) { const bool in = (i <= wlen) && (i <= pos0); const v4u vw = *(const v4u*)(base - (size_t)(in ? i : 0) * NPJ); f32x4 u0, u1; unpack8(vw, u0, u1); const float m = in ? 1.f : 0.f; a0 += u0 * m; a1 += u1 * m; }
#pragma unroll 4
        for (int i = 0; i < RUN; ++i) {
            const int pos = pos0 + i; const bool drop = pos >= wlen;
            const v4u nw = *(const v4u*)(base + (size_t)i * NPJ), ow = *(const v4u*)(base + (size_t)(drop ? i - wlen : i) * NPJ);
            f32x4 n0, n1, o0, o1; unpack8(nw, n0, n1); unpack8(ow, o0, o1); const float m = drop ? 1.f : 0.f;
            a0 += n0 - o0 * m; a1 += n1 - o1 * m;
            const float inv = __builtin_amdgcn_rcpf((float)(pos + 1 < wlen ? pos + 1 : wlen));
            *(v4u*)(PD + (size_t)(t0 + i) * PW + cb * 8) = pack8(a0 * inv - n0, a1 * inv - n1);
        }
    }
}
__device__ __forceinline__ void p2a_phase(Frame& F) {
    constexpr int NU = BATCH * GH * NSEG;
    for (int u = F.bid; u < NU; u += F.G) gla_unit(F, u >> 4, (u >> 2) & 3, u & 3);
}
__device__ __forceinline__ void p2b_phase(Frame& F) {
    constexpr int NU = BATCH * GH * (NSEG - 1);
#pragma unroll 1
    for (int r_ = 0; r_ < REPS(10); ++r_)
    for (int u = F.bid; u < NU; u += F.G) gla_fix_unit(F, u / (GH * (NSEG - 1)), (u / (NSEG - 1)) % GH, 1 + u % (NSEG - 1));
#pragma unroll 1
    for (int r_ = 0; r_ < REPS(11); ++r_) pool_items(F, F.bid, F.G);
#pragma unroll 1
    for (int r_ = 0; r_ < REPS(12); ++r_) moe_weight_items(F, F.bid, F.G);
}

#if DBG
__device__ __forceinline__ void dbg_fail(Frame& F, unsigned code) { unsigned expect = 0u; __hip_atomic_compare_exchange_strong((unsigned*)(F.ctl + CW_DBG), &expect, code, __ATOMIC_RELAXED, __ATOMIC_RELAXED, __HIP_MEMORY_SCOPE_AGENT); }
__device__ __forceinline__ bool dbg_close(float got, float want) { return fabsf(got - want) <= 0.03f + 0.03f * fabsf(want); }
__device__ __forceinline__ void dbg_check_p1(Frame& F) {
    if (F.bid != 0 || F.tid >= 256) return;
    const float* x = F.in[0]; const float* g1 = F.in[1]; const float* w_in = F.in[2]; const float* wau = F.in[3]; const float* ba = F.in[4];
    const bf16* PJ = WSP(bf16, WS_PJ);
    const int tok = (int)(((unsigned)F.tid * 2654435761u) % (unsigned)T);
    const int col = (int)(((unsigned)F.tid * 40503u + 17u * (unsigned)F.tid * (unsigned)F.tid) % (unsigned)NPROJ);
    const float* xr = x + (size_t)tok * D; float ss = 0.f;
    for (int k = 0; k < D; ++k) ss += xr[k] * xr[k];
    const float rstd = 1.0f / sqrtf(ss / D + EPS);
    float want;
    if (col >= PJ_Z && col < PJ_U) {
        return;
        float al[16];
#pragma unroll
        for (int j = 0; j < 16; ++j) al[j] = 0.f;
        for (int k = 0; k < D; ++k) { const float hk = xr[k] * rstd * g1[k];
#pragma unroll
            for (int j = 0; j < 16; ++j) al[j] += hk * w_in[(size_t)k * D_IN + IN_A + j]; }
        float z = 0.f;
#pragma unroll
        for (int j = 0; j < 16; ++j) z += al[j] * wau[j * GKW + (col - PJ_Z)];
        z += ba[col - PJ_Z];
        want = (fminf(z, 0.f) - logf(1.0f + expf(-fabsf(z)))) / 16.0f;
    } else {
        const int wc_ = col < PJ_Z ? col : col - PJ_U + IN_U; float a = 0.f;
        for (int k = 0; k < D; ++k) a += xr[k] * rstd * g1[k] * w_in[(size_t)k * D_IN + wc_];
        if (col >= PJ_R && col < PJ_Z) want = a / (1.0f + expf(-a)); else if (col >= PJ_GG) want = 1.0f / (1.0f + expf(-a)); else want = a;
    }
    const float got = (col >= PJ_GG) ? bf1(WSP(bf16, WS_GATES)[gate_elem(col >= PJ_GP ? 1 : 0, tok, (col - PJ_GG) & 1023)]) : bf1(PJ[(size_t)tok * NPJ + col]);
    if (!dbg_close(got, want)) dbg_fail(F, 1u);
}


__device__ __forceinline__ void dbg_check_bc(Frame& F) {
    if (F.bid != 5 || F.tid >= 64) return;
    const float* x = F.in[0]; const float* g1 = F.in[1]; const float* w_in = F.in[2]; const float* wau = F.in[3]; const float* ba = F.in[4]; const float* BC = WSP(float, WS_BC);
    const int offs[5] = {0, 1, 5, 18, 63}; const int off = (F.tid % 5 == 0) ? 0 : (F.tid % 5 == 1) ? 1 : (F.tid % 5 == 2) ? 5 : (F.tid % 5 == 3) ? 18 : 63; (void)offs;
    const int chunk = (int)(((unsigned)F.tid * 2654435761u) % (unsigned)(T / 64)), col = (int)(((unsigned)F.tid * 40503u + 3u) % (unsigned)GKW);
    float cum = 0.f;
    for (int r = 0; r <= off; ++r) { const float* xr = x + ((size_t)chunk * 64 + r) * D; float ss = 0.f; for (int k = 0; k < D; ++k) ss += xr[k] * xr[k];
        const float rstd = 1.0f / sqrtf(ss / D + EPS); float al[16];
#pragma unroll
        for (int j = 0; j < 16; ++j) al[j] = 0.f;
        for (int k = 0; k < D; ++k) { const float hk = xr[k] * rstd * g1[k];
#pragma unroll
            for (int j = 0; j < 16; ++j) al[j] += hk * w_in[(size_t)k * D_IN + IN_A + j]; }
        float z = ba[col];
#pragma unroll
        for (int j = 0; j < 16; ++j) z += al[j] * wau[j * GKW + col];
        cum += (fminf(z, 0.f) - logf(1.0f + expf(-fabsf(z)))) / 16.0f; }
    const float got = BC[((size_t)chunk * 64 + off) * GKW + col];
    if (fabsf(got - cum) > 0.004f + 0.01f * fabsf(cum)) dbg_fail(F, 7u);
}
__device__ __forceinline__ void dbg_check_gla(Frame& F) {
    if (F.bid != 1) return;
    const bf16* PJ = WSP(bf16, WS_PJ); const bf16* ON = WSP(bf16, WS_ON);
    const int b = 2, h = 1, v = F.tid & 127; const bool act = F.tid < 128;
    LAS float* S = (LAS float*)F.lds;
    LAS float* red = (LAS float*)(F.lds + 32768);
    if (act) for (int d = 0; d < 64; ++d) S[d * 128 + v] = 0.f;
    __syncthreads();
    bool bad = false;
    for (int t = 0; t < 1100; ++t) {
        const bf16* rp = PJ + ((size_t)b * SEQ + t) * NPJ; float o = 0.f;
        if (act) { const float vv = bf1(rp[PJ_V + h * 128 + v]);
            for (int d = 0; d < 64; ++d) { const float* bcp = WSP(float, WS_BC) + ((size_t)b * SEQ + t) * GKW + h * 64 + d; const float la = (t & 63) ? bcp[0] - bcp[-GKW] : bcp[0]; const float kk = bf1(rp[PJ_K + h * 64 + d]), qq = bf1(rp[PJ_Q + h * 64 + d]);
                const float sn = expf(la) * S[d * 128 + v] + kk * vv; S[d * 128 + v] = sn; o += qq * 0.125f * sn; }
            red[v] = o * o; }
        __syncthreads();
        if (act) { float ss = 0.f; for (int i = 0; i < 128; ++i) ss += red[i];
            const float want = o * (1.0f / sqrtf(ss / 128.f + EPS)) * bf1(rp[PJ_R + h * 128 + v]);
            const float got = bf1(ON[((size_t)b * SEQ + t) * GVW + h * 128 + v]);
            if ((t < 150 || t >= 1000) && !dbg_close(got, want)) bad = true; }
        __syncthreads();
    }
    if (bad) dbg_fail(F, 2u);
}
__device__ __forceinline__ void dbg_check_pool(Frame& F) {
    if (F.bid != 2) return;
    const bf16* PJ = WSP(bf16, WS_PJ); const bf16* PD = WSP(bf16, WS_PD);
    int tok = (int)(((unsigned)F.tid * 2654435761u) % (unsigned)T); if (F.tid < 40) tok = (F.tid & 1) * SEQ * 3 + (F.tid >> 1);
    const int c = (int)(((unsigned)F.tid * 40503u) % (unsigned)PW), pos = tok & (SEQ - 1), wlen = 2 << (c >> 7), cnt = pos + 1 < wlen ? pos + 1 : wlen;
    float a = 0.f; for (int i = 0; i < cnt; ++i) a += bf1(PJ[(size_t)(tok - i) * NPJ + PJ_U + c]);
    const float want = a / cnt - bf1(PJ[(size_t)tok * NPJ + PJ_U + c]);
    if (!dbg_close(bf1(PD[(size_t)tok * PW + c]), want)) dbg_fail(F, 3u);
}
__device__ __forceinline__ void dbg_check_mg(Frame& F) {
    if (F.bid != 3 || F.tid >= 64) return;
    const bf16* PJ = WSP(bf16, WS_PJ); const bf16* ON = WSP(bf16, WS_ON); const bf16* PD = WSP(bf16, WS_PD); const bf16* MG = WSP(bf16, WS_MG);
    const float* gng = F.in[5]; const float* wgb = F.in[6]; const float* pw = F.in[7]; const float* ps = F.in[8]; const float* wpb = F.in[9];
    const int tok = (int)(((unsigned)F.tid * 2654435761u + 12345u) % (unsigned)T), col = (int)(((unsigned)F.tid * 40503u + 77u) % (unsigned)D);
    float yg = 0.f; for (int k = 0; k < GVW; ++k) yg += bf1(ON[(size_t)tok * GVW + k]) * gng[k] * wgb[(size_t)k * D + col];
    float yp = 0.f;
    for (int g = 0; g < 4; ++g) for (int d = 0; d < 128; ++d) { float m = 0.f; for (int c = 0; c < 128; ++c) m += bf1(PD[(size_t)tok * PW + g * 128 + c]) * pw[((size_t)g * 128 + c) * 128 + d];
        yp += m * ps[g * 128 + d] * wpb[(size_t)(g * 128 + d) * D + col]; }
    const float want = bf1(WSP(bf16, WS_GATES)[gate_elem(0, tok, col)]) * yg + bf1(WSP(bf16, WS_GATES)[gate_elem(1, tok, col)]) * yp;
    if (!dbg_close(bf1(MG[(size_t)tok * D + col]), want)) dbg_fail(F, 4u);
}
__device__ __forceinline__ void dbg_check_x1(Frame& F) {
    if (F.bid != 4 || F.tid >= 128) return;
    const bf16* MG = WSP(bf16, WS_MG); const bf16* X1B = WSP(bf16, WS_X1B); const float* SSQ = WSP(float, WS_SSQ); const float* x = F.in[0]; const float* wout = F.in[10];
    const int tok = (int)(((unsigned)F.tid * 2654435761u + 999u) % (unsigned)T), col = (int)(((unsigned)F.tid * 40503u + 5u) % (unsigned)D);
    float a = x[(size_t)tok * D + col]; for (int k = 0; k < D; ++k) a += bf1(MG[(size_t)tok * D + k]) * wout[(size_t)k * D + col];
    if (!dbg_close(bf1(X1B[(size_t)tok * D + col]), a)) dbg_fail(F, 5u);
    float ss = 0.f; for (int k = 0; k < D; ++k) { const float v = bf1(X1B[(size_t)tok * D + k]); ss += v * v; }
    float sp = 0.f; for (int j = 0; j < 16; ++j) sp += SSQ[(size_t)tok * 16 + j];
    if (fabsf(ss - sp) > 1e-2f * ss) dbg_fail(F, 6u);
}
#endif

struct Args { const float* in[20]; float* out; unsigned char* ws; };
__global__ void __launch_bounds__(512, 2) fwd_kernel(Args args) {
    extern __shared__ __attribute__((aligned(16))) unsigned char lds[];
    Frame F;
    F.lds = (LAS unsigned char*)lds;
    F.MISC = (volatile LAS unsigned*)(F.lds + MISC_OFF);
    F.tid = threadIdx.x; F.lane = F.tid & 63; F.wave = __builtin_amdgcn_readfirstlane(F.tid >> 6);
    F.G = gridDim.x; F.bid = blockIdx.x;
    F.ws = args.ws; F.out = args.out; F.ctl = (gu32*)(args.ws + WS_CTL);
#pragma unroll
    for (int i = 0; i < 20; ++i) F.in[i] = args.in[i];
    for (int u = F.tid; u < (LDS_BYTES - RING_BYTES) / 4; u += 512) ((LAS unsigned*)(F.lds + RING_BYTES))[u] = 0u;
    __syncthreads();
    XcdBarrier bar = xcd_barrier_post((unsigned*)(F.ctl + CW_BAR), F.MISC + 8);
#define GRID_BAR() xcd_barrier(bar)

#pragma unroll 1
    for (int rep_ = 0; rep_ < REPS(0); ++rep_) p0_prologue(F);
    GRID_BAR();
    if (NPH > 1) {
        pg8::StaticSched S; S.init(WSP(bf16, WS_HB), D, WSP(bf16, WS_WIN), D, T, NPROJ, F.G, F.bid);
        EpiP1 E{WSP(bf16, WS_PJ), F.in[4], WSP(float, WS_BC), WSP(bf16, WS_GATES)};
#pragma unroll 1
        for (int rep_ = 0; rep_ < REPS(1); ++rep_) pg8::gemm_phase<EpiP1, pg8::StaticSched, false, true>(F.lds, D, D, D, S, E);
        GRID_BAR();
#if DBG
        dbg_check_p1(F); dbg_check_bc(F);
        GRID_BAR();
#endif
    }
    if (NPH > 2) {
#pragma unroll 1
        for (int rep_ = 0; rep_ < REPS(2); ++rep_) p2a_phase(F);
        GRID_BAR();
        p2b_phase(F);
        GRID_BAR();
#if DBG
        dbg_check_gla(F); dbg_check_pool(F);
        GRID_BAR();
#endif
    }
    if (NPH > 4) {
        PairSched S; S.S0.init(WSP(bf16, WS_ON), GVW, WSP(bf16, WS_WG), GVW, T, D, F.G, F.bid); S.A1 = (const char*)WSP(bf16, WS_PD); S.B1 = (const char*)WSP(bf16, WS_WP);
        EpiDE E{WSP(bf16, WS_MG), WSP(bf16, WS_GATES)};
#pragma unroll 1
        for (int rep_ = 0; rep_ < REPS(3); ++rep_) pg8::gemm_phase<EpiDE, PairSched, false, true>(F.lds, GVW, GVW, GVW, S, E);
        GRID_BAR();
#if DBG
        dbg_check_mg(F);
        GRID_BAR();
#endif
    }
    if (NPH > 5) {
        pg8::StaticSched S; S.init(WSP(bf16, WS_MG), D, WSP(bf16, WS_WOUT), D, T, D, F.G, F.bid);
        EpiF E{WSP(bf16, WS_HB), WSP(float, WS_XS), WSP(bf16, WS_X1B), WSP(float, WS_SSQ)};
#pragma unroll 1
        for (int rep_ = 0; rep_ < REPS(5); ++rep_) pg8::gemm_phase<EpiF, pg8::StaticSched, false, true>(F.lds, D, D, D, S, E);
        GRID_BAR();
#if DBG
        dbg_check_x1(F);
        GRID_BAR();
#endif
    }
    if (NPH > 6) {
        pg8::StaticSched S; S.init(WSP(bf16, WS_X1B), D, WSP(bf16, WS_WR), D, T, 256, F.G, F.bid);
        EpiG E{WSP(float, WS_LG)};
#pragma unroll 1
        for (int rep_ = 0; rep_ < REPS(6); ++rep_) pg8::gemm_phase<EpiG, pg8::StaticSched, false, true>(F.lds, D, D, D, S, E);
        VM_WAIT(); __syncthreads();
        pg8::Unit u; for (int i = 0; S.next(i, u); ++i) route_rows(F, u.r0);
        GRID_BAR();
    }
    if (NPH > 7) {
        moe_tables(F);
        MoeSched S{(const LAS int*)(F.lds + SCHED_OFF + 256), (const LAS int*)(F.lds + SCHED_OFF + 256) + 40, WSP(unsigned, WS_LIST), (const char*)WSP(bf16, WS_X1B), (const char*)WSP(bf16, WS_WGU), 2, F.G, F.bid, 0};
        EpiH E{WSP(bf16, WS_ACT), WSP(float, WS_LISTR)};
#pragma unroll 1
        for (int rep_ = 0; rep_ < REPS(7); ++rep_) pg8::gemm_phase<EpiH, MoeSched, true, true>(F.lds, D, D, D, S, E);
        GRID_BAR();
    }
    if (NPH > 8) {
        MoeSched S{(const LAS int*)(F.lds + SCHED_OFF + 256), (const LAS int*)(F.lds + SCHED_OFF + 256) + 40, WSP(unsigned, WS_LIST), (const char*)WSP(bf16, WS_ACT), (const char*)WSP(bf16, WS_WD), 4, F.G, F.bid, 1};
        EpiI E{WSP(unsigned char, WS_Y), WSP(unsigned, WS_LIST), WSP(float, WS_LISTW)};
#pragma unroll 1
        for (int rep_ = 0; rep_ < REPS(8); ++rep_) pg8::gemm_phase<EpiI, MoeSched, false, true>(F.lds, DE, DE, DE, S, E);
        GRID_BAR();
    }
    if (NPH > 9) {
        const float* gf = F.in[19]; const bf16* X1B = WSP(bf16, WS_X1B); const unsigned char* Y = WSP(unsigned char, WS_Y);
        const int gw = F.bid * 8 + F.wave, NGW = F.G * 8;
        unsigned code = 0;
#if DBG
        code = __hip_atomic_load((unsigned*)(F.ctl + CW_DBG), RLX_AGENT);
        if (__hip_atomic_load((unsigned*)(F.ctl + CW_BAR) + XB_TMO, RLX_AGENT) != 0u) code = 9;
#endif
#pragma unroll 1
        for (int rep_ = 0; rep_ < REPS(9); ++rep_)
        for (int m = gw; m < T; m += NGW) {
            const GAS v2u* xr = (const GAS v2u*)(X1B + (size_t)m * D) + F.lane;
            const GAS unsigned* y0 = (const GAS unsigned*)(Y + (size_t)(2 * m) * D) + F.lane; const GAS unsigned* y1 = (const GAS unsigned*)(Y + (size_t)(2 * m + 1) * D) + F.lane;
            f32x4 v[4]; float s_ = 0.f;
#pragma unroll
            for (int j = 0; j < 4; ++j) { const unsigned a = y0[64 * j], b = y1[64 * j]; const v2u c = xr[64 * j]; v[j] = (f32x4){bflo(c.x), bfhi(c.x), bflo(c.y), bfhi(c.y)} + (unpk4_fp8(a) + unpk4_fp8(b)) * (1.0f / YSCALE);
                s_ += (v[j].x * v[j].x + v[j].y * v[j].y) + (v[j].z * v[j].z + v[j].w * v[j].w); }
            const float rstd = 1.0f / sqrtf(wave_sum(s_) * (1.f / D) + EPS);
            GAS f32x4* o = (GAS f32x4*)(F.out + (size_t)m * D) + F.lane;
#pragma unroll
            for (int j = 0; j < 4; ++j) { const f32x4 g = *((const GAS f32x4*)gf + F.lane + 64 * j); f32x4 r = v[j] * rstd * g; if (code) r = (f32x4){10.f * code, 10.f * code, 10.f * code, 10.f * code}; o[64 * j] = r; }
        }
    } else
    {
        const float* gf = F.in[19]; const float* x = F.in[0];
        const int gw = F.bid * 8 + F.wave, NGW = F.G * 8;
        unsigned code = 0;
#if DBG
        code = __hip_atomic_load((unsigned*)(F.ctl + CW_DBG), RLX_AGENT);
        if (__hip_atomic_load((unsigned*)(F.ctl + CW_BAR) + XB_TMO, RLX_AGENT) != 0u) code = 9;
#endif
        for (int m = gw; m < T; m += NGW) {
            const GAS f32x4* xr = (const GAS f32x4*)(x + (size_t)m * D) + F.lane;
            f32x4 v[4]; float s = 0.f;
#pragma unroll
            for (int j = 0; j < 4; ++j) { v[j] = xr[64 * j]; s += (v[j].x * v[j].x + v[j].y * v[j].y) + (v[j].z * v[j].z + v[j].w * v[j].w); }
            const float rstd = 1.0f / sqrtf(wave_sum(s) * (1.f / D) + EPS);
            GAS f32x4* o = (GAS f32x4*)(F.out + (size_t)m * D) + F.lane;
#pragma unroll
            for (int j = 0; j < 4; ++j) { const f32x4 g = *((const GAS f32x4*)gf + F.lane + 64 * j); f32x4 r = v[j] * rstd * g; if (code) r = (f32x4){10.f * code, 10.f * code, 10.f * code, 10.f * code}; o[64 * j] = r; }
        }
    }
}

extern "C" void kernel_launch(void* const* d_in, const int* in_sizes, int n_in, void* d_out, int out_size, void* d_ws, size_t ws_size, hipStream_t stream) {
    static int grid = 0;
    if (grid == 0) {
        if (n_in != 20 || in_sizes[0] != T * D || out_size != T * D || ws_size < WS_END) { fprintf(stderr, "kernel_launch: unexpected shapes (n_in %d, in0 %d, out %d, ws %zu)\n", n_in, n_in > 0 ? in_sizes[0] : -1, out_size, ws_size); grid = -1; return; }
        int dev = 0, cus = 0, per_cu = 0;
        if (hipGetDevice(&dev) != hipSuccess || hipDeviceGetAttribute(&cus, hipDeviceAttributeMultiprocessorCount, dev) != hipSuccess) { grid = -1; return; }
        if (hipFuncSetAttribute((const void*)fwd_kernel, hipFuncAttributeMaxDynamicSharedMemorySize, LDS_BYTES) != hipSuccess) { fprintf(stderr, "kernel_launch: hipFuncSetAttribute failed\n"); grid = -1; return; }
        if (hipOccupancyMaxActiveBlocksPerMultiprocessor(&per_cu, (const void*)fwd_kernel, 512, LDS_BYTES) != hipSuccess || per_cu < 1) fprintf(stderr, "kernel_launch: occupancy query says %d\n", per_cu);
        (void)hipGetLastError();
        grid = cus;
    }
    if (grid < 0) return;
    if (hipMemsetAsync((char*)d_ws + WS_CTL, 0, CTL_ZERO_BYTES, stream) != hipSuccess) return;
    Args a{};
    for (int i = 0; i < 20; ++i) a.in[i] = (const float*)d_in[i];
    a.out = (float*)d_out; a.ws = (unsigned char*)d_ws;
    hipLaunchKernelGGL(fwd_kernel, dim3(grid), dim3(512), LDS_BYTES, stream, a);
}
```

```cpp
#include <hip/hip_runtime.h>
#include <cstdio>
#include <cstdint>

#ifndef DBG
#define DBG 0
#endif
#ifndef REPMASK
#define REPMASK 0
#endif
#define REPS(k) ((((REPMASK) >> (k)) & 1) ? 2 : 1)
#ifndef NPH
#define NPH 10
#endif

constexpr int BATCH = 16, SEQ = 4096, T = BATCH * SEQ, D = 1024;
constexpr int GH = 4, GDK = 64, GDV = 128, GKW = 256, GVW = 512, GRANK = 16, GCH = 64;
constexpr int PW = 512, PGW = 128;
constexpr int D_IN = 4112;
constexpr int IN_Q = 0, IN_K = 256, IN_V = 512, IN_R = 1024, IN_A = 1536, IN_U = 1552, IN_GG = 2064, IN_GP = 3088;
constexpr int NPROJ = 4352;
constexpr int NPJ = 2304;
constexpr int PJ_Q = 0, PJ_K = 256, PJ_V = 512, PJ_R = 1024, PJ_Z = 1536, PJ_U = 1792, PJ_GG = 2304, PJ_GP = 3328;
constexpr int NE = 32, EPG = 8, NG = 4, DE = 256;
constexpr int NSEG = 4, SEGCH = SEQ / GCH / NSEG;
constexpr int NA = 2 * T;
constexpr int LCAP = T;
constexpr float EPS = 1e-6f;
constexpr float YSCALE = 32.0f;

constexpr size_t MiB = 1u << 20;
constexpr size_t WS_CTL = 0, CTL_ZERO_BYTES = 1 * MiB;
constexpr size_t WS_WIN = 1 * MiB;
constexpr size_t WS_WG = 10 * MiB;
constexpr size_t WS_WP = 11 * MiB;
constexpr size_t WS_WOUT = 12 * MiB;
constexpr size_t WS_WR = 14 * MiB;
constexpr size_t WS_WGU = 15 * MiB;
constexpr size_t WS_WD = 47 * MiB;
constexpr size_t WS_XS = 63 * MiB;
constexpr size_t WS_HB = 64 * MiB;
constexpr size_t WS_TG = WS_HB;
constexpr size_t WS_MG = 192 * MiB;
constexpr size_t WS_SLOC = 256 * MiB;
constexpr size_t WS_DTOT = 264 * MiB;
constexpr size_t WS_CUMB = 265 * MiB;
constexpr size_t WS_BC = 192 * MiB;
constexpr size_t WS_Y = 64 * MiB;
constexpr size_t WS_ON = 320 * MiB;
constexpr size_t WS_PD = 384 * MiB;
constexpr size_t WS_ACT = 320 * MiB;
constexpr size_t WS_PJ = 448 * MiB;
constexpr size_t WS_GATES = 736 * MiB;
constexpr size_t WS_X1B = 448 * MiB;
constexpr size_t WS_LG = 576 * MiB;
constexpr size_t WS_SSQ = 592 * MiB;
constexpr size_t WS_LIST = 596 * MiB;
constexpr size_t WS_LISTW = 604 * MiB;
constexpr size_t WS_LISTR = 612 * MiB;
constexpr size_t WS_END = 992 * MiB;
static_assert(WS_PJ + (size_t)T * NPJ * 2 <= WS_GATES && WS_GATES + (size_t)2 * T * D * 2 <= WS_END && WS_LISTR + (size_t)NE * LCAP * 4 <= WS_GATES && WS_ACT + (size_t)(NA + NE * 256) * DE * 2 <= WS_PJ, "d_ws map");
constexpr int CW_TMO = 0, CW_DBG = 2;
constexpr int CW_BAR = 4096;
constexpr int CW_ECNT = 16384;

constexpr int RING_BYTES = 131072;
constexpr int MISC_OFF = RING_BYTES + 320;
constexpr int SCHED_OFF = RING_BYTES + 1024;
constexpr int LDS_BYTES = 147456;

#define GAS __attribute__((address_space(1)))
#define LAS __attribute__((address_space(3)))
typedef unsigned short bf16;
typedef unsigned v4u __attribute__((ext_vector_type(4)));
typedef unsigned v2u __attribute__((ext_vector_type(2)));
typedef float f32x4 __attribute__((ext_vector_type(4)));
typedef short bf16x8 __attribute__((ext_vector_type(8)));
typedef short bf16x4 __attribute__((ext_vector_type(4)));
typedef GAS unsigned gu32;
#define RLX_AGENT __ATOMIC_RELAXED, __HIP_MEMORY_SCOPE_AGENT
#define LDS_WAIT() asm volatile("s_waitcnt lgkmcnt(0)" ::: "memory")
#define VM_WAIT() asm volatile("s_waitcnt vmcnt(0)" ::: "memory")
__device__ __forceinline__ unsigned f2bf(float f) { unsigned u = __builtin_bit_cast(unsigned, f); return (u + 0x7fffu + ((u >> 16) & 1u)) >> 16; }
__device__ __forceinline__ unsigned pk2(float lo, float hi) { unsigned r; asm volatile("v_cvt_pk_bf16_f32 %0, %1, %2" : "=v"(r) : "v"(lo), "v"(hi)); return r; }
__device__ __forceinline__ float bflo(unsigned w) { return __builtin_bit_cast(float, w << 16); }
__device__ __forceinline__ float bfhi(unsigned w) { return __builtin_bit_cast(float, w & 0xffff0000u); }
__device__ __forceinline__ float bf1(bf16 h) { return __builtin_bit_cast(float, (unsigned)h << 16); }
__device__ __forceinline__ float fsigmoid(float x) { return __builtin_amdgcn_rcpf(1.0f + __expf(-x)); }
__device__ __forceinline__ float wave_sum(float v) {
#pragma unroll
    for (int o = 1; o < 64; o <<= 1) v += __shfl_xor(v, o);
    return v;
}


__device__ __forceinline__ unsigned pk4_fp8(const f32x4 v) { int w = 0; w = __builtin_amdgcn_cvt_pk_fp8_f32(v[0], v[1], w, false); w = __builtin_amdgcn_cvt_pk_fp8_f32(v[2], v[3], w, true); return (unsigned)w; }
__device__ __forceinline__ f32x4 unpk4_fp8(const unsigned w) { const auto lo = __builtin_amdgcn_cvt_pk_f32_fp8((int)w, false), hi = __builtin_amdgcn_cvt_pk_f32_fp8((int)w, true); return (f32x4){lo[0], lo[1], hi[0], hi[1]}; }

__device__ __forceinline__ unsigned pk4_unorm8(const f32x4 v) { const unsigned a = (unsigned)(v[0] * 255.0f + 0.5f), b = (unsigned)(v[1] * 255.0f + 0.5f), c = (unsigned)(v[2] * 255.0f + 0.5f), d = (unsigned)(v[3] * 255.0f + 0.5f); return a | (b << 8) | (c << 16) | (d << 24); }
__device__ __forceinline__ f32x4 unpk4_unorm8(const unsigned w) { return (f32x4){(float)(w & 0xffu), (float)((w >> 8) & 0xffu), (float)((w >> 16) & 0xffu), (float)(w >> 24)} * (1.0f / 255.0f); }
template <int CTRL> __device__ __forceinline__ float dpp_f(float x) { return __builtin_bit_cast(float, __builtin_amdgcn_update_dpp(0, __builtin_bit_cast(int, x), CTRL, 0xf, 0xf, true)); }
__device__ __forceinline__ float row16_sum(float x) { x += dpp_f<0x128>(x); x += dpp_f<0x124>(x); x += dpp_f<0x122>(x); x += dpp_f<0x121>(x); return x; }
__device__ __forceinline__ float row16_scan(float x) { x += dpp_f<0x111>(x); x += dpp_f<0x112>(x); x += dpp_f<0x114>(x); x += dpp_f<0x118>(x); return x; }

#define XB_TMO      128
#define XB_XCNT(j)  (256  + 64 * (j))
#define XB_XSUB(j)  (1280 + 64 * (j))
#define XB_XGEN(j)  (2304 + 64 * (j))
#define XB_TOP      3328
#define XB_TOPGEN   3392
#define XCD_BAR_WORDS 3456
#define XB_SPIN_CAP (1u << 18)
__device__ __forceinline__ unsigned xb_ld(unsigned* p)              { return __hip_atomic_load(p, __ATOMIC_RELAXED, __HIP_MEMORY_SCOPE_AGENT); }
__device__ __forceinline__ unsigned xb_add(unsigned* p, unsigned v) { return __hip_atomic_fetch_add(p, v, __ATOMIC_RELAXED, __HIP_MEMORY_SCOPE_AGENT); }
__device__ __forceinline__ unsigned xb_xcc_id() { return (unsigned)__builtin_amdgcn_s_getreg((3 << 11) | 20) & 0xFu; }
#define XB_SPIN(cond, bar) do { unsigned _sp = 0; while (cond) { __builtin_amdgcn_s_sleep(1); \
    if ((++_sp & 255u) == 0u) { if (xb_ld(&(bar)[XB_TMO])) break; if (_sp > XB_SPIN_CAP) { atomicAdd(&(bar)[XB_TMO], 1u); break; } } } } while (0)
struct XcdBarrier { unsigned* bar; unsigned x; volatile LAS unsigned* st; };
__device__ __forceinline__ XcdBarrier xcd_barrier_post(unsigned* bar, volatile LAS unsigned* st) {
    XcdBarrier b; b.bar = bar; b.x = xb_xcc_id(); b.st = st;
    if (threadIdx.x == 0) (void)xb_add(&bar[XB_XCNT(b.x)], 1u);
    return b;
}
__device__ __forceinline__ void xcd_barrier_complete(unsigned* bar, unsigned x, unsigned& nloc, unsigned& nx) {
    const unsigned G = gridDim.x * gridDim.y * gridDim.z;
    unsigned sum, cnt, mine, sp = 0u;
    for (;;) {
        sum = 0u; cnt = 0u; mine = 0u;
#pragma unroll
        for (unsigned j = 0; j < 16; ++j) { const unsigned c = xb_ld(&bar[XB_XCNT(j)]); sum += c; cnt += (c > 0u) ? 1u : 0u; mine = (j == x) ? c : mine; }
        if (sum == G) break;
        __builtin_amdgcn_s_sleep(1);
        if ((++sp & 255u) == 0u) { if (xb_ld(&bar[XB_TMO])) break; if (sp > XB_SPIN_CAP) { atomicAdd(&bar[XB_TMO], 1u); break; } }
    }
    nloc = mine > 0u ? mine : 1u; nx = cnt > 0u ? cnt : 1u;
}
__device__ __forceinline__ void xcd_barrier(const XcdBarrier& b) {
    asm volatile("s_waitcnt vmcnt(0)" ::: "memory");
    __syncthreads();
    if (threadIdx.x == 0) {
        unsigned* bar = b.bar;
        __builtin_amdgcn_s_waitcnt(0);
        unsigned nloc = b.st[0], nx = b.st[1];
        if (nloc == 0u) { xcd_barrier_complete(bar, b.x, nloc, nx); b.st[0] = nloc; b.st[1] = nx; }
        const unsigned old = xb_add(&bar[XB_XSUB(b.x)], 1u);
        const unsigned gen = old / nloc;
        if (old + 1u == (gen + 1u) * nloc) {
            __builtin_amdgcn_fence(__ATOMIC_RELEASE, "agent");
            asm volatile("s_waitcnt vmcnt(0)" ::: "memory");
            const unsigned og = xb_add(&bar[XB_TOP], 1u);
            const unsigned tg = og / nx;
            if (og + 1u == (tg + 1u) * nx) xb_add(&bar[XB_TOPGEN], 1u);
            else XB_SPIN(xb_ld(&bar[XB_TOPGEN]) == tg, bar);
            __builtin_amdgcn_fence(__ATOMIC_ACQUIRE, "agent");
            xb_add(&bar[XB_XGEN(b.x)], 1u);
            asm volatile("s_waitcnt vmcnt(0)" ::: "memory");
        } else {
            XB_SPIN(xb_ld(&bar[XB_XGEN(b.x)]) == gen, bar);
            __builtin_amdgcn_fence(__ATOMIC_ACQUIRE, "agent");
            asm volatile("s_waitcnt vmcnt(0)" ::: "memory");
        }
    }
    __syncthreads();
}

namespace pg8 {
#define PG8_LAS __attribute__((address_space(3)))
constexpr int BM = 256, BK = 64, HALF = 128, HTB = HALF * BK * 2, STAGE_BYTES = 8 * HTB, NXCD = 8, WGM = 8;
__host__ __device__ __forceinline__ int lds_byte(int r, int c) { const int st = (r >> 4) * 2 + (c >> 5), rr = r & 15, cc = c & 31, ob = rr * 64 + cc * 2; return st * 1024 + (ob ^ (((ob >> 9) & 1) << 5)); }
__host__ __device__ __forceinline__ void stage_rc(int b, int& R, int& C) { const int st = b / 1024, sb = b % 1024, swz = sb ^ (((sb >> 9) & 1) << 5); R = (st >> 1) * 16 + swz / 64; C = (st & 1) * 32 + (swz % 64) / 2; }
__host__ __device__ __forceinline__ int perm32(int rho) { const int n = rho >> 4, i = rho & 15; return 8 * (i >> 2) + 4 * n + (i & 3); }

struct Unit { const char* A; const char* B; int r0, c0, e, nvalid, lb, pad; };

__device__ __forceinline__ int remap_xcd(int L, int nwg) { const int q = nwg / NXCD, r = nwg % NXCD, xcd = L % NXCD, off = L / NXCD; return (xcd < r ? xcd * (q + 1) : r * (q + 1) + (xcd - r) * q) + off; }
struct StaticSched {
    const char* A; const char* B; int lda, ldb, nM, nN, nwg, G, c;
    __device__ __forceinline__ void init(const void* A_, int lda_, const void* B_, int ldb_, int M, int N, int G_, int c_) { A = (const char*)A_; B = (const char*)B_; lda = lda_; ldb = ldb_; nM = M / BM; nN = N / BM; nwg = nM * nN; G = G_; c = c_; }
    __device__ __forceinline__ bool next(int i, Unit& u) const {
        const long L = (long)i * G + c; if (L >= nwg) return false;
        const int wgid = remap_xcd((int)L, nwg);
        const int nig = WGM * nN, gid = wgid / nig, fm = gid * WGM, gsz = (nM - fm) < WGM ? (nM - fm) : WGM;
        const int pm = fm + ((wgid % nig) % gsz), pn = (wgid % nig) / gsz;
        u.A = A + (size_t)pm * BM * lda * 2; u.B = B + (size_t)pn * BM * ldb * 2; u.r0 = pm * BM; u.c0 = pn * BM; u.e = 0; u.nvalid = BM; u.lb = 0; u.pad = 0; return true;
    }
    __device__ __forceinline__ void fill_tab(const Unit&, PG8_LAS unsigned*) const {}
};

template <class Epi, class Sched, bool GATHER, bool ALIGN_EPI>
__device__ __forceinline__ void gemm_phase(PG8_LAS unsigned char* lds, const int K, const int lda, const int ldb, const Sched& S, const Epi& E) {
    int tid_ = threadIdx.x; asm volatile("" : "+v"(tid_));
    const int tid = tid_, wid = __builtin_amdgcn_readfirstlane(tid >> 6), lane = tid & 63, wr = wid >> 2, wc = wid & 3, fr = lane & 15, fq = lane >> 4;
    const int nt = K / BK;
    int Rr[2], Cc[2];
    unsigned voffA[2][2], voffB[2], nvA[2][2];
#pragma unroll
    for (int i = 0; i < 2; ++i) { int R, C; stage_rc(tid * 16 + i * 8192, R, C); Rr[i] = R; Cc[i] = C; const int Rb = Epi::PERM ? ((R & ~31) + perm32(R & 31)) : R;
        voffB[i] = (unsigned)(Rb * ldb + C) * 2u;
#pragma unroll
        for (int h = 0; h < 2; ++h) { voffA[h][i] = (unsigned)((R + HALF * h) * lda + C) * 2u; nvA[h][i] = voffA[h][i]; } }
    const size_t kstep = (size_t)(BK * 2);
    const size_t hstepB = (size_t)HALF * ldb * 2;
    const unsigned ldsw = (unsigned)wid * 1024u;
    const int aoff = lds_byte(wr * 64 + fr, fq * 8), boff = lds_byte(wc * 32 + fr, fq * 8);
#define PG8_SA(b, h) (((b) * 2 + (h)) * HTB)
#define PG8_SB(b, h) ((4 + (b) * 2 + (h)) * HTB)
#define PG8_STAGE(bufoff, gbase, voff) do { _Pragma("unroll") for (int _i = 0; _i < 2; ++_i) \
        __builtin_amdgcn_global_load_lds((const unsigned*)((const char*)(gbase) + (voff)[_i]), (PG8_LAS unsigned*)(lds + (bufoff) + ldsw + _i * 8192), 16, 0, 0); } while (0)
#define PG8_LDA(dst, b, h) do { _Pragma("unroll") for (int m = 0; m < 4; ++m) _Pragma("unroll") for (int k = 0; k < 2; ++k) dst[m][k] = *(const PG8_LAS bf16x8*)(lds + PG8_SA(b, h) + aoff + m * 2048 + k * 1024); } while (0)
#define PG8_LDB(dst, b, h) do { _Pragma("unroll") for (int n = 0; n < 2; ++n) _Pragma("unroll") for (int k = 0; k < 2; ++k) dst[n][k] = *(const PG8_LAS bf16x8*)(lds + PG8_SB(b, h) + boff + n * 2048 + k * 1024); } while (0)
#define PG8_MMA(ai, bj, At, Bt) do { __builtin_amdgcn_s_setprio(1); _Pragma("unroll") for (int m = 0; m < 4; ++m) _Pragma("unroll") for (int n = 0; n < 2; ++n) _Pragma("unroll") for (int k = 0; k < 2; ++k) \
        acc[ai][bj][m][n] = __builtin_amdgcn_mfma_f32_16x16x32_bf16(Bt[n][k], At[m][k], acc[ai][bj][m][n], 0, 0, 0); __builtin_amdgcn_s_setprio(0); } while (0)
#define PG8_WAIT_V(n) asm volatile("s_waitcnt vmcnt(" #n ")" ::: "memory")
#define PG8_WAIT_L(n) asm volatile("s_waitcnt lgkmcnt(" #n ")" ::: "memory")
#define PG8_BAR __builtin_amdgcn_s_barrier()
#define PG8_SCHED __builtin_amdgcn_sched_barrier(0)
    Unit cur, nxt; int ui = 0;
    if (!S.next(0, cur)) return;
    f32x4 acc[2][2][4][2];
#pragma unroll
    for (int a = 0; a < 2; ++a)
#pragma unroll
        for (int b = 0; b < 2; ++b)
#pragma unroll
            for (int m = 0; m < 4; ++m)
#pragma unroll
                for (int n = 0; n < 2; ++n) acc[a][b][m][n] = (f32x4){0.f, 0.f, 0.f, 0.f};
    bf16x8 At[4][2], B0[2][2], B1[2][2];
    const char* cA = cur.A; const char* cB = cur.B;
    PG8_LAS unsigned* gtab = (PG8_LAS unsigned*)(lds + STAGE_BYTES + 2048);
    if constexpr (GATHER) {
        S.fill_tab(cur, gtab);
        asm volatile("s_waitcnt lgkmcnt(0)" ::: "memory"); __builtin_amdgcn_s_barrier(); asm volatile("" ::: "memory");
#pragma unroll
        for (int h = 0; h < 2; ++h)
#pragma unroll
            for (int i = 0; i < 2; ++i) { voffA[h][i] = gtab[Rr[i] + HALF * h] + (unsigned)Cc[i] * 2u; nvA[h][i] = voffA[h][i]; }
    }
    PG8_STAGE(PG8_SB(0, 0), cB, voffB); PG8_STAGE(PG8_SB(0, 1), cB + hstepB, voffB); PG8_STAGE(PG8_SA(0, 0), cA, voffA[0]); PG8_STAGE(PG8_SA(0, 1), cA, voffA[1]);
    if (wr == 1) PG8_BAR;
    PG8_WAIT_V(2); PG8_BAR;
    PG8_STAGE(PG8_SB(1, 0), cB + kstep, voffB); PG8_STAGE(PG8_SA(1, 0), cA + kstep, voffA[0]); PG8_STAGE(PG8_SB(1, 1), cB + hstepB + kstep, voffB);
    PG8_WAIT_V(6); PG8_BAR;
    for (;;) {
        const bool has_next = S.next(ui + 1, nxt);
        const char* nA = has_next ? nxt.A : cA; const char* nB = has_next ? nxt.B : cB;
        if constexpr (GATHER) { if (has_next) S.fill_tab(nxt, gtab + ((ui + 1) & 1) * 256); }
#pragma unroll 1
        for (int t = 0; t < nt; t += 2) {
            const bool last = (t == nt - 2);
            const char* a1 = cA + (size_t)(t + 1) * kstep;
            const char* a2 = last ? nA : cA + (size_t)(t + 2) * kstep; const char* b2 = last ? nB : cB + (size_t)(t + 2) * kstep;
            const char* a3 = a2 + kstep; const char* b3 = b2 + kstep;
            unsigned sv[2][2];
            if constexpr (GATHER) {
                if (last && has_next) {
#pragma unroll
                    for (int h = 0; h < 2; ++h)
#pragma unroll
                        for (int i = 0; i < 2; ++i) nvA[h][i] = gtab[((ui + 1) & 1) * 256 + Rr[i] + HALF * h] + (unsigned)Cc[i] * 2u;
                }
#pragma unroll
                for (int h = 0; h < 2; ++h)
#pragma unroll
                    for (int i = 0; i < 2; ++i) sv[h][i] = last ? nvA[h][i] : voffA[h][i];
            } else {
#pragma unroll
                for (int h = 0; h < 2; ++h)
#pragma unroll
                    for (int i = 0; i < 2; ++i) sv[h][i] = voffA[h][i];
            }
            PG8_LDB(B0, 0, 0); PG8_LDB(B1, 0, 1); PG8_SCHED; PG8_LDA(At, 0, 0); PG8_STAGE(PG8_SA(1, 1), a1, voffA[1]);
            PG8_WAIT_V(8); PG8_WAIT_L(0); PG8_BAR; PG8_MMA(0, 0, At, B0); PG8_MMA(0, 1, At, B1); PG8_BAR; PG8_SCHED;
            PG8_LDA(At, 0, 1); PG8_STAGE(PG8_SB(0, 0), b2, voffB); PG8_STAGE(PG8_SB(0, 1), b2 + hstepB, voffB); PG8_STAGE(PG8_SA(0, 0), a2, sv[0]);
            PG8_WAIT_V(8); PG8_WAIT_L(0); PG8_BAR; PG8_MMA(1, 0, At, B0); PG8_MMA(1, 1, At, B1); PG8_BAR; PG8_SCHED;
            PG8_LDB(B0, 1, 0); PG8_LDB(B1, 1, 1); PG8_SCHED; PG8_LDA(At, 1, 0); PG8_STAGE(PG8_SA(0, 1), a2, sv[1]);
            PG8_WAIT_V(8); PG8_WAIT_L(0); PG8_BAR; PG8_MMA(0, 0, At, B0); PG8_MMA(0, 1, At, B1); PG8_BAR; PG8_SCHED;
            PG8_LDA(At, 1, 1); PG8_STAGE(PG8_SB(1, 0), b3, voffB); PG8_STAGE(PG8_SB(1, 1), b3 + hstepB, voffB); PG8_STAGE(PG8_SA(1, 0), a3, sv[0]);
            PG8_WAIT_V(8); PG8_WAIT_L(0); PG8_BAR; PG8_MMA(1, 0, At, B0); PG8_MMA(1, 1, At, B1); PG8_BAR; PG8_SCHED;
        }
        if constexpr (ALIGN_EPI) { if (wr == 0) PG8_BAR; }
#if defined(EPIX2)
#pragma unroll 1
        for (int e_ = 0; e_ < ((EPIX2 == Epi::ID) ? 2 : 1); ++e_)
#endif
        E(acc, cur, wr, wc, fr, fq);
        if (!has_next) break;
        if (!(cur.pad & 1)) {
#pragma unroll
        for (int a = 0; a < 2; ++a)
#pragma unroll
            for (int b = 0; b < 2; ++b)
#pragma unroll
                for (int m = 0; m < 4; ++m)
#pragma unroll
                    for (int n = 0; n < 2; ++n) acc[a][b][m][n] = (f32x4){0.f, 0.f, 0.f, 0.f};
        }
        cur = nxt; cA = nA; cB = nB; ++ui;
        if constexpr (GATHER) {
#pragma unroll
            for (int h = 0; h < 2; ++h)
#pragma unroll
                for (int i = 0; i < 2; ++i) voffA[h][i] = nvA[h][i];
        }
        if constexpr (ALIGN_EPI) { if (wr == 1) PG8_BAR; }
    }
    PG8_WAIT_V(0);
    if constexpr (!ALIGN_EPI) { if (wr == 0) PG8_BAR; }
    PG8_BAR;
#undef PG8_SA
#undef PG8_SB
#undef PG8_STAGE
#undef PG8_LDA
#undef PG8_LDB
#undef PG8_MMA
#undef PG8_WAIT_V
#undef PG8_WAIT_L
#undef PG8_BAR
#undef PG8_SCHED
}
}

struct Frame {
    LAS unsigned char* lds;
    volatile LAS unsigned* MISC;
    gu32* ctl;
    int tid, lane, wave, G, bid;
    const float* in[20]; float* out; unsigned char* ws;
};
#define WSP(T_, off) ((T_*)(F.ws + (off)))

__device__ __forceinline__ v4u pack8(const f32x4 a, const f32x4 b) { v4u w; w.x = pk2(a[0], a[1]); w.y = pk2(a[2], a[3]); w.z = pk2(b[0], b[1]); w.w = pk2(b[2], b[3]); return w; }
__device__ __forceinline__ void unpack8(const v4u w, f32x4& a, f32x4& b) { a = (f32x4){bflo(w.x), bfhi(w.x), bflo(w.y), bfhi(w.y)}; b = (f32x4){bflo(w.z), bfhi(w.z), bflo(w.w), bfhi(w.w)}; }

__device__ __forceinline__ size_t gate_elem(int which, int row, int col) { return ((size_t)which * T + row) * D + col; }
struct EpiP1 {
    static constexpr int ID = 1; static constexpr bool PERM = true;
    bf16* PJ; const float* b_alpha; float* BC; unsigned char* GATES;
    __device__ __forceinline__ void operator()(const f32x4 (&acc)[2][2][4][2], const pg8::Unit& u, int wr, int wc, int fr, int fq) const {
        const int pn = u.c0 >> 8;
        const int mode = (pn == 4 || pn == 5) ? 1 : (pn == 6) ? 2 : (pn >= 9) ? 3 : 0;
        const int row0 = u.r0 + wr * 64 + fr, col0 = u.c0 + wc * 32 + 8 * fq;
        f32x4 bv[2][2];
        const int bidx = (mode == 2) ? (col0 - PJ_Z) : 0;
#pragma unroll
        for (int bj = 0; bj < 2; ++bj)
#pragma unroll
            for (int n = 0; n < 2; ++n) { bv[bj][n] = *(const f32x4*)(b_alpha + bidx + bj * 128 + 4 * n); asm volatile("" :: "v"(bv[bj][n])); }
        if (mode == 2) {
#pragma unroll
            for (int ai = 0; ai < 2; ++ai)
#pragma unroll
                for (int bj = 0; bj < 2; ++bj) { f32x4 pr[4][2];
#pragma unroll
                    for (int n = 0; n < 2; ++n)
#pragma unroll
                        for (int j = 0; j < 4; ++j) { float carry = 0.f;
#pragma unroll
                            for (int m = 0; m < 4; ++m) { const float z = acc[ai][bj][m][n][j] + bv[bj][n][j]; const float la = (fminf(z, 0.f) - __logf(1.0f + __expf(-fabsf(z)))) * (1.0f / 16.0f);
                                pr[m][n][j] = row16_scan(la) + carry; carry += row16_sum(la); } }
#pragma unroll
                    for (int m = 0; m < 4; ++m) { float* bp = BC + (size_t)(row0 + ai * 128 + m * 16) * GKW + (col0 - PJ_Z) + bj * 128; *(f32x4*)bp = pr[m][0]; *(f32x4*)(bp + 4) = pr[m][1]; } }
            return;
        }
#pragma unroll
        for (int ai = 0; ai < 2; ++ai)
#pragma unroll
            for (int m = 0; m < 4; ++m) { bf16* rowp = PJ + (size_t)(row0 + ai * 128 + m * 16) * NPJ + col0;
#pragma unroll
                for (int bj = 0; bj < 2; ++bj) { f32x4 v[2] = {acc[ai][bj][m][0], acc[ai][bj][m][1]};
                    if (mode == 1) {
#pragma unroll
                        for (int n = 0; n < 2; ++n)
#pragma unroll
                            for (int j = 0; j < 4; ++j) v[n][j] = v[n][j] * fsigmoid(v[n][j]);
                    } else if (mode == 3) {
#pragma unroll
                        for (int n = 0; n < 2; ++n)
#pragma unroll
                            for (int j = 0; j < 4; ++j) v[n][j] = fsigmoid(v[n][j]);
                        { v2u gw8; gw8.x = pk4_unorm8(v[0]); gw8.y = pk4_unorm8(v[1]); *(v2u*)(GATES + ((size_t)((pn - 9) >> 2) * T + (size_t)(row0 + ai * 128 + m * 16)) * D + (((pn - 9) & 3) << 8) + wc * 32 + 8 * fq + bj * 128) = gw8; }
                        continue;
                    }
                    *(v4u*)(rowp + bj * 128) = pack8(v[0], v[1]); } }
    }
};

struct EpiF {
    static constexpr int ID = 5; static constexpr bool PERM = true;
    const bf16* HB; const float* XS; bf16* X1B; float* SSQ;
    __device__ __forceinline__ void operator()(const f32x4 (&acc)[2][2][4][2], const pg8::Unit& u, int wr, int wc, int fr, int fq) const {
        const int row0 = u.r0 + wr * 64 + fr, col0 = u.c0 + wc * 32 + 8 * fq;
#pragma unroll
        for (int ai = 0; ai < 2; ++ai) {
            v4u H[4][2]; float xs[4];
#pragma unroll
            for (int m = 0; m < 4; ++m) { const size_t row = (size_t)(row0 + ai * 128 + m * 16); xs[m] = XS[row];
#pragma unroll
                for (int bj = 0; bj < 2; ++bj) H[m][bj] = *(const v4u*)(HB + row * D + col0 + bj * 128); }
            asm volatile("" ::: "memory");
#pragma unroll
            for (int m = 0; m < 4; ++m) { const size_t row = (size_t)(row0 + ai * 128 + m * 16); float ss = 0.f;
#pragma unroll
                for (int bj = 0; bj < 2; ++bj) { f32x4 x0, x1; unpack8(H[m][bj], x0, x1);
                    const f32x4 y0 = x0 * xs[m] + acc[ai][bj][m][0], y1 = x1 * xs[m] + acc[ai][bj][m][1];
                    *(v4u*)(X1B + row * D + col0 + bj * 128) = pack8(y0, y1);
                    ss += (y0[0] * y0[0] + y0[1] * y0[1]) + (y0[2] * y0[2] + y0[3] * y0[3]) + (y1[0] * y1[0] + y1[1] * y1[1]) + (y1[2] * y1[2] + y1[3] * y1[3]); }
                ss += __shfl_xor(ss, 16); ss += __shfl_xor(ss, 32);
                if (fq == 0) SSQ[row * 16 + (u.c0 >> 8) * 4 + wc] = ss; }
            asm volatile("" ::: "memory");
        }
    }
};
struct MoeSched {
    const LAS int* cum; const LAS int* cnt; const unsigned* LIST;
    const char* Abase; const char* Bbase; int NT, G, c, mode;
    __device__ __forceinline__ bool next(int i, pg8::Unit& u) const {
        const int nunits = __builtin_amdgcn_readfirstlane(cum[NE]) * NT; const long L = (long)i * G + c; if (L >= nunits) return false;
        const int wgid = pg8::remap_xcd((int)L, nunits), gb = wgid / NT, pn = wgid % NT;
        int e_ = 0;
#pragma unroll 8
        for (int j = 1; j < NE; ++j) e_ += (cum[j] <= gb) ? 1 : 0;
        const int e = __builtin_amdgcn_readfirstlane(e_);
        const int blk = gb - __builtin_amdgcn_readfirstlane(cum[e]), rem = __builtin_amdgcn_readfirstlane(cnt[e]) - blk * 256;
        u.e = e; u.nvalid = rem < 256 ? rem : 256; u.lb = e * LCAP + blk * 256; u.r0 = gb * 256; u.pad = 0;
        if (mode == 0) { u.A = Abase; u.B = Bbase + ((size_t)e * 512 + (size_t)pn * 256) * D * 2; u.c0 = pn * 128; }
        else { u.A = Abase + (size_t)gb * 256 * DE * 2; u.B = Bbase + ((size_t)e * D + (size_t)pn * 256) * DE * 2; u.c0 = pn * 256; }
        return true;
    }
    __device__ __forceinline__ void fill_tab(const pg8::Unit& u, LAS unsigned* tab) const {
        const int t = threadIdx.x;
        if (t < 256) { const int lp = t < u.nvalid ? t : u.nvalid - 1; const unsigned slot = LIST[u.lb + lp]; tab[t] = (slot >> 1) * (unsigned)(D * 2); }
    }
};
struct EpiG {
    static constexpr int ID = 6; static constexpr bool PERM = false;
    float* LG;
    __device__ __forceinline__ void operator()(const f32x4 (&acc)[2][2][4][2], const pg8::Unit& u, int wr, int wc, int fr, int fq) const {
        if (wc >= 2) return;
        const int row0 = u.r0 + wr * 64 + fr;
#pragma unroll
        for (int ai = 0; ai < 2; ++ai)
#pragma unroll
            for (int m = 0; m < 4; ++m)
#pragma unroll
                for (int n = 0; n < 2; ++n) *(f32x4*)(LG + (size_t)(row0 + ai * 128 + m * 16) * 64 + 32 * wc + 16 * n + 4 * fq) = acc[ai][0][m][n];
    }
};
struct EpiH {
    static constexpr int ID = 7; static constexpr bool PERM = true;
    bf16* ACT; const float* LISTR;
    __device__ __forceinline__ void operator()(const f32x4 (&acc)[2][2][4][2], const pg8::Unit& u, int wr, int wc, int fr, int fq) const {
        float rs[2][4];
#pragma unroll
        for (int ai = 0; ai < 2; ++ai)
#pragma unroll
            for (int m = 0; m < 4; ++m) { const int rl = ai * 128 + wr * 64 + m * 16 + fr, lp = rl < u.nvalid ? rl : u.nvalid - 1; rs[ai][m] = LISTR[u.lb + lp]; }
#pragma unroll
        for (int ai = 0; ai < 2; ++ai)
#pragma unroll
            for (int m = 0; m < 4; ++m) { asm volatile("" :: "v"(rs[ai][m])); }
#pragma unroll
        for (int ai = 0; ai < 2; ++ai)
#pragma unroll
            for (int m = 0; m < 4; ++m) { const int rl = ai * 128 + wr * 64 + m * 16 + fr; const float r = rs[ai][m]; f32x4 a[2];
#pragma unroll
                for (int n = 0; n < 2; ++n)
#pragma unroll
                    for (int j = 0; j < 4; ++j) { const float g = acc[ai][0][m][n][j] * r, up = acc[ai][1][m][n][j] * r; a[n][j] = g * fsigmoid(g) * up; }
                *(v4u*)(ACT + (size_t)(u.r0 + rl) * DE + u.c0 + wc * 32 + 8 * fq) = pack8(a[0], a[1]); }
    }
};
struct EpiI {
    static constexpr int ID = 8; static constexpr bool PERM = true;
    unsigned char* Y; const unsigned* LIST; const float* LISTW;
    __device__ __forceinline__ void operator()(const f32x4 (&acc)[2][2][4][2], const pg8::Unit& u, int wr, int wc, int fr, int fq) const {
        unsigned sl[8]; float gw[8];
#pragma unroll
        for (int b = 0; b < 8; ++b) { const int rl = (b >> 2) * 128 + wr * 64 + (b & 3) * 16 + fr, lp = rl < u.nvalid ? rl : u.nvalid - 1; sl[b] = LIST[u.lb + lp]; gw[b] = LISTW[u.lb + lp]; }
        asm volatile("" ::: "memory");
#pragma unroll
        for (int b = 0; b < 8; ++b) { asm volatile("" :: "v"(gw[b]), "v"(sl[b])); }
#pragma unroll
        for (int b = 0; b < 8; ++b) { const int ai = b >> 2, m = b & 3, rl = ai * 128 + wr * 64 + m * 16 + fr; const float g = gw[b] * YSCALE;
            if (rl < u.nvalid) {
#pragma unroll
                for (int bj = 0; bj < 2; ++bj) { v2u w; w.x = pk4_fp8(acc[ai][bj][m][0] * g); w.y = pk4_fp8(acc[ai][bj][m][1] * g); *(v2u*)(Y + (size_t)sl[b] * D + u.c0 + bj * 128 + wc * 32 + 8 * fq) = w; } } }
    }
};
__device__ __forceinline__ void route_rows(Frame& F, const int r0) {
    const float* LG = WSP(float, WS_LG); const float* SSQ = WSP(float, WS_SSQ); const float* brg = F.in[13]; const float* bre = F.in[15];
    unsigned* LIST = WSP(unsigned, WS_LIST); float* LISTW = WSP(float, WS_LISTW); float* LISTR = WSP(float, WS_LISTR);
    LAS unsigned* hcnt = (LAS unsigned*)(F.lds + SCHED_OFF); LAS unsigned* hbase = hcnt + 32;
    if (F.tid < 32) hcnt[F.tid] = 0u;
    __syncthreads();
    int e0 = 0, e1 = 0; unsigned p0 = 0, p1 = 0; float w0 = 0.f, w1 = 0.f, rstd = 0.f; const int row = r0 + F.tid;
    if (F.tid < 256) {
        float ss = 0.f;
#pragma unroll
        for (int j = 0; j < 16; ++j) ss += SSQ[(size_t)row * 16 + j];
        rstd = 1.0f / sqrtf(ss * (1.0f / D) + EPS);
        const float* lr = LG + (size_t)row * 64;
        float gl[4];
#pragma unroll
        for (int g = 0; g < 4; ++g) gl[g] = __hip_atomic_load(lr + g, RLX_AGENT) * rstd + brg[g];
        int gi = 0; float gm = gl[0];
#pragma unroll
        for (int g = 1; g < 4; ++g) if (gl[g] > gm) { gm = gl[g]; gi = g; }
        float den = 0.f;
#pragma unroll
        for (int g = 0; g < 4; ++g) den += expf(gl[g] - gm);
        const float gp = 1.0f / den;
        float el[8];
#pragma unroll
        for (int e = 0; e < 8; ++e) el[e] = __hip_atomic_load(lr + 4 + gi * 8 + e, RLX_AGENT) * rstd + bre[gi * 8 + e];
        int i0 = 0; float m0 = el[0];
#pragma unroll
        for (int e = 1; e < 8; ++e) if (el[e] > m0) { m0 = el[e]; i0 = e; }
        int i1 = -1; float m1 = 0.f;
#pragma unroll
        for (int e = 0; e < 8; ++e) if (e != i0 && (i1 < 0 || el[e] > m1)) { m1 = el[e]; i1 = e; }
        const float q = expf(m1 - m0); w0 = gp / (1.0f + q); w1 = gp * q / (1.0f + q);
        e0 = gi * 8 + i0; e1 = gi * 8 + i1;
        p0 = __hip_atomic_fetch_add(&hcnt[e0], 1u, __ATOMIC_RELAXED, __HIP_MEMORY_SCOPE_WORKGROUP); p1 = __hip_atomic_fetch_add(&hcnt[e1], 1u, __ATOMIC_RELAXED, __HIP_MEMORY_SCOPE_WORKGROUP);
    }
    __syncthreads();
    if (F.tid < 32) hbase[F.tid] = hcnt[F.tid] ? __hip_atomic_fetch_add((unsigned*)(F.ctl + CW_ECNT + 64 * F.tid), hcnt[F.tid], RLX_AGENT) : 0u;
    __syncthreads();
    if (F.tid < 256) { const size_t q0 = (size_t)e0 * LCAP + hbase[e0] + p0, q1 = (size_t)e1 * LCAP + hbase[e1] + p1;
        LIST[q0] = (unsigned)row * 2u; LIST[q1] = (unsigned)row * 2u + 1u; LISTW[q0] = w0; LISTW[q1] = w1; LISTR[q0] = rstd; LISTR[q1] = rstd; }
    __syncthreads();
}
__device__ __forceinline__ void moe_tables(Frame& F) {
    LAS int* cum = (LAS int*)(F.lds + SCHED_OFF + 256); LAS int* cnt = cum + 40;
    if (F.tid == 0) { int a = 0; for (int e = 0; e < NE; ++e) { const int c = (int)__hip_atomic_load((unsigned*)(F.ctl + CW_ECNT + 64 * e), RLX_AGENT); cnt[e] = c; cum[e] = a; a += (c + 255) >> 8; } cum[NE] = a; }
    __syncthreads();
}


struct PairSched {
    pg8::StaticSched S0; const char* A1; const char* B1;
    __device__ __forceinline__ bool next(int i, pg8::Unit& u) const {
        if (!S0.next(i >> 1, u)) return false;
        if (i & 1) { u.A = A1 + (u.A - S0.A); u.B = B1 + (u.B - S0.B); u.pad = 2; } else u.pad = 1;
        return true;
    }
    __device__ __forceinline__ void fill_tab(const pg8::Unit&, LAS unsigned*) const {}
};
struct EpiDE {
    static constexpr int ID = 3; static constexpr bool PERM = true;
    bf16* MG; const unsigned char* GATES;
    __device__ __forceinline__ void operator()(f32x4 (&acc)[2][2][4][2], const pg8::Unit& u, int wr, int wc, int fr, int fq) const {
        const int row0 = u.r0 + wr * 64 + fr, col0 = u.c0 + wc * 32 + 8 * fq; const bool first = (u.pad & 1) != 0;
        const unsigned char* gp = GATES + ((size_t)T + row0) * D + col0;
        const unsigned char* gg = GATES + (size_t)row0 * D + col0;
#pragma unroll
        for (int ai = 0; ai < 2; ++ai) {
            v2u P[4][2], G[4][2];
#pragma unroll
            for (int m = 0; m < 4; ++m)
#pragma unroll
                for (int bj = 0; bj < 2; ++bj) { G[m][bj] = (v2u){0u, 0u}; if (first) G[m][bj] = *(const v2u*)(gg + (size_t)(ai * 128 + m * 16) * D + bj * 128); }
#pragma unroll
            for (int m = 0; m < 4; ++m)
#pragma unroll
                for (int bj = 0; bj < 2; ++bj) P[m][bj] = *(const v2u*)(gp + (size_t)(ai * 128 + m * 16) * D + bj * 128);
            asm volatile("" ::: "memory");
#pragma unroll
            for (int m = 0; m < 4; ++m)
#pragma unroll
                for (int bj = 0; bj < 2; ++bj) { asm volatile("" :: "v"(P[m][bj]));
                    const float lo = 0.5f / 255.0f;
                    const f32x4 p0 = __builtin_elementwise_max(unpk4_unorm8(P[m][bj].x), (f32x4){lo, lo, lo, lo}), p1 = __builtin_elementwise_max(unpk4_unorm8(P[m][bj].y), (f32x4){lo, lo, lo, lo});
                    if (first) { const f32x4 g0 = unpk4_unorm8(G[m][bj].x), g1 = unpk4_unorm8(G[m][bj].y);
#pragma unroll
                        for (int j = 0; j < 4; ++j) { acc[ai][bj][m][0][j] *= g0[j] * __builtin_amdgcn_rcpf(p0[j]); acc[ai][bj][m][1][j] *= g1[j] * __builtin_amdgcn_rcpf(p1[j]); }
                    } else {
                        *(v4u*)(MG + (size_t)(row0 + ai * 128 + m * 16) * D + col0 + bj * 128) = pack8(acc[ai][bj][m][0] * p0, acc[ai][bj][m][1] * p1);
                    } }
            asm volatile("" ::: "memory");
        }
    }
};

__device__ __forceinline__ void transpose_item64(const float* W, const int ld, const float* g, int k0, int n0, bf16* dst, int drow0, int dld, LAS bf16* tl, int lane) {
    const int c4 = (lane & 15) * 4, kr = lane >> 4;
    f32x4 v[16];
#pragma unroll
    for (int i = 0; i < 16; ++i) v[i] = *(const f32x4*)(W + (size_t)(k0 + kr + 4 * i) * ld + n0 + c4);
#pragma unroll
    for (int i = 0; i < 16; ++i) { const int k = kr + 4 * i; const float sc = g ? g[k0 + k] : 1.0f;
#pragma unroll
        for (int j = 0; j < 4; ++j) tl[(c4 + j) * 66 + k] = (bf16)(pk2(v[i][j] * sc, 0.f) & 0xffffu); }
    LDS_WAIT(); asm volatile("" ::: "memory");
    const int pc = (lane & 7) * 8, nr = lane >> 3;
#pragma unroll
    for (int i = 0; i < 8; ++i) { const int n = nr + 8 * i; const LAS unsigned* sp = (const LAS unsigned*)(tl + n * 66 + pc);
        v4u o; o.x = sp[0]; o.y = sp[1]; o.z = sp[2]; o.w = sp[3];
        *(GAS v4u*)(dst + (size_t)(drow0 + n) * dld + k0 + pc) = o; }
    LDS_WAIT(); asm volatile("" ::: "memory");
}
template <class Src>
__device__ __forceinline__ void transpose_item(const Src& src, int k0, int n0, bf16* dst, int drow0, int dld, LAS float* scr, int lane) {
#pragma unroll 8
    for (int i = 0; i < 32; ++i) { const int kk = 2 * i + (lane >> 5); scr[kk * 33 + (lane & 31)] = src(k0 + kk, n0 + (lane & 31)); }
    LDS_WAIT(); asm volatile("" ::: "memory");
    const int c = lane & 7;
#pragma unroll
    for (int j = 0; j < 4; ++j) { const int n = (lane >> 3) + 8 * j; const LAS float* s = scr + (8 * c) * 33 + n;
        v4u o; o.x = pk2(s[0 * 33], s[1 * 33]); o.y = pk2(s[2 * 33], s[3 * 33]); o.z = pk2(s[4 * 33], s[5 * 33]); o.w = pk2(s[6 * 33], s[7 * 33]);
        *(GAS v4u*)(dst + (size_t)(drow0 + n) * dld + k0 + 8 * c) = o; }
    LDS_WAIT(); asm volatile("" ::: "memory");
}
struct SrcScaled { const float* W; int ld; const float* g;
    __device__ __forceinline__ float operator()(int k, int n) const { const float w = W[(size_t)k * ld + n]; return g ? w * g[k] : w; } };

__device__ __forceinline__ void p0_prologue(Frame& F) {
    const float* x = F.in[0]; const float* g1 = F.in[1]; const float* w_in = F.in[2]; const float* wau = F.in[3];
    const float* gng = F.in[5]; const float* wgb = F.in[6]; const float* pw = F.in[7]; const float* ps = F.in[8]; const float* wpb = F.in[9];
    const float* wout = F.in[10]; const float* g2 = F.in[11]; const float* wrg = F.in[12]; const float* wre = F.in[14];
    const float* weg = F.in[16]; const float* weu = F.in[17]; const float* wed = F.in[18];
    bf16* WIN = WSP(bf16, WS_WIN); bf16* WG = WSP(bf16, WS_WG); bf16* WP = WSP(bf16, WS_WP); bf16* WOUT = WSP(bf16, WS_WOUT); bf16* WR = WSP(bf16, WS_WR);
    bf16* WGU = WSP(bf16, WS_WGU); bf16* WD = WSP(bf16, WS_WD); bf16* HB = WSP(bf16, WS_HB); float* XS = WSP(float, WS_XS);
    {
        LAS float* PWL = (LAS float*)F.lds;
        LAS float* WL = (LAS float*)(F.lds + 65536);
        for (int it = F.bid; it < 64; it += F.G) {
            const int g = it >> 4, nb = it & 15;
            for (int i = F.tid; i < 128 * 128; i += 512) { const int d = i & 127; PWL[i] = pw[(size_t)g * 16384 + i] * ps[g * 128 + d]; }
            for (int i = F.tid; i < 128 * 64; i += 512) { const int d = i >> 6, n = i & 63; WL[i] = wpb[(size_t)(g * 128 + d) * D + nb * 64 + n]; }
            __syncthreads();
            const int n = F.tid & 63, cg = F.tid >> 6;
            float a[16];
#pragma unroll
            for (int ci = 0; ci < 16; ++ci) a[ci] = 0.f;
            for (int d = 0; d < 128; d += 4) {
                const float w0 = WL[(d + 0) * 64 + n], w1 = WL[(d + 1) * 64 + n], w2 = WL[(d + 2) * 64 + n], w3 = WL[(d + 3) * 64 + n];
#pragma unroll
                for (int ci = 0; ci < 16; ++ci) { const f32x4 p = *(const LAS f32x4*)(PWL + (cg * 16 + ci) * 128 + d); a[ci] += p[0] * w0 + p[1] * w1 + p[2] * w2 + p[3] * w3; }
            }
            v4u o0, o1; o0.x = pk2(a[0], a[1]); o0.y = pk2(a[2], a[3]); o0.z = pk2(a[4], a[5]); o0.w = pk2(a[6], a[7]); o1.x = pk2(a[8], a[9]); o1.y = pk2(a[10], a[11]); o1.z = pk2(a[12], a[13]); o1.w = pk2(a[14], a[15]);
            bf16* dp = WP + (size_t)(nb * 64 + n) * PW + g * 128 + cg * 16;
            *(GAS v4u*)dp = o0; *(GAS v4u*)(dp + 8) = o1;
            __syncthreads();
        }
    }
    LAS float* scr = (LAS float*)(F.lds + F.wave * 16384);
    const int gw = F.bid * 8 + F.wave, NGW = F.G * 8;
    constexpr int I_IN1 = 16 * (1536 / 32), I_IN2 = 16 * (2560 / 32), I_Z = 4 * 64, I_WG = 8 * 32, I_WO = 16 * 32, I_WR = 256;
    constexpr int NITEMS = I_IN1 + I_IN2 + I_Z + I_WG + I_WO + I_WR;
    for (int it = gw; it < NITEMS; it += NGW) {
        int r = it;
        if (r < I_IN1) { const int kb = r / 48, nb = r % 48; SrcScaled s{w_in, D_IN, g1}; transpose_item(s, 64 * kb, 32 * nb, WIN, 32 * nb, D, scr, F.lane); continue; } r -= I_IN1;
        if (r < I_IN2) { const int kb = r / 80, nb = r % 80; SrcScaled s{w_in, D_IN, g1}; transpose_item(s, 64 * kb, IN_U + 32 * nb, WIN, PJ_U + 32 * nb, D, scr, F.lane); continue; } r -= I_IN2;
        if (r < I_Z) {
            const int nb = r & 3, kb = r >> 2, n = nb * 64 + F.lane;
            float wa[16];
#pragma unroll
            for (int j = 0; j < 16; ++j) wa[j] = wau[j * GKW + n];
            float o[16];
#pragma unroll
            for (int kk = 0; kk < 16; ++kk) { const int k = kb * 16 + kk; const float* wr_ = w_in + (size_t)k * D_IN + IN_A; float a = 0.f;
#pragma unroll
                for (int j = 0; j < 16; ++j) a += wr_[j] * wa[j];
                o[kk] = a * g1[k]; }
            v4u o0, o1; o0.x = pk2(o[0], o[1]); o0.y = pk2(o[2], o[3]); o0.z = pk2(o[4], o[5]); o0.w = pk2(o[6], o[7]); o1.x = pk2(o[8], o[9]); o1.y = pk2(o[10], o[11]); o1.z = pk2(o[12], o[13]); o1.w = pk2(o[14], o[15]);
            bf16* dp = WIN + (size_t)(PJ_Z + n) * D + kb * 16; *(GAS v4u*)dp = o0; *(GAS v4u*)(dp + 8) = o1; continue; } r -= I_Z;
        if (r < I_WG) { const int kb = r / 32, nb = r % 32; SrcScaled s{wgb, D, gng}; transpose_item(s, 64 * kb, 32 * nb, WG, 32 * nb, GVW, scr, F.lane); continue; } r -= I_WG;
        if (r < I_WO) { const int kb = r / 32, nb = r % 32; SrcScaled s{wout, D, nullptr}; transpose_item(s, 64 * kb, 32 * nb, WOUT, 32 * nb, D, scr, F.lane); continue; } r -= I_WO;
        if (r < I_WR) {
            const int j = r; bf16* dp = WR + (size_t)j * D;
#pragma unroll
            for (int q = 0; q < 16; ++q) { const int k = q * 64 + F.lane; float v = 0.f;
                if (j < NG) v = wrg[(size_t)k * NG + j] * g2[k]; else if (j < NG + NE) { const int g = (j - NG) >> 3, e = (j - NG) & 7; v = wre[((size_t)g * D + k) * EPG + e] * g2[k]; }
                dp[k] = (bf16)f2bf(v); }
            continue; }
    }
    for (int m = gw; m < T / 2; m += NGW) {
        const GAS f32x4* xa = (const GAS f32x4*)(x + (size_t)m * D) + F.lane; const GAS f32x4* xb = (const GAS f32x4*)(x + (size_t)(m + T / 2) * D) + F.lane;
        f32x4 va[4], vb[4]; float sa = 0.f, sb = 0.f;
#pragma unroll
        for (int j = 0; j < 4; ++j) { va[j] = __builtin_nontemporal_load(xa + 64 * j); vb[j] = __builtin_nontemporal_load(xb + 64 * j); }
#pragma unroll
        for (int j = 0; j < 4; ++j) { sa += (va[j].x * va[j].x + va[j].y * va[j].y) + (va[j].z * va[j].z + va[j].w * va[j].w); sb += (vb[j].x * vb[j].x + vb[j].y * vb[j].y) + (vb[j].z * vb[j].z + vb[j].w * vb[j].w); }
        const float qa = sqrtf(wave_sum(sa) * (1.f / D) + EPS), qb = sqrtf(wave_sum(sb) * (1.f / D) + EPS); const float ra = 1.0f / qa, rb = 1.0f / qb;
        if (F.lane == 0) { XS[m] = qa; XS[m + T / 2] = qb; }
        GAS v2u* oa = (GAS v2u*)(HB + (size_t)m * D) + F.lane; GAS v2u* ob = (GAS v2u*)(HB + (size_t)(m + T / 2) * D) + F.lane;
#pragma unroll
        for (int j = 0; j < 4; ++j) { v2u w; w.x = pk2(va[j].x * ra, va[j].y * ra); w.y = pk2(va[j].z * ra, va[j].w * ra); oa[64 * j] = w; w.x = pk2(vb[j].x * rb, vb[j].y * rb); w.y = pk2(vb[j].z * rb, vb[j].w * rb); ob[64 * j] = w; }
    }
}

__device__ __forceinline__ void moe_weight_items(Frame& F, const int widx, const int nworkers) {
    const float* g2 = F.in[11]; const float* weg = F.in[16]; const float* weu = F.in[17]; const float* wed = F.in[18];
    bf16* WGU = WSP(bf16, WS_WGU); bf16* WD = WSP(bf16, WS_WD);
    LAS bf16* tl = (LAS bf16*)(F.lds + F.wave * 16384);
    const int gw = widx * 8 + F.wave, NGW = nworkers * 8;
    constexpr int I_GU = NE * 2 * 16 * 4, I_WD = NE * 4 * 16;
    for (int it = gw; it < I_GU + I_WD; it += NGW) {
        int r = it;
        if (r < I_GU) {
            const int e = r / 128, q = r % 128, bj = q / 64, kb = (q % 64) / 4, nb = q % 4;
            const int hid0 = 64 * nb, pn = hid0 >> 7, i0 = hid0 & 127;
            transpose_item64((bj ? weu : weg) + (size_t)e * D * DE, DE, g2, 64 * kb, hid0, WGU + (size_t)e * 512 * D, pn * 256 + bj * 128 + i0, D, tl, F.lane); continue; } r -= I_GU;
        { const int e = r / 64, q = r % 64, kb = q / 16, nb = q % 16;
            transpose_item64(wed + (size_t)e * DE * D, D, nullptr, 64 * kb, 64 * nb, WD + (size_t)e * D * DE, 64 * nb, DE, tl, F.lane); }
    }
}

#define WG_SYNC() do { asm volatile("s_waitcnt lgkmcnt(0)" ::: "memory"); __builtin_amdgcn_s_barrier(); asm volatile("" ::: "memory"); } while (0)
constexpr int GL_QD = 0, GL_KD = 9216, GL_KET = 18432, GL_P = 27648, GL_VT = 36864, GL_DEC = 55296, GL_SS = 55552, GL_OT = 57600;
constexpr int GLS = 72, OTS = 132;
__device__ __forceinline__ void gla_unit(Frame& F, const int b, const int h, const int seg) {
    const bf16* PJ = WSP(bf16, WS_PJ); const float* BC = WSP(float, WS_BC); bf16* ON = WSP(bf16, WS_ON);
    int tid_ = threadIdx.x; asm volatile("" : "+v"(tid_));
    const int tid = tid_, lane = tid & 63, w = __builtin_amdgcn_readfirstlane(tid >> 6), fr = lane & 15, fq = lane >> 4;
    LAS bf16* QD = (LAS bf16*)(F.lds + GL_QD); LAS bf16* KD = (LAS bf16*)(F.lds + GL_KD); LAS bf16* KET = (LAS bf16*)(F.lds + GL_KET);
    LAS bf16* P = (LAS bf16*)(F.lds + GL_P); LAS bf16* VT = (LAS bf16*)(F.lds + GL_VT);
    LAS float* DEC = (LAS float*)(F.lds + GL_DEC); LAS float* OT = (LAS float*)(F.lds + GL_OT);
    f32x4 Sacc[4];
#pragma unroll
    for (int i = 0; i < 4; ++i) Sacc[i] = (f32x4){0.f, 0.f, 0.f, 0.f};
    const size_t rowbase = (size_t)b * SEQ + (size_t)seg * SEGCH * GCH;
    float* CUMB = WSP(float, WS_CUMB) + ((size_t)(b * GH + h) * (SEQ / GCH) + seg * SEGCH) * GDK; float cumb[8];
#pragma unroll
    for (int j = 0; j < 8; ++j) cumb[j] = 0.f;
    const int vsl = lane & 31, vbk = 2 * w + (lane >> 5);
    const int ot = tid >> 3, ov = (tid & 7) * 16;
    v4u qq, kq, vq0, vq1, rq0, rq1; f32x4 bq0, bq1; v4u qq2, kq2, vq02, vq12, rq02, rq12; f32x4 bq02, bq12;
#define GLA_LOADS(tb_, Q, K_, V0, V1, R0, R1, B0, B1) do { const size_t tb__ = (tb_); \
        const bf16* rp = PJ + (tb__ + lane) * NPJ + h * 64 + w * 8; Q = *(const v4u*)(rp + PJ_Q); K_ = *(const v4u*)(rp + PJ_K); \
        const float* bp = BC + (tb__ + lane) * GKW + h * 64 + w * 8; B0 = *(const f32x4*)bp; B1 = *(const f32x4*)(bp + 4); \
        const bf16* vp = PJ + (tb__ + vsl) * NPJ + PJ_V + h * 128 + vbk * 8; V0 = *(const v4u*)vp; V1 = *(const v4u*)(vp + (size_t)32 * NPJ); \
        const bf16* rr = PJ + (tb__ + ot) * NPJ + PJ_R + h * 128 + ov; R0 = *(const v4u*)rr; R1 = *(const v4u*)(rr + 8); } while (0)
    GLA_LOADS(rowbase, qq, kq, vq0, vq1, rq0, rq1, bq0, bq1);
    GLA_LOADS(rowbase + GCH, qq2, kq2, vq02, vq12, rq02, rq12, bq02, bq12);
    for (int n = 0; n < SEGCH; ++n) {
        const size_t tb = rowbase + (size_t)n * GCH;
        const v4u q8 = qq, k8 = kq, v80 = vq0, v81 = vq1, r80 = rq0, r81 = rq1; const f32x4 b80 = bq0, b81 = bq1;
        qq = qq2; kq = kq2; vq0 = vq02; vq1 = vq12; rq0 = rq02; rq1 = rq12; bq0 = bq02; bq1 = bq12;
        { const size_t tn = (n + 2 < SEGCH) ? tb + 2 * GCH : tb; GLA_LOADS(tn, qq2, kq2, vq02, vq12, rq02, rq12, bq02, bq12); }
        { float bx[8] = {b80[0], b80[1], b80[2], b80[3], b81[0], b81[1], b81[2], b81[3]}, qf[8], kf[8];
          { f32x4 a, c; unpack8(q8, a, c); qf[0] = a[0]; qf[1] = a[1]; qf[2] = a[2]; qf[3] = a[3]; qf[4] = c[0]; qf[5] = c[1]; qf[6] = c[2]; qf[7] = c[3];
            unpack8(k8, a, c); kf[0] = a[0]; kf[1] = a[1]; kf[2] = a[2]; kf[3] = a[3]; kf[4] = c[0]; kf[5] = c[1]; kf[6] = c[2]; kf[7] = c[3]; }
          float qd[8], kd[8], ke[8], dc[8];
          if (lane == 0) { *(f32x4*)(CUMB + (size_t)n * GDK + w * 8) = (f32x4){cumb[0], cumb[1], cumb[2], cumb[3]}; *(f32x4*)(CUMB + (size_t)n * GDK + w * 8 + 4) = (f32x4){cumb[4], cumb[5], cumb[6], cumb[7]}; }
#pragma unroll
          for (int j = 0; j < 8; ++j) { const float blast = __builtin_bit_cast(float, __builtin_amdgcn_readlane(__builtin_bit_cast(int, bx[j]), 63));
              cumb[j] += blast;
              const float eb = __expf(bx[j]), enb = __builtin_amdgcn_rcpf(eb); dc[j] = __expf(blast);
              qd[j] = qf[j] * eb * 0.125f; kd[j] = kf[j] * enb; ke[j] = kd[j] * dc[j]; }
          v4u o; o.x = pk2(qd[0], qd[1]); o.y = pk2(qd[2], qd[3]); o.z = pk2(qd[4], qd[5]); o.w = pk2(qd[6], qd[7]); *(LAS v4u*)(QD + lane * GLS + w * 8) = o;
          o.x = pk2(kd[0], kd[1]); o.y = pk2(kd[2], kd[3]); o.z = pk2(kd[4], kd[5]); o.w = pk2(kd[6], kd[7]); *(LAS v4u*)(KD + lane * GLS + w * 8) = o;
#pragma unroll
          for (int j = 0; j < 8; ++j) KET[(w * 8 + j) * GLS + lane] = (bf16)(pk2(ke[j], ke[j]) & 0xffffu);
          if (lane == 0) { *(LAS f32x4*)(DEC + w * 8) = (f32x4){dc[0], dc[1], dc[2], dc[3]}; *(LAS f32x4*)(DEC + w * 8 + 4) = (f32x4){dc[4], dc[5], dc[6], dc[7]}; }
          const unsigned vw0[4] = {v80.x, v80.y, v80.z, v80.w}, vw1[4] = {v81.x, v81.y, v81.z, v81.w};
#pragma unroll
          for (int j = 0; j < 4; ++j) { VT[(vbk * 8 + 2 * j) * GLS + vsl] = (bf16)(vw0[j] & 0xffffu); VT[(vbk * 8 + 2 * j + 1) * GLS + vsl] = (bf16)(vw0[j] >> 16);
              VT[(vbk * 8 + 2 * j) * GLS + vsl + 32] = (bf16)(vw1[j] & 0xffffu); VT[(vbk * 8 + 2 * j + 1) * GLS + vsl + 32] = (bf16)(vw1[j] >> 16); } }
        WG_SYNC();
        { const int tt = w >> 1, st0 = (w & 1) * 2;
          bf16x8 af[2];
#pragma unroll
          for (int ks = 0; ks < 2; ++ks) af[ks] = *(const LAS bf16x8*)(QD + (16 * tt + fr) * GLS + 32 * ks + 8 * fq);
#pragma unroll
          for (int q2 = 0; q2 < 2; ++q2) { const int st = st0 + q2; f32x4 c = (f32x4){0.f, 0.f, 0.f, 0.f};
              if (st <= tt) {
#pragma unroll
                  for (int ks = 0; ks < 2; ++ks) { const bf16x8 bfm = *(const LAS bf16x8*)(KD + (16 * st + fr) * GLS + 32 * ks + 8 * fq); c = __builtin_amdgcn_mfma_f32_16x16x32_bf16(af[ks], bfm, c, 0, 0, 0); } }
#pragma unroll
              for (int i = 0; i < 4; ++i) { const int t = 16 * tt + 4 * fq + i, sidx = 16 * st + fr; const float val = (sidx <= t) ? c[i] : 0.f; P[t * GLS + sidx] = (bf16)(pk2(val, val) & 0xffffu); } } }
        WG_SYNC();
        { bf16x8 vtf[2], sb[2];
#pragma unroll
          for (int ks = 0; ks < 2; ++ks) { vtf[ks] = *(const LAS bf16x8*)(VT + (16 * w + fr) * GLS + 32 * ks + 8 * fq);
              v4u pw_; pw_.x = pk2(Sacc[2 * ks][0], Sacc[2 * ks][1]); pw_.y = pk2(Sacc[2 * ks][2], Sacc[2 * ks][3]); pw_.z = pk2(Sacc[2 * ks + 1][0], Sacc[2 * ks + 1][1]); pw_.w = pk2(Sacc[2 * ks + 1][2], Sacc[2 * ks + 1][3]);
              sb[ks] = __builtin_bit_cast(bf16x8, pw_); }
          f32x4 o[4];
#pragma unroll
          for (int mt = 0; mt < 4; ++mt) { o[mt] = (f32x4){0.f, 0.f, 0.f, 0.f};
#pragma unroll
              for (int ks = 0; ks < 2; ++ks) { const bf16x8 a = *(const LAS bf16x8*)(P + (16 * mt + fr) * GLS + 32 * ks + 8 * fq); o[mt] = __builtin_amdgcn_mfma_f32_16x16x32_bf16(a, vtf[ks], o[mt], 0, 0, 0); }
#pragma unroll
              for (int ks = 0; ks < 2; ++ks) { const v2u lo = *(const LAS v2u*)(QD + (16 * mt + fr) * GLS + 32 * ks + 4 * fq), hi = *(const LAS v2u*)(QD + (16 * mt + fr) * GLS + 32 * ks + 16 + 4 * fq);
                  v4u aw; aw.x = lo.x; aw.y = lo.y; aw.z = hi.x; aw.w = hi.y; o[mt] = __builtin_amdgcn_mfma_f32_16x16x32_bf16(__builtin_bit_cast(bf16x8, aw), sb[ks], o[mt], 0, 0, 0); } }
#pragma unroll
          for (int mt = 0; mt < 4; ++mt) { const f32x4 d4 = *(const LAS f32x4*)(DEC + 16 * mt + 4 * fq); Sacc[mt] = Sacc[mt] * d4;
#pragma unroll
              for (int ks = 0; ks < 2; ++ks) { const bf16x8 a = *(const LAS bf16x8*)(KET + (16 * mt + fr) * GLS + 32 * ks + 8 * fq); Sacc[mt] = __builtin_amdgcn_mfma_f32_16x16x32_bf16(a, vtf[ks], Sacc[mt], 0, 0, 0); } }
#pragma unroll
          for (int mt = 0; mt < 4; ++mt)
#pragma unroll
              for (int i = 0; i < 4; ++i) OT[(16 * mt + 4 * fq + i) * OTS + 16 * w + fr] = o[mt][i]; }
        WG_SYNC();
        { f32x4 ov4[4]; float tot2 = 0.f;
#pragma unroll
          for (int q = 0; q < 4; ++q) { ov4[q] = *(const LAS f32x4*)(OT + ot * OTS + ov + 4 * q); tot2 += (ov4[q][0] * ov4[q][0] + ov4[q][1] * ov4[q][1]) + (ov4[q][2] * ov4[q][2] + ov4[q][3] * ov4[q][3]); }
          tot2 += dpp_f<0xB1>(tot2); tot2 += dpp_f<0x4E>(tot2); tot2 += dpp_f<0x141>(tot2);
          const float rstd = (seg == 0) ? __builtin_amdgcn_rsqf(tot2 * (1.0f / GDV) + EPS) : 1.0f;
          f32x4 r0, r1, r2, r3; unpack8(r80, r0, r1); unpack8(r81, r2, r3);
          if (seg != 0) { r0 = (f32x4){1.f, 1.f, 1.f, 1.f}; r1 = r0; r2 = r0; r3 = r0; }
          bf16* op = ON + (tb + ot) * GVW + h * 128 + ov;
          *(v4u*)op = pack8(ov4[0] * rstd * r0, ov4[1] * rstd * r1); *(v4u*)(op + 8) = pack8(ov4[2] * rstd * r2, ov4[3] * rstd * r3); }
    }
#undef GLA_LOADS
    if (seg + 1 < NSEG) {
        float* SL = WSP(float, WS_SLOC) + ((size_t)(b * GH + h) * NSEG + seg) * GDK * GDV;
#pragma unroll
        for (int mt = 0; mt < 4; ++mt)
#pragma unroll
            for (int i = 0; i < 4; ++i) SL[(16 * mt + 4 * fq + i) * GDV + 16 * w + fr] = Sacc[mt][i];
        if (lane == 0) { float* DT = WSP(float, WS_DTOT) + ((size_t)(b * GH + h) * NSEG + seg) * GDK + w * 8;
#pragma unroll
            for (int j = 0; j < 8; ++j) DT[j] = __expf(cumb[j]); }
    }
    WG_SYNC();
}
constexpr int FX_QD = 0, FX_SB = 9216, FX_OT = 27648;
__device__ __forceinline__ void gla_fix_unit(Frame& F, const int b, const int h, const int seg) {
    const bf16* PJ = WSP(bf16, WS_PJ); const float* BC = WSP(float, WS_BC); bf16* ON = WSP(bf16, WS_ON);
    int tid_ = threadIdx.x; asm volatile("" : "+v"(tid_));
    const int tid = tid_, lane = tid & 63, w = __builtin_amdgcn_readfirstlane(tid >> 6), fr = lane & 15, fq = lane >> 4;
    LAS bf16* QD2 = (LAS bf16*)(F.lds + FX_QD); LAS bf16* SB = (LAS bf16*)(F.lds + FX_SB); LAS float* OT = (LAS float*)(F.lds + FX_OT);
    { const float* SL = WSP(float, WS_SLOC) + (size_t)(b * GH + h) * NSEG * GDK * GDV; const float* DT = WSP(float, WS_DTOT) + (size_t)(b * GH + h) * NSEG * GDK;
#pragma unroll
      for (int j = 0; j < 8; ++j) { const int d = 8 * w + j; float s0 = 0.f, s1 = 0.f;
          for (int i = 0; i < seg; ++i) { const float dt = DT[i * GDK + d]; s0 = dt * s0 + SL[((size_t)i * GDK + d) * GDV + lane]; s1 = dt * s1 + SL[((size_t)i * GDK + d) * GDV + lane + 64]; }
          SB[lane * GLS + d] = (bf16)(pk2(s0, s0) & 0xffffu); SB[(lane + 64) * GLS + d] = (bf16)(pk2(s1, s1) & 0xffffu); } }
    const size_t rowbase = (size_t)b * SEQ + (size_t)seg * SEGCH * GCH;
    const float* CUMB = WSP(float, WS_CUMB) + ((size_t)(b * GH + h) * (SEQ / GCH) + seg * SEGCH) * GDK;
    const int ot = tid >> 3, ov = (tid & 7) * 16, dq = (tid & 7) * 8;
    v4u qq, oq0, oq1, rq0, rq1; f32x4 bq0, bq1, cq0, cq1;
#define FIX_LOADS(n_) do { const size_t tb__ = rowbase + (size_t)(n_) * GCH;         qq = *(const v4u*)(PJ + (tb__ + ot) * NPJ + PJ_Q + h * 64 + dq); const float* bp = BC + (tb__ + ot) * GKW + h * 64 + dq; bq0 = *(const f32x4*)bp; bq1 = *(const f32x4*)(bp + 4);         const float* cp = CUMB + (size_t)(n_) * GDK + dq; cq0 = *(const f32x4*)cp; cq1 = *(const f32x4*)(cp + 4);         const bf16* op_ = ON + (tb__ + ot) * GVW + h * 128 + ov; oq0 = *(const v4u*)op_; oq1 = *(const v4u*)(op_ + 8);         const bf16* rr = PJ + (tb__ + ot) * NPJ + PJ_R + h * 128 + ov; rq0 = *(const v4u*)rr; rq1 = *(const v4u*)(rr + 8); } while (0)
    FIX_LOADS(0);
    for (int n = 0; n < SEGCH; ++n) {
        const size_t tb = rowbase + (size_t)n * GCH;
        const v4u q8 = qq, o80 = oq0, o81 = oq1, r80 = rq0, r81 = rq1; const f32x4 b80 = bq0, b81 = bq1, c80 = cq0, c81 = cq1;
        if (n + 1 < SEGCH) FIX_LOADS(n + 1);
        { f32x4 qa, qb; unpack8(q8, qa, qb); f32x4 e0, e1;
#pragma unroll
          for (int j = 0; j < 4; ++j) { e0[j] = qa[j] * 0.125f * __expf(b80[j] + c80[j]); e1[j] = qb[j] * 0.125f * __expf(b81[j] + c81[j]); }
          *(LAS v4u*)(QD2 + ot * GLS + dq) = pack8(e0, e1); }
        WG_SYNC();
        { bf16x8 bfm[2];
#pragma unroll
          for (int ks = 0; ks < 2; ++ks) bfm[ks] = *(const LAS bf16x8*)(SB + (16 * w + fr) * GLS + 32 * ks + 8 * fq);
#pragma unroll
          for (int mt = 0; mt < 4; ++mt) { f32x4 c = (f32x4){0.f, 0.f, 0.f, 0.f};
#pragma unroll
              for (int ks = 0; ks < 2; ++ks) { const bf16x8 a = *(const LAS bf16x8*)(QD2 + (16 * mt + fr) * GLS + 32 * ks + 8 * fq); c = __builtin_amdgcn_mfma_f32_16x16x32_bf16(a, bfm[ks], c, 0, 0, 0); }
#pragma unroll
              for (int i = 0; i < 4; ++i) OT[(16 * mt + 4 * fq + i) * OTS + 16 * w + fr] = c[i]; } }
        WG_SYNC();
        { f32x4 t4[4], l0, l1, l2, l3; unpack8(o80, l0, l1); unpack8(o81, l2, l3);
          t4[0] = *(const LAS f32x4*)(OT + ot * OTS + ov) + l0; t4[1] = *(const LAS f32x4*)(OT + ot * OTS + ov + 4) + l1; t4[2] = *(const LAS f32x4*)(OT + ot * OTS + ov + 8) + l2; t4[3] = *(const LAS f32x4*)(OT + ot * OTS + ov + 12) + l3;
          float sq = 0.f;
#pragma unroll
          for (int q = 0; q < 4; ++q) sq += (t4[q][0] * t4[q][0] + t4[q][1] * t4[q][1]) + (t4[q][2] * t4[q][2] + t4[q][3] * t4[q][3]);
          sq += dpp_f<0xB1>(sq); sq += dpp_f<0x4E>(sq); sq += dpp_f<0x141>(sq);
          const float rstd = __builtin_amdgcn_rsqf(sq * (1.0f / GDV) + EPS);
          f32x4 r0, r1, r2, r3; unpack8(r80, r0, r1); unpack8(r81, r2, r3);
          bf16* op = ON + (tb + ot) * GVW + h * 128 + ov;
          *(v4u*)op = pack8(t4[0] * rstd * r0, t4[1] * rstd * r1); *(v4u*)(op + 8) = pack8(t4[2] * rstd * r2, t4[3] * rstd * r3); }
    }
#undef FIX_LOADS
    WG_SYNC();
}
__device__ __forceinline__ void pool_items(Frame& F, const int widx, const int nworkers) {
    const bf16* PJ = WSP(bf16, WS_PJ); bf16* PD = WSP(bf16, WS_PD);
    const int gw = widx * 8 + F.wave, NGW = nworkers * 8, cb = F.lane, wlen = 2 << (cb >> 4);
    constexpr int RUN = 32;
    for (int u = gw; u < T / RUN; u += NGW) {
        const int t0 = u * RUN, pos0 = t0 & (SEQ - 1);
        const bf16* base = PJ + (size_t)t0 * NPJ + PJ_U + cb * 8;
        f32x4 a0 = (f32x4){0.f, 0.f, 0.f, 0.f}, a1 = a0;
#pragma unroll
        for (int i = 1; i <= 16; ++i) { const bool in = (i <= wlen) && (i <= pos0); const v4u vw = *(const v4u*)(base - (size_t)(in ? i : 0) * NPJ); f32x4 u0, u1; unpack8(vw, u0, u1); const float m = in ? 1.f : 0.f; a0 += u0 * m; a1 += u1 * m; }
#pragma unroll 4
        for (int i = 0; i < RUN; ++i) {
            const int pos = pos0 + i; const bool drop = pos >= wlen;
            const v4u nw = *(const v4u*)(base + (size_t)i * NPJ), ow = *(const v4u*)(base + (size_t)(drop ? i - wlen : i) * NPJ);
            f32x4 n0, n1, o0, o1; unpack8(nw, n0, n1); unpack8(ow, o0, o1); const float m = drop ? 1.f : 0.f;
            a0 += n0 - o0 * m; a1 += n1 - o1 * m;
            const float inv = __builtin_amdgcn_rcpf((float)(pos + 1 < wlen ? pos + 1 : wlen));
            *(v4u*)(PD + (size_t)(t0 + i) * PW + cb * 8) = pack8(a0 * inv - n0, a1 * inv - n1);
        }
    }
}
__device__ __forceinline__ void p2a_phase(Frame& F) {
    constexpr int NU = BATCH * GH * NSEG;
    for (int u = F.bid; u < NU; u += F.G) gla_unit(F, u >> 4, (u >> 2) & 3, u & 3);
}
__device__ __forceinline__ void p2b_phase(Frame& F) {
    constexpr int NU = BATCH * GH * (NSEG - 1);
#pragma unroll 1
    for (int r_ = 0; r_ < REPS(10); ++r_)
    for (int u = F.bid; u < NU; u += F.G) gla_fix_unit(F, u / (GH * (NSEG - 1)), (u / (NSEG - 1)) % GH, 1 + u % (NSEG - 1));
#pragma unroll 1
    for (int r_ = 0; r_ < REPS(11); ++r_) pool_items(F, F.bid, F.G);
#pragma unroll 1
    for (int r_ = 0; r_ < REPS(12); ++r_) moe_weight_items(F, F.bid, F.G);
}

#if DBG
__device__ __forceinline__ void dbg_fail(Frame& F, unsigned code) { unsigned expect = 0u; __hip_atomic_compare_exchange_strong((unsigned*)(F.ctl + CW_DBG), &expect, code, __ATOMIC_RELAXED, __ATOMIC_RELAXED, __HIP_MEMORY_SCOPE_AGENT); }
__device__ __forceinline__ bool dbg_close(float got, float want) { return fabsf(got - want) <= 0.03f + 0.03f * fabsf(want); }
__device__ __forceinline__ void dbg_check_p1(Frame& F) {
    if (F.bid != 0 || F.tid >= 256) return;
    const float* x = F.in[0]; const float* g1 = F.in[1]; const float* w_in = F.in[2]; const float* wau = F.in[3]; const float* ba = F.in[4];
    const bf16* PJ = WSP(bf16, WS_PJ);
    const int tok = (int)(((unsigned)F.tid * 2654435761u) % (unsigned)T);
    const int col = (int)(((unsigned)F.tid * 40503u + 17u * (unsigned)F.tid * (unsigned)F.tid) % (unsigned)NPROJ);
    const float* xr = x + (size_t)tok * D; float ss = 0.f;
    for (int k = 0; k < D; ++k) ss += xr[k] * xr[k];
    const float rstd = 1.0f / sqrtf(ss / D + EPS);
    float want;
    if (col >= PJ_Z && col < PJ_U) {
        return;
        float al[16];
#pragma unroll
        for (int j = 0; j < 16; ++j) al[j] = 0.f;
        for (int k = 0; k < D; ++k) { const float hk = xr[k] * rstd * g1[k];
#pragma unroll
            for (int j = 0; j < 16; ++j) al[j] += hk * w_in[(size_t)k * D_IN + IN_A + j]; }
        float z = 0.f;
#pragma unroll
        for (int j = 0; j < 16; ++j) z += al[j] * wau[j * GKW + (col - PJ_Z)];
        z += ba[col - PJ_Z];
        want = (fminf(z, 0.f) - logf(1.0f + expf(-fabsf(z)))) / 16.0f;
    } else {
        const int wc_ = col < PJ_Z ? col : col - PJ_U + IN_U; float a = 0.f;
        for (int k = 0; k < D; ++k) a += xr[k] * rstd * g1[k] * w_in[(size_t)k * D_IN + wc_];
        if (col >= PJ_R && col < PJ_Z) want = a / (1.0f + expf(-a)); else if (col >= PJ_GG) want = 1.0f / (1.0f + expf(-a)); else want = a;
    }
    const float got = (col >= PJ_GG) ? (float)WSP(unsigned char, WS_GATES)[gate_elem(col >= PJ_GP ? 1 : 0, tok, (col - PJ_GG) & 1023)] * (1.0f / 255.0f) : bf1(PJ[(size_t)tok * NPJ + col]);
    if (!dbg_close(got, want)) dbg_fail(F, 1u);
}


__device__ __forceinline__ void dbg_check_bc(Frame& F) {
    if (F.bid != 5 || F.tid >= 64) return;
    const float* x = F.in[0]; const float* g1 = F.in[1]; const float* w_in = F.in[2]; const float* wau = F.in[3]; const float* ba = F.in[4]; const float* BC = WSP(float, WS_BC);
    const int offs[5] = {0, 1, 5, 18, 63}; const int off = (F.tid % 5 == 0) ? 0 : (F.tid % 5 == 1) ? 1 : (F.tid % 5 == 2) ? 5 : (F.tid % 5 == 3) ? 18 : 63; (void)offs;
    const int chunk = (int)(((unsigned)F.tid * 2654435761u) % (unsigned)(T / 64)), col = (int)(((unsigned)F.tid * 40503u + 3u) % (unsigned)GKW);
    float cum = 0.f;
    for (int r = 0; r <= off; ++r) { const float* xr = x + ((size_t)chunk * 64 + r) * D; float ss = 0.f; for (int k = 0; k < D; ++k) ss += xr[k] * xr[k];
        const float rstd = 1.0f / sqrtf(ss / D + EPS); float al[16];
#pragma unroll
        for (int j = 0; j < 16; ++j) al[j] = 0.f;
        for (int k = 0; k < D; ++k) { const float hk = xr[k] * rstd * g1[k];
#pragma unroll
            for (int j = 0; j < 16; ++j) al[j] += hk * w_in[(size_t)k * D_IN + IN_A + j]; }
        float z = ba[col];
#pragma unroll
        for (int j = 0; j < 16; ++j) z += al[j] * wau[j * GKW + col];
        cum += (fminf(z, 0.f) - logf(1.0f + expf(-fabsf(z)))) / 16.0f; }
    const float got = BC[((size_t)chunk * 64 + off) * GKW + col];
    if (fabsf(got - cum) > 0.004f + 0.01f * fabsf(cum)) dbg_fail(F, 7u);
}
__device__ __forceinline__ void dbg_check_gla(Frame& F) {
    if (F.bid != 1) return;
    const bf16* PJ = WSP(bf16, WS_PJ); const bf16* ON = WSP(bf16, WS_ON);
    const int b = 2, h = 1, v = F.tid & 127; const bool act = F.tid < 128;
    LAS float* S = (LAS float*)F.lds;
    LAS float* red = (LAS float*)(F.lds + 32768);
    if (act) for (int d = 0; d < 64; ++d) S[d * 128 + v] = 0.f;
    __syncthreads();
    bool bad = false;
    for (int t = 0; t < 1100; ++t) {
        const bf16* rp = PJ + ((size_t)b * SEQ + t) * NPJ; float o = 0.f;
        if (act) { const float vv = bf1(rp[PJ_V + h * 128 + v]);
            for (int d = 0; d < 64; ++d) { const float* bcp = WSP(float, WS_BC) + ((size_t)b * SEQ + t) * GKW + h * 64 + d; const float la = (t & 63) ? bcp[0] - bcp[-GKW] : bcp[0]; const float kk = bf1(rp[PJ_K + h * 64 + d]), qq = bf1(rp[PJ_Q + h * 64 + d]);
                const float sn = expf(la) * S[d * 128 + v] + kk * vv; S[d * 128 + v] = sn; o += qq * 0.125f * sn; }
            red[v] = o * o; }
        __syncthreads();
        if (act) { float ss = 0.f; for (int i = 0; i < 128; ++i) ss += red[i];
            const float want = o * (1.0f / sqrtf(ss / 128.f + EPS)) * bf1(rp[PJ_R + h * 128 + v]);
            const float got = bf1(ON[((size_t)b * SEQ + t) * GVW + h * 128 + v]);
            if ((t < 150 || t >= 1000) && !dbg_close(got, want)) bad = true; }
        __syncthreads();
    }
    if (bad) dbg_fail(F, 2u);
}
__device__ __forceinline__ void dbg_check_pool(Frame& F) {
    if (F.bid != 2) return;
    const bf16* PJ = WSP(bf16, WS_PJ); const bf16* PD = WSP(bf16, WS_PD);
    int tok = (int)(((unsigned)F.tid * 2654435761u) % (unsigned)T); if (F.tid < 40) tok = (F.tid & 1) * SEQ * 3 + (F.tid >> 1);
    const int c = (int)(((unsigned)F.tid * 40503u) % (unsigned)PW), pos = tok & (SEQ - 1), wlen = 2 << (c >> 7), cnt = pos + 1 < wlen ? pos + 1 : wlen;
    float a = 0.f; for (int i = 0; i < cnt; ++i) a += bf1(PJ[(size_t)(tok - i) * NPJ + PJ_U + c]);
    const float want = a / cnt - bf1(PJ[(size_t)tok * NPJ + PJ_U + c]);
    if (!dbg_close(bf1(PD[(size_t)tok * PW + c]), want)) dbg_fail(F, 3u);
}
__device__ __forceinline__ void dbg_check_mg(Frame& F) {
    if (F.bid != 3 || F.tid >= 64) return;
    const bf16* PJ = WSP(bf16, WS_PJ); const bf16* ON = WSP(bf16, WS_ON); const bf16* PD = WSP(bf16, WS_PD); const bf16* MG = WSP(bf16, WS_MG);
    const float* gng = F.in[5]; const float* wgb = F.in[6]; const float* pw = F.in[7]; const float* ps = F.in[8]; const float* wpb = F.in[9];
    const int tok = (int)(((unsigned)F.tid * 2654435761u + 12345u) % (unsigned)T), col = (int)(((unsigned)F.tid * 40503u + 77u) % (unsigned)D);
    float yg = 0.f; for (int k = 0; k < GVW; ++k) yg += bf1(ON[(size_t)tok * GVW + k]) * gng[k] * wgb[(size_t)k * D + col];
    float yp = 0.f;
    for (int g = 0; g < 4; ++g) for (int d = 0; d < 128; ++d) { float m = 0.f; for (int c = 0; c < 128; ++c) m += bf1(PD[(size_t)tok * PW + g * 128 + c]) * pw[((size_t)g * 128 + c) * 128 + d];
        yp += m * ps[g * 128 + d] * wpb[(size_t)(g * 128 + d) * D + col]; }
    const float want = (float)WSP(unsigned char, WS_GATES)[gate_elem(0, tok, col)] * (1.0f / 255.0f) * yg + fmaxf((float)WSP(unsigned char, WS_GATES)[gate_elem(1, tok, col)] * (1.0f / 255.0f), 0.5f / 255.0f) * yp;
    if (!dbg_close(bf1(MG[(size_t)tok * D + col]), want)) dbg_fail(F, 4u);
}
__device__ __forceinline__ void dbg_check_x1(Frame& F) {
    if (F.bid != 4 || F.tid >= 128) return;
    const bf16* MG = WSP(bf16, WS_MG); const bf16* X1B = WSP(bf16, WS_X1B); const float* SSQ = WSP(float, WS_SSQ); const float* x = F.in[0]; const float* wout = F.in[10];
    const int tok = (int)(((unsigned)F.tid * 2654435761u + 999u) % (unsigned)T), col = (int)(((unsigned)F.tid * 40503u + 5u) % (unsigned)D);
    float a = x[(size_t)tok * D + col]; for (int k = 0; k < D; ++k) a += bf1(MG[(size_t)tok * D + k]) * wout[(size_t)k * D + col];
    if (!dbg_close(bf1(X1B[(size_t)tok * D + col]), a)) dbg_fail(F, 5u);
    float ss = 0.f; for (int k = 0; k < D; ++k) { const float v = bf1(X1B[(size_t)tok * D + k]); ss += v * v; }
    float sp = 0.f; for (int j = 0; j < 16; ++j) sp += SSQ[(size_t)tok * 16 + j];
    if (fabsf(ss - sp) > 1e-2f * ss) dbg_fail(F, 6u);
}
#endif

struct Args { const float* in[20]; float* out; unsigned char* ws; };
__global__ void __launch_bounds__(512, 2) fwd_kernel(Args args) {
    extern __shared__ __attribute__((aligned(16))) unsigned char lds[];
    Frame F;
    F.lds = (LAS unsigned char*)lds;
    F.MISC = (volatile LAS unsigned*)(F.lds + MISC_OFF);
    F.tid = threadIdx.x; F.lane = F.tid & 63; F.wave = __builtin_amdgcn_readfirstlane(F.tid >> 6);
    F.G = gridDim.x; F.bid = blockIdx.x;
    F.ws = args.ws; F.out = args.out; F.ctl = (gu32*)(args.ws + WS_CTL);
#pragma unroll
    for (int i = 0; i < 20; ++i) F.in[i] = args.in[i];
    for (int u = F.tid; u < (LDS_BYTES - RING_BYTES) / 4; u += 512) ((LAS unsigned*)(F.lds + RING_BYTES))[u] = 0u;
    __syncthreads();
    XcdBarrier bar = xcd_barrier_post((unsigned*)(F.ctl + CW_BAR), F.MISC + 8);
#define GRID_BAR() xcd_barrier(bar)

#pragma unroll 1
    for (int rep_ = 0; rep_ < REPS(0); ++rep_) p0_prologue(F);
    GRID_BAR();
    if (NPH > 1) {
        pg8::StaticSched S; S.init(WSP(bf16, WS_HB), D, WSP(bf16, WS_WIN), D, T, NPROJ, F.G, F.bid);
        EpiP1 E{WSP(bf16, WS_PJ), F.in[4], WSP(float, WS_BC), WSP(unsigned char, WS_GATES)};
#pragma unroll 1
        for (int rep_ = 0; rep_ < REPS(1); ++rep_) pg8::gemm_phase<EpiP1, pg8::StaticSched, false, true>(F.lds, D, D, D, S, E);
        GRID_BAR();
#if DBG
        dbg_check_p1(F); dbg_check_bc(F);
        GRID_BAR();
#endif
    }
    if (NPH > 2) {
#pragma unroll 1
        for (int rep_ = 0; rep_ < REPS(2); ++rep_) p2a_phase(F);
        GRID_BAR();
        p2b_phase(F);
        GRID_BAR();
#if DBG
        dbg_check_gla(F); dbg_check_pool(F);
        GRID_BAR();
#endif
    }
    if (NPH > 4) {
        PairSched S; S.S0.init(WSP(bf16, WS_ON), GVW, WSP(bf16, WS_WG), GVW, T, D, F.G, F.bid); S.A1 = (const char*)WSP(bf16, WS_PD); S.B1 = (const char*)WSP(bf16, WS_WP);
        EpiDE E{WSP(bf16, WS_MG), WSP(unsigned char, WS_GATES)};
#pragma unroll 1
        for (int rep_ = 0; rep_ < REPS(3); ++rep_) pg8::gemm_phase<EpiDE, PairSched, false, true>(F.lds, GVW, GVW, GVW, S, E);
        GRID_BAR();
#if DBG
        dbg_check_mg(F);
        GRID_BAR();
#endif
    }
    if (NPH > 5) {
        pg8::StaticSched S; S.init(WSP(bf16, WS_MG), D, WSP(bf16, WS_WOUT), D, T, D, F.G, F.bid);
        EpiF E{WSP(bf16, WS_HB), WSP(float, WS_XS), WSP(bf16, WS_X1B), WSP(float, WS_SSQ)};
#pragma unroll 1
        for (int rep_ = 0; rep_ < REPS(5); ++rep_) pg8::gemm_phase<EpiF, pg8::StaticSched, false, true>(F.lds, D, D, D, S, E);
        GRID_BAR();
#if DBG
        dbg_check_x1(F);
        GRID_BAR();
#endif
    }
    if (NPH > 6) {
        pg8::StaticSched S; S.init(WSP(bf16, WS_X1B), D, WSP(bf16, WS_WR), D, T, 256, F.G, F.bid);
        EpiG E{WSP(float, WS_LG)};
#pragma unroll 1
        for (int rep_ = 0; rep_ < REPS(6); ++rep_) pg8::gemm_phase<EpiG, pg8::StaticSched, false, true>(F.lds, D, D, D, S, E);
        VM_WAIT(); __syncthreads();
        pg8::Unit u; for (int i = 0; S.next(i, u); ++i) route_rows(F, u.r0);
        GRID_BAR();
    }
    if (NPH > 7) {
        moe_tables(F);
        MoeSched S{(const LAS int*)(F.lds + SCHED_OFF + 256), (const LAS int*)(F.lds + SCHED_OFF + 256) + 40, WSP(unsigned, WS_LIST), (const char*)WSP(bf16, WS_X1B), (const char*)WSP(bf16, WS_WGU), 2, F.G, F.bid, 0};
        EpiH E{WSP(bf16, WS_ACT), WSP(float, WS_LISTR)};
#pragma unroll 1
        for (int rep_ = 0; rep_ < REPS(7); ++rep_) pg8::gemm_phase<EpiH, MoeSched, true, true>(F.lds, D, D, D, S, E);
        GRID_BAR();
    }
    if (NPH > 8) {
        MoeSched S{(const LAS int*)(F.lds + SCHED_OFF + 256), (const LAS int*)(F.lds + SCHED_OFF + 256) + 40, WSP(unsigned, WS_LIST), (const char*)WSP(bf16, WS_ACT), (const char*)WSP(bf16, WS_WD), 4, F.G, F.bid, 1};
        EpiI E{WSP(unsigned char, WS_Y), WSP(unsigned, WS_LIST), WSP(float, WS_LISTW)};
#pragma unroll 1
        for (int rep_ = 0; rep_ < REPS(8); ++rep_) pg8::gemm_phase<EpiI, MoeSched, false, true>(F.lds, DE, DE, DE, S, E);
        GRID_BAR();
    }
    if (NPH > 9) {
        const float* gf = F.in[19]; const bf16* X1B = WSP(bf16, WS_X1B); const unsigned char* Y = WSP(unsigned char, WS_Y);
        const int gw = F.bid * 8 + F.wave, NGW = F.G * 8;
        unsigned code = 0;
#if DBG
        code = __hip_atomic_load((unsigned*)(F.ctl + CW_DBG), RLX_AGENT);
        if (__hip_atomic_load((unsigned*)(F.ctl + CW_BAR) + XB_TMO, RLX_AGENT) != 0u) code = 9;
#endif
#pragma unroll 1
        for (int rep_ = 0; rep_ < REPS(9); ++rep_)
        for (int m = gw; m < T; m += NGW) {
            const GAS v2u* xr = (const GAS v2u*)(X1B + (size_t)m * D) + F.lane;
            const GAS unsigned* y0 = (const GAS unsigned*)(Y + (size_t)(2 * m) * D) + F.lane; const GAS unsigned* y1 = (const GAS unsigned*)(Y + (size_t)(2 * m + 1) * D) + F.lane;
            f32x4 v[4]; float s_ = 0.f;
#pragma unroll
            for (int j = 0; j < 4; ++j) { const unsigned a = y0[64 * j], b = y1[64 * j]; const v2u c = xr[64 * j]; v[j] = (f32x4){bflo(c.x), bfhi(c.x), bflo(c.y), bfhi(c.y)} + (unpk4_fp8(a) + unpk4_fp8(b)) * (1.0f / YSCALE);
                s_ += (v[j].x * v[j].x + v[j].y * v[j].y) + (v[j].z * v[j].z + v[j].w * v[j].w); }
            const float rstd = 1.0f / sqrtf(wave_sum(s_) * (1.f / D) + EPS);
            GAS f32x4* o = (GAS f32x4*)(F.out + (size_t)m * D) + F.lane;
#pragma unroll
            for (int j = 0; j < 4; ++j) { const f32x4 g = *((const GAS f32x4*)gf + F.lane + 64 * j); f32x4 r = v[j] * rstd * g; if (code) r = (f32x4){10.f * code, 10.f * code, 10.f * code, 10.f * code}; o[64 * j] = r; }
        }
    } else
    {
        const float* gf = F.in[19]; const float* x = F.in[0];
        const int gw = F.bid * 8 + F.wave, NGW = F.G * 8;
        unsigned code = 0;
#if DBG
        code = __hip_atomic_load((unsigned*)(F.ctl + CW_DBG), RLX_AGENT);
        if (__hip_atomic_load((unsigned*)(F.ctl + CW_BAR) + XB_TMO, RLX_AGENT) != 0u) code = 9;
#endif
        for (int m = gw; m < T; m += NGW) {
            const GAS f32x4* xr = (const GAS f32x4*)(x + (size_t)m * D) + F.lane;
            f32x4 v[4]; float s = 0.f;
#pragma unroll
            for (int j = 0; j < 4; ++j) { v[j] = xr[64 * j]; s += (v[j].x * v[j].x + v[j].y * v[j].y) + (v[j].z * v[j].z + v[j].w * v[j].w); }
            const float rstd = 1.0f / sqrtf(wave_sum(s) * (1.f / D) + EPS);
            GAS f32x4* o = (GAS f32x4*)(F.out + (size_t)m * D) + F.lane;
#pragma unroll
            for (int j = 0; j < 4; ++j) { const f32x4 g = *((const GAS f32x4*)gf + F.lane + 64 * j); f32x4 r = v[j] * rstd * g; if (code) r = (f32x4){10.f * code, 10.f * code, 10.f * code, 10.f * code}; o[64 * j] = r; }
        }
    }
}

extern "C" void kernel_launch(void* const* d_in, const int* in_sizes, int n_in, void* d_out, int out_size, void* d_ws, size_t ws_size, hipStream_t stream) {
    static int grid = 0;
    if (grid == 0) {
        if (n_in != 20 || in_sizes[0] != T * D || out_size != T * D || ws_size < WS_END) { fprintf(stderr, "kernel_launch: unexpected shapes (n_in %d, in0 %d, out %d, ws %zu)\n", n_in, n_in > 0 ? in_sizes[0] : -1, out_size, ws_size); grid = -1; return; }
        int dev = 0, cus = 0, per_cu = 0;
        if (hipGetDevice(&dev) != hipSuccess || hipDeviceGetAttribute(&cus, hipDeviceAttributeMultiprocessorCount, dev) != hipSuccess) { grid = -1; return; }
        if (hipFuncSetAttribute((const void*)fwd_kernel, hipFuncAttributeMaxDynamicSharedMemorySize, LDS_BYTES) != hipSuccess) { fprintf(stderr, "kernel_launch: hipFuncSetAttribute failed\n"); grid = -1; return; }
        if (hipOccupancyMaxActiveBlocksPerMultiprocessor(&per_cu, (const void*)fwd_kernel, 512, LDS_BYTES) != hipSuccess || per_cu < 1) fprintf(stderr, "kernel_launch: occupancy query says %d\n", per_cu);
        (void)hipGetLastError();
        grid = cus;
    }
    if (grid < 0) return;
    if (hipMemsetAsync((char*)d_ws + WS_CTL, 0, CTL_ZERO_BYTES, stream) != hipSuccess) return;
    Args a{};
    for (int i = 0; i < 20; ++i) a.in[i] = (const float*)d_in[i];
    a.out = (float*)d_out; a.ws = (unsigned char*)d_ws;
    hipLaunchKernelGGL(fwd_kernel, dim3(grid), dim3(512), LDS_BYTES, stream, a);
}
```
